# Optimizing an MI355X kernel written in HIP

```python
import math
import jax, jax.numpy as jnp
from jax import lax
import numpy as np

D_MODEL = 2048
BATCH = 4
SEQ = 2048
DEPTH = 2

HEAD_DIM = 128
SB_HEADS = 8
SB_WIDTH = SB_HEADS * HEAD_DIM
MLA_HEADS = 8
MLA_Q_LORA = 512
MLA_KV_LORA = 256
MLA_NOPE = 128
MLA_ROPE = 64
MLA_V = 128
MLA_WIDTH = MLA_HEADS * MLA_V
EVEN_IN_WIDTH = 3 * SB_WIDTH + MLA_Q_LORA + MLA_KV_LORA + MLA_ROPE
EVEN_OUT_WIDTH = SB_WIDTH + MLA_WIDTH
RET_HEADS = 8
RET_QK = 256
RET_V = 512
RET_QK_WIDTH = RET_HEADS * RET_QK
RET_V_WIDTH = RET_HEADS * RET_V
ODD_IN_WIDTH = 2 * RET_QK_WIDTH + 2 * RET_V_WIDTH
N_GROUPS = 4
EXPERTS_PER_GROUP = 8
N_EXPERTS = N_GROUPS * EXPERTS_PER_GROUP
TOP_K_IN_GROUP = 2
EXPERT_HIDDEN = 512
BLOCK = 128
CHUNK = 128
ROPE_BASE = 10000.0
EPS = 1e-6

kernel_name = "hybrid_sbattn_mla_retnet_hmoe_adaln"


def rms_norm(x, g):
    xf = x.astype(jnp.float32)
    y = xf * lax.rsqrt(jnp.mean(xf * xf, axis=-1, keepdims=True) + EPS)
    return (y * g.astype(jnp.float32)).astype(x.dtype)


def rope(x, positions):
    d = x.shape[-1]
    half = d // 2
    inv_freq = jnp.exp(-math.log(ROPE_BASE) * jnp.arange(half, dtype=jnp.float32) / half)
    ang = positions.astype(jnp.float32)[..., None] * inv_freq
    ang = ang.reshape(ang.shape[:2] + (1,) * (x.ndim - 3) + (half,))
    cos, sin = jnp.cos(ang), jnp.sin(ang)
    xf = x.astype(jnp.float32)
    x1, x2 = xf[..., :half], xf[..., half:]
    return jnp.concatenate([x1 * cos - x2 * sin, x1 * sin + x2 * cos], axis=-1).astype(x.dtype)


def to_blocks(t, blk):
    B, S, H, d = t.shape
    return t.reshape(B, S // blk, blk, H, d).transpose(1, 0, 3, 2, 4)


def from_blocks(o):
    NB, B, H, blk, d = o.shape
    return o.transpose(1, 0, 3, 2, 4).reshape(B, NB * blk, H * d)


def adaln(cond, w_mod, b_mod):
    mod = (cond @ w_mod + b_mod)[:, None, :]
    shift, scale, gate = jnp.split(mod, 3, axis=-1)
    return shift, scale, gate


def stick_breaking_attention(q, k, v):
    B, S, H, dh = q.shape
    kh = k.transpose(0, 2, 1, 3)
    vh = v.transpose(0, 2, 1, 3)
    kpos = jnp.arange(S)
    inv_sqrt = dh ** -0.5

    def block(args):
        qb, start = args
        z = jnp.einsum("bhqd,bhkd->bhqk", qb, kh).astype(jnp.float32) * inv_sqrt
        qpos = start + jnp.arange(BLOCK)
        strict = kpos[None, :] < qpos[:, None]
        log_keep = jnp.where(strict, jax.nn.log_sigmoid(-z), 0.0)
        after = lax.cumsum(log_keep, axis=3, reverse=True) - log_keep
        a = jnp.where(strict, jnp.exp(jax.nn.log_sigmoid(z) + after), 0.0)
        return jnp.einsum("bhqk,bhkd->bhqd", a.astype(vh.dtype), vh)

    starts = jnp.arange(S // BLOCK, dtype=jnp.int32) * BLOCK
    o = lax.map(block, (to_blocks(q, BLOCK), starts))
    return from_blocks(o)


def mla_attention(q_nope, q_rope, k_nope, k_rope, v):
    B, S, H, _ = q_nope.shape
    kn = k_nope.transpose(0, 2, 1, 3)
    vh = v.transpose(0, 2, 1, 3)
    kpos = jnp.arange(S)
    scale = (MLA_NOPE + MLA_ROPE) ** -0.5

    def block(args):
        qn, qr, start = args
        z = (jnp.einsum("bhqd,bhkd->bhqk", qn, kn)
             + jnp.einsum("bhqr,bkr->bhqk", qr, k_rope)).astype(jnp.float32) * scale
        qpos = start + jnp.arange(BLOCK)
        causal = kpos[None, :] <= qpos[:, None]
        p = jax.nn.softmax(jnp.where(causal, z, -jnp.inf), axis=-1)
        return jnp.einsum("bhqk,bhkd->bhqd", p.astype(vh.dtype), vh)

    starts = jnp.arange(S // BLOCK, dtype=jnp.int32) * BLOCK
    o = lax.map(block, (to_blocks(q_nope, BLOCK), to_blocks(q_rope, BLOCK), starts))
    return from_blocks(o)


def hybrid_attention(h, positions, w_in, q_norm, w_q_up, kv_norm, w_kv_up, w_out):
    B, S, _ = h.shape
    proj = h @ w_in
    cuts = [SB_WIDTH, 2 * SB_WIDTH, 3 * SB_WIDTH,
            3 * SB_WIDTH + MLA_Q_LORA, 3 * SB_WIDTH + MLA_Q_LORA + MLA_KV_LORA]
    sb_q, sb_k, sb_v, c_q, c_kv, k_rope = jnp.split(proj, cuts, axis=-1)
    o_sb = stick_breaking_attention(sb_q.reshape(B, S, SB_HEADS, HEAD_DIM),
                                    sb_k.reshape(B, S, SB_HEADS, HEAD_DIM),
                                    sb_v.reshape(B, S, SB_HEADS, HEAD_DIM))
    q = (rms_norm(c_q, q_norm) @ w_q_up).reshape(B, S, MLA_HEADS, MLA_NOPE + MLA_ROPE)
    q_nope, q_rope = q[..., :MLA_NOPE], rope(q[..., MLA_NOPE:], positions)
    kv = (rms_norm(c_kv, kv_norm) @ w_kv_up).reshape(B, S, MLA_HEADS, MLA_NOPE + MLA_V)
    k_nope, v = kv[..., :MLA_NOPE], kv[..., MLA_NOPE:]
    k_rope = rope(k_rope, positions)
    o_mla = mla_attention(q_nope, q_rope, k_nope, k_rope, v)
    return jnp.concatenate([o_sb, o_mla], axis=-1) @ w_out


def retention(h, positions, w_in, w_out):
    B, S, _ = h.shape
    proj = h @ w_in
    q, k, v, g = jnp.split(proj, [RET_QK_WIDTH, 2 * RET_QK_WIDTH, 2 * RET_QK_WIDTH + RET_V_WIDTH], axis=-1)
    q = rope(q.reshape(B, S, RET_HEADS, RET_QK), positions)
    k = rope(k.reshape(B, S, RET_HEADS, RET_QK), positions) * (RET_QK ** -0.5)
    v = v.reshape(B, S, RET_HEADS, RET_V)

    log_gamma = jnp.log1p(-jnp.exp2(-5.0 - jnp.arange(RET_HEADS, dtype=jnp.float32)))
    idx = jnp.arange(CHUNK, dtype=jnp.float32)
    rel = idx[:, None] - idx[None, :]
    intra = jnp.where(rel >= 0, jnp.exp(jnp.maximum(rel, 0.0) * log_gamma[:, None, None]), 0.0)
    q_decay = jnp.exp((idx + 1.0) * log_gamma[:, None])
    k_decay = jnp.exp((CHUNK - 1.0 - idx) * log_gamma[:, None])
    chunk_decay = jnp.exp(CHUNK * log_gamma)

    def step(state, inputs):
        qc, kc, vc = (t.astype(jnp.float32) for t in inputs)
        scores = jnp.einsum("bhnd,bhmd->bhnm", qc, kc) * intra
        inner = jnp.einsum("bhnm,bhme->bhne", scores, vc)
        cross = jnp.einsum("bhnd,bhde->bhne", qc, state) * q_decay[None, :, :, None]
        new_state = (state * chunk_decay[None, :, None, None]
                     + jnp.einsum("bhmd,bhme->bhde", kc * k_decay[None, :, :, None], vc))
        return new_state, inner + cross

    state0 = jnp.zeros((B, RET_HEADS, RET_QK, RET_V), jnp.float32)
    _, o = lax.scan(step, state0, (to_blocks(q, CHUNK), to_blocks(k, CHUNK), to_blocks(v, CHUNK)))
    o = o.transpose(1, 0, 3, 2, 4).reshape(B, S, RET_HEADS, RET_V)
    o = o * lax.rsqrt(jnp.mean(o * o, axis=-1, keepdims=True) + EPS)
    o = o.reshape(B, S, RET_V_WIDTH)
    return (jax.nn.silu(g.astype(jnp.float32)) * o).astype(h.dtype) @ w_out


def hierarchical_moe(h, w_group, b_group, w_expert, b_expert, w_gate, w_up, w_down):
    B, S, D = h.shape
    ht = h.reshape(B * S, D)
    g_prob = jax.nn.softmax((ht @ w_group + b_group).astype(jnp.float32), axis=-1)
    g_w, g_idx = lax.top_k(g_prob, 1)
    e_logits = (ht @ w_expert + b_expert).astype(jnp.float32).reshape(-1, N_GROUPS, EXPERTS_PER_GROUP)
    sel = jnp.take_along_axis(e_logits, g_idx[:, :, None], axis=1)[:, 0]
    e_w, e_idx = lax.top_k(jax.nn.softmax(sel, axis=-1), TOP_K_IN_GROUP)
    e_w = e_w / jnp.sum(e_w, axis=-1, keepdims=True)
    weights = g_w * e_w
    flat_idx = g_idx * EXPERTS_PER_GROUP + e_idx
    combine = jnp.sum(jax.nn.one_hot(flat_idx, N_EXPERTS, dtype=jnp.float32) * weights[..., None], axis=1)
    combine = combine.astype(ht.dtype)
    out = jnp.zeros_like(ht)
    for e in range(N_EXPERTS):
        a = jax.nn.silu(ht @ w_gate[e]) * (ht @ w_up[e])
        out = out + combine[:, e:e + 1] * (a @ w_down[e])
    return out.reshape(B, S, D)


def setup_inputs(seed: int = 0) -> dict:
    key = jax.random.key(seed)
    ks = jax.random.split(key, 28)
    n_even = (DEPTH + 1) // 2
    n_odd = DEPTH // 2
    D = D_MODEL
    f32 = jnp.float32

    def nrm(k, shape, scale):
        return jax.random.normal(k, shape, f32) * scale

    x = nrm(ks[0], (BATCH, SEQ, D), 1.0)
    c = nrm(ks[1], (BATCH, D), 1.0)
    offsets = jax.random.randint(ks[2], (BATCH, 1), 0, 4096, dtype=jnp.int32)
    positions = offsets + jnp.arange(SEQ, dtype=jnp.int32)[None, :]
    return {
        "x": x,
        "c": c,
        "positions": positions,
        "w_mod_mix": nrm(ks[3], (DEPTH, D, 3 * D), 0.5 * D ** -0.5),
        "b_mod_mix": nrm(ks[4], (DEPTH, 3 * D), 0.02),
        "norm_mix": 1.0 + nrm(ks[5], (DEPTH, D), 0.05),
        "w_mod_ffn": nrm(ks[6], (DEPTH, D, 3 * D), 0.5 * D ** -0.5),
        "b_mod_ffn": nrm(ks[7], (DEPTH, 3 * D), 0.02),
        "norm_ffn": 1.0 + nrm(ks[8], (DEPTH, D), 0.05),
        "ev_w_in": nrm(ks[9], (n_even, D, EVEN_IN_WIDTH), D ** -0.5),
        "ev_q_norm": 1.0 + nrm(ks[10], (n_even, MLA_Q_LORA), 0.05),
        "ev_w_q_up": nrm(ks[11], (n_even, MLA_Q_LORA, MLA_HEADS * (MLA_NOPE + MLA_ROPE)), MLA_Q_LORA ** -0.5),
        "ev_kv_norm": 1.0 + nrm(ks[12], (n_even, MLA_KV_LORA), 0.05),
        "ev_w_kv_up": nrm(ks[13], (n_even, MLA_KV_LORA, MLA_HEADS * (MLA_NOPE + MLA_V)), MLA_KV_LORA ** -0.5),
        "ev_w_out": nrm(ks[14], (n_even, EVEN_OUT_WIDTH, D), EVEN_OUT_WIDTH ** -0.5),
        "od_w_in": nrm(ks[15], (n_odd, D, ODD_IN_WIDTH), D ** -0.5),
        "od_w_out": nrm(ks[16], (n_odd, RET_V_WIDTH, D), RET_V_WIDTH ** -0.5),
        "moe_w_group": nrm(ks[17], (DEPTH, D, N_GROUPS), D ** -0.5),
        "moe_b_group": nrm(ks[18], (DEPTH, N_GROUPS), 0.01),
        "moe_w_expert": nrm(ks[19], (DEPTH, D, N_EXPERTS), D ** -0.5),
        "moe_b_expert": nrm(ks[20], (DEPTH, N_EXPERTS), 0.01),
        "moe_w_gate": nrm(ks[21], (DEPTH, N_EXPERTS, D, EXPERT_HIDDEN), D ** -0.5),
        "moe_w_up": nrm(ks[22], (DEPTH, N_EXPERTS, D, EXPERT_HIDDEN), D ** -0.5),
        "moe_w_down": nrm(ks[23], (DEPTH, N_EXPERTS, EXPERT_HIDDEN, D), EXPERT_HIDDEN ** -0.5),
        "final_norm": 1.0 + nrm(ks[24], (D,), 0.05),
    }


def reference(x, c, positions, w_mod_mix, b_mod_mix, norm_mix, w_mod_ffn, b_mod_ffn, norm_ffn,
              ev_w_in, ev_q_norm, ev_w_q_up, ev_kv_norm, ev_w_kv_up, ev_w_out,
              od_w_in, od_w_out,
              moe_w_group, moe_b_group, moe_w_expert, moe_b_expert, moe_w_gate, moe_w_up, moe_w_down,
              final_norm):
    cond = jax.nn.silu(c)
    for layer in range(DEPTH):
        i = layer // 2
        shift, scale, gate = adaln(cond, w_mod_mix[layer], b_mod_mix[layer])
        h = rms_norm(x, norm_mix[layer]) * (1.0 + scale) + shift
        if layer % 2 == 0:
            y = hybrid_attention(h, positions, ev_w_in[i], ev_q_norm[i], ev_w_q_up[i],
                                 ev_kv_norm[i], ev_w_kv_up[i], ev_w_out[i])
        else:
            y = retention(h, positions, od_w_in[i], od_w_out[i])
        x = x + gate * y
        shift, scale, gate = adaln(cond, w_mod_ffn[layer], b_mod_ffn[layer])
        h = rms_norm(x, norm_ffn[layer]) * (1.0 + scale) + shift
        x = x + gate * hierarchical_moe(h, moe_w_group[layer], moe_b_group[layer],
                                        moe_w_expert[layer], moe_b_expert[layer],
                                        moe_w_gate[layer], moe_w_up[layer], moe_w_down[layer])
    return rms_norm(x, final_norm)
```

```cpp
#include <hip/hip_runtime.h>
#include <cstdio>
#include <cstdint>

#ifndef MK_MULTI
#define MK_MULTI 0
#endif

namespace pg8 {
#define PG8_LAS __attribute__((address_space(3)))
typedef unsigned short bf16_t;
typedef short bf16x8 __attribute__((ext_vector_type(8)));
typedef float f32x4 __attribute__((ext_vector_type(4)));
typedef unsigned u32x4 __attribute__((ext_vector_type(4)));
constexpr int BM = 256, BK = 64, HALF = 128, HTB = HALF * BK * 2  , STAGE_BYTES = 8 * HTB, NXCD = 8, WGM = 8;

__host__ __device__ __forceinline__ int lds_byte(int r, int c) { const int st = (r >> 4) * 2 + (c >> 5), rr = r & 15, cc = c & 31, ob = rr * 64 + cc * 2; return st * 1024 + (ob ^ (((ob >> 9) & 1) << 5)); }
__host__ __device__ __forceinline__ void stage_rc(int b, int& R, int& C) { const int st = b / 1024, sb = b % 1024, swz = sb ^ (((sb >> 9) & 1) << 5); R = (st >> 1) * 16 + swz / 64; C = (st & 1) * 32 + (swz % 64) / 2; }
__host__ __device__ __forceinline__ int perm32(int rho) { const int n = rho >> 4, i = rho & 15; return 8 * (i >> 2) + 4 * n + (i & 3); }

struct Unit { int pm, pn; const char* a; const char* b; };
struct Gemm { int K, lda, ldb; };

struct StaticOrder {
    int nM, nN, nwg, G, c; const char* A; const char* Bt; size_t tstepA, tstepB;
    __device__ void init(int M, int N, int G_, int c_, const void* A_, int lda, const void* Bt_, int ldb) { nM = M / BM; nN = N / BM; nwg = nM * nN; G = G_; c = c_; A = (const char*)A_; Bt = (const char*)Bt_; tstepA = (size_t)BM * lda * 2; tstepB = (size_t)BM * ldb * 2; }
    __device__ bool next(int i, Unit& u) const {
        const long L = (long)i * G + c; if (L >= nwg) return false;
        int wgid = (int)L; { const int q = nwg / NXCD, r = nwg % NXCD, xcd = wgid % NXCD, off = wgid / NXCD; wgid = (xcd < r ? xcd * (q + 1) : r * (q + 1) + (xcd - r) * q) + off; }
        const int nig = WGM * nN, gid = wgid / nig, fm = gid * WGM, gsz = (nM - fm) < WGM ? (nM - fm) : WGM;
        u.pm = fm + ((wgid % nig) % gsz); u.pn = (wgid % nig) / gsz; u.a = A + (size_t)u.pm * tstepA; u.b = Bt + (size_t)u.pn * tstepB; return true;
    }
    __device__ __forceinline__ void a_ready(const Unit&) const {}
    __device__ __forceinline__ void done(const Unit&) const {}
};
struct MoeOrder {
    int ntn, t0, nunits, gdeal, busy, G, c; const char* A; const char* W; size_t tstepA, tstepB, estep; const PG8_LAS int* tile_expert;
    __device__ bool next(int i, Unit& u) const {
        int L;
        if (busy == 0) { if (c >= gdeal) return false; L = i * gdeal + c; }
        else { const int nfree = G - busy;
            if (c >= busy) { const int cap = 3 * nfree < nunits ? 3 * nfree : nunits; if (i >= 3) return false; L = i * nfree + (c - busy); if (L >= cap) return false; }
            else { L = 3 * nfree + i * busy + c; } }
        if (L >= nunits) return false;
        const int mt = t0 + L / ntn, pn = L % ntn, e = tile_expert[mt];
        u.pm = mt; u.pn = pn; u.a = A + (size_t)mt * tstepA; u.b = W + (size_t)e * estep + (size_t)pn * tstepB; return true;
    }
    __device__ __forceinline__ void a_ready(const Unit&) const {}
    __device__ __forceinline__ void done(const Unit&) const {}
};

template <class Epi, class Sched, bool ALIGN_EPI = false, bool SP2 = false>
__device__ __forceinline__ void gemm_phase(PG8_LAS unsigned char* lds, const Gemm g, const Sched& S, const Epi& E, const int wave_id) {
    int lane; asm volatile("v_mbcnt_lo_u32_b32 %0, -1, 0\n\tv_mbcnt_hi_u32_b32 %0, -1, %0" : "=v"(lane));
    const int wid = wave_id, tid = wid * 64 + lane, wr = wid >> 2, wc = wid & 3, fr = lane & 15, fq = lane >> 4;
    const int K = g.K, nt = K / BK;
    unsigned voffA[2], voffB[2];
#pragma unroll
    for (int i = 0; i < 2; ++i) { int R, C; stage_rc(tid * 16 + i * 8192, R, C); const int Rb = Epi::PERM ? ((R & ~31) + perm32(R & 31)) : R;
        voffA[i] = (unsigned)(R * g.lda + C) * 2u; voffB[i] = (unsigned)(Rb * g.ldb + C) * 2u; }
    const size_t kstep = (size_t)(BK * 2);
    const size_t hstepA = (size_t)HALF * g.lda * 2, hstepB = (size_t)HALF * g.ldb * 2;
    const unsigned ldsw = (unsigned)wid * 1024u;
    const int aoff = lds_byte(wr * 64 + fr, fq * 8), boff = lds_byte(wc * 32 + fr, fq * 8);
#define PG8_SA(b, h) (((b) * 2 + (h)) * HTB)
#define PG8_SB(b, h) ((4 + (b) * 2 + (h)) * HTB)
#define PG8_STAGE(bufoff, gbase, voff) do { _Pragma("unroll") for (int _i = 0; _i < 2; ++_i) \
        __builtin_amdgcn_global_load_lds((const unsigned*)((const char*)(gbase) + (voff)[_i]), (PG8_LAS unsigned*)(lds + (bufoff) + ldsw + _i * 8192), 16, 0, 0); } while (0)
#define PG8_LDA(dst, b, h) do { _Pragma("unroll") for (int m = 0; m < 4; ++m) _Pragma("unroll") for (int k = 0; k < 2; ++k) dst[m][k] = *(const PG8_LAS bf16x8*)(lds + PG8_SA(b, h) + aoff + m * 2048 + k * 1024); } while (0)
#define PG8_LDB(dst, b, h) do { _Pragma("unroll") for (int n = 0; n < 2; ++n) _Pragma("unroll") for (int k = 0; k < 2; ++k) dst[n][k] = *(const PG8_LAS bf16x8*)(lds + PG8_SB(b, h) + boff + n * 2048 + k * 1024); } while (0)
#define PG8_MMA(ai, bj, At, Bt) do { __builtin_amdgcn_s_setprio(1); _Pragma("unroll") for (int m = 0; m < 4; ++m) _Pragma("unroll") for (int n = 0; n < 2; ++n) _Pragma("unroll") for (int k = 0; k < 2; ++k) \
        acc[ai][bj][m][n] = __builtin_amdgcn_mfma_f32_16x16x32_bf16(Bt[n][k], At[m][k], acc[ai][bj][m][n], 0, 0, 0); __builtin_amdgcn_s_setprio(0); } while (0)
#define PG8_WAIT_V(n) asm volatile("s_waitcnt vmcnt(" #n ")" ::: "memory")
#define PG8_WAIT_L(n) asm volatile("s_waitcnt lgkmcnt(" #n ")" ::: "memory")
#define PG8_BAR __builtin_amdgcn_s_barrier()
#define PG8_SCHED __builtin_amdgcn_sched_barrier(0)
    Unit cur, nxt; int ui = 0;
    if (!S.next(0, cur)) return;
    f32x4 acc[2][2][4][2];
#pragma unroll
    for (int a = 0; a < 2; ++a)
#pragma unroll
        for (int b = 0; b < 2; ++b)
#pragma unroll
            for (int m = 0; m < 4; ++m)
#pragma unroll
                for (int n = 0; n < 2; ++n) acc[a][b][m][n] = (f32x4){0.f, 0.f, 0.f, 0.f};
    bf16x8 At[4][2], B0[2][2], B1[2][2];
    const char* cA = cur.a; const char* cB = cur.b;
    S.a_ready(cur);
    if constexpr (SP2) {
        PG8_STAGE(PG8_SB(0, 0), cB, voffB); PG8_STAGE(PG8_SB(0, 1), cB + hstepB, voffB); PG8_STAGE(PG8_SA(0, 0), cA, voffA); PG8_STAGE(PG8_SA(0, 1), cA + hstepA, voffA);
        if (wr == 1) PG8_BAR;
        PG8_WAIT_V(2); PG8_BAR;
        PG8_STAGE(PG8_SB(1, 0), cB + kstep, voffB); PG8_STAGE(PG8_SA(1, 0), cA + kstep, voffA); PG8_STAGE(PG8_SB(1, 1), cB + hstepB + kstep, voffB);
        PG8_WAIT_V(6); PG8_BAR;
    } else {
        PG8_STAGE(PG8_SB(0, 0), cB, voffB); PG8_STAGE(PG8_SA(0, 0), cA, voffA); PG8_STAGE(PG8_SB(0, 1), cB + hstepB, voffB); PG8_STAGE(PG8_SA(0, 1), cA + hstepA, voffA);
        if (wr == 1) PG8_BAR;
        PG8_WAIT_V(4); PG8_BAR;
        PG8_STAGE(PG8_SB(1, 0), cB + kstep, voffB); PG8_STAGE(PG8_SA(1, 0), cA + kstep, voffA); PG8_STAGE(PG8_SB(1, 1), cB + hstepB + kstep, voffB);
        PG8_WAIT_V(6); PG8_BAR;
    }
    for (;;) {
        const bool has_next = S.next(ui + 1, nxt);
        const char* nA = has_next ? nxt.a : cA; const char* nB = has_next ? nxt.b : cB;
        for (int t = 0; t < nt; t += 2) {
            const bool last = (t == nt - 2);
            const char* a1 = cA + (size_t)(t + 1) * kstep;
            const char* a2 = last ? nA : cA + (size_t)(t + 2) * kstep; const char* b2 = last ? nB : cB + (size_t)(t + 2) * kstep;
            const char* a3 = a2 + kstep; const char* b3 = b2 + kstep;
            if (last && has_next) S.a_ready(nxt);
            if constexpr (SP2) {
            PG8_LDB(B0, 0, 0); PG8_LDB(B1, 0, 1); PG8_SCHED; PG8_LDA(At, 0, 0); PG8_STAGE(PG8_SA(1, 1), a1 + hstepA, voffA);
            PG8_WAIT_V(8); PG8_WAIT_L(0); PG8_BAR; PG8_MMA(0, 0, At, B0); PG8_MMA(0, 1, At, B1); PG8_BAR; PG8_SCHED;
            PG8_LDA(At, 0, 1); PG8_STAGE(PG8_SB(0, 0), b2, voffB); PG8_STAGE(PG8_SB(0, 1), b2 + hstepB, voffB); PG8_STAGE(PG8_SA(0, 0), a2, voffA);
            PG8_WAIT_V(8); PG8_WAIT_L(0); PG8_BAR; PG8_MMA(1, 0, At, B0); PG8_MMA(1, 1, At, B1); PG8_BAR; PG8_SCHED;
            PG8_LDB(B0, 1, 0); PG8_LDB(B1, 1, 1); PG8_SCHED; PG8_LDA(At, 1, 0); PG8_STAGE(PG8_SA(0, 1), a2 + hstepA, voffA);
            PG8_WAIT_V(8); PG8_WAIT_L(0); PG8_BAR; PG8_MMA(0, 0, At, B0); PG8_MMA(0, 1, At, B1); PG8_BAR; PG8_SCHED;
            PG8_LDA(At, 1, 1); PG8_STAGE(PG8_SB(1, 0), b3, voffB); PG8_STAGE(PG8_SB(1, 1), b3 + hstepB, voffB); PG8_STAGE(PG8_SA(1, 0), a3, voffA);
            PG8_WAIT_V(8); PG8_WAIT_L(0); PG8_BAR; PG8_MMA(1, 0, At, B0); PG8_MMA(1, 1, At, B1); PG8_BAR; PG8_SCHED;
            } else {
            PG8_LDB(B0, 0, 0); PG8_SCHED; PG8_LDA(At, 0, 0); PG8_STAGE(PG8_SA(1, 1), a1 + hstepA, voffA);
            PG8_WAIT_L(8); PG8_BAR; PG8_WAIT_L(0); PG8_MMA(0, 0, At, B0); PG8_BAR; PG8_SCHED;
            PG8_LDB(B1, 0, 1); PG8_STAGE(PG8_SB(0, 0), b2, voffB);
            PG8_BAR; PG8_WAIT_L(0); PG8_MMA(0, 1, At, B1); PG8_BAR;
            PG8_LDA(At, 0, 1); PG8_STAGE(PG8_SA(0, 0), a2, voffA);
            PG8_BAR; PG8_WAIT_L(0); PG8_MMA(1, 0, At, B0); PG8_BAR; PG8_SCHED;
            PG8_STAGE(PG8_SB(0, 1), b2 + hstepB, voffB);
            PG8_WAIT_V(6); PG8_BAR; PG8_MMA(1, 1, At, B1); PG8_BAR;
            PG8_LDB(B0, 1, 0); PG8_SCHED; PG8_LDA(At, 1, 0); PG8_STAGE(PG8_SA(0, 1), a2 + hstepA, voffA);
            PG8_WAIT_L(8); PG8_BAR; PG8_WAIT_L(0); PG8_MMA(0, 0, At, B0); PG8_BAR; PG8_SCHED;
            PG8_LDB(B1, 1, 1); PG8_STAGE(PG8_SB(1, 0), b3, voffB);
            PG8_BAR; PG8_WAIT_L(0); PG8_MMA(0, 1, At, B1); PG8_BAR;
            PG8_LDA(At, 1, 1); PG8_STAGE(PG8_SA(1, 0), a3, voffA);
            PG8_BAR; PG8_WAIT_L(0); PG8_MMA(1, 0, At, B0); PG8_BAR; PG8_SCHED;
            PG8_STAGE(PG8_SB(1, 1), b3 + hstepB, voffB);
            PG8_WAIT_V(6); PG8_BAR; PG8_MMA(1, 1, At, B1); PG8_BAR;
            }
        }
        if constexpr (ALIGN_EPI) { if (wr == 0) PG8_BAR; }
        if constexpr (!Epi::AFTER_DRAIN) { E(acc, cur, wr, wc, fr, fq); S.done(cur); }
        if (!has_next) break;
#pragma unroll
        for (int a = 0; a < 2; ++a)
#pragma unroll
            for (int b = 0; b < 2; ++b)
#pragma unroll
                for (int m = 0; m < 4; ++m)
#pragma unroll
                    for (int n = 0; n < 2; ++n) acc[a][b][m][n] = (f32x4){0.f, 0.f, 0.f, 0.f};
        cur = nxt; cA = nA; cB = nB; ++ui;
        if constexpr (ALIGN_EPI) { if (wr == 1) PG8_BAR; }
    }
    PG8_WAIT_V(0);
    if constexpr (!ALIGN_EPI) { if (wr == 0) PG8_BAR; }
    PG8_BAR;
    if constexpr (Epi::AFTER_DRAIN) { E.fused(acc, cur, wr, wc, fr, fq, lds, wid, lane); S.done(cur); }
#undef PG8_SA
#undef PG8_SB
#undef PG8_STAGE
#undef PG8_LDA
#undef PG8_LDB
#undef PG8_MMA
#undef PG8_WAIT_V
#undef PG8_WAIT_L
#undef PG8_BAR
#undef PG8_SCHED
}
}

constexpr int NWAVES = 8;
constexpr int T_ = 8192, D_ = 2048, NB_ = 4, S_ = 2048;
constexpr float EPS_ = 1e-6f;
constexpr float LOG2E = 1.4426950408889634f;
constexpr float C_SB = 0.08838834764831845f * LOG2E;
constexpr float C_MLA = 0.07216878364870323f * LOG2E;
constexpr int NPH = 22;

constexpr size_t MiB = 1u << 20;
constexpr size_t WS_CTL = 0, CTL_ZERO_BYTES = 1 * MiB;
constexpr size_t WS_TAB64 = 2 * MiB, WS_TAB256 = 4 * MiB, WS_WR = 12 * MiB, WS_ROUTE = 13 * MiB;
constexpr size_t WS_W_IN0T = 16 * MiB, WS_W_QUPT = 32 * MiB, WS_W_KVUPT = 34 * MiB, WS_W_OUT0T = 36 * MiB, WS_W_IN1T = 44 * MiB, WS_W_OUT1T = 92 * MiB;
constexpr size_t WS_W_GU = 108 * MiB, WS_W_DN = 364 * MiB;
constexpr size_t WS_XA = 492 * MiB, WS_XB = 556 * MiB, WS_H = 620 * MiB;
constexpr size_t WS_PROJ0 = 652 * MiB, WS_QMLA = 716 * MiB, WS_KVMLA = 740 * MiB, WS_KR = 772 * MiB, WS_ATTO = 774 * MiB;
constexpr size_t WS_PROJ1 = 652 * MiB;
constexpr size_t WS_HG = 844 * MiB, WS_ACT = 940 * MiB, WS_Y = 964 * MiB;
constexpr size_t WS_RETO = 844 * MiB, WS_A5 = 908 * MiB;
constexpr size_t WS_MODP = 1060 * MiB;
constexpr size_t WS_RS = 13 * MiB + 256 * 1024;
constexpr size_t WS_SSQP = 13 * MiB + 512 * 1024;
constexpr size_t WS_END = 1064 * MiB;
constexpr int CW_TMO = 0, CW_CODE = 1;
constexpr int CW_BAR = 4096;
constexpr int CW_QMLA = 8192, CW_QSB = 8256, CW_QRET = 8320, CW_QC1 = 8384, CW_QC2 = 8416;
constexpr int CW_ECNT = 8448, CW_ECUR = 8576;
constexpr int CW_MOD = 16384;
constexpr int CW_SSQQ = 114688, CW_SSQKV = 122880;
static_assert((CW_SSQKV + 8192) * 4 <= (int)CTL_ZERO_BYTES, "CTL words inside the memset region");
constexpr int RING_OFF = 0, RING_BYTES = 147456;
constexpr int LDSCTL_OFF = RING_BYTES, MISC_OFF = LDSCTL_OFF + 320;
constexpr int MOE_TAB_OFF = LDSCTL_OFF + 1024;
constexpr int LDS_BYTES = 155648;
static_assert(MOE_TAB_OFF + 1024 <= LDS_BYTES, "LDS map");

#define GAS __attribute__((address_space(1)))
#define LAS __attribute__((address_space(3)))
typedef unsigned short bf16;
typedef unsigned v4u __attribute__((ext_vector_type(4)));
typedef unsigned v2u __attribute__((ext_vector_type(2)));
typedef float f32x4 __attribute__((ext_vector_type(4)));
typedef float f32x2 __attribute__((ext_vector_type(2)));
typedef float f32x16 __attribute__((ext_vector_type(16)));
typedef short bf16x8 __attribute__((ext_vector_type(8)));
typedef short s16x4 __attribute__((ext_vector_type(4)));
typedef short v4i16_t __attribute__((ext_vector_type(4)));
typedef GAS unsigned gu32;
#define RLX_AGENT __ATOMIC_RELAXED, __HIP_MEMORY_SCOPE_AGENT
#define LDS_WAIT() asm volatile("s_waitcnt lgkmcnt(0)" ::: "memory")
#define VM_WAIT() asm volatile("s_waitcnt vmcnt(0)" ::: "memory")
typedef __bf16 bf16x2_t __attribute__((ext_vector_type(2)));
__device__ __forceinline__ unsigned pk2(float lo, float hi) { f32x2 v = {lo, hi}; bf16x2_t b = __builtin_convertvector(v, bf16x2_t); return __builtin_bit_cast(unsigned, b); }
__device__ __forceinline__ float bf_lo(unsigned w) { return __uint_as_float(w << 16); }
__device__ __forceinline__ float bf_hi(unsigned w) { return __uint_as_float(w & 0xffff0000u); }
__device__ __forceinline__ float ex2(float x) { return __builtin_amdgcn_exp2f(x); }
__device__ __forceinline__ float lg2(float x) { return __builtin_amdgcn_logf(x); }
__device__ __forceinline__ float silu_f(float v) { return v / (1.0f + __expf(-v)); }
__device__ __forceinline__ int lane_id_opaque() { int l; asm volatile("v_mbcnt_lo_u32_b32 %0, -1, 0\n\tv_mbcnt_hi_u32_b32 %0, -1, %0" : "=v"(l)); return l; }

#define XB_TMO      128
#define XB_XCNT(j)  (256  + 64 * (j))
#define XB_XSUB(j)  (1280 + 64 * (j))
#define XB_XGEN(j)  (2304 + 64 * (j))
#define XB_TOP      3328
#define XB_TOPGEN   3392
#define XCD_BAR_WORDS 3456
#define XB_SPIN_CAP (1u << 18)
__device__ __forceinline__ unsigned xb_ld(unsigned* p)              { return __hip_atomic_load(p, __ATOMIC_RELAXED, __HIP_MEMORY_SCOPE_AGENT); }
__device__ __forceinline__ unsigned xb_add(unsigned* p, unsigned v) { return __hip_atomic_fetch_add(p, v, __ATOMIC_RELAXED, __HIP_MEMORY_SCOPE_AGENT); }
__device__ __forceinline__ unsigned xb_xcc_id() { return (unsigned)__builtin_amdgcn_s_getreg((3 << 11) | 20) & 0xFu; }
#define XB_SPIN(cond, bar) do { unsigned _sp = 0; while (cond) { __builtin_amdgcn_s_sleep(1); \
    if ((++_sp & 255u) == 0u) { if (xb_ld(&(bar)[XB_TMO])) break; if (_sp > XB_SPIN_CAP) { atomicAdd(&(bar)[XB_TMO], 1u); break; } } } } while (0)
struct XcdBarrier { unsigned* bar; unsigned x; volatile LAS unsigned* st; };
__device__ __forceinline__ XcdBarrier xcd_barrier_post(unsigned* bar, volatile LAS unsigned* st, int wave) {
    XcdBarrier b; b.bar = bar; b.x = xb_xcc_id(); b.st = st;
    if (wave == 0 && lane_id_opaque() == 0) (void)xb_add(&bar[XB_XCNT(b.x)], 1u);
    return b;
}
__device__ __forceinline__ void xcd_barrier_complete(unsigned* bar, unsigned x, unsigned& nloc, unsigned& nx) {
    const unsigned G = gridDim.x * gridDim.y * gridDim.z;
    unsigned sum, cnt, mine, sp = 0u;
    for (;;) {
        sum = 0u; cnt = 0u; mine = 0u;
#pragma unroll
        for (unsigned j = 0; j < 16; ++j) { const unsigned c = xb_ld(&bar[XB_XCNT(j)]); sum += c; cnt += (c > 0u) ? 1u : 0u; mine = (j == x) ? c : mine; }
        if (sum == G) break;
        __builtin_amdgcn_s_sleep(1);
        if ((++sp & 255u) == 0u) { if (xb_ld(&bar[XB_TMO])) break; if (sp > XB_SPIN_CAP) { atomicAdd(&bar[XB_TMO], 1u); break; } }
    }
    nloc = mine > 0u ? mine : 1u; nx = cnt > 0u ? cnt : 1u;
}
__device__ __forceinline__ void xcd_barrier(const XcdBarrier& b, int wave) {
    asm volatile("s_waitcnt vmcnt(0)" ::: "memory");
    __syncthreads();
    if (wave == 0 && lane_id_opaque() == 0) {
        unsigned* bar = b.bar;
        __builtin_amdgcn_s_waitcnt(0);
        unsigned nloc = b.st[0], nx = b.st[1];
        if (nloc == 0u) { xcd_barrier_complete(bar, b.x, nloc, nx); b.st[0] = nloc; b.st[1] = nx; }
        const unsigned old = xb_add(&bar[XB_XSUB(b.x)], 1u);
        const unsigned gen = old / nloc;
        if (old + 1u == (gen + 1u) * nloc) {
            __builtin_amdgcn_fence(__ATOMIC_RELEASE, "agent");
            asm volatile("s_waitcnt vmcnt(0)" ::: "memory");
            const unsigned og = xb_add(&bar[XB_TOP], 1u);
            const unsigned tg = og / nx;
            if (og + 1u == (tg + 1u) * nx) xb_add(&bar[XB_TOPGEN], 1u);
            else XB_SPIN(xb_ld(&bar[XB_TOPGEN]) == tg, bar);
            __builtin_amdgcn_fence(__ATOMIC_ACQUIRE, "agent");
            xb_add(&bar[XB_XGEN(b.x)], 1u);
            asm volatile("s_waitcnt vmcnt(0)" ::: "memory");
        } else {
            XB_SPIN(xb_ld(&bar[XB_XGEN(b.x)]) == gen, bar);
            __builtin_amdgcn_fence(__ATOMIC_ACQUIRE, "agent");
            asm volatile("s_waitcnt vmcnt(0)" ::: "memory");
        }
    }
    __syncthreads();
}

struct Frame {
    LAS unsigned char* lds;
    volatile LAS unsigned* MISC;
    gu32* ctl;
    unsigned char* ws;
    int wave;
    int vcu, G;
    float* out;
};
struct Args { const float* in[25]; float* out; unsigned char* ws; int ph_lo, ph_hi; };
__device__ __forceinline__ float wave_sum(float v) {
#pragma unroll
    for (int o = 1; o < 64; o <<= 1) v += __shfl_xor(v, o);
    return v;
}
#define PHASE_IDS(F) const int lane = lane_id_opaque(), wave = (F).wave, tid = wave * 64 + lane; (void)lane; (void)wave; (void)tid
struct ConvSrc { const float* W; int ldn; bf16* WT; int ldk; const float* scale; };
__device__ __forceinline__ void conv_load(const ConvSrc& c, int lane, f32x4 (&v)[8]) {
    const float* src = c.W + (size_t)(8 * (lane >> 3)) * c.ldn + 4 * (lane & 7);
#pragma unroll
    for (int t = 0; t < 8; ++t) v[t] = __builtin_nontemporal_load((const f32x4*)(src + (size_t)t * c.ldn));
}
__device__ __forceinline__ void conv_store(const ConvSrc& c, int lane, f32x4 (&v)[8]) {
    if (c.scale) { const f32x4 s0 = *(const f32x4*)(c.scale + 8 * (lane >> 3)), s1 = *(const f32x4*)(c.scale + 8 * (lane >> 3) + 4);
        v[0] *= s0.x; v[1] *= s0.y; v[2] *= s0.z; v[3] *= s0.w; v[4] *= s1.x; v[5] *= s1.y; v[6] *= s1.z; v[7] *= s1.w; }
    bf16* dst = c.WT + (size_t)(4 * (lane & 7)) * c.ldk + 8 * (lane >> 3);
#pragma unroll
    for (int j = 0; j < 4; ++j) { v4u o; o.x = pk2(v[0][j], v[1][j]); o.y = pk2(v[2][j], v[3][j]); o.z = pk2(v[4][j], v[5][j]); o.w = pk2(v[6][j], v[7][j]); __builtin_nontemporal_store(o, (v4u*)(dst + (size_t)j * c.ldk)); }
}
constexpr int CONV_N0 = 122 * 32 + 48 * 8 + 64 * 4, CONV_N1 = 64 * 32 + 384 * 32 + 32 * 1024 + 32 * 512, CONV_N2 = 64 * 64 + 32 * 1024 + 32 * 512;
__device__ __forceinline__ ConvSrc conv_moe_gu(const Args& A, unsigned char* ws, int le, int r) {
    const int nb = r / 32, kb = r % 32, t = nb >> 3, hf = (nb >> 2) & 1, jb = nb & 3;
    return ConvSrc{(hf ? A.in[22] : A.in[21]) + (size_t)le * 2048 * 512 + (size_t)(64 * kb) * 512 + 128 * t + 32 * jb, 512, (bf16*)(ws + WS_W_GU) + (size_t)le * 1024 * 2048 + (size_t)(32 * nb) * 2048 + 64 * kb, 2048, nullptr};
}
__device__ __forceinline__ ConvSrc conv_moe_dn(const Args& A, unsigned char* ws, int le, int r) {
    const int nb = r / 8, kb = r % 8;
    return ConvSrc{A.in[23] + (size_t)le * 512 * 2048 + (size_t)(64 * kb) * 2048 + 32 * nb, 2048, (bf16*)(ws + WS_W_DN) + (size_t)le * 2048 * 512 + (size_t)(32 * nb) * 512 + 64 * kb, 512, nullptr};
}
template <int STREAM> __device__ __forceinline__ ConvSrc conv_item(const Args& A, unsigned char* ws, int it) {
    if (STREAM == 0) {
        if (it < 122 * 32) { const int t = it / 32, kb = it % 32; const int dnb = t < 120 ? t : (t == 120 ? 120 : 124), sc = t < 120 ? 32 * t : (t == 120 ? 3840 : 3872);
            return ConvSrc{A.in[9] + (size_t)(64 * kb) * 3904 + sc, 3904, (bf16*)(ws + WS_W_IN0T) + (size_t)(32 * dnb) * 2048 + 64 * kb, 2048, nullptr}; }
        it -= 122 * 32;
        if (it < 48 * 8) { const int nb = it / 8, kb = it % 8; int sc;
            if (nb < 32) sc = (nb >> 2) * 192 + 32 * (nb & 3);
            else { const int t = (nb - 32) >> 3, blk = (nb - 32) & 7, hf = blk >> 2, hh = blk & 3; sc = (4 * t + hh) * 192 + 128 + 32 * hf; }
            return ConvSrc{A.in[11] + (size_t)(64 * kb) * 1536 + sc, 1536, (bf16*)(ws + WS_W_QUPT) + (size_t)(32 * nb) * 512 + 64 * kb, 512, A.in[10] + 64 * kb}; }
        it -= 48 * 8;
        { const int nb = it / 4, kb = it % 4;
            return ConvSrc{A.in[13] + (size_t)(64 * kb) * 2048 + 32 * nb, 2048, (bf16*)(ws + WS_W_KVUPT) + (size_t)(32 * nb) * 256 + 64 * kb, 256, A.in[12] + 64 * kb}; }
    } else if (STREAM == 1) {
        if (it < 64 * 32) { const int nb = it / 32, kb = it % 32;
            return ConvSrc{A.in[14] + (size_t)(64 * kb) * 2048 + 32 * nb, 2048, (bf16*)(ws + WS_W_OUT0T) + (size_t)(32 * nb) * 2048 + 64 * kb, 2048, nullptr}; }
        it -= 64 * 32;
        if (it < 384 * 32) { const int nb = it / 32, kb = it % 32;
            return ConvSrc{A.in[15] + (size_t)(64 * kb) * 12288 + 32 * nb, 12288, (bf16*)(ws + WS_W_IN1T) + (size_t)(32 * nb) * 2048 + 64 * kb, 2048, nullptr}; }
        it -= 384 * 32;
        if (it < 32 * 1024) return conv_moe_gu(A, ws, it / 1024, it % 1024);
        it -= 32 * 1024;
        return conv_moe_dn(A, ws, it / 512, it % 512);
    } else {
        if (it < 64 * 64) { const int nb = it / 64, kb = it % 64;
            return ConvSrc{A.in[16] + (size_t)(64 * kb) * 2048 + 32 * nb, 2048, (bf16*)(ws + WS_W_OUT1T) + (size_t)(32 * nb) * 4096 + 64 * kb, 4096, nullptr}; }
        it -= 64 * 64;
        if (it < 32 * 1024) return conv_moe_gu(A, ws, 32 + it / 1024, it % 1024);
        it -= 32 * 1024;
        return conv_moe_dn(A, ws, 32 + it / 512, it % 512);
    }
}
template <int STREAM> __device__ __forceinline__ void conv_burst(Frame& F, const Args& A, int lane, int gw, int NGW, int& cur, int n) {
    constexpr int N = STREAM == 0 ? CONV_N0 : (STREAM == 1 ? CONV_N1 : CONV_N2);
#pragma unroll 1
    while (n > 0) {
        const int i0 = gw + NGW * cur; if (i0 >= N) break;
        const int i1 = i0 + NGW; const bool two = n > 1 && i1 < N;
        const ConvSrc c0 = conv_item<STREAM>(A, F.ws, i0); f32x4 v0[8], v1[8];
        conv_load(c0, lane, v0);
        if (two) { const ConvSrc c1 = conv_item<STREAM>(A, F.ws, i1); conv_load(c1, lane, v1); conv_store(c0, lane, v0); conv_store(c1, lane, v1); cur += 2; n -= 2; }
        else { conv_store(c0, lane, v0); cur += 1; n -= 1; }
    }
}

__device__ __forceinline__ void p0a_mod_partials(Frame& F, const Args& A) {
    PHASE_IDS(F);
    const int gw = F.vcu * NWAVES + wave, NGW = F.G * NWAVES;
    LAS float* cond = (LAS float*)(F.lds + RING_OFF);
    for (int i = tid; i < NB_ * D_; i += 512) cond[i] = silu_f(A.in[1][i]);
    __syncthreads();
    float* MODP = (float*)(F.ws + WS_MODP);
    for (int u = gw; u < 768; u += NGW) {
        const int j = u / 192, r = u % 192, nc = r / 8, kc = r % 8, layer = j >> 1;
        const float* W = ((j & 1) ? A.in[6] : A.in[3]) + (size_t)layer * 2048 * 6144 + (size_t)(kc * 256) * 6144 + nc * 256 + 4 * lane;
        f32x4 acc[4];
#pragma unroll
        for (int b = 0; b < 4; ++b) acc[b] = (f32x4){0.f, 0.f, 0.f, 0.f};
#pragma unroll 16
        for (int k = 0; k < 256; ++k) { const f32x4 w = *(const f32x4*)(W + (size_t)k * 6144);
#pragma unroll
            for (int b = 0; b < 4; ++b) acc[b] += cond[b * 2048 + kc * 256 + k] * w; }
#pragma unroll
        for (int b = 0; b < 4; ++b) *(f32x4*)(MODP + ((size_t)(kc * 16 + j * 4 + b)) * 6144 + nc * 256 + 4 * lane) = acc[b];
    }
}
__device__ __forceinline__ void p0_prologue(Frame& F, const Args& A) {
    PHASE_IDS(F);
    const int gw = F.vcu * NWAVES + wave, NGW = F.G * NWAVES;
    const int gt = F.vcu * 512 + tid, NGT = F.G * 512;
    { float* MOD = (float*)(F.ctl + CW_MOD); const float* MODP = (const float*)(F.ws + WS_MODP);
      for (int idx = gt; idx < 16 * 6144; idx += NGT) { const int j = idx / (4 * 6144), n = idx % 6144; float a = ((j & 1) ? A.in[7] : A.in[4])[(j >> 1) * 6144 + n];
#pragma unroll
          for (int kc = 0; kc < 8; ++kc) a += MODP[(size_t)kc * 16 * 6144 + idx];
          MOD[idx] = a; } }
    { int cur = 0; conv_burst<0>(F, A, lane, gw, NGW, cur, 1 << 20); }
    { const int* pos = (const int*)A.in[2]; f32x2* t64 = (f32x2*)(F.ws + WS_TAB64); f32x2* t256 = (f32x2*)(F.ws + WS_TAB256);
      for (int idx = gt; idx < T_ * 160; idx += NGT) { const int m = idx / 160, i = idx % 160; const double p = (double)pos[m];
          double fr; if (i < 32) fr = exp(-9.210340371976184 * (double)i / 32.0); else fr = exp(-9.210340371976184 * (double)(i - 32) / 128.0);
          double sn, cs; sincos(p * fr, &sn, &cs); const f32x2 v = {(float)cs, (float)sn};
          if (i < 32) t64[m * 32 + i] = v; else t256[m * 128 + (i - 32)] = v; } }
    { float* WR = (float*)(F.ws + WS_WR);
      for (int idx = gt; idx < 2 * 512 * 36 * 4; idx += NGT) { const int q = idx & 3, c = (idx >> 2) % 36, kq = ((idx >> 2) / 36) % 512, l = (idx >> 2) / (36 * 512); const int k = 4 * kq + q;
          WR[idx] = c < 4 ? A.in[17][(size_t)l * 2048 * 4 + k * 4 + c] : A.in[19][(size_t)l * 2048 * 32 + k * 32 + (c - 4)]; } }
}

__device__ __forceinline__ void local_mod(Frame& F, const float* bias, int j) {
    PHASE_IDS(F);
    const float* MODP = (const float*)(F.ws + WS_MODP); LAS f32x4* lm = (LAS f32x4*)(F.lds + RING_OFF);
    __syncthreads();
    for (int q = tid; q < 4096; q += 512) { const int b = q >> 10, n = 4 * (q & 1023); f32x4 a = *(const f32x4*)(bias + n);
#pragma unroll
        for (int kc = 0; kc < 8; ++kc) a += *(const f32x4*)(MODP + ((size_t)(kc * 16 + j * 4 + b)) * 6144 + n);
        lm[q] = a; }
    __syncthreads();
}
template <int MODE, bool LM = false> __device__ __forceinline__ void norm_phase(Frame& F, const float* src, float* xdst, const float* gvec, int jn, int jg, int layer_moe) {
    PHASE_IDS(F);
    const int gw = F.vcu * NWAVES + wave, NGW = F.G * NWAVES;
    const float* MOD = (const float*)(F.ctl + CW_MOD);
    bf16* H = (bf16*)(F.ws + WS_H);
    const bf16* Y = (const bf16*)(F.ws + WS_Y);
    const int* RT = (const int*)(F.ws + WS_ROUTE);
    for (int row = gw; row < T_; row += NGW) {
        const int b = row >> 11;
        f32x4 v[8]; float ss = 0.f;
        const f32x4* xr = (const f32x4*)(src + (size_t)row * D_) + lane;
#pragma unroll
        for (int j = 0; j < 8; ++j) v[j] = xr[64 * j];
        if (MODE >= 2) {
            const int* rt = RT + (size_t)row * 8; const int p0 = rt[4], p1 = rt[5]; const float w0 = __int_as_float(rt[2]), w1 = __int_as_float(rt[3]);
            const v2u* y0 = (const v2u*)(Y + (size_t)p0 * D_) + lane; const v2u* y1 = (const v2u*)(Y + (size_t)p1 * D_) + lane;
            const f32x4* gt = (const f32x4*)(MOD + (size_t)(jg * 4 + b) * 6144 + 4096) + lane;
#pragma unroll
            for (int j = 0; j < 8; ++j) { const v2u a = y0[64 * j], c = y1[64 * j]; const f32x4 g = gt[64 * j];
                f32x4 m; m.x = w0 * bf_lo(a.x) + w1 * bf_lo(c.x); m.y = w0 * bf_hi(a.x) + w1 * bf_hi(c.x); m.z = w0 * bf_lo(a.y) + w1 * bf_lo(c.y); m.w = w0 * bf_hi(a.y) + w1 * bf_hi(c.y);
                v[j] += g * m; }
            if (MODE == 2) { f32x4* xo = (f32x4*)(xdst + (size_t)row * D_) + lane;
#pragma unroll
                for (int j = 0; j < 8; ++j) xo[64 * j] = v[j]; }
        }
#pragma unroll
        for (int j = 0; j < 8; ++j) ss += (v[j].x * v[j].x + v[j].y * v[j].y) + (v[j].z * v[j].z + v[j].w * v[j].w);
        const float rstd = 1.0f / sqrtf(wave_sum(ss) * (1.0f / D_) + EPS_);
        const f32x4* gv = (const f32x4*)gvec + lane;
        if (MODE == 3) { f32x4* o = (f32x4*)(F.out + (size_t)row * D_) + lane;
#pragma unroll
            for (int j = 0; j < 8; ++j) o[64 * j] = v[j] * rstd * gv[64 * j];
        } else {
            v2u* o = (v2u*)(H + (size_t)row * D_) + lane;
            if (LM) { const LAS f32x4* sh = (const LAS f32x4*)(F.lds + RING_OFF) + b * 1024 + lane; const LAS f32x4* sc = sh + 512;
#pragma unroll
                for (int j = 0; j < 8; ++j) { const f32x4 h = v[j] * rstd * gv[64 * j] * (1.0f + sc[64 * j]) + sh[64 * j]; v2u w; w.x = pk2(h.x, h.y); w.y = pk2(h.z, h.w); o[64 * j] = w; }
            } else { const f32x4* sh = (const f32x4*)(MOD + (size_t)(jn * 4 + b) * 6144) + lane; const f32x4* sc = sh + 512;
#pragma unroll
                for (int j = 0; j < 8; ++j) { const f32x4 h = v[j] * rstd * gv[64 * j] * (1.0f + sc[64 * j]) + sh[64 * j]; v2u w; w.x = pk2(h.x, h.y); w.y = pk2(h.z, h.w); o[64 * j] = w; } }
        }
    }
}

__device__ __forceinline__ void router_phase(Frame& F, const Args& A, const float* X, const float* gvec, int jn, int layer, bool first) {
    const float* MOD = (const float*)(F.ctl + CW_MOD);
    const f32x4* WR4 = (const f32x4*)(F.ws + WS_WR) + (size_t)layer * 512 * 36;
    int* RT = (int*)(F.ws + WS_ROUTE); float* RS = (float*)(F.ws + WS_RS);
    LAS f32x4* hs = (LAS f32x4*)(F.lds + RING_OFF);
    LAS f32x4* wsm = (LAS f32x4*)(F.lds + RING_OFF + 40960);
    LAS f32x4* shs = (LAS f32x4*)(F.lds + RING_OFF + 81920);
    LAS float* rs = (LAS float*)(F.lds + RING_OFF + 83968);
    LAS float* lg = (LAS float*)(F.lds + RING_OFF + 84224);
    PHASE_IDS(F);
    const int r = tid >> 4, kp = tid & 15, kpart = lane & 15, cg = lane >> 4;
    int wpos[5];
#pragma unroll
    for (int i = 0; i < 5; ++i) { const int idx = tid + 512 * i; wpos[i] = idx + idx / 36; }
    for (int tile = F.vcu; tile < T_ / 32; tile += F.G) {
        const int row0 = tile * 32, b = row0 >> 11;
        const f32x4* sh = (const f32x4*)(MOD + (size_t)(jn * 4 + b) * 6144); const f32x4* sc = sh + 512; const f32x4* gv = (const f32x4*)gvec;
        const f32x4* xr = (const f32x4*)(X + (size_t)(row0 + r) * D_);
        float acc[4][9], accq[9], ss = 0.f;
#pragma unroll
        for (int c = 0; c < 9; ++c) { accq[c] = 0.f;
#pragma unroll
            for (int rr = 0; rr < 4; ++rr) acc[rr][c] = 0.f; }
        f32x4 xq[4], gq[4], sq[4], wq[5];
#define RT_LOAD(ch) do { _Pragma("unroll") for (int g = 0; g < 4; ++g) { const int q = (ch) * 64 + kp + 16 * g; xq[g] = xr[q]; gq[g] = gv[q] * (1.0f + sc[q]); if (r == 0) sq[g] = sh[q]; } \
            _Pragma("unroll") for (int i = 0; i < 5; ++i) { const int idx = tid + 512 * i; if (idx < 2304) wq[i] = WR4[(size_t)(ch) * 2304 + idx]; } } while (0)
        RT_LOAD(0);
#pragma unroll 1
        for (int ch = 0; ch < 8; ++ch) {
#pragma unroll
            for (int g = 0; g < 4; ++g) { const f32x4 x = xq[g]; ss += (x.x * x.x + x.y * x.y) + (x.z * x.z + x.w * x.w); hs[r * 65 + kp + 16 * g] = x * gq[g]; if (r == 0) shs[kp + 16 * g] = sq[g]; }
#pragma unroll
            for (int i = 0; i < 5; ++i) if (tid + 512 * i < 2304) wsm[wpos[i]] = wq[i];
            __syncthreads();
            if (ch + 1 < 8) RT_LOAD(ch + 1);
#pragma unroll 1
            for (int g = 0; g < 4; ++g) { const int kq = kpart + 16 * g; f32x4 h4[4];
#pragma unroll
                for (int rr = 0; rr < 4; ++rr) h4[rr] = hs[(wave * 4 + rr) * 65 + kq];
                const f32x4 q4 = shs[kq];
#pragma unroll
                for (int c = 0; c < 9; ++c) { const f32x4 w4 = wsm[kq * 37 + 9 * cg + c];
#pragma unroll
                    for (int rr = 0; rr < 4; ++rr) acc[rr][c] += (h4[rr].x * w4.x + h4[rr].y * w4.y) + (h4[rr].z * w4.z + h4[rr].w * w4.w);
                    if (wave == 0) accq[c] += (q4.x * w4.x + q4.y * w4.y) + (q4.z * w4.z + q4.w * w4.w); } }
            __syncthreads();
        }
#undef RT_LOAD
#pragma unroll
        for (int rr = 0; rr < 4; ++rr)
#pragma unroll
            for (int c = 0; c < 9; ++c) { float a = acc[rr][c]; a += __shfl_xor(a, 1); a += __shfl_xor(a, 2); a += __shfl_xor(a, 4); a += __shfl_xor(a, 8); if (kpart == 0) lg[(wave * 4 + rr) * 36 + 9 * cg + c] = a; }
        if (wave == 0) {
#pragma unroll
            for (int c = 0; c < 9; ++c) { float a = accq[c]; a += __shfl_xor(a, 1); a += __shfl_xor(a, 2); a += __shfl_xor(a, 4); a += __shfl_xor(a, 8); if (kpart == 0) lg[1152 + 9 * cg + c] = a; } }
        ss += __shfl_xor(ss, 1); ss += __shfl_xor(ss, 2); ss += __shfl_xor(ss, 4); ss += __shfl_xor(ss, 8);
        if (kp == 0) rs[r] = 1.0f / sqrtf(ss * (1.0f / D_) + EPS_);
        __syncthreads();
        if (tid < 32) { const int row = row0 + tid; const LAS float* l = lg + tid * 36; const LAS float* q = lg + 1152; const float* bg = A.in[18] + layer * 4; const float* be = A.in[20] + layer * 32; const float rstd = rs[tid];
            if (first) RS[row] = rstd;
            float g[4]; int gi = 0; float gm;
#pragma unroll
            for (int i = 0; i < 4; ++i) g[i] = rstd * l[i] + q[i] + bg[i];
            gm = g[0];
#pragma unroll
            for (int i = 1; i < 4; ++i) if (g[i] > gm) { gm = g[i]; gi = i; }
            float gs = 0.f;
#pragma unroll
            for (int i = 0; i < 4; ++i) gs += __expf(g[i] - gm);
            const float gw = 1.0f / gs;
            float e[8];
#pragma unroll
            for (int i = 0; i < 8; ++i) e[i] = rstd * l[4 + 8 * gi + i] + q[4 + 8 * gi + i] + be[8 * gi + i];
            int i0 = 0; float m0 = e[0];
#pragma unroll
            for (int i = 1; i < 8; ++i) if (e[i] > m0) { m0 = e[i]; i0 = i; }
            int i1 = -1; float m1 = -3.0e38f;
#pragma unroll
            for (int i = 0; i < 8; ++i) if (i != i0 && e[i] > m1) { m1 = e[i]; i1 = i; }
            const float p1 = __expf(m1 - m0), w0 = gw / (1.0f + p1), w1 = gw * p1 / (1.0f + p1);
            const int e0 = 8 * gi + i0, e1 = 8 * gi + i1;
            int* rt = RT + (size_t)row * 8; rt[0] = e0; rt[1] = e1; rt[2] = __float_as_int(w0); rt[3] = __float_as_int(w1);
            if (first) { atomicAdd((unsigned*)(F.ctl + CW_ECNT + 64 * layer + e0), 1u); atomicAdd((unsigned*)(F.ctl + CW_ECNT + 64 * layer + e1), 1u); }
        }
        __syncthreads();
    }
}

__device__ __forceinline__ void scatter_phase(Frame& F, const float* X, const float* gvec, int jn, int layer, bool first) {
    LAS int* tab = (LAS int*)(F.lds + MOE_TAB_OFF);
    PHASE_IDS(F);
    const int gw = F.vcu * NWAVES + wave, NGW = F.G * NWAVES;
    const float* MOD = (const float*)(F.ctl + CW_MOD);
    int* RT = (int*)(F.ws + WS_ROUTE); const float* RS = (const float*)(F.ws + WS_RS); bf16* HG = (bf16*)(F.ws + WS_HG);
    for (int tok = gw; tok < T_; tok += NGW) {
        int* rt = RT + (size_t)tok * 8; int p0 = 0, p1 = 0;
        const f32x4* xr = (const f32x4*)(X + (size_t)tok * D_) + lane; f32x4 v[8];
#pragma unroll
        for (int j = 0; j < 8; ++j) v[j] = xr[64 * j];
        if (lane == 0 && !first) { p0 = rt[4]; p1 = rt[5]; }
        if (lane == 0 && first) { const int e0 = rt[0], e1 = rt[1];
            p0 = tab[128 + e0] + (int)atomicAdd((unsigned*)(F.ctl + CW_ECUR + 64 * layer + e0), 1u);
            p1 = tab[128 + e1] + (int)atomicAdd((unsigned*)(F.ctl + CW_ECUR + 64 * layer + e1), 1u);
            rt[4] = p0; rt[5] = p1; }
        p0 = __builtin_amdgcn_readfirstlane(p0); p1 = __builtin_amdgcn_readfirstlane(p1);
        const float rstd = RS[tok]; const int b = tok >> 11;
        const f32x4* sh = (const f32x4*)(MOD + (size_t)(jn * 4 + b) * 6144) + lane; const f32x4* sc = sh + 512; const f32x4* gv = (const f32x4*)gvec + lane;
        v2u* d0 = (v2u*)(HG + (size_t)p0 * D_) + lane; v2u* d1 = (v2u*)(HG + (size_t)p1 * D_) + lane;
#pragma unroll
        for (int j = 0; j < 8; ++j) { const f32x4 h = v[j] * rstd * gv[64 * j] * (1.0f + sc[64 * j]) + sh[64 * j]; v2u w; w.x = pk2(h.x, h.y); w.y = pk2(h.z, h.w); d0[64 * j] = w; d1[64 * j] = w; }
    }
}

__device__ __forceinline__ void retnorm_phase(Frame& F) {
    PHASE_IDS(F);
    const int gw = F.vcu * NWAVES + wave, NGW = F.G * NWAVES;
    const bf16* O = (const bf16*)(F.ws + WS_RETO); const bf16* P1 = (const bf16*)(F.ws + WS_PROJ1); bf16* A5 = (bf16*)(F.ws + WS_A5);
    for (int row = gw; row < T_; row += NGW) {
        const v4u* o = (const v4u*)(O + (size_t)row * 4096) + lane; const v4u* g = (const v4u*)(P1 + (size_t)row * 12288 + 8192) + lane; v4u* a = (v4u*)(A5 + (size_t)row * 4096) + lane;
#pragma unroll
        for (int h = 0; h < 8; ++h) { const v4u x = o[64 * h], s = g[64 * h];
            float f[8] = {bf_lo(x.x), bf_hi(x.x), bf_lo(x.y), bf_hi(x.y), bf_lo(x.z), bf_hi(x.z), bf_lo(x.w), bf_hi(x.w)};
            float ss = 0.f;
#pragma unroll
            for (int i = 0; i < 8; ++i) ss += f[i] * f[i];
            const float rstd = 1.0f / sqrtf(wave_sum(ss) * (1.0f / 512.0f) + EPS_);
            v4u w; w.x = pk2(f[0] * rstd * bf_lo(s.x), f[1] * rstd * bf_hi(s.x)); w.y = pk2(f[2] * rstd * bf_lo(s.y), f[3] * rstd * bf_hi(s.y));
            w.z = pk2(f[4] * rstd * bf_lo(s.z), f[5] * rstd * bf_hi(s.z)); w.w = pk2(f[6] * rstd * bf_lo(s.w), f[7] * rstd * bf_hi(s.w));
            a[64 * h] = w; }
    }
}
#ifndef ATT_REP
#define ATT_REP 1
#endif
#ifndef RET_REP
#define RET_REP 1
#endif
#ifndef ATT_KPF
#define ATT_KPF 4
#endif
constexpr int ATT_VST = 320;
__device__ __forceinline__ s16x4 vtr(const LAS unsigned char* p) { return __builtin_bit_cast(s16x4, __builtin_amdgcn_ds_read_tr16_b64_v4i16((LAS v4i16_t*)p)); }
__device__ __forceinline__ float xhalf(float v) { return __shfl_xor(v, 32); }

template <int DQK, int MODE>
__device__ __forceinline__ void attn_unit(LAS unsigned char* lds, const bf16* Qp, int qpitch, const bf16* Kp, int kpitch, const bf16* K2p, int k2pitch,
                                          const bf16* Vp, int vpitch, bf16* Op, int opitch, int q0, float dlog2, int tid_, int wave, int lane_, volatile LAS unsigned* flg) {
    const int lane = lane_id_opaque(), tid = wave * 64 + lane; (void)tid_; (void)lane_;
    constexpr int RB = DQK * 2, SW = (DQK == 192) ? 7 : 15, KB = 64 * RB, STG = KB + 16384;
    constexpr int NIK = KB / 8192, NI = NIK + 2;
    constexpr int NKS = DQK / 16;
    static_assert(3 * STG <= RING_BYTES, "three stages in the ring");
    const int r = lane & 31, h = lane >> 5, qrow = q0 + 32 * wave + r;
    bf16x8 qf[NKS];
    { const bf16* qp = Qp + (size_t)qrow * qpitch + 8 * h;
#pragma unroll
      for (int ks = 0; ks < NKS; ++ks) qf[ks] = *(const bf16x8*)(qp + 16 * ks); }
    f32x16 o[4];
#pragma unroll
    for (int db = 0; db < 4; ++db)
#pragma unroll
        for (int i = 0; i < 16; ++i) o[db][i] = 0.f;
    float m_run = -1.0e30f, l_run = 0.f, carry = 0.f;
    const int ntiles = (q0 + 256) >> 6;
    constexpr bool KLIN = (DQK != 192); constexpr int NKG = KLIN ? 1 : NIK;
    unsigned kgo[NKG], vgo0; bool krope[NKG];
#pragma unroll
    for (int j = 0; j < NKG; ++j) { const int pos = (j * 8 + wave) * 1024 + lane * 16, row = pos / RB, c = ((pos % RB) >> 4) ^ (row & SW);
        krope[j] = (DQK == 192) && c >= 16;
        kgo[j] = krope[j] ? (unsigned)(row * k2pitch * 2 + (c - 16) * 16) : (unsigned)(row * kpitch * 2 + c * 16); }
    { const int pos = wave * 1024 + lane * 16, row = pos >> 8, ch = ((pos & 255) >> 4) ^ (((row & 3) << 2) | ((row >> 2) & 3)); vgo0 = (unsigned)(row * vpitch * 2 + ch * 16); }
#define ATT_DMA(kt, stg) do { const size_t key0_ = (size_t)(kt) * 64; \
        const char* kb_ = (const char*)Kp + key0_ * kpitch * 2; const char* k2_ = (const char*)K2p + key0_ * k2pitch * 2; const char* vb_ = (const char*)Vp + key0_ * vpitch * 2; \
        LAS unsigned char* st_ = lds + (stg) * STG + wave * 1024; \
        _Pragma("unroll") for (int j_ = 0; j_ < NIK; ++j_) { const char* g_ = KLIN ? kb_ + kgo[0] + (size_t)j_ * (8192 / RB) * kpitch * 2 : ((krope[KLIN ? 0 : j_] ? k2_ : kb_) + kgo[KLIN ? 0 : j_]); \
            __builtin_amdgcn_global_load_lds((const unsigned*)g_, (LAS unsigned*)(st_ + j_ * 8192), 16, 0, 0); } \
        _Pragma("unroll") for (int j_ = 0; j_ < 2; ++j_) __builtin_amdgcn_global_load_lds((const unsigned*)(vb_ + vgo0 + (size_t)j_ * 32 * vpitch * 2), (LAS unsigned*)(st_ + KB + j_ * 8192), 16, 0, 0); } while (0)
    if (MODE == 1 && tid < 16) flg[tid] = 0u;
    ATT_DMA(ntiles - 1, 0);
    ATT_DMA(ntiles > 1 ? ntiles - 2 : 0, 1);
    const int q4 = (lane & 15) >> 2, p4 = lane & 3, blk = (lane >> 4) & 1, x4 = 2 * blk + (p4 >> 1);
    constexpr int NKO = (SW + 1) / 2;
    const int krow = r * RB, kxy = (r & SW) ^ h;
    const int vlo_off = 256 * (4 * h + q4) + 16 * (x4 ^ h) + 8 * (p4 & 1), vhi_off = 256 * (4 * h + q4 + 8) + 16 * (x4 ^ (h + 2)) + 8 * (p4 & 1);
    for (int it = 0; it < ntiles; ++it) {
        const int kt = ntiles - 1 - it;
        int y_ = kxy, q4_ = q4; asm volatile("" : "+v"(y_), "+v"(q4_));
        const bool wdone = (MODE == 1) && __all(carry < -140.0f);
        if (MODE == 1 && lane == 0) flg[8 * (it & 1) + wave] = wdone ? 1u : 0u;
        asm volatile("s_waitcnt vmcnt(%0)" :: "n"(NI) : "memory");
        asm volatile("s_waitcnt lgkmcnt(0)" ::: "memory");
        __builtin_amdgcn_s_barrier();
        asm volatile("" ::: "memory");
        if (MODE == 1) { v4u fa, fb; const unsigned fad = (unsigned)(size_t)(flg + 8 * (it & 1));
            asm volatile("ds_read_b128 %0, %2\n\tds_read_b128 %1, %2 offset:16\n\ts_waitcnt lgkmcnt(0)" : "=&v"(fa), "=&v"(fb) : "v"(fad) : "memory");
            if ((fa.x & fa.y & fa.z & fa.w & fb.x & fb.y & fb.z & fb.w) != 0u) break; }
        { const int ktn = kt >= 2 ? kt - 2 : 0; ATT_DMA(ktn, (it + 2) % 3); }
        if (!wdone && 64 * kt <= q0 + 32 * wave + 31) {
            const LAS unsigned char* Kb = lds + (it % 3) * STG; const LAS unsigned char* Vb = Kb + KB;
            f32x16 s[2];
            const int kbase = 64 * kt + 4 * h;
            const bool diag = 64 * kt + 63 > q0 + 32 * wave;
            unsigned va[8];
#pragma unroll
            for (int db = 0; db < 4; ++db) { va[db] = (unsigned)(size_t)(Vb + vlo_off + 64 * (db ^ q4_)); va[4 + db] = (unsigned)(size_t)(Vb + vhi_off + 64 * (db ^ q4_)); }
            s16x4 lo_[2][4], hi_[2][4];
#define ATT_VRD(buf, sidx) do { _Pragma("unroll") for (int db = 0; db < 4; ++db) { \
                    asm volatile("ds_read_b64_tr_b16 %0, %1 offset:%c2" : "=&v"(lo_[buf][db]) : "v"(va[db]), "i"(4096 * (sidx)) : "memory"); \
                    asm volatile("ds_read_b64_tr_b16 %0, %1 offset:%c2" : "=&v"(hi_[buf][db]) : "v"(va[4 + db]), "i"(4096 * (sidx)) : "memory"); } } while (0)
#define ATT_VMM(buf, sidx) do { const int kb_ = (sidx) >> 1, ss_ = (sidx) & 1; \
                v4u pw; pw.x = pk2(s[kb_][8 * ss_ + 0], s[kb_][8 * ss_ + 1]); pw.y = pk2(s[kb_][8 * ss_ + 2], s[kb_][8 * ss_ + 3]); pw.z = pk2(s[kb_][8 * ss_ + 4], s[kb_][8 * ss_ + 5]); pw.w = pk2(s[kb_][8 * ss_ + 6], s[kb_][8 * ss_ + 7]); \
                const bf16x8 pf = __builtin_bit_cast(bf16x8, pw); \
                _Pragma("unroll") for (int db = 0; db < 4; ++db) { \
                    const bf16x8 vf = __builtin_shufflevector(lo_[buf][db], hi_[buf][db], 0, 1, 2, 3, 4, 5, 6, 7); \
                    o[db] = __builtin_amdgcn_mfma_f32_32x32x16_bf16(vf, pf, o[db], 0, 0, 0); } } while (0)
#define ATT_PVN(first, count) do { ATT_VRD(0, first); \
                _Pragma("unroll") for (int i_ = 0; i_ < (count); ++i_) { \
                    if (i_ + 1 < (count)) { if (i_ & 1) ATT_VRD(0, (first) + i_ + 1); else ATT_VRD(1, (first) + i_ + 1); asm volatile("s_waitcnt lgkmcnt(8)" ::: "memory"); } \
                    else asm volatile("s_waitcnt lgkmcnt(0)" ::: "memory"); \
                    __builtin_amdgcn_sched_barrier(0); \
                    if (i_ & 1) ATT_VMM(1, (first) + i_); else ATT_VMM(0, (first) + i_); \
                    __builtin_amdgcn_sched_barrier(0); } } while (0)
#pragma unroll
            for (int kb = 0; kb < 2; ++kb) {
#pragma unroll
                for (int i = 0; i < 16; ++i) s[kb][i] = 0.f;
                const LAS unsigned char* kp = Kb + 32 * kb * RB;
#define ATT_KF(ks) (*(const LAS bf16x8*)(kp + krow + (((2 * ((ks) % NKO)) ^ y_) << 4) + (((2 * (ks)) & ~SW) << 4)))
                bf16x8 fa = ATT_KF(0), fb = ATT_KF(1);
#pragma unroll
                for (int g2 = 0; g2 < NKS / 2; ++g2) {
                    bf16x8 na = fa, nb = fb;
                    if (g2 + 1 < NKS / 2) { na = ATT_KF(2 * g2 + 2); nb = ATT_KF(2 * g2 + 3); }
                    __builtin_amdgcn_sched_barrier(0);
                    s[kb] = __builtin_amdgcn_mfma_f32_32x32x16_bf16(fa, qf[2 * g2], s[kb], 0, 0, 0); s[kb] = __builtin_amdgcn_mfma_f32_32x32x16_bf16(fb, qf[2 * g2 + 1], s[kb], 0, 0, 0);
                    __builtin_amdgcn_sched_barrier(0);
                    fa = na; fb = nb;
                }
#undef ATT_KF
                if (MODE == 2) {
                    if (diag) {
#pragma unroll
                        for (int i = 0; i < 16; ++i) { const int key = kbase + 32 * kb + (i & 3) + 8 * (i >> 2); s[kb][i] = key <= qrow ? s[kb][i] : 0.f; } }
                    ATT_PVN(2 * kb, 2);
                }
            }
            if (MODE == 0) {
                float tmax = -1.0e30f;
#pragma unroll
                for (int kb = 0; kb < 2; ++kb)
#pragma unroll
                    for (int i = 0; i < 16; ++i) { const int key = kbase + 32 * kb + (i & 3) + 8 * (i >> 2); const float v = (!diag || key <= qrow) ? s[kb][i] : -1.0e30f; s[kb][i] = v; tmax = fmaxf(tmax, v); }
                tmax = fmaxf(tmax, xhalf(tmax));
                const float m_new = fmaxf(m_run, tmax), alpha = ex2(m_run - m_new); m_run = m_new;
                float ps = 0.f;
#pragma unroll
                for (int kb = 0; kb < 2; ++kb)
#pragma unroll
                    for (int i = 0; i < 16; ++i) { const float p = ex2(s[kb][i] - m_new); s[kb][i] = p; ps += p; }
                l_run = l_run * alpha + ps;
#pragma unroll
                for (int db = 0; db < 4; ++db)
#pragma unroll
                    for (int i = 0; i < 16; ++i) o[db][i] *= alpha;
            } else if (MODE == 1) {
                float lkv[2][16], gs[2][4], go[2][4];
#pragma unroll
                for (int kb = 0; kb < 2; ++kb)
#pragma unroll
                    for (int g = 0; g < 4; ++g) { float t = 0.f;
#pragma unroll
                        for (int j = 0; j < 4; ++j) { const int i = 4 * g + j, key = kbase + 32 * kb + 8 * g + j; const float z = s[kb][i];
                            const bool vis = key < qrow;
                            const float lk = vis ? -(fmaxf(z, 0.f) + lg2(1.0f + ex2(-fabsf(z)))) : 0.f;
                            lkv[kb][i] = lk; s[kb][i] = vis ? z + lk : -1.0e30f; t += lk; }
                        gs[kb][g] = t; }
#pragma unroll
                for (int kb = 0; kb < 2; ++kb)
#pragma unroll
                    for (int g = 0; g < 4; ++g) go[kb][g] = xhalf(gs[kb][g]);
                float R = carry;
#pragma unroll
                for (int kb = 1; kb >= 0; --kb)
#pragma unroll
                    for (int g = 3; g >= 0; --g) {
                        float run = R + (h == 0 ? go[kb][g] : 0.f);
#pragma unroll
                        for (int j = 3; j >= 0; --j) { const int i = 4 * g + j; const float a = ex2(s[kb][i] + run); run += lkv[kb][i]; s[kb][i] = a; }
                        R += gs[kb][g] + go[kb][g];
                    }
                carry = R;
            }
            if (MODE != 2) { ATT_PVN(0, 4); }
#undef ATT_PVN
#undef ATT_VMM
#undef ATT_VRD
        }
    }
#undef ATT_DMA
    asm volatile("s_waitcnt vmcnt(0) lgkmcnt(0)" ::: "memory");
    __builtin_amdgcn_s_barrier();
    asm volatile("" ::: "memory");
    float inv = 1.0f;
    if (MODE == 0) { const float lt = l_run + xhalf(l_run); inv = 1.0f / lt; }
    bf16* op = Op + (size_t)qrow * opitch + 4 * h;
#pragma unroll
    for (int db = 0; db < 4; ++db)
#pragma unroll
        for (int g = 0; g < 4; ++g) { v2u w; w.x = pk2(o[db][4 * g] * inv, o[db][4 * g + 1] * inv); w.y = pk2(o[db][4 * g + 2] * inv, o[db][4 * g + 3] * inv); *(v2u*)(op + 32 * db + 8 * g) = w; }
}

struct WorkQ { gu32* q; int total; int slot; unsigned nxt; };
__device__ __forceinline__ void wq_init(Frame& F, WorkQ& Q, gu32* q, int total, int slot, int lane) {
    Q.q = q; Q.total = total; Q.slot = slot; Q.nxt = 0u;
    if (F.wave == 0 && lane == 0) Q.nxt = __hip_atomic_fetch_add(q, 1u, RLX_AGENT);
}
__device__ __forceinline__ bool wq_take(Frame& F, WorkQ& Q, int lane, int& u) {
    if (F.wave == 0 && lane == 0) F.MISC[Q.slot] = Q.nxt;
    __syncthreads();
    u = (int)F.MISC[Q.slot];
    __syncthreads();
    if (u >= Q.total) return false;
    if (F.wave == 0 && lane == 0) Q.nxt = __hip_atomic_fetch_add(Q.q, 1u, RLX_AGENT);
    return true;
}
template <int STREAM> __device__ __forceinline__ bool conv_batch(Frame& F, const Args& A, WorkQ& Q, int lane, int wave) {
    int b; if (!wq_take(F, Q, lane, b)) return false;
    const int i0 = 32 * b + 4 * wave;
    const ConvSrc c0 = conv_item<STREAM>(A, F.ws, i0), c1 = conv_item<STREAM>(A, F.ws, i0 + 1), c2 = conv_item<STREAM>(A, F.ws, i0 + 2), c3 = conv_item<STREAM>(A, F.ws, i0 + 3);
    f32x4 v0[8], v1[8], v2[8], v3[8];
    conv_load(c0, lane, v0); conv_load(c1, lane, v1); conv_load(c2, lane, v2); conv_load(c3, lane, v3);
    conv_store(c0, lane, v0); conv_store(c1, lane, v1); conv_store(c2, lane, v2); conv_store(c3, lane, v3);
    return true;
}
__device__ __forceinline__ void mla_phase(Frame& F, const Args& A, WorkQ& QC, bool& conv_left) {
    PHASE_IDS(F);
    WorkQ QU; wq_init(F, QU, F.ctl + CW_QMLA, 256, 16, lane);
    if (F.vcu & 1) { for (int i = 0; i < 2 && conv_left; ++i) conv_left = conv_batch<1>(F, A, QC, lane, wave); }
    const bf16* Q = (const bf16*)(F.ws + WS_QMLA); const bf16* KV = (const bf16*)(F.ws + WS_KVMLA); const bf16* KR = (const bf16*)(F.ws + WS_KR); bf16* O = (bf16*)(F.ws + WS_ATTO);
    int u;
    while (wq_take(F, QU, lane, u)) {
        const int qb = 7 - (u >> 5), bh = u & 31, b = bh >> 3, h = bh & 7; const size_t r0 = (size_t)b * S_;
#pragma unroll 1
        for (int rep_ = 0; rep_ < ATT_REP; ++rep_)
        attn_unit<192, 0>(F.lds + RING_OFF, Q + r0 * 1536 + h * 192, 1536, KV + r0 * 2048 + h * 256, 2048, KR + r0 * 64, 64, KV + r0 * 2048 + h * 256 + 128, 2048,
                          O + r0 * 2048 + 1024 + h * 128, 2048, qb * 256, 0.f, tid, wave, lane, F.MISC + 32);
        for (int i = 0; i < 4 && conv_left; ++i) conv_left = conv_batch<1>(F, A, QC, lane, wave);
    }
}
__device__ __forceinline__ void sb_phase(Frame& F, const Args& A, WorkQ& QC, bool& conv_left) {
    PHASE_IDS(F);
    WorkQ QU; wq_init(F, QU, F.ctl + CW_QSB, 256, 17, lane);
    const bf16* P0 = (const bf16*)(F.ws + WS_PROJ0); bf16* O = (bf16*)(F.ws + WS_ATTO);
    int u;
    while (wq_take(F, QU, lane, u)) {
        const int qb = 7 - (u >> 5), bh = u & 31, b = bh >> 3, h = bh & 7; const size_t r0 = (size_t)b * S_;
#pragma unroll 1
        for (int rep_ = 0; rep_ < ATT_REP; ++rep_)
        attn_unit<128, 1>(F.lds + RING_OFF, P0 + r0 * 4096 + h * 128, 4096, P0 + r0 * 4096 + 1024 + h * 128, 4096, nullptr, 0, P0 + r0 * 4096 + 2048 + h * 128, 4096,
                          O + r0 * 2048 + h * 128, 2048, qb * 256, 0.f, tid, wave, lane, F.MISC + 32);
        for (int i = 0; i < 4 && conv_left; ++i) conv_left = conv_batch<1>(F, A, QC, lane, wave);
    }
    while (conv_left) conv_left = conv_batch<1>(F, A, QC, lane, wave);
}
__device__ __forceinline__ void ret_phase(Frame& F, const Args& A) {
    PHASE_IDS(F);
    WorkQ QC; wq_init(F, QC, F.ctl + CW_QC2, CONV_N2 / 32, 18, lane); bool conv_left = true;
    WorkQ QU; wq_init(F, QU, F.ctl + CW_QRET, 1024, 16, lane);
    if (F.vcu & 1) conv_left = conv_batch<2>(F, A, QC, lane, wave);
    const bf16* P1 = (const bf16*)(F.ws + WS_PROJ1); bf16* O = (bf16*)(F.ws + WS_RETO);
    int u;
    while (wq_take(F, QU, lane, u)) {
        const int qb = 7 - (u >> 7), rem = u & 127, eq = rem >> 5, bh = rem & 31, b = bh >> 3, h = bh & 7; const size_t r0 = (size_t)b * S_;
        const float dlog2 = log1pf(-exp2f(-5.0f - (float)h)) * LOG2E;
#pragma unroll 1
        for (int rep_ = 0; rep_ < RET_REP; ++rep_)
        attn_unit<256, 2>(F.lds + RING_OFF, P1 + r0 * 12288 + h * 256, 12288, P1 + r0 * 12288 + 2048 + h * 256, 12288, nullptr, 0, P1 + r0 * 12288 + 4096 + h * 512 + eq * 128, 12288,
                          O + r0 * 4096 + h * 512 + eq * 128, 4096, qb * 256, dlog2, tid, wave, lane, F.MISC + 32);
        for (int i = 0; i < 2 && conv_left; ++i) conv_left = conv_batch<2>(F, A, QC, lane, wave);
    }
    while (conv_left) conv_left = conv_batch<2>(F, A, QC, lane, wave);
}
typedef f32x4 AccT[2][2][4][2];
__device__ __forceinline__ v4u pack8(const f32x4& a, const f32x4& b) { v4u w; w.x = pk2(a.x, a.y); w.y = pk2(a.z, a.w); w.z = pk2(b.x, b.y); w.w = pk2(b.z, b.w); return w; }
__device__ __forceinline__ float sq4(const f32x4& a) { return (a.x * a.x + a.y * a.y) + (a.z * a.z + a.w * a.w); }
__device__ __forceinline__ void rope4(const f32x4& x1, const f32x4& x2, const f32x2* cs, f32x4& o1, f32x4& o2) {
    const f32x4 c01 = *(const f32x4*)cs, c23 = *(const f32x4*)(cs + 2);
    o1.x = x1.x * c01.x - x2.x * c01.y; o2.x = x1.x * c01.y + x2.x * c01.x;
    o1.y = x1.y * c01.z - x2.y * c01.w; o2.y = x1.y * c01.w + x2.y * c01.z;
    o1.z = x1.z * c23.x - x2.z * c23.y; o2.z = x1.z * c23.y + x2.z * c23.x;
    o1.w = x1.w * c23.z - x2.w * c23.w; o2.w = x1.w * c23.w + x2.w * c23.z;
}
struct EpiG1 { static constexpr bool PERM = true, AFTER_DRAIN = false;
    bf16* P0; bf16* KR; float* ssqp; const f32x2* cs64;
    __device__ __forceinline__ void operator()(const AccT& acc, const pg8::Unit& u, int wr, int wc, int fr, int fq) const {
        const int row0 = u.pm * 256 + wr * 64 + fr, tc = wc * 32 + 8 * fq;
        if (u.pn < 15) {
            const float scl = u.pn < 4 ? C_SB : 1.0f;
#pragma unroll
            for (int ai = 0; ai < 2; ++ai)
#pragma unroll
                for (int m = 0; m < 4; ++m) { const int row = row0 + ai * 128 + m * 16; float ss = 0.f;
#pragma unroll
                    for (int bj = 0; bj < 2; ++bj) { const f32x4 v0 = acc[ai][bj][m][0], v1 = acc[ai][bj][m][1]; ss += sq4(v0) + sq4(v1);
                        *(v4u*)(P0 + (size_t)row * 4096 + u.pn * 256 + bj * 128 + tc) = pack8(v0 * scl, v1 * scl); }
                    if (u.pn >= 12) { ss += __shfl_xor(ss, 16); ss += __shfl_xor(ss, 32); if (fq == 0) { if (u.pn < 14) ssqp[(size_t)row * 8 + 4 * (u.pn - 12) + wc] = ss; else ssqp[(size_t)T_ * 8 + (size_t)row * 4 + wc] = ss; } } }
        } else if (wc == 0) {
#pragma unroll
            for (int ai = 0; ai < 2; ++ai)
#pragma unroll
                for (int m = 0; m < 4; ++m) { const int row = row0 + ai * 128 + m * 16; f32x4 a0, b0, a1, b1;
                    rope4(acc[ai][0][m][0], acc[ai][1][m][0], cs64 + (size_t)row * 32 + 8 * fq, a0, b0);
                    rope4(acc[ai][0][m][1], acc[ai][1][m][1], cs64 + (size_t)row * 32 + 8 * fq + 4, a1, b1);
                    *(v4u*)(KR + (size_t)row * 64 + 8 * fq) = pack8(a0, a1); *(v4u*)(KR + (size_t)row * 64 + 32 + 8 * fq) = pack8(b0, b1); asm volatile("" ::: "memory"); }
        }
    }
};
struct EpiG2q { static constexpr bool PERM = true, AFTER_DRAIN = false;
    bf16* Q; const float* ssq; const f32x2* cs64;
    __device__ __forceinline__ void operator()(const AccT& acc, const pg8::Unit& u, int wr, int wc, int fr, int fq) const {
        const int row0 = u.pm * 256 + wr * 64 + fr, tc = wc * 32 + 8 * fq;
        if (u.pn < 4) {
#pragma unroll
            for (int ai = 0; ai < 2; ++ai)
#pragma unroll
                for (int m = 0; m < 4; ++m) { const int row = row0 + ai * 128 + m * 16; const f32x4 pa = *(const f32x4*)(ssq + (size_t)row * 8), pb = *(const f32x4*)(ssq + (size_t)row * 8 + 4); const float rs = C_MLA * __builtin_amdgcn_rsqf(((((((pa.x + pa.y) + pa.z) + pa.w) + pb.x) + pb.y) + pb.z + pb.w) * (1.0f / 512.0f) + EPS_);
#pragma unroll
                    for (int bj = 0; bj < 2; ++bj) { const int nidx = u.pn * 256 + bj * 128 + tc, hh = nidx >> 7, d = nidx & 127;
                        *(v4u*)(Q + (size_t)row * 1536 + hh * 192 + d) = pack8(acc[ai][bj][m][0] * rs, acc[ai][bj][m][1] * rs); }
                    asm volatile("" ::: "memory"); }
        } else {
            const int head = 4 * (u.pn - 4) + wc;
#pragma unroll
            for (int ai = 0; ai < 2; ++ai)
#pragma unroll
                for (int m = 0; m < 4; ++m) { const int row = row0 + ai * 128 + m * 16; const f32x4 pa = *(const f32x4*)(ssq + (size_t)row * 8), pb = *(const f32x4*)(ssq + (size_t)row * 8 + 4); const float rs = C_MLA * __builtin_amdgcn_rsqf(((((((pa.x + pa.y) + pa.z) + pa.w) + pb.x) + pb.y) + pb.z + pb.w) * (1.0f / 512.0f) + EPS_); f32x4 a0, b0, a1, b1;
                    rope4(acc[ai][0][m][0] * rs, acc[ai][1][m][0] * rs, cs64 + (size_t)row * 32 + 8 * fq, a0, b0);
                    rope4(acc[ai][0][m][1] * rs, acc[ai][1][m][1] * rs, cs64 + (size_t)row * 32 + 8 * fq + 4, a1, b1);
                    *(v4u*)(Q + (size_t)row * 1536 + head * 192 + 128 + 8 * fq) = pack8(a0, a1); *(v4u*)(Q + (size_t)row * 1536 + head * 192 + 160 + 8 * fq) = pack8(b0, b1);
                    asm volatile("" ::: "memory"); }
        }
    }
};
struct EpiG2kv { static constexpr bool PERM = true, AFTER_DRAIN = false;
    bf16* KV; const float* ssq;
    __device__ __forceinline__ void operator()(const AccT& acc, const pg8::Unit& u, int wr, int wc, int fr, int fq) const {
        const int row0 = u.pm * 256 + wr * 64 + fr, tc = wc * 32 + 8 * fq;
#pragma unroll
        for (int ai = 0; ai < 2; ++ai)
#pragma unroll
            for (int m = 0; m < 4; ++m) { const int row = row0 + ai * 128 + m * 16; const f32x4 pa = *(const f32x4*)(ssq + (size_t)row * 4); const float rs = __builtin_amdgcn_rsqf((((pa.x + pa.y) + pa.z) + pa.w) * (1.0f / 256.0f) + EPS_);
#pragma unroll
                for (int bj = 0; bj < 2; ++bj) *(v4u*)(KV + (size_t)row * 2048 + u.pn * 256 + bj * 128 + tc) = pack8(acc[ai][bj][m][0] * rs, acc[ai][bj][m][1] * rs); asm volatile("" ::: "memory"); }
    }
};
struct EpiRes { static constexpr bool PERM = false, AFTER_DRAIN = false;
    const float* src; float* dst; const float* gate;
    __device__ __forceinline__ void operator()(const AccT& acc, const pg8::Unit& u, int wr, int wc, int fr, int fq) const {
        const int row0 = u.pm * 256 + wr * 64 + fr, col0 = u.pn * 256 + wc * 32 + 4 * fq;
#pragma unroll
        for (int ai = 0; ai < 2; ++ai)
#pragma unroll
            for (int m = 0; m < 4; ++m) { const int row = row0 + ai * 128 + m * 16; const float* g = gate + (size_t)(row >> 11) * 6144 + col0; const size_t off = (size_t)row * 2048 + col0;
#pragma unroll
                for (int bj = 0; bj < 2; ++bj)
#pragma unroll
                    for (int n = 0; n < 2; ++n) { const int o = bj * 128 + n * 16; *(f32x4*)(dst + off + o) = *(const f32x4*)(src + off + o) + *(const f32x4*)(g + o) * acc[ai][bj][m][n]; } asm volatile("" ::: "memory"); }
    }
};
struct EpiG4 { static constexpr bool PERM = true, AFTER_DRAIN = false;
    bf16* P1; const f32x2* cs256;
    __device__ __forceinline__ void operator()(const AccT& acc, const pg8::Unit& u, int wr, int wc, int fr, int fq) const {
        const int row0 = u.pm * 256 + wr * 64 + fr, tc = wc * 32 + 8 * fq;
#pragma unroll
        for (int ai = 0; ai < 2; ++ai)
#pragma unroll
            for (int m = 0; m < 4; ++m) { const int row = row0 + ai * 128 + m * 16; bf16* dst = P1 + (size_t)row * 12288 + u.pn * 256 + tc;
                if (u.pn < 16) {
                    const float dl2 = log1pf(-exp2f(-5.0f - (float)(u.pn & 7))) * LOG2E, rel = (float)((row & 2047) - 1024);
                    const float scl = u.pn >= 8 ? 0.0625f * ex2(-dl2 * rel) : ex2(dl2 * rel); f32x4 a0, b0, a1, b1;
                    rope4(acc[ai][0][m][0] * scl, acc[ai][1][m][0] * scl, cs256 + (size_t)row * 128 + tc, a0, b0);
                    rope4(acc[ai][0][m][1] * scl, acc[ai][1][m][1] * scl, cs256 + (size_t)row * 128 + tc + 4, a1, b1);
                    *(v4u*)dst = pack8(a0, a1); *(v4u*)(dst + 128) = pack8(b0, b1);
                } else if (u.pn < 32) {
#pragma unroll
                    for (int bj = 0; bj < 2; ++bj) *(v4u*)(dst + bj * 128) = pack8(acc[ai][bj][m][0], acc[ai][bj][m][1]);
                } else {
#pragma unroll
                    for (int bj = 0; bj < 2; ++bj) { f32x4 v0 = acc[ai][bj][m][0], v1 = acc[ai][bj][m][1];
                        v0.x = silu_f(v0.x); v0.y = silu_f(v0.y); v0.z = silu_f(v0.z); v0.w = silu_f(v0.w); v1.x = silu_f(v1.x); v1.y = silu_f(v1.y); v1.z = silu_f(v1.z); v1.w = silu_f(v1.w);
                        *(v4u*)(dst + bj * 128) = pack8(v0, v1); }
                } asm volatile("" ::: "memory"); }
    }
};
struct EpiM3 { static constexpr bool PERM = true, AFTER_DRAIN = false;
    bf16* ACT;
    __device__ __forceinline__ void operator()(const AccT& acc, const pg8::Unit& u, int wr, int wc, int fr, int fq) const {
        const int row0 = u.pm * 256 + wr * 64 + fr, tc = wc * 32 + 8 * fq;
#pragma unroll
        for (int ai = 0; ai < 2; ++ai)
#pragma unroll
            for (int m = 0; m < 4; ++m) { const int row = row0 + ai * 128 + m * 16; const f32x4 g0 = acc[ai][0][m][0], g1 = acc[ai][0][m][1], u0 = acc[ai][1][m][0], u1 = acc[ai][1][m][1]; f32x4 a0, a1;
                a0.x = silu_f(g0.x) * u0.x; a0.y = silu_f(g0.y) * u0.y; a0.z = silu_f(g0.z) * u0.z; a0.w = silu_f(g0.w) * u0.w;
                a1.x = silu_f(g1.x) * u1.x; a1.y = silu_f(g1.y) * u1.y; a1.z = silu_f(g1.z) * u1.z; a1.w = silu_f(g1.w) * u1.w;
                *(v4u*)(ACT + (size_t)row * 512 + u.pn * 128 + tc) = pack8(a0, a1); }
    }
};
struct EpiM4 { static constexpr bool PERM = true, AFTER_DRAIN = false;
    bf16* Y;
    __device__ __forceinline__ void operator()(const AccT& acc, const pg8::Unit& u, int wr, int wc, int fr, int fq) const {
        const int row0 = u.pm * 256 + wr * 64 + fr, tc = wc * 32 + 8 * fq;
#pragma unroll
        for (int ai = 0; ai < 2; ++ai)
#pragma unroll
            for (int m = 0; m < 4; ++m) { const int row = row0 + ai * 128 + m * 16;
#pragma unroll
                for (int bj = 0; bj < 2; ++bj) *(v4u*)(Y + (size_t)row * 2048 + u.pn * 256 + bj * 128 + tc) = pack8(acc[ai][bj][m][0], acc[ai][bj][m][1]); }
    }
};
__device__ __forceinline__ void moe_tables(Frame& F, int layer) {
    LAS int* tab = (LAS int*)(F.lds + MOE_TAB_OFF);
    __syncthreads();
    if (F.wave == 0) { const int lane = lane_id_opaque();
        const int cnt = lane < 32 ? (int)__hip_atomic_load(F.ctl + CW_ECNT + 64 * layer + lane, RLX_AGENT) : 0; const int nt = (cnt + 255) >> 8;
        int incl = nt;
#pragma unroll
        for (int off = 1; off < 32; off <<= 1) { const int v = __shfl_up(incl, off); if (lane >= off) incl += v; }
        const int start = incl - nt;
        if (lane < 32) { tab[128 + lane] = 256 * start; for (int i = 0; i < nt && start + i < 96; ++i) tab[start + i] = lane; }
        if (lane == 31) tab[160] = incl < 96 ? incl : 96; }
    __syncthreads();
}

#ifndef PH_MASK
#define PH_MASK 0x7FFFFFu
#endif
#ifndef PH_DUP
#define PH_DUP 0u
#endif
#define REP(k) _Pragma("unroll 1") for (int rep_ = 0; rep_ < ((((PH_DUP) >> (k)) & 1u) ? 2 : 1); ++rep_)
#define IN(k) (((PH_MASK >> (k)) & 1u) && lo <= (k) && (k) < hi)
#define SEAM(k) do { if (IN(k) && IN((k) + 1)) xcd_barrier(bar, F.wave); } while (0)
template <int LAYER, int PB> __device__ __forceinline__ void moe_phases(Frame& F, const Args& args, const XcdBarrier& bar, int lo, int hi) {
    unsigned char* ws = F.ws; LAS unsigned char* ring = F.lds + RING_OFF; const int c = (int)blockIdx.x;
    if (IN(PB)) { router_phase(F, args, (const float*)(ws + WS_XA), args.in[8] + LAYER * 2048, 2 * LAYER + 1, LAYER, true);
#if defined(ROUTER_TWICE)
        router_phase(F, args, (const float*)(ws + WS_XA), args.in[8] + LAYER * 2048, 2 * LAYER + 1, LAYER, false);
#endif
    } SEAM(PB);
    if (IN(PB + 1)) { moe_tables(F, LAYER); scatter_phase(F, (const float*)(ws + WS_XA), args.in[8] + LAYER * 2048, 2 * LAYER + 1, LAYER, true);
#if defined(SCATTER_TWICE)
        scatter_phase(F, (const float*)(ws + WS_XA), args.in[8] + LAYER * 2048, 2 * LAYER + 1, LAYER, false);
#endif
    } SEAM(PB + 1);
    if (IN(PB + 2)) {
        moe_tables(F, LAYER); const LAS int* tab = (const LAS int*)(F.lds + MOE_TAB_OFF); const int TM = tab[160], TA = (TM + 1) >> 1;
        pg8::Gemm g{2048, 2048, 2048}; pg8::MoeOrder S; S.ntn = 4; S.t0 = 0; S.nunits = TA * 4; S.gdeal = F.G; S.busy = 0; S.G = F.G; S.c = c; S.A = (const char*)(ws + WS_HG); S.W = (const char*)(ws + WS_W_GU + (size_t)LAYER * 128 * MiB);
        S.tstepA = (size_t)256 * 2048 * 2; S.tstepB = (size_t)256 * 2048 * 2; S.estep = (size_t)1024 * 2048 * 2; S.tile_expert = tab;
        EpiM3 E{(bf16*)(ws + WS_ACT)};
        pg8::gemm_phase<EpiM3, pg8::MoeOrder, true, true>(ring, g, S, E, F.wave);
#if defined(M3_TWICE)
        pg8::gemm_phase<EpiM3, pg8::MoeOrder, true, true>(ring, g, S, E, F.wave);
#endif
    } SEAM(PB + 2);
    if (IN(PB + 3)) {
        moe_tables(F, LAYER); const LAS int* tab = (const LAS int*)(F.lds + MOE_TAB_OFF); const int TM = tab[160], TA = (TM + 1) >> 1, nb3 = (TM - TA) * 4;
        { pg8::Gemm g{2048, 2048, 2048}; pg8::MoeOrder S; S.ntn = 4; S.t0 = TA; S.nunits = nb3; S.gdeal = nb3 < F.G ? nb3 : F.G; S.busy = 0; S.G = F.G; S.c = c; S.A = (const char*)(ws + WS_HG); S.W = (const char*)(ws + WS_W_GU + (size_t)LAYER * 128 * MiB);
          S.tstepA = (size_t)256 * 2048 * 2; S.tstepB = (size_t)256 * 2048 * 2; S.estep = (size_t)1024 * 2048 * 2; S.tile_expert = tab;
          EpiM3 E{(bf16*)(ws + WS_ACT)};
          pg8::gemm_phase<EpiM3, pg8::MoeOrder, true, true>(ring, g, S, E, F.wave); }
        { pg8::Gemm g{512, 512, 512}; pg8::MoeOrder S; S.ntn = 8; S.t0 = 0; S.nunits = TA * 8; S.gdeal = F.G; S.busy = (nb3 > 0 && nb3 < F.G) ? nb3 : 0; S.G = F.G; S.c = c; S.A = (const char*)(ws + WS_ACT); S.W = (const char*)(ws + WS_W_DN + (size_t)LAYER * 64 * MiB);
          S.tstepA = (size_t)256 * 512 * 2; S.tstepB = (size_t)256 * 512 * 2; S.estep = (size_t)2048 * 512 * 2; S.tile_expert = tab;
          EpiM4 E{(bf16*)(ws + WS_Y)};
          pg8::gemm_phase<EpiM4, pg8::MoeOrder, true, true>(ring, g, S, E, F.wave); }
    } SEAM(PB + 3);
    if (IN(PB + 4)) {
        moe_tables(F, LAYER); const LAS int* tab = (const LAS int*)(F.lds + MOE_TAB_OFF); const int TM = tab[160], TA = (TM + 1) >> 1;
        pg8::Gemm g{512, 512, 512}; pg8::MoeOrder S; S.ntn = 8; S.t0 = TA; S.nunits = (TM - TA) * 8; S.gdeal = F.G; S.busy = 0; S.G = F.G; S.c = c; S.A = (const char*)(ws + WS_ACT); S.W = (const char*)(ws + WS_W_DN + (size_t)LAYER * 64 * MiB);
        S.tstepA = (size_t)256 * 512 * 2; S.tstepB = (size_t)256 * 512 * 2; S.estep = (size_t)2048 * 512 * 2; S.tile_expert = tab;
        EpiM4 E{(bf16*)(ws + WS_Y)};
        pg8::gemm_phase<EpiM4, pg8::MoeOrder, true, true>(ring, g, S, E, F.wave);
#if defined(M4_TWICE)
        pg8::gemm_phase<EpiM4, pg8::MoeOrder, true, true>(ring, g, S, E, F.wave);
#endif
    } SEAM(PB + 4);
}
__global__ void __launch_bounds__(NWAVES * 64, 2) mk_fwd(Args args) {
    extern __shared__ __attribute__((aligned(16))) unsigned char lds[];
    Frame F;
    F.lds = (LAS unsigned char*)lds;
    F.MISC = (volatile LAS unsigned*)(F.lds + MISC_OFF);
    F.wave = __builtin_amdgcn_readfirstlane((int)threadIdx.x >> 6);
    F.G = gridDim.x; { const int bx = blockIdx.x; F.vcu = (F.G % 8 == 0) ? (bx % 8) * (F.G / 8) + bx / 8 : bx; }
    F.ws = args.ws; F.ctl = (gu32*)(args.ws + WS_CTL); F.out = args.out;
    for (int u = threadIdx.x; u < (LDS_BYTES - LDSCTL_OFF) / 4; u += NWAVES * 64) ((LAS unsigned*)(F.lds + LDSCTL_OFF))[u] = 0u;
    __syncthreads();
    XcdBarrier bar; bar.bar = (unsigned*)(F.ctl + CW_BAR); bar.x = 0; bar.st = nullptr;
    if (!MK_MULTI) bar = xcd_barrier_post((unsigned*)(F.ctl + CW_BAR), F.MISC + 8, F.wave);
    const int lo = args.ph_lo, hi = args.ph_hi;
    unsigned char* ws = args.ws;
    const float* MOD = (const float*)(F.ctl + CW_MOD);
    LAS unsigned char* ring = F.lds + RING_OFF;
    const int c = (int)blockIdx.x;

    if (IN(0)) REP(0) { p0a_mod_partials(F, args); } SEAM(0);
    if (IN(1)) REP(1) { p0_prologue(F, args); local_mod(F, args.in[4], 0); norm_phase<0, true>(F, args.in[0], nullptr, args.in[5], 0, 0, 0); } SEAM(1);
    if (IN(3)) REP(3) {
        pg8::Gemm g{2048, 2048, 2048}; pg8::StaticOrder S; S.init(T_, 4096, F.G, c, ws + WS_H, 2048, ws + WS_W_IN0T, 2048);
        EpiG1 E{(bf16*)(ws + WS_PROJ0), (bf16*)(ws + WS_KR), (float*)(ws + WS_SSQP), (const f32x2*)(ws + WS_TAB64)};
        pg8::gemm_phase<EpiG1, pg8::StaticOrder, true, true>(ring, g, S, E, F.wave);
    } SEAM(3);
    if (IN(4)) REP(4) {
        { pg8::Gemm g{512, 4096, 512}; pg8::StaticOrder S; S.init(T_, 1536, F.G, c, ws + WS_PROJ0 + 3072 * 2, 4096, ws + WS_W_QUPT, 512);
          EpiG2q E{(bf16*)(ws + WS_QMLA), (const float*)(ws + WS_SSQP), (const f32x2*)(ws + WS_TAB64)};
          pg8::gemm_phase<EpiG2q, pg8::StaticOrder, true, true>(ring, g, S, E, F.wave); }
        { pg8::Gemm g{256, 4096, 256}; pg8::StaticOrder S; S.init(T_, 2048, F.G, c, ws + WS_PROJ0 + 3584 * 2, 4096, ws + WS_W_KVUPT, 256);
          EpiG2kv E{(bf16*)(ws + WS_KVMLA), (const float*)(ws + WS_SSQP) + (size_t)T_ * 8};
          pg8::gemm_phase<EpiG2kv, pg8::StaticOrder, true, true>(ring, g, S, E, F.wave); }
    } SEAM(4);
    if (IN(5)) REP(5) { bool conv_left = true; WorkQ QC; wq_init(F, QC, F.ctl + CW_QC1, CONV_N1 / 32, 18, lane_id_opaque()); mla_phase(F, args, QC, conv_left); sb_phase(F, args, QC, conv_left); } SEAM(5);
    if (IN(6)) REP(6) {
        pg8::Gemm g{2048, 2048, 2048}; pg8::StaticOrder S; S.init(T_, 2048, F.G, c, ws + WS_ATTO, 2048, ws + WS_W_OUT0T, 2048);
        EpiRes E{args.in[0], (float*)(ws + WS_XA), MOD + (size_t)(0 * 4) * 6144 + 4096};
        pg8::gemm_phase<EpiRes, pg8::StaticOrder, true, true>(ring, g, S, E, F.wave);
    } SEAM(6);
    moe_phases<0, 7>(F, args, bar, lo, hi);
    if (IN(12)) REP(12) { norm_phase<2>(F, (const float*)(ws + WS_XA), (float*)(ws + WS_XB), args.in[5] + 2048, 2, 1, 0); } SEAM(12);
    if (IN(13)) REP(13) {
        pg8::Gemm g{2048, 2048, 2048}; pg8::StaticOrder S; S.init(T_, 12288, F.G, c, ws + WS_H, 2048, ws + WS_W_IN1T, 2048);
        EpiG4 E{(bf16*)(ws + WS_PROJ1), (const f32x2*)(ws + WS_TAB256)};
        pg8::gemm_phase<EpiG4, pg8::StaticOrder, true, true>(ring, g, S, E, F.wave);
    } SEAM(13);
    if (IN(14)) REP(14) { ret_phase(F, args); } SEAM(14);
    if (IN(15)) REP(15) { retnorm_phase(F); } SEAM(15);
    if (IN(16)) REP(16) {
        pg8::Gemm g{4096, 4096, 4096}; pg8::StaticOrder S; S.init(T_, 2048, F.G, c, ws + WS_A5, 4096, ws + WS_W_OUT1T, 4096);
        EpiRes E{(const float*)(ws + WS_XB), (float*)(ws + WS_XA), MOD + (size_t)(2 * 4) * 6144 + 4096};
        pg8::gemm_phase<EpiRes, pg8::StaticOrder, true, true>(ring, g, S, E, F.wave);
    } SEAM(16);
    moe_phases<1, 17>(F, args, bar, lo, hi);
    if (IN(22)) REP(22) { norm_phase<3>(F, (const float*)(ws + WS_XA), nullptr, args.in[24], 0, 3, 1); }
}
#undef IN
#undef SEAM

extern "C" void kernel_launch(void* const* d_in, const int* in_sizes, int n_in, void* d_out, int out_size, void* d_ws, size_t ws_size, hipStream_t stream) {
    static int grid = 0;
    if (grid == 0) {
        if (n_in != 25 || in_sizes[0] != T_ * D_ || out_size != T_ * D_ || ws_size < WS_END) { fprintf(stderr, "kernel_launch: unexpected shapes (n_in %d, in0 %d, out %d, ws %zu < %zu); nothing launched\n", n_in, n_in > 0 ? in_sizes[0] : -1, out_size, ws_size, (size_t)WS_END); grid = -1; return; }
        int dev = 0, cus = 0, per_cu = 0;
        if (hipGetDevice(&dev) != hipSuccess || hipDeviceGetAttribute(&cus, hipDeviceAttributeMultiprocessorCount, dev) != hipSuccess) { fprintf(stderr, "kernel_launch: device query failed\n"); grid = -1; return; }
        if (hipFuncSetAttribute((const void*)mk_fwd, hipFuncAttributeMaxDynamicSharedMemorySize, LDS_BYTES) != hipSuccess) { fprintf(stderr, "kernel_launch: hipFuncSetAttribute failed\n"); grid = -1; return; }
        if (hipOccupancyMaxActiveBlocksPerMultiprocessor(&per_cu, (const void*)mk_fwd, NWAVES * 64, LDS_BYTES) != hipSuccess || per_cu < 1) fprintf(stderr, "kernel_launch: note: occupancy query reports %d workgroups per CU\n", per_cu);
        (void)hipGetLastError();
        grid = cus;
    }
    if (grid < 0) return;
    if (hipMemsetAsync((char*)d_ws + WS_CTL, 0, CTL_ZERO_BYTES, stream) != hipSuccess) { fprintf(stderr, "kernel_launch: memset failed\n"); return; }
    Args a{};
    for (int i = 0; i < 25; ++i) a.in[i] = (const float*)d_in[i];
    a.out = (float*)d_out; a.ws = (unsigned char*)d_ws;
#if MK_MULTI
    for (int p = 0; p < 23; ++p) { a.ph_lo = p; a.ph_hi = p + 1; hipLaunchKernelGGL(mk_fwd, dim3(grid), dim3(NWAVES * 64), LDS_BYTES, stream, a); }
#else
    a.ph_lo = 0; a.ph_hi = 23;
    hipLaunchKernelGGL(mk_fwd, dim3(grid), dim3(NWAVES * 64), LDS_BYTES, stream, a);
#endif
    const hipError_t le = hipPeekAtLastError();
    if (le != hipSuccess) fprintf(stderr, "kernel_launch: launch failed: %s\n", hipGetErrorName(le));
}
```

```cpp
#include <hip/hip_runtime.h>
#include <cstdio>
#include <cstdint>

#ifndef MK_MULTI
#define MK_MULTI 0
#endif

namespace pg8 {
#define PG8_LAS __attribute__((address_space(3)))
typedef unsigned short bf16_t;
typedef short bf16x8 __attribute__((ext_vector_type(8)));
typedef float f32x4 __attribute__((ext_vector_type(4)));
typedef unsigned u32x4 __attribute__((ext_vector_type(4)));
constexpr int BM = 256, BK = 64, HALF = 128, HTB = HALF * BK * 2  , STAGE_BYTES = 8 * HTB, NXCD = 8, WGM = 8;

__host__ __device__ __forceinline__ int lds_byte(int r, int c) { const int st = (r >> 4) * 2 + (c >> 5), rr = r & 15, cc = c & 31, ob = rr * 64 + cc * 2; return st * 1024 + (ob ^ (((ob >> 9) & 1) << 5)); }
__host__ __device__ __forceinline__ void stage_rc(int b, int& R, int& C) { const int st = b / 1024, sb = b % 1024, swz = sb ^ (((sb >> 9) & 1) << 5); R = (st >> 1) * 16 + swz / 64; C = (st & 1) * 32 + (swz % 64) / 2; }
__host__ __device__ __forceinline__ int perm32(int rho) { const int n = rho >> 4, i = rho & 15; return 8 * (i >> 2) + 4 * n + (i & 3); }

struct Unit { int pm, pn; const char* a; const char* b; };
struct Gemm { int K, lda, ldb; };

struct StaticOrder {
    int nM, nN, nwg, G, c; const char* A; const char* Bt; size_t tstepA, tstepB;
    __device__ void init(int M, int N, int G_, int c_, const void* A_, int lda, const void* Bt_, int ldb) { nM = M / BM; nN = N / BM; nwg = nM * nN; G = G_; c = c_; A = (const char*)A_; Bt = (const char*)Bt_; tstepA = (size_t)BM * lda * 2; tstepB = (size_t)BM * ldb * 2; }
    __device__ bool next(int i, Unit& u) const {
        const long L = (long)i * G + c; if (L >= nwg) return false;
        int wgid = (int)L; { const int q = nwg / NXCD, r = nwg % NXCD, xcd = wgid % NXCD, off = wgid / NXCD; wgid = (xcd < r ? xcd * (q + 1) : r * (q + 1) + (xcd - r) * q) + off; }
        const int nig = WGM * nN, gid = wgid / nig, fm = gid * WGM, gsz = (nM - fm) < WGM ? (nM - fm) : WGM;
        u.pm = fm + ((wgid % nig) % gsz); u.pn = (wgid % nig) / gsz; u.a = A + (size_t)u.pm * tstepA; u.b = Bt + (size_t)u.pn * tstepB; return true;
    }
    __device__ __forceinline__ void a_ready(const Unit&) const {}
    __device__ __forceinline__ void done(const Unit&) const {}
};
struct MoeOrder {
    int ntn, t0, nunits, gdeal, busy, G, c; const char* A; const char* W; size_t tstepA, tstepB, estep; const PG8_LAS int* tile_expert;
    __device__ bool next(int i, Unit& u) const {
        int L;
        if (busy == 0) { if (c >= gdeal) return false; L = i * gdeal + c; }
        else { const int nfree = G - busy;
            if (c >= busy) { const int cap = 3 * nfree < nunits ? 3 * nfree : nunits; if (i >= 3) return false; L = i * nfree + (c - busy); if (L >= cap) return false; }
            else { L = 3 * nfree + i * busy + c; } }
        if (L >= nunits) return false;
        const int mt = t0 + L / ntn, pn = L % ntn, e = tile_expert[mt];
        u.pm = mt; u.pn = pn; u.a = A + (size_t)mt * tstepA; u.b = W + (size_t)e * estep + (size_t)pn * tstepB; return true;
    }
    __device__ __forceinline__ void a_ready(const Unit&) const {}
    __device__ __forceinline__ void done(const Unit&) const {}
};

template <class Epi, class Sched, bool ALIGN_EPI = false, bool SP2 = false>
__device__ __forceinline__ void gemm_phase(PG8_LAS unsigned char* lds, const Gemm g, const Sched& S, const Epi& E, const int wave_id) {
    int lane; asm volatile("v_mbcnt_lo_u32_b32 %0, -1, 0\n\tv_mbcnt_hi_u32_b32 %0, -1, %0" : "=v"(lane));
    const int wid = wave_id, tid = wid * 64 + lane, wr = wid >> 2, wc = wid & 3, fr = lane & 15, fq = lane >> 4;
    const int K = g.K, nt = K / BK;
    unsigned voffA[2], voffB[2];
#pragma unroll
    for (int i = 0; i < 2; ++i) { int R, C; stage_rc(tid * 16 + i * 8192, R, C); const int Rb = Epi::PERM ? ((R & ~31) + perm32(R & 31)) : R;
        voffA[i] = (unsigned)(R * g.lda + C) * 2u; voffB[i] = (unsigned)(Rb * g.ldb + C) * 2u; }
    const size_t kstep = (size_t)(BK * 2);
    const size_t hstepA = (size_t)HALF * g.lda * 2, hstepB = (size_t)HALF * g.ldb * 2;
    const unsigned ldsw = (unsigned)wid * 1024u;
    const int aoff = lds_byte(wr * 64 + fr, fq * 8), boff = lds_byte(wc * 32 + fr, fq * 8);
#define PG8_SA(b, h) (((b) * 2 + (h)) * HTB)
#define PG8_SB(b, h) ((4 + (b) * 2 + (h)) * HTB)
#define PG8_STAGE(bufoff, gbase, voff) do { _Pragma("unroll") for (int _i = 0; _i < 2; ++_i) \
        __builtin_amdgcn_global_load_lds((const unsigned*)((const char*)(gbase) + (voff)[_i]), (PG8_LAS unsigned*)(lds + (bufoff) + ldsw + _i * 8192), 16, 0, 0); } while (0)
#define PG8_LDA(dst, b, h) do { _Pragma("unroll") for (int m = 0; m < 4; ++m) _Pragma("unroll") for (int k = 0; k < 2; ++k) dst[m][k] = *(const PG8_LAS bf16x8*)(lds + PG8_SA(b, h) + aoff + m * 2048 + k * 1024); } while (0)
#define PG8_LDB(dst, b, h) do { _Pragma("unroll") for (int n = 0; n < 2; ++n) _Pragma("unroll") for (int k = 0; k < 2; ++k) dst[n][k] = *(const PG8_LAS bf16x8*)(lds + PG8_SB(b, h) + boff + n * 2048 + k * 1024); } while (0)
#define PG8_MMA(ai, bj, At, Bt) do { __builtin_amdgcn_s_setprio(1); _Pragma("unroll") for (int m = 0; m < 4; ++m) _Pragma("unroll") for (int n = 0; n < 2; ++n) _Pragma("unroll") for (int k = 0; k < 2; ++k) \
        acc[ai][bj][m][n] = __builtin_amdgcn_mfma_f32_16x16x32_bf16(Bt[n][k], At[m][k], acc[ai][bj][m][n], 0, 0, 0); __builtin_amdgcn_s_setprio(0); } while (0)
#define PG8_WAIT_V(n) asm volatile("s_waitcnt vmcnt(" #n ")" ::: "memory")
#define PG8_WAIT_L(n) asm volatile("s_waitcnt lgkmcnt(" #n ")" ::: "memory")
#define PG8_BAR __builtin_amdgcn_s_barrier()
#define PG8_SCHED __builtin_amdgcn_sched_barrier(0)
    Unit cur, nxt; int ui = 0;
    if (!S.next(0, cur)) return;
    f32x4 acc[2][2][4][2];
#pragma unroll
    for (int a = 0; a < 2; ++a)
#pragma unroll
        for (int b = 0; b < 2; ++b)
#pragma unroll
            for (int m = 0; m < 4; ++m)
#pragma unroll
                for (int n = 0; n < 2; ++n) acc[a][b][m][n] = (f32x4){0.f, 0.f, 0.f, 0.f};
    bf16x8 At[4][2], B0[2][2], B1[2][2];
    const char* cA = cur.a; const char* cB = cur.b;
    S.a_ready(cur);
    if constexpr (SP2) {
        PG8_STAGE(PG8_SB(0, 0), cB, voffB); PG8_STAGE(PG8_SB(0, 1), cB + hstepB, voffB); PG8_STAGE(PG8_SA(0, 0), cA, voffA); PG8_STAGE(PG8_SA(0, 1), cA + hstepA, voffA);
        if (wr == 1) PG8_BAR;
        PG8_WAIT_V(2); PG8_BAR;
        PG8_STAGE(PG8_SB(1, 0), cB + kstep, voffB); PG8_STAGE(PG8_SA(1, 0), cA + kstep, voffA); PG8_STAGE(PG8_SB(1, 1), cB + hstepB + kstep, voffB);
        PG8_WAIT_V(6); PG8_BAR;
    } else {
        PG8_STAGE(PG8_SB(0, 0), cB, voffB); PG8_STAGE(PG8_SA(0, 0), cA, voffA); PG8_STAGE(PG8_SB(0, 1), cB + hstepB, voffB); PG8_STAGE(PG8_SA(0, 1), cA + hstepA, voffA);
        if (wr == 1) PG8_BAR;
        PG8_WAIT_V(4); PG8_BAR;
        PG8_STAGE(PG8_SB(1, 0), cB + kstep, voffB); PG8_STAGE(PG8_SA(1, 0), cA + kstep, voffA); PG8_STAGE(PG8_SB(1, 1), cB + hstepB + kstep, voffB);
        PG8_WAIT_V(6); PG8_BAR;
    }
    for (;;) {
        const bool has_next = S.next(ui + 1, nxt);
        const char* nA = has_next ? nxt.a : cA; const char* nB = has_next ? nxt.b : cB;
        for (int t = 0; t < nt; t += 2) {
            const bool last = (t == nt - 2);
            const char* a1 = cA + (size_t)(t + 1) * kstep;
            const char* a2 = last ? nA : cA + (size_t)(t + 2) * kstep; const char* b2 = last ? nB : cB + (size_t)(t + 2) * kstep;
            const char* a3 = a2 + kstep; const char* b3 = b2 + kstep;
            if (last && has_next) S.a_ready(nxt);
            if constexpr (SP2) {
            PG8_LDB(B0, 0, 0); PG8_LDB(B1, 0, 1); PG8_SCHED; PG8_LDA(At, 0, 0); PG8_STAGE(PG8_SA(1, 1), a1 + hstepA, voffA);
            PG8_WAIT_V(8); PG8_WAIT_L(0); PG8_BAR; PG8_MMA(0, 0, At, B0); PG8_MMA(0, 1, At, B1); PG8_BAR; PG8_SCHED;
            PG8_LDA(At, 0, 1); PG8_STAGE(PG8_SB(0, 0), b2, voffB); PG8_STAGE(PG8_SB(0, 1), b2 + hstepB, voffB); PG8_STAGE(PG8_SA(0, 0), a2, voffA);
            PG8_WAIT_V(8); PG8_WAIT_L(0); PG8_BAR; PG8_MMA(1, 0, At, B0); PG8_MMA(1, 1, At, B1); PG8_BAR; PG8_SCHED;
            PG8_LDB(B0, 1, 0); PG8_LDB(B1, 1, 1); PG8_SCHED; PG8_LDA(At, 1, 0); PG8_STAGE(PG8_SA(0, 1), a2 + hstepA, voffA);
            PG8_WAIT_V(8); PG8_WAIT_L(0); PG8_BAR; PG8_MMA(0, 0, At, B0); PG8_MMA(0, 1, At, B1); PG8_BAR; PG8_SCHED;
            PG8_LDA(At, 1, 1); PG8_STAGE(PG8_SB(1, 0), b3, voffB); PG8_STAGE(PG8_SB(1, 1), b3 + hstepB, voffB); PG8_STAGE(PG8_SA(1, 0), a3, voffA);
            PG8_WAIT_V(8); PG8_WAIT_L(0); PG8_BAR; PG8_MMA(1, 0, At, B0); PG8_MMA(1, 1, At, B1); PG8_BAR; PG8_SCHED;
            } else {
            PG8_LDB(B0, 0, 0); PG8_SCHED; PG8_LDA(At, 0, 0); PG8_STAGE(PG8_SA(1, 1), a1 + hstepA, voffA);
            PG8_WAIT_L(8); PG8_BAR; PG8_WAIT_L(0); PG8_MMA(0, 0, At, B0); PG8_BAR; PG8_SCHED;
            PG8_LDB(B1, 0, 1); PG8_STAGE(PG8_SB(0, 0), b2, voffB);
            PG8_BAR; PG8_WAIT_L(0); PG8_MMA(0, 1, At, B1); PG8_BAR;
            PG8_LDA(At, 0, 1); PG8_STAGE(PG8_SA(0, 0), a2, voffA);
            PG8_BAR; PG8_WAIT_L(0); PG8_MMA(1, 0, At, B0); PG8_BAR; PG8_SCHED;
            PG8_STAGE(PG8_SB(0, 1), b2 + hstepB, voffB);
            PG8_WAIT_V(6); PG8_BAR; PG8_MMA(1, 1, At, B1); PG8_BAR;
            PG8_LDB(B0, 1, 0); PG8_SCHED; PG8_LDA(At, 1, 0); PG8_STAGE(PG8_SA(0, 1), a2 + hstepA, voffA);
            PG8_WAIT_L(8); PG8_BAR; PG8_WAIT_L(0); PG8_MMA(0, 0, At, B0); PG8_BAR; PG8_SCHED;
            PG8_LDB(B1, 1, 1); PG8_STAGE(PG8_SB(1, 0), b3, voffB);
            PG8_BAR; PG8_WAIT_L(0); PG8_MMA(0, 1, At, B1); PG8_BAR;
            PG8_LDA(At, 1, 1); PG8_STAGE(PG8_SA(1, 0), a3, voffA);
            PG8_BAR; PG8_WAIT_L(0); PG8_MMA(1, 0, At, B0); PG8_BAR; PG8_SCHED;
            PG8_STAGE(PG8_SB(1, 1), b3 + hstepB, voffB);
            PG8_WAIT_V(6); PG8_BAR; PG8_MMA(1, 1, At, B1); PG8_BAR;
            }
        }
        if constexpr (ALIGN_EPI) { if (wr == 0) PG8_BAR; }
        if constexpr (!Epi::AFTER_DRAIN) { E(acc, cur, wr, wc, fr, fq); S.done(cur); }
        if (!has_next) break;
#pragma unroll
        for (int a = 0; a < 2; ++a)
#pragma unroll
            for (int b = 0; b < 2; ++b)
#pragma unroll
                for (int m = 0; m < 4; ++m)
#pragma unroll
                    for (int n = 0; n < 2; ++n) acc[a][b][m][n] = (f32x4){0.f, 0.f, 0.f, 0.f};
        cur = nxt; cA = nA; cB = nB; ++ui;
        if constexpr (ALIGN_EPI) { if (wr == 1) PG8_BAR; }
    }
    PG8_WAIT_V(0);
    if constexpr (!ALIGN_EPI) { if (wr == 0) PG8_BAR; }
    PG8_BAR;
    if constexpr (Epi::AFTER_DRAIN) { E.fused(acc, cur, wr, wc, fr, fq, lds, wid, lane); S.done(cur); }
#undef PG8_SA
#undef PG8_SB
#undef PG8_STAGE
#undef PG8_LDA
#undef PG8_LDB
#undef PG8_MMA
#undef PG8_WAIT_V
#undef PG8_WAIT_L
#undef PG8_BAR
#undef PG8_SCHED
}
}

constexpr int NWAVES = 8;
constexpr int T_ = 8192, D_ = 2048, NB_ = 4, S_ = 2048;
constexpr float EPS_ = 1e-6f;
constexpr float LOG2E = 1.4426950408889634f;
constexpr float C_SB = 0.08838834764831845f * LOG2E;
constexpr float C_MLA = 0.07216878364870323f * LOG2E;
constexpr int NPH = 22;

constexpr size_t MiB = 1u << 20;
constexpr size_t WS_CTL = 0, CTL_ZERO_BYTES = 1 * MiB;
constexpr size_t WS_TAB64 = 2 * MiB, WS_TAB256 = 4 * MiB, WS_WR = 12 * MiB, WS_ROUTE = 13 * MiB;
constexpr size_t WS_W_IN0T = 16 * MiB, WS_W_QUPT = 32 * MiB, WS_W_KVUPT = 34 * MiB, WS_W_OUT0T = 36 * MiB, WS_W_IN1T = 44 * MiB, WS_W_OUT1T = 92 * MiB;
constexpr size_t WS_W_GU = 108 * MiB, WS_W_DN = 364 * MiB;
constexpr size_t WS_XA = 492 * MiB, WS_XB = 556 * MiB, WS_H = 620 * MiB;
constexpr size_t WS_PROJ0 = 652 * MiB, WS_QMLA = 716 * MiB, WS_KVMLA = 740 * MiB, WS_KR = 772 * MiB, WS_ATTO = 774 * MiB;
constexpr size_t WS_PROJ1 = 652 * MiB;
constexpr size_t WS_HG = 844 * MiB, WS_ACT = 940 * MiB, WS_Y = 964 * MiB;
constexpr size_t WS_RETO = 844 * MiB, WS_A5 = 908 * MiB;
constexpr size_t WS_MODP = 1060 * MiB;
constexpr size_t WS_RS = 13 * MiB + 256 * 1024;
constexpr size_t WS_SSQP = 13 * MiB + 512 * 1024;
constexpr size_t WS_END = 1064 * MiB;
constexpr int CW_TMO = 0, CW_CODE = 1;
constexpr int CW_BAR = 4096;
constexpr int CW_QMLA = 8192, CW_QSB = 8256, CW_QRET = 8320, CW_QC1 = 8384, CW_QC2 = 8416;
constexpr int CW_ECNT = 8448, CW_ECUR = 8576;
constexpr int CW_MOD = 16384;
constexpr int CW_SSQQ = 114688, CW_SSQKV = 122880;
static_assert((CW_SSQKV + 8192) * 4 <= (int)CTL_ZERO_BYTES, "CTL words inside the memset region");
constexpr int RING_OFF = 0, RING_BYTES = 147456;
constexpr int LDSCTL_OFF = RING_BYTES, MISC_OFF = LDSCTL_OFF + 320;
constexpr int MOE_TAB_OFF = LDSCTL_OFF + 1024;
constexpr int LDS_BYTES = 155648;
static_assert(MOE_TAB_OFF + 1024 <= LDS_BYTES, "LDS map");

#define GAS __attribute__((address_space(1)))
#define LAS __attribute__((address_space(3)))
typedef unsigned short bf16;
typedef unsigned v4u __attribute__((ext_vector_type(4)));
typedef unsigned v2u __attribute__((ext_vector_type(2)));
typedef float f32x4 __attribute__((ext_vector_type(4)));
typedef float f32x2 __attribute__((ext_vector_type(2)));
typedef float f32x16 __attribute__((ext_vector_type(16)));
typedef short bf16x8 __attribute__((ext_vector_type(8)));
typedef short s16x4 __attribute__((ext_vector_type(4)));
typedef short v4i16_t __attribute__((ext_vector_type(4)));
typedef GAS unsigned gu32;
#define RLX_AGENT __ATOMIC_RELAXED, __HIP_MEMORY_SCOPE_AGENT
#define LDS_WAIT() asm volatile("s_waitcnt lgkmcnt(0)" ::: "memory")
#define VM_WAIT() asm volatile("s_waitcnt vmcnt(0)" ::: "memory")
typedef __bf16 bf16x2_t __attribute__((ext_vector_type(2)));
__device__ __forceinline__ unsigned pk2(float lo, float hi) { f32x2 v = {lo, hi}; bf16x2_t b = __builtin_convertvector(v, bf16x2_t); return __builtin_bit_cast(unsigned, b); }
__device__ __forceinline__ float bf_lo(unsigned w) { return __uint_as_float(w << 16); }
__device__ __forceinline__ float bf_hi(unsigned w) { return __uint_as_float(w & 0xffff0000u); }
__device__ __forceinline__ float ex2(float x) { return __builtin_amdgcn_exp2f(x); }
__device__ __forceinline__ float lg2(float x) { return __builtin_amdgcn_logf(x); }
__device__ __forceinline__ float silu_f(float v) { return v / (1.0f + __expf(-v)); }
__device__ __forceinline__ int lane_id_opaque() { int l; asm volatile("v_mbcnt_lo_u32_b32 %0, -1, 0\n\tv_mbcnt_hi_u32_b32 %0, -1, %0" : "=v"(l)); return l; }

#define XB_TMO      128
#define XB_XCNT(j)  (256  + 64 * (j))
#define XB_XSUB(j)  (1280 + 64 * (j))
#define XB_XGEN(j)  (2304 + 64 * (j))
#define XB_TOP      3328
#define XB_TOPGEN   3392
#define XCD_BAR_WORDS 3456
#define XB_SPIN_CAP (1u << 18)
__device__ __forceinline__ unsigned xb_ld(unsigned* p)              { return __hip_atomic_load(p, __ATOMIC_RELAXED, __HIP_MEMORY_SCOPE_AGENT); }
__device__ __forceinline__ unsigned xb_add(unsigned* p, unsigned v) { return __hip_atomic_fetch_add(p, v, __ATOMIC_RELAXED, __HIP_MEMORY_SCOPE_AGENT); }
__device__ __forceinline__ unsigned xb_xcc_id() { return (unsigned)__builtin_amdgcn_s_getreg((3 << 11) | 20) & 0xFu; }
#define XB_SPIN(cond, bar) do { unsigned _sp = 0; while (cond) { __builtin_amdgcn_s_sleep(1); \
    if ((++_sp & 255u) == 0u) { if (xb_ld(&(bar)[XB_TMO])) break; if (_sp > XB_SPIN_CAP) { atomicAdd(&(bar)[XB_TMO], 1u); break; } } } } while (0)
struct XcdBarrier { unsigned* bar; unsigned x; volatile LAS unsigned* st; };
__device__ __forceinline__ XcdBarrier xcd_barrier_post(unsigned* bar, volatile LAS unsigned* st, int wave) {
    XcdBarrier b; b.bar = bar; b.x = xb_xcc_id(); b.st = st;
    if (wave == 0 && lane_id_opaque() == 0) (void)xb_add(&bar[XB_XCNT(b.x)], 1u);
    return b;
}
__device__ __forceinline__ void xcd_barrier_complete(unsigned* bar, unsigned x, unsigned& nloc, unsigned& nx) {
    const unsigned G = gridDim.x * gridDim.y * gridDim.z;
    unsigned sum, cnt, mine, sp = 0u;
    for (;;) {
        sum = 0u; cnt = 0u; mine = 0u;
#pragma unroll
        for (unsigned j = 0; j < 16; ++j) { const unsigned c = xb_ld(&bar[XB_XCNT(j)]); sum += c; cnt += (c > 0u) ? 1u : 0u; mine = (j == x) ? c : mine; }
        if (sum == G) break;
        __builtin_amdgcn_s_sleep(1);
        if ((++sp & 255u) == 0u) { if (xb_ld(&bar[XB_TMO])) break; if (sp > XB_SPIN_CAP) { atomicAdd(&bar[XB_TMO], 1u); break; } }
    }
    nloc = mine > 0u ? mine : 1u; nx = cnt > 0u ? cnt : 1u;
}
__device__ __forceinline__ void xcd_barrier(const XcdBarrier& b, int wave) {
    asm volatile("s_waitcnt vmcnt(0)" ::: "memory");
    __syncthreads();
    if (wave == 0 && lane_id_opaque() == 0) {
        unsigned* bar = b.bar;
        __builtin_amdgcn_s_waitcnt(0);
        unsigned nloc = b.st[0], nx = b.st[1];
        if (nloc == 0u) { xcd_barrier_complete(bar, b.x, nloc, nx); b.st[0] = nloc; b.st[1] = nx; }
        const unsigned old = xb_add(&bar[XB_XSUB(b.x)], 1u);
        const unsigned gen = old / nloc;
        if (old + 1u == (gen + 1u) * nloc) {
            __builtin_amdgcn_fence(__ATOMIC_RELEASE, "agent");
            asm volatile("s_waitcnt vmcnt(0)" ::: "memory");
            const unsigned og = xb_add(&bar[XB_TOP], 1u);
            const unsigned tg = og / nx;
            if (og + 1u == (tg + 1u) * nx) xb_add(&bar[XB_TOPGEN], 1u);
            else XB_SPIN(xb_ld(&bar[XB_TOPGEN]) == tg, bar);
            __builtin_amdgcn_fence(__ATOMIC_ACQUIRE, "agent");
            xb_add(&bar[XB_XGEN(b.x)], 1u);
            asm volatile("s_waitcnt vmcnt(0)" ::: "memory");
        } else {
            XB_SPIN(xb_ld(&bar[XB_XGEN(b.x)]) == gen, bar);
            __builtin_amdgcn_fence(__ATOMIC_ACQUIRE, "agent");
            asm volatile("s_waitcnt vmcnt(0)" ::: "memory");
        }
    }
    __syncthreads();
}

struct Frame {
    LAS unsigned char* lds;
    volatile LAS unsigned* MISC;
    gu32* ctl;
    unsigned char* ws;
    int wave;
    int vcu, G;
    float* out;
};
struct Args { const float* in[25]; float* out; unsigned char* ws; int ph_lo, ph_hi; };
__device__ __forceinline__ float wave_sum(float v) {
#pragma unroll
    for (int o = 1; o < 64; o <<= 1) v += __shfl_xor(v, o);
    return v;
}
#define PHASE_IDS(F) const int lane = lane_id_opaque(), wave = (F).wave, tid = wave * 64 + lane; (void)lane; (void)wave; (void)tid
struct ConvSrc { const float* W; int ldn; bf16* WT; int ldk; const float* scale; };
__device__ __forceinline__ void conv_load(const ConvSrc& c, int lane, f32x4 (&v)[8]) {
    const float* src = c.W + (size_t)(8 * (lane >> 3)) * c.ldn + 4 * (lane & 7);
#pragma unroll
    for (int t = 0; t < 8; ++t) v[t] = __builtin_nontemporal_load((const f32x4*)(src + (size_t)t * c.ldn));
}
__device__ __forceinline__ void conv_store(const ConvSrc& c, int lane, f32x4 (&v)[8]) {
    if (c.scale) { const f32x4 s0 = *(const f32x4*)(c.scale + 8 * (lane >> 3)), s1 = *(const f32x4*)(c.scale + 8 * (lane >> 3) + 4);
        v[0] *= s0.x; v[1] *= s0.y; v[2] *= s0.z; v[3] *= s0.w; v[4] *= s1.x; v[5] *= s1.y; v[6] *= s1.z; v[7] *= s1.w; }
    bf16* dst = c.WT + (size_t)(4 * (lane & 7)) * c.ldk + 8 * (lane >> 3);
#pragma unroll
    for (int j = 0; j < 4; ++j) { v4u o; o.x = pk2(v[0][j], v[1][j]); o.y = pk2(v[2][j], v[3][j]); o.z = pk2(v[4][j], v[5][j]); o.w = pk2(v[6][j], v[7][j]); __builtin_nontemporal_store(o, (v4u*)(dst + (size_t)j * c.ldk)); }
}
constexpr int CONV_N0 = 122 * 32 + 48 * 8 + 64 * 4, CONV_N1 = 64 * 32 + 384 * 32 + 32 * 1024 + 32 * 512, CONV_N2 = 64 * 64 + 32 * 1024 + 32 * 512;
__device__ __forceinline__ ConvSrc conv_moe_gu(const Args& A, unsigned char* ws, int le, int r) {
    const int nb = r / 32, kb = r % 32, t = nb >> 3, hf = (nb >> 2) & 1, jb = nb & 3;
    return ConvSrc{(hf ? A.in[22] : A.in[21]) + (size_t)le * 2048 * 512 + (size_t)(64 * kb) * 512 + 128 * t + 32 * jb, 512, (bf16*)(ws + WS_W_GU) + (size_t)le * 1024 * 2048 + (size_t)(32 * nb) * 2048 + 64 * kb, 2048, nullptr};
}
__device__ __forceinline__ ConvSrc conv_moe_dn(const Args& A, unsigned char* ws, int le, int r) {
    const int nb = r / 8, kb = r % 8;
    return ConvSrc{A.in[23] + (size_t)le * 512 * 2048 + (size_t)(64 * kb) * 2048 + 32 * nb, 2048, (bf16*)(ws + WS_W_DN) + (size_t)le * 2048 * 512 + (size_t)(32 * nb) * 512 + 64 * kb, 512, nullptr};
}
template <int STREAM> __device__ __forceinline__ ConvSrc conv_item(const Args& A, unsigned char* ws, int it) {
    if (STREAM == 0) {
        if (it < 122 * 32) { const int t = it / 32, kb = it % 32; const int dnb = t < 120 ? t : (t == 120 ? 120 : 124), sc = t < 120 ? 32 * t : (t == 120 ? 3840 : 3872);
            return ConvSrc{A.in[9] + (size_t)(64 * kb) * 3904 + sc, 3904, (bf16*)(ws + WS_W_IN0T) + (size_t)(32 * dnb) * 2048 + 64 * kb, 2048, nullptr}; }
        it -= 122 * 32;
        if (it < 48 * 8) { const int nb = it / 8, kb = it % 8; int sc;
            if (nb < 32) sc = (nb >> 2) * 192 + 32 * (nb & 3);
            else { const int t = (nb - 32) >> 3, blk = (nb - 32) & 7, hf = blk >> 2, hh = blk & 3; sc = (4 * t + hh) * 192 + 128 + 32 * hf; }
            return ConvSrc{A.in[11] + (size_t)(64 * kb) * 1536 + sc, 1536, (bf16*)(ws + WS_W_QUPT) + (size_t)(32 * nb) * 512 + 64 * kb, 512, A.in[10] + 64 * kb}; }
        it -= 48 * 8;
        { const int nb = it / 4, kb = it % 4;
            return ConvSrc{A.in[13] + (size_t)(64 * kb) * 2048 + 32 * nb, 2048, (bf16*)(ws + WS_W_KVUPT) + (size_t)(32 * nb) * 256 + 64 * kb, 256, A.in[12] + 64 * kb}; }
    } else if (STREAM == 1) {
        if (it < 64 * 32) { const int nb = it / 32, kb = it % 32;
            return ConvSrc{A.in[14] + (size_t)(64 * kb) * 2048 + 32 * nb, 2048, (bf16*)(ws + WS_W_OUT0T) + (size_t)(32 * nb) * 2048 + 64 * kb, 2048, nullptr}; }
        it -= 64 * 32;
        if (it < 384 * 32) { const int nb = it / 32, kb = it % 32;
            return ConvSrc{A.in[15] + (size_t)(64 * kb) * 12288 + 32 * nb, 12288, (bf16*)(ws + WS_W_IN1T) + (size_t)(32 * nb) * 2048 + 64 * kb, 2048, nullptr}; }
        it -= 384 * 32;
        if (it < 32 * 1024) return conv_moe_gu(A, ws, it / 1024, it % 1024);
        it -= 32 * 1024;
        return conv_moe_dn(A, ws, it / 512, it % 512);
    } else {
        if (it < 64 * 64) { const int nb = it / 64, kb = it % 64;
            return ConvSrc{A.in[16] + (size_t)(64 * kb) * 2048 + 32 * nb, 2048, (bf16*)(ws + WS_W_OUT1T) + (size_t)(32 * nb) * 4096 + 64 * kb, 4096, nullptr}; }
        it -= 64 * 64;
        if (it < 32 * 1024) return conv_moe_gu(A, ws, 32 + it / 1024, it % 1024);
        it -= 32 * 1024;
        return conv_moe_dn(A, ws, 32 + it / 512, it % 512);
    }
}
template <int STREAM> __device__ __forceinline__ void conv_burst(Frame& F, const Args& A, int lane, int gw, int NGW, int& cur, int n) {
    constexpr int N = STREAM == 0 ? CONV_N0 : (STREAM == 1 ? CONV_N1 : CONV_N2);
#pragma unroll 1
    while (n > 0) {
        const int i0 = gw + NGW * cur; if (i0 >= N) break;
        const int i1 = i0 + NGW; const bool two = n > 1 && i1 < N;
        const ConvSrc c0 = conv_item<STREAM>(A, F.ws, i0); f32x4 v0[8], v1[8];
        conv_load(c0, lane, v0);
        if (two) { const ConvSrc c1 = conv_item<STREAM>(A, F.ws, i1); conv_load(c1, lane, v1); conv_store(c0, lane, v0); conv_store(c1, lane, v1); cur += 2; n -= 2; }
        else { conv_store(c0, lane, v0); cur += 1; n -= 1; }
    }
}

__device__ __forceinline__ void p0a_mod_partials(Frame& F, const Args& A) {
    PHASE_IDS(F);
    const int gw = F.vcu * NWAVES + wave, NGW = F.G * NWAVES;
    LAS float* cond = (LAS float*)(F.lds + RING_OFF);
    for (int i = tid; i < NB_ * D_; i += 512) cond[i] = silu_f(A.in[1][i]);
    __syncthreads();
    float* MODP = (float*)(F.ws + WS_MODP);
    for (int u = gw; u < 768; u += NGW) {
        const int j = u / 192, r = u % 192, nc = r / 8, kc = r % 8, layer = j >> 1;
        const float* W = ((j & 1) ? A.in[6] : A.in[3]) + (size_t)layer * 2048 * 6144 + (size_t)(kc * 256) * 6144 + nc * 256 + 4 * lane;
        f32x4 acc[4];
#pragma unroll
        for (int b = 0; b < 4; ++b) acc[b] = (f32x4){0.f, 0.f, 0.f, 0.f};
#pragma unroll 16
        for (int k = 0; k < 256; ++k) { const f32x4 w = *(const f32x4*)(W + (size_t)k * 6144);
#pragma unroll
            for (int b = 0; b < 4; ++b) acc[b] += cond[b * 2048 + kc * 256 + k] * w; }
#pragma unroll
        for (int b = 0; b < 4; ++b) *(f32x4*)(MODP + ((size_t)(kc * 16 + j * 4 + b)) * 6144 + nc * 256 + 4 * lane) = acc[b];
    }
}
__device__ __forceinline__ void p0_prologue(Frame& F, const Args& A) {
    PHASE_IDS(F);
    const int gw = F.vcu * NWAVES + wave, NGW = F.G * NWAVES;
    const int gt = F.vcu * 512 + tid, NGT = F.G * 512;
    { float* MOD = (float*)(F.ctl + CW_MOD); const float* MODP = (const float*)(F.ws + WS_MODP);
      for (int idx = gt; idx < 16 * 6144; idx += NGT) { const int j = idx / (4 * 6144), n = idx % 6144; float a = ((j & 1) ? A.in[7] : A.in[4])[(j >> 1) * 6144 + n];
#pragma unroll
          for (int kc = 0; kc < 8; ++kc) a += MODP[(size_t)kc * 16 * 6144 + idx];
          MOD[idx] = a; } }
    { int cur = 0; conv_burst<0>(F, A, lane, gw, NGW, cur, 1 << 20); }
    { const int* pos = (const int*)A.in[2]; f32x2* t64 = (f32x2*)(F.ws + WS_TAB64); f32x2* t256 = (f32x2*)(F.ws + WS_TAB256);
      for (int idx = gt; idx < T_ * 160; idx += NGT) { const int m = idx / 160, i = idx % 160; const double p = (double)pos[m];
          double fr; if (i < 32) fr = exp(-9.210340371976184 * (double)i / 32.0); else fr = exp(-9.210340371976184 * (double)(i - 32) / 128.0);
          double sn, cs; sincos(p * fr, &sn, &cs); const f32x2 v = {(float)cs, (float)sn};
          if (i < 32) t64[m * 32 + i] = v; else t256[m * 128 + (i - 32)] = v; } }
    { float* WR = (float*)(F.ws + WS_WR);
      for (int idx = gt; idx < 2 * 512 * 36 * 4; idx += NGT) { const int q = idx & 3, c = (idx >> 2) % 36, kq = ((idx >> 2) / 36) % 512, l = (idx >> 2) / (36 * 512); const int k = 4 * kq + q;
          WR[idx] = c < 4 ? A.in[17][(size_t)l * 2048 * 4 + k * 4 + c] : A.in[19][(size_t)l * 2048 * 32 + k * 32 + (c - 4)]; } }
}

__device__ __forceinline__ void local_mod(Frame& F, const float* bias, int j) {
    PHASE_IDS(F);
    const float* MODP = (const float*)(F.ws + WS_MODP); LAS f32x4* lm = (LAS f32x4*)(F.lds + RING_OFF);
    __syncthreads();
    for (int q = tid; q < 4096; q += 512) { const int b = q >> 10, n = 4 * (q & 1023); f32x4 a = *(const f32x4*)(bias + n);
#pragma unroll
        for (int kc = 0; kc < 8; ++kc) a += *(const f32x4*)(MODP + ((size_t)(kc * 16 + j * 4 + b)) * 6144 + n);
        lm[q] = a; }
    __syncthreads();
}
template <int MODE, bool LM = false> __device__ __forceinline__ void norm_phase(Frame& F, const float* src, float* xdst, const float* gvec, int jn, int jg, int layer_moe) {
    PHASE_IDS(F);
    const int gw = F.vcu * NWAVES + wave, NGW = F.G * NWAVES;
    const float* MOD = (const float*)(F.ctl + CW_MOD);
    bf16* H = (bf16*)(F.ws + WS_H);
    const bf16* Y = (const bf16*)(F.ws + WS_Y);
    const int* RT = (const int*)(F.ws + WS_ROUTE);
    for (int row = gw; row < T_; row += NGW) {
        const int b = row >> 11;
        f32x4 v[8]; float ss = 0.f;
        const f32x4* xr = (const f32x4*)(src + (size_t)row * D_) + lane;
#pragma unroll
        for (int j = 0; j < 8; ++j) v[j] = xr[64 * j];
        if (MODE >= 2) {
            const int* rt = RT + (size_t)row * 8; const int p0 = rt[4], p1 = rt[5]; const float w0 = __int_as_float(rt[2]), w1 = __int_as_float(rt[3]);
            const v2u* y0 = (const v2u*)(Y + (size_t)p0 * D_) + lane; const v2u* y1 = (const v2u*)(Y + (size_t)p1 * D_) + lane;
            const f32x4* gt = (const f32x4*)(MOD + (size_t)(jg * 4 + b) * 6144 + 4096) + lane;
#pragma unroll
            for (int j = 0; j < 8; ++j) { const v2u a = y0[64 * j], c = y1[64 * j]; const f32x4 g = gt[64 * j];
                f32x4 m; m.x = w0 * bf_lo(a.x) + w1 * bf_lo(c.x); m.y = w0 * bf_hi(a.x) + w1 * bf_hi(c.x); m.z = w0 * bf_lo(a.y) + w1 * bf_lo(c.y); m.w = w0 * bf_hi(a.y) + w1 * bf_hi(c.y);
                v[j] += g * m; }
            if (MODE == 2) { f32x4* xo = (f32x4*)(xdst + (size_t)row * D_) + lane;
#pragma unroll
                for (int j = 0; j < 8; ++j) xo[64 * j] = v[j]; }
        }
#pragma unroll
        for (int j = 0; j < 8; ++j) ss += (v[j].x * v[j].x + v[j].y * v[j].y) + (v[j].z * v[j].z + v[j].w * v[j].w);
        const float rstd = 1.0f / sqrtf(wave_sum(ss) * (1.0f / D_) + EPS_);
        const f32x4* gv = (const f32x4*)gvec + lane;
        if (MODE == 3) { f32x4* o = (f32x4*)(F.out + (size_t)row * D_) + lane;
#pragma unroll
            for (int j = 0; j < 8; ++j) o[64 * j] = v[j] * rstd * gv[64 * j];
        } else {
            v2u* o = (v2u*)(H + (size_t)row * D_) + lane;
            if (LM) { const LAS f32x4* sh = (const LAS f32x4*)(F.lds + RING_OFF) + b * 1024 + lane; const LAS f32x4* sc = sh + 512;
#pragma unroll
                for (int j = 0; j < 8; ++j) { const f32x4 h = v[j] * rstd * gv[64 * j] * (1.0f + sc[64 * j]) + sh[64 * j]; v2u w; w.x = pk2(h.x, h.y); w.y = pk2(h.z, h.w); o[64 * j] = w; }
            } else { const f32x4* sh = (const f32x4*)(MOD + (size_t)(jn * 4 + b) * 6144) + lane; const f32x4* sc = sh + 512;
#pragma unroll
                for (int j = 0; j < 8; ++j) { const f32x4 h = v[j] * rstd * gv[64 * j] * (1.0f + sc[64 * j]) + sh[64 * j]; v2u w; w.x = pk2(h.x, h.y); w.y = pk2(h.z, h.w); o[64 * j] = w; } }
        }
    }
}

__device__ __forceinline__ void router_phase(Frame& F, const Args& A, const float* X, const float* gvec, int jn, int layer, bool first) {
    const float* MOD = (const float*)(F.ctl + CW_MOD);
    const f32x4* WR4 = (const f32x4*)(F.ws + WS_WR) + (size_t)layer * 512 * 36;
    int* RT = (int*)(F.ws + WS_ROUTE); float* RS = (float*)(F.ws + WS_RS);
    LAS f32x4* hs = (LAS f32x4*)(F.lds + RING_OFF);
    LAS f32x4* wsm = (LAS f32x4*)(F.lds + RING_OFF + 40960);
    LAS f32x4* shs = (LAS f32x4*)(F.lds + RING_OFF + 81920);
    LAS float* rs = (LAS float*)(F.lds + RING_OFF + 83968);
    LAS float* lg = (LAS float*)(F.lds + RING_OFF + 84224);
    PHASE_IDS(F);
    const int r = tid >> 4, kp = tid & 15, kpart = lane & 15, cg = lane >> 4;
    int wpos[5];
#pragma unroll
    for (int i = 0; i < 5; ++i) { const int idx = tid + 512 * i; wpos[i] = idx + idx / 36; }
    for (int tile = F.vcu; tile < T_ / 32; tile += F.G) {
        const int row0 = tile * 32, b = row0 >> 11;
        const f32x4* sh = (const f32x4*)(MOD + (size_t)(jn * 4 + b) * 6144); const f32x4* sc = sh + 512; const f32x4* gv = (const f32x4*)gvec;
        const f32x4* xr = (const f32x4*)(X + (size_t)(row0 + r) * D_);
        float acc[4][9], accq[9], ss = 0.f;
#pragma unroll
        for (int c = 0; c < 9; ++c) { accq[c] = 0.f;
#pragma unroll
            for (int rr = 0; rr < 4; ++rr) acc[rr][c] = 0.f; }
        f32x4 xq[4], gq[4], sq[4], wq[5];
#define RT_LOAD(ch) do { _Pragma("unroll") for (int g = 0; g < 4; ++g) { const int q = (ch) * 64 + kp + 16 * g; xq[g] = xr[q]; gq[g] = gv[q] * (1.0f + sc[q]); if (r == 0) sq[g] = sh[q]; } \
            _Pragma("unroll") for (int i = 0; i < 5; ++i) { const int idx = tid + 512 * i; if (idx < 2304) wq[i] = WR4[(size_t)(ch) * 2304 + idx]; } } while (0)
        RT_LOAD(0);
#pragma unroll 1
        for (int ch = 0; ch < 8; ++ch) {
#pragma unroll
            for (int g = 0; g < 4; ++g) { const f32x4 x = xq[g]; ss += (x.x * x.x + x.y * x.y) + (x.z * x.z + x.w * x.w); hs[r * 65 + kp + 16 * g] = x * gq[g]; if (r == 0) shs[kp + 16 * g] = sq[g]; }
#pragma unroll
            for (int i = 0; i < 5; ++i) if (tid + 512 * i < 2304) wsm[wpos[i]] = wq[i];
            __syncthreads();
            if (ch + 1 < 8) RT_LOAD(ch + 1);
#pragma unroll 1
            for (int g = 0; g < 4; ++g) { const int kq = kpart + 16 * g; f32x4 h4[4];
#pragma unroll
                for (int rr = 0; rr < 4; ++rr) h4[rr] = hs[(wave * 4 + rr) * 65 + kq];
                const f32x4 q4 = shs[kq];
#pragma unroll
                for (int c = 0; c < 9; ++c) { const f32x4 w4 = wsm[kq * 37 + 9 * cg + c];
#pragma unroll
                    for (int rr = 0; rr < 4; ++rr) acc[rr][c] += (h4[rr].x * w4.x + h4[rr].y * w4.y) + (h4[rr].z * w4.z + h4[rr].w * w4.w);
                    if (wave == 0) accq[c] += (q4.x * w4.x + q4.y * w4.y) + (q4.z * w4.z + q4.w * w4.w); } }
            __syncthreads();
        }
#undef RT_LOAD
#pragma unroll
        for (int rr = 0; rr < 4; ++rr)
#pragma unroll
            for (int c = 0; c < 9; ++c) { float a = acc[rr][c]; a += __shfl_xor(a, 1); a += __shfl_xor(a, 2); a += __shfl_xor(a, 4); a += __shfl_xor(a, 8); if (kpart == 0) lg[(wave * 4 + rr) * 36 + 9 * cg + c] = a; }
        if (wave == 0) {
#pragma unroll
            for (int c = 0; c < 9; ++c) { float a = accq[c]; a += __shfl_xor(a, 1); a += __shfl_xor(a, 2); a += __shfl_xor(a, 4); a += __shfl_xor(a, 8); if (kpart == 0) lg[1152 + 9 * cg + c] = a; } }
        ss += __shfl_xor(ss, 1); ss += __shfl_xor(ss, 2); ss += __shfl_xor(ss, 4); ss += __shfl_xor(ss, 8);
        if (kp == 0) rs[r] = 1.0f / sqrtf(ss * (1.0f / D_) + EPS_);
        __syncthreads();
        if (tid < 32) { const int row = row0 + tid; const LAS float* l = lg + tid * 36; const LAS float* q = lg + 1152; const float* bg = A.in[18] + layer * 4; const float* be = A.in[20] + layer * 32; const float rstd = rs[tid];
            if (first) RS[row] = rstd;
            float g[4]; int gi = 0; float gm;
#pragma unroll
            for (int i = 0; i < 4; ++i) g[i] = rstd * l[i] + q[i] + bg[i];
            gm = g[0];
#pragma unroll
            for (int i = 1; i < 4; ++i) if (g[i] > gm) { gm = g[i]; gi = i; }
            float gs = 0.f;
#pragma unroll
            for (int i = 0; i < 4; ++i) gs += __expf(g[i] - gm);
            const float gw = 1.0f / gs;
            float e[8];
#pragma unroll
            for (int i = 0; i < 8; ++i) e[i] = rstd * l[4 + 8 * gi + i] + q[4 + 8 * gi + i] + be[8 * gi + i];
            int i0 = 0; float m0 = e[0];
#pragma unroll
            for (int i = 1; i < 8; ++i) if (e[i] > m0) { m0 = e[i]; i0 = i; }
            int i1 = -1; float m1 = -3.0e38f;
#pragma unroll
            for (int i = 0; i < 8; ++i) if (i != i0 && e[i] > m1) { m1 = e[i]; i1 = i; }
            const float p1 = __expf(m1 - m0), w0 = gw / (1.0f + p1), w1 = gw * p1 / (1.0f + p1);
            const int e0 = 8 * gi + i0, e1 = 8 * gi + i1;
            int* rt = RT + (size_t)row * 8; rt[0] = e0; rt[1] = e1; rt[2] = __float_as_int(w0); rt[3] = __float_as_int(w1);
            if (first) { atomicAdd((unsigned*)(F.ctl + CW_ECNT + 64 * layer + e0), 1u); atomicAdd((unsigned*)(F.ctl + CW_ECNT + 64 * layer + e1), 1u); }
        }
        __syncthreads();
    }
}

__device__ __forceinline__ void scatter_phase(Frame& F, const float* X, const float* gvec, int jn, int layer, bool first) {
    LAS int* tab = (LAS int*)(F.lds + MOE_TAB_OFF);
    PHASE_IDS(F);
    const int gw = F.vcu * NWAVES + wave, NGW = F.G * NWAVES;
    const float* MOD = (const float*)(F.ctl + CW_MOD);
    int* RT = (int*)(F.ws + WS_ROUTE); const float* RS = (const float*)(F.ws + WS_RS); bf16* HG = (bf16*)(F.ws + WS_HG);
    for (int tok = gw; tok < T_; tok += NGW) {
        int* rt = RT + (size_t)tok * 8; int p0 = 0, p1 = 0;
        const f32x4* xr = (const f32x4*)(X + (size_t)tok * D_) + lane; f32x4 v[8];
#pragma unroll
        for (int j = 0; j < 8; ++j) v[j] = xr[64 * j];
        if (lane == 0 && !first) { p0 = rt[4]; p1 = rt[5]; }
        if (lane == 0 && first) { const int e0 = rt[0], e1 = rt[1];
            p0 = tab[128 + e0] + (int)atomicAdd((unsigned*)(F.ctl + CW_ECUR + 64 * layer + e0), 1u);
            p1 = tab[128 + e1] + (int)atomicAdd((unsigned*)(F.ctl + CW_ECUR + 64 * layer + e1), 1u);
            rt[4] = p0; rt[5] = p1; }
        p0 = __builtin_amdgcn_readfirstlane(p0); p1 = __builtin_amdgcn_readfirstlane(p1);
        const float rstd = RS[tok]; const int b = tok >> 11;
        const f32x4* sh = (const f32x4*)(MOD + (size_t)(jn * 4 + b) * 6144) + lane; const f32x4* sc = sh + 512; const f32x4* gv = (const f32x4*)gvec + lane;
        v2u* d0 = (v2u*)(HG + (size_t)p0 * D_) + lane; v2u* d1 = (v2u*)(HG + (size_t)p1 * D_) + lane;
#pragma unroll
        for (int j = 0; j < 8; ++j) { const f32x4 h = v[j] * rstd * gv[64 * j] * (1.0f + sc[64 * j]) + sh[64 * j]; v2u w; w.x = pk2(h.x, h.y); w.y = pk2(h.z, h.w); d0[64 * j] = w; d1[64 * j] = w; }
    }
}

__device__ __forceinline__ void retnorm_phase(Frame& F) {
    PHASE_IDS(F);
    const int gw = F.vcu * NWAVES + wave, NGW = F.G * NWAVES;
    const bf16* O = (const bf16*)(F.ws + WS_RETO); const bf16* P1 = (const bf16*)(F.ws + WS_PROJ1); bf16* A5 = (bf16*)(F.ws + WS_A5);
    for (int row = gw; row < T_; row += NGW) {
        const v4u* o = (const v4u*)(O + (size_t)row * 4096) + lane; const v4u* g = (const v4u*)(P1 + (size_t)row * 12288 + 8192) + lane; v4u* a = (v4u*)(A5 + (size_t)row * 4096) + lane;
#pragma unroll
        for (int h = 0; h < 8; ++h) { const v4u x = o[64 * h], s = g[64 * h];
            float f[8] = {bf_lo(x.x), bf_hi(x.x), bf_lo(x.y), bf_hi(x.y), bf_lo(x.z), bf_hi(x.z), bf_lo(x.w), bf_hi(x.w)};
            float ss = 0.f;
#pragma unroll
            for (int i = 0; i < 8; ++i) ss += f[i] * f[i];
            const float rstd = 1.0f / sqrtf(wave_sum(ss) * (1.0f / 512.0f) + EPS_);
            v4u w; w.x = pk2(f[0] * rstd * bf_lo(s.x), f[1] * rstd * bf_hi(s.x)); w.y = pk2(f[2] * rstd * bf_lo(s.y), f[3] * rstd * bf_hi(s.y));
            w.z = pk2(f[4] * rstd * bf_lo(s.z), f[5] * rstd * bf_hi(s.z)); w.w = pk2(f[6] * rstd * bf_lo(s.w), f[7] * rstd * bf_hi(s.w));
            a[64 * h] = w; }
    }
}
#ifndef ATT_REP
#define ATT_REP 1
#endif
#ifndef RET_REP
#define RET_REP 1
#endif
#ifndef ATT_KPF
#define ATT_KPF 4
#endif
constexpr int ATT_VST = 320;
__device__ __forceinline__ s16x4 vtr(const LAS unsigned char* p) { return __builtin_bit_cast(s16x4, __builtin_amdgcn_ds_read_tr16_b64_v4i16((LAS v4i16_t*)p)); }
__device__ __forceinline__ float xhalf(float v) { return __shfl_xor(v, 32); }

template <int DQK, int MODE>
__device__ __forceinline__ void attn_unit(LAS unsigned char* lds, const bf16* Qp, int qpitch, const bf16* Kp, int kpitch, const bf16* K2p, int k2pitch,
                                          const bf16* Vp, int vpitch, bf16* Op, int opitch, int q0, float dlog2, int tid_, int wave, int lane_, volatile LAS unsigned* flg) {
    const int lane = lane_id_opaque(), tid = wave * 64 + lane; (void)tid_; (void)lane_;
    constexpr int RB = DQK * 2, SW = (DQK == 192) ? 7 : 15, KB = 64 * RB, STG = KB + 16384;
    constexpr int NIK = KB / 8192, NI = NIK + 2;
    constexpr int NKS = DQK / 16;
    static_assert(3 * STG <= RING_BYTES, "three stages in the ring");
    const int r = lane & 31, h = lane >> 5, qrow = q0 + 32 * wave + r;
    bf16x8 qf[NKS];
    { const bf16* qp = Qp + (size_t)qrow * qpitch + 8 * h;
#pragma unroll
      for (int ks = 0; ks < NKS; ++ks) qf[ks] = *(const bf16x8*)(qp + 16 * ks); }
    f32x16 o[4];
#pragma unroll
    for (int db = 0; db < 4; ++db)
#pragma unroll
        for (int i = 0; i < 16; ++i) o[db][i] = 0.f;
    float m_run = -1.0e30f, l_run = 0.f, carry = 0.f;
    const int ntiles = (q0 + 256) >> 6;
    constexpr bool KLIN = (DQK != 192); constexpr int NKG = KLIN ? 1 : NIK;
    unsigned kgo[NKG], vgo0; bool krope[NKG];
#pragma unroll
    for (int j = 0; j < NKG; ++j) { const int pos = (j * 8 + wave) * 1024 + lane * 16, row = pos / RB, c = ((pos % RB) >> 4) ^ (row & SW);
        krope[j] = (DQK == 192) && c >= 16;
        kgo[j] = krope[j] ? (unsigned)(row * k2pitch * 2 + (c - 16) * 16) : (unsigned)(row * kpitch * 2 + c * 16); }
    { const int pos = wave * 1024 + lane * 16, row = pos >> 8, ch = ((pos & 255) >> 4) ^ (((row & 3) << 2) | ((row >> 2) & 3)); vgo0 = (unsigned)(row * vpitch * 2 + ch * 16); }
#define ATT_DMA(kt, stg) do { const size_t key0_ = (size_t)(kt) * 64; \
        const char* kb_ = (const char*)Kp + key0_ * kpitch * 2; const char* k2_ = (const char*)K2p + key0_ * k2pitch * 2; const char* vb_ = (const char*)Vp + key0_ * vpitch * 2; \
        LAS unsigned char* st_ = lds + (stg) * STG + wave * 1024; \
        _Pragma("unroll") for (int j_ = 0; j_ < NIK; ++j_) { const char* g_ = KLIN ? kb_ + kgo[0] + (size_t)j_ * (8192 / RB) * kpitch * 2 : ((krope[KLIN ? 0 : j_] ? k2_ : kb_) + kgo[KLIN ? 0 : j_]); \
            __builtin_amdgcn_global_load_lds((const unsigned*)g_, (LAS unsigned*)(st_ + j_ * 8192), 16, 0, 0); } \
        _Pragma("unroll") for (int j_ = 0; j_ < 2; ++j_) __builtin_amdgcn_global_load_lds((const unsigned*)(vb_ + vgo0 + (size_t)j_ * 32 * vpitch * 2), (LAS unsigned*)(st_ + KB + j_ * 8192), 16, 0, 0); } while (0)
    if (MODE == 1 && tid < 16) flg[tid] = 0u;
    ATT_DMA(ntiles - 1, 0);
    ATT_DMA(ntiles > 1 ? ntiles - 2 : 0, 1);
    const int q4 = (lane & 15) >> 2, p4 = lane & 3, blk = (lane >> 4) & 1, x4 = 2 * blk + (p4 >> 1);
    constexpr int NKO = (SW + 1) / 2;
    const int krow = r * RB, kxy = (r & SW) ^ h;
    const int vlo_off = 256 * (4 * h + q4) + 16 * (x4 ^ h) + 8 * (p4 & 1), vhi_off = 256 * (4 * h + q4 + 8) + 16 * (x4 ^ (h + 2)) + 8 * (p4 & 1);
    for (int it = 0; it < ntiles; ++it) {
        const int kt = ntiles - 1 - it;
        int y_ = kxy, q4_ = q4; asm volatile("" : "+v"(y_), "+v"(q4_));
        const bool wdone = (MODE == 1) && __all(carry < -140.0f);
        if (MODE == 1 && lane == 0) flg[8 * (it & 1) + wave] = wdone ? 1u : 0u;
        asm volatile("s_waitcnt vmcnt(%0)" :: "n"(NI) : "memory");
        asm volatile("s_waitcnt lgkmcnt(0)" ::: "memory");
        __builtin_amdgcn_s_barrier();
        asm volatile("" ::: "memory");
        if (MODE == 1) { v4u fa, fb; const unsigned fad = (unsigned)(size_t)(flg + 8 * (it & 1));
            asm volatile("ds_read_b128 %0, %2\n\tds_read_b128 %1, %2 offset:16\n\ts_waitcnt lgkmcnt(0)" : "=&v"(fa), "=&v"(fb) : "v"(fad) : "memory");
            if ((fa.x & fa.y & fa.z & fa.w & fb.x & fb.y & fb.z & fb.w) != 0u) break; }
        { const int ktn = kt >= 2 ? kt - 2 : 0; ATT_DMA(ktn, (it + 2) % 3); }
        if (!wdone && 64 * kt <= q0 + 32 * wave + 31) {
            const LAS unsigned char* Kb = lds + (it % 3) * STG; const LAS unsigned char* Vb = Kb + KB;
            f32x16 s[2];
            const int kbase = 64 * kt + 4 * h;
            const bool diag = 64 * kt + 63 > q0 + 32 * wave;
            unsigned va[8];
#pragma unroll
            for (int db = 0; db < 4; ++db) { va[db] = (unsigned)(size_t)(Vb + vlo_off + 64 * (db ^ q4_)); va[4 + db] = (unsigned)(size_t)(Vb + vhi_off + 64 * (db ^ q4_)); }
            s16x4 lo_[2][4], hi_[2][4];
#define ATT_VRD(buf, sidx) do { _Pragma("unroll") for (int db = 0; db < 4; ++db) { \
                    asm volatile("ds_read_b64_tr_b16 %0, %1 offset:%c2" : "=&v"(lo_[buf][db]) : "v"(va[db]), "i"(4096 * (sidx)) : "memory"); \
                    asm volatile("ds_read_b64_tr_b16 %0, %1 offset:%c2" : "=&v"(hi_[buf][db]) : "v"(va[4 + db]), "i"(4096 * (sidx)) : "memory"); } } while (0)
#define ATT_VMM(buf, sidx) do { const int kb_ = (sidx) >> 1, ss_ = (sidx) & 1; \
                v4u pw; pw.x = pk2(s[kb_][8 * ss_ + 0], s[kb_][8 * ss_ + 1]); pw.y = pk2(s[kb_][8 * ss_ + 2], s[kb_][8 * ss_ + 3]); pw.z = pk2(s[kb_][8 * ss_ + 4], s[kb_][8 * ss_ + 5]); pw.w = pk2(s[kb_][8 * ss_ + 6], s[kb_][8 * ss_ + 7]); \
                const bf16x8 pf = __builtin_bit_cast(bf16x8, pw); \
                _Pragma("unroll") for (int db = 0; db < 4; ++db) { \
                    const bf16x8 vf = __builtin_shufflevector(lo_[buf][db], hi_[buf][db], 0, 1, 2, 3, 4, 5, 6, 7); \
                    o[db] = __builtin_amdgcn_mfma_f32_32x32x16_bf16(vf, pf, o[db], 0, 0, 0); } } while (0)
#define ATT_PVN(first, count) do { ATT_VRD(0, first); \
                _Pragma("unroll") for (int i_ = 0; i_ < (count); ++i_) { \
                    if (i_ + 1 < (count)) { if (i_ & 1) ATT_VRD(0, (first) + i_ + 1); else ATT_VRD(1, (first) + i_ + 1); asm volatile("s_waitcnt lgkmcnt(8)" ::: "memory"); } \
                    else asm volatile("s_waitcnt lgkmcnt(0)" ::: "memory"); \
                    __builtin_amdgcn_sched_barrier(0); \
                    if (i_ & 1) ATT_VMM(1, (first) + i_); else ATT_VMM(0, (first) + i_); \
                    __builtin_amdgcn_sched_barrier(0); } } while (0)
#pragma unroll
            for (int kb = 0; kb < 2; ++kb) {
#pragma unroll
                for (int i = 0; i < 16; ++i) s[kb][i] = 0.f;
                const LAS unsigned char* kp = Kb + 32 * kb * RB;
#define ATT_KF(ks) (*(const LAS bf16x8*)(kp + krow + (((2 * ((ks) % NKO)) ^ y_) << 4) + (((2 * (ks)) & ~SW) << 4)))
                bf16x8 fa = ATT_KF(0), fb = ATT_KF(1);
#pragma unroll
                for (int g2 = 0; g2 < NKS / 2; ++g2) {
                    bf16x8 na = fa, nb = fb;
                    if (g2 + 1 < NKS / 2) { na = ATT_KF(2 * g2 + 2); nb = ATT_KF(2 * g2 + 3); }
                    __builtin_amdgcn_sched_barrier(0);
                    s[kb] = __builtin_amdgcn_mfma_f32_32x32x16_bf16(fa, qf[2 * g2], s[kb], 0, 0, 0); s[kb] = __builtin_amdgcn_mfma_f32_32x32x16_bf16(fb, qf[2 * g2 + 1], s[kb], 0, 0, 0);
                    __builtin_amdgcn_sched_barrier(0);
                    fa = na; fb = nb;
                }
#undef ATT_KF
                if (MODE == 2) {
                    if (diag) {
#pragma unroll
                        for (int i = 0; i < 16; ++i) { const int key = kbase + 32 * kb + (i & 3) + 8 * (i >> 2); s[kb][i] = key <= qrow ? s[kb][i] : 0.f; } }
                    ATT_PVN(2 * kb, 2);
                }
            }
            if (MODE == 0) {
                float tmax = -1.0e30f;
#pragma unroll
                for (int kb = 0; kb < 2; ++kb)
#pragma unroll
                    for (int i = 0; i < 16; ++i) { const int key = kbase + 32 * kb + (i & 3) + 8 * (i >> 2); const float v = (!diag || key <= qrow) ? s[kb][i] : -1.0e30f; s[kb][i] = v; tmax = fmaxf(tmax, v); }
                tmax = fmaxf(tmax, xhalf(tmax));
                const float m_new = fmaxf(m_run, tmax), alpha = ex2(m_run - m_new); m_run = m_new;
                float ps = 0.f;
#pragma unroll
                for (int kb = 0; kb < 2; ++kb)
#pragma unroll
                    for (int i = 0; i < 16; ++i) { const float p = ex2(s[kb][i] - m_new); s[kb][i] = p; ps += p; }
                l_run = l_run * alpha + ps;
#pragma unroll
                for (int db = 0; db < 4; ++db)
#pragma unroll
                    for (int i = 0; i < 16; ++i) o[db][i] *= alpha;
            } else if (MODE == 1) {
                float lkv[2][16], gs[2][4], go[2][4];
#pragma unroll
                for (int kb = 0; kb < 2; ++kb)
#pragma unroll
                    for (int g = 0; g < 4; ++g) { float t = 0.f;
#pragma unroll
                        for (int j = 0; j < 4; ++j) { const int i = 4 * g + j, key = kbase + 32 * kb + 8 * g + j; const float z = s[kb][i];
                            const bool vis = key < qrow;
                            const float lk = vis ? -(fmaxf(z, 0.f) + lg2(1.0f + ex2(-fabsf(z)))) : 0.f;
                            lkv[kb][i] = lk; s[kb][i] = vis ? z + lk : -1.0e30f; t += lk; }
                        gs[kb][g] = t; }
#pragma unroll
                for (int kb = 0; kb < 2; ++kb)
#pragma unroll
                    for (int g = 0; g < 4; ++g) go[kb][g] = xhalf(gs[kb][g]);
                float R = carry;
#pragma unroll
                for (int kb = 1; kb >= 0; --kb)
#pragma unroll
                    for (int g = 3; g >= 0; --g) {
                        float run = R + (h == 0 ? go[kb][g] : 0.f);
#pragma unroll
                        for (int j = 3; j >= 0; --j) { const int i = 4 * g + j; const float a = ex2(s[kb][i] + run); run += lkv[kb][i]; s[kb][i] = a; }
                        R += gs[kb][g] + go[kb][g];
                    }
                carry = R;
            }
            if (MODE != 2) { ATT_PVN(0, 4); }
#undef ATT_PVN
#undef ATT_VMM
#undef ATT_VRD
        }
    }
#undef ATT_DMA
    asm volatile("s_waitcnt vmcnt(0) lgkmcnt(0)" ::: "memory");
    __builtin_amdgcn_s_barrier();
    asm volatile("" ::: "memory");
    float inv = 1.0f;
    if (MODE == 0) { const float lt = l_run + xhalf(l_run); inv = 1.0f / lt; }
    bf16* op = Op + (size_t)qrow * opitch + 4 * h;
#pragma unroll
    for (int db = 0; db < 4; ++db)
#pragma unroll
        for (int g = 0; g < 4; ++g) { v2u w; w.x = pk2(o[db][4 * g] * inv, o[db][4 * g + 1] * inv); w.y = pk2(o[db][4 * g + 2] * inv, o[db][4 * g + 3] * inv); *(v2u*)(op + 32 * db + 8 * g) = w; }
}

struct WorkQ { gu32* q; int total; int slot; unsigned nxt; };
__device__ __forceinline__ void wq_init(Frame& F, WorkQ& Q, gu32* q, int total, int slot, int lane) {
    Q.q = q; Q.total = total; Q.slot = slot; Q.nxt = 0u;
    if (F.wave == 0 && lane == 0) Q.nxt = __hip_atomic_fetch_add(q, 1u, RLX_AGENT);
}
__device__ __forceinline__ bool wq_take(Frame& F, WorkQ& Q, int lane, int& u) {
    if (F.wave == 0 && lane == 0) F.MISC[Q.slot] = Q.nxt;
    __syncthreads();
    u = (int)F.MISC[Q.slot];
    __syncthreads();
    if (u >= Q.total) return false;
    if (F.wave == 0 && lane == 0) Q.nxt = __hip_atomic_fetch_add(Q.q, 1u, RLX_AGENT);
    return true;
}
template <int STREAM> __device__ __forceinline__ bool conv_batch(Frame& F, const Args& A, WorkQ& Q, int lane, int wave) {
    int b; if (!wq_take(F, Q, lane, b)) return false;
    const int i0 = 32 * b + 4 * wave;
    const ConvSrc c0 = conv_item<STREAM>(A, F.ws, i0), c1 = conv_item<STREAM>(A, F.ws, i0 + 1), c2 = conv_item<STREAM>(A, F.ws, i0 + 2), c3 = conv_item<STREAM>(A, F.ws, i0 + 3);
    f32x4 v0[8], v1[8], v2[8], v3[8];
    conv_load(c0, lane, v0); conv_load(c1, lane, v1); conv_load(c2, lane, v2); conv_load(c3, lane, v3);
    conv_store(c0, lane, v0); conv_store(c1, lane, v1); conv_store(c2, lane, v2); conv_store(c3, lane, v3);
    return true;
}
__device__ __forceinline__ void mla_phase(Frame& F, const Args& A, WorkQ& QC, bool& conv_left) {
    PHASE_IDS(F);
    WorkQ QU; wq_init(F, QU, F.ctl + CW_QMLA, 256, 16, lane);
    if (F.vcu & 1) { for (int i = 0; i < 8 && conv_left; ++i) conv_left = conv_batch<1>(F, A, QC, lane, wave); }
    const bf16* Q = (const bf16*)(F.ws + WS_QMLA); const bf16* KV = (const bf16*)(F.ws + WS_KVMLA); const bf16* KR = (const bf16*)(F.ws + WS_KR); bf16* O = (bf16*)(F.ws + WS_ATTO);
    int u;
    while (wq_take(F, QU, lane, u)) {
        const int qb = 7 - (u >> 5), bh = u & 31, b = bh >> 3, h = bh & 7; const size_t r0 = (size_t)b * S_;
#pragma unroll 1
        for (int rep_ = 0; rep_ < ATT_REP; ++rep_)
        attn_unit<192, 0>(F.lds + RING_OFF, Q + r0 * 1536 + h * 192, 1536, KV + r0 * 2048 + h * 256, 2048, KR + r0 * 64, 64, KV + r0 * 2048 + h * 256 + 128, 2048,
                          O + r0 * 2048 + 1024 + h * 128, 2048, qb * 256, 0.f, tid, wave, lane, F.MISC + 32);
        for (int i = 0; i < 4 && conv_left; ++i) conv_left = conv_batch<1>(F, A, QC, lane, wave);
    }
}
__device__ __forceinline__ void sb_phase(Frame& F, const Args& A, WorkQ& QC, bool& conv_left) {
    PHASE_IDS(F);
    WorkQ QU; wq_init(F, QU, F.ctl + CW_QSB, 256, 17, lane);
    const bf16* P0 = (const bf16*)(F.ws + WS_PROJ0); bf16* O = (bf16*)(F.ws + WS_ATTO);
    int u;
    while (wq_take(F, QU, lane, u)) {
        const int qb = 7 - (u >> 5), bh = u & 31, b = bh >> 3, h = bh & 7; const size_t r0 = (size_t)b * S_;
#pragma unroll 1
        for (int rep_ = 0; rep_ < ATT_REP; ++rep_)
        attn_unit<128, 1>(F.lds + RING_OFF, P0 + r0 * 4096 + h * 128, 4096, P0 + r0 * 4096 + 1024 + h * 128, 4096, nullptr, 0, P0 + r0 * 4096 + 2048 + h * 128, 4096,
                          O + r0 * 2048 + h * 128, 2048, qb * 256, 0.f, tid, wave, lane, F.MISC + 32);
        for (int i = 0; i < 4 && conv_left; ++i) conv_left = conv_batch<1>(F, A, QC, lane, wave);
    }
    while (conv_left) conv_left = conv_batch<1>(F, A, QC, lane, wave);
}
__device__ __forceinline__ void ret_phase(Frame& F, const Args& A) {
    PHASE_IDS(F);
    WorkQ QC; wq_init(F, QC, F.ctl + CW_QC2, CONV_N2 / 32, 18, lane); bool conv_left = true;
    WorkQ QU; wq_init(F, QU, F.ctl + CW_QRET, 1024, 16, lane);
    if (F.vcu & 1) conv_left = conv_batch<2>(F, A, QC, lane, wave);
    const bf16* P1 = (const bf16*)(F.ws + WS_PROJ1); bf16* O = (bf16*)(F.ws + WS_RETO);
    int u;
    while (wq_take(F, QU, lane, u)) {
        const int qb = 7 - (u >> 7), rem = u & 127, eq = rem >> 5, bh = rem & 31, b = bh >> 3, h = bh & 7; const size_t r0 = (size_t)b * S_;
        const float dlog2 = log1pf(-exp2f(-5.0f - (float)h)) * LOG2E;
#pragma unroll 1
        for (int rep_ = 0; rep_ < RET_REP; ++rep_)
        attn_unit<256, 2>(F.lds + RING_OFF, P1 + r0 * 12288 + h * 256, 12288, P1 + r0 * 12288 + 2048 + h * 256, 12288, nullptr, 0, P1 + r0 * 12288 + 4096 + h * 512 + eq * 128, 12288,
                          O + r0 * 4096 + h * 512 + eq * 128, 4096, qb * 256, dlog2, tid, wave, lane, F.MISC + 32);
        for (int i = 0; i < 2 && conv_left; ++i) conv_left = conv_batch<2>(F, A, QC, lane, wave);
    }
    while (conv_left) conv_left = conv_batch<2>(F, A, QC, lane, wave);
}
typedef f32x4 AccT[2][2][4][2];
__device__ __forceinline__ v4u pack8(const f32x4& a, const f32x4& b) { v4u w; w.x = pk2(a.x, a.y); w.y = pk2(a.z, a.w); w.z = pk2(b.x, b.y); w.w = pk2(b.z, b.w); return w; }
__device__ __forceinline__ float sq4(const f32x4& a) { return (a.x * a.x + a.y * a.y) + (a.z * a.z + a.w * a.w); }
__device__ __forceinline__ void rope4(const f32x4& x1, const f32x4& x2, const f32x2* cs, f32x4& o1, f32x4& o2) {
    const f32x4 c01 = *(const f32x4*)cs, c23 = *(const f32x4*)(cs + 2);
    o1.x = x1.x * c01.x - x2.x * c01.y; o2.x = x1.x * c01.y + x2.x * c01.x;
    o1.y = x1.y * c01.z - x2.y * c01.w; o2.y = x1.y * c01.w + x2.y * c01.z;
    o1.z = x1.z * c23.x - x2.z * c23.y; o2.z = x1.z * c23.y + x2.z * c23.x;
    o1.w = x1.w * c23.z - x2.w * c23.w; o2.w = x1.w * c23.w + x2.w * c23.z;
}
struct EpiG1 { static constexpr bool PERM = true, AFTER_DRAIN = false;
    bf16* P0; bf16* KR; float* ssqp; const f32x2* cs64;
    __device__ __forceinline__ void operator()(const AccT& acc, const pg8::Unit& u, int wr, int wc, int fr, int fq) const {
        const int row0 = u.pm * 256 + wr * 64 + fr, tc = wc * 32 + 8 * fq;
        if (u.pn < 15) {
            const float scl = u.pn < 4 ? C_SB : 1.0f;
#pragma unroll
            for (int ai = 0; ai < 2; ++ai)
#pragma unroll
                for (int m = 0; m < 4; ++m) { const int row = row0 + ai * 128 + m * 16; float ss = 0.f;
#pragma unroll
                    for (int bj = 0; bj < 2; ++bj) { const f32x4 v0 = acc[ai][bj][m][0], v1 = acc[ai][bj][m][1]; ss += sq4(v0) + sq4(v1);
                        *(v4u*)(P0 + (size_t)row * 4096 + u.pn * 256 + bj * 128 + tc) = pack8(v0 * scl, v1 * scl); }
                    if (u.pn >= 12) { ss += __shfl_xor(ss, 16); ss += __shfl_xor(ss, 32); if (fq == 0) { if (u.pn < 14) ssqp[(size_t)row * 8 + 4 * (u.pn - 12) + wc] = ss; else ssqp[(size_t)T_ * 8 + (size_t)row * 4 + wc] = ss; } } }
        } else if (wc == 0) {
#pragma unroll
            for (int ai = 0; ai < 2; ++ai)
#pragma unroll
                for (int m = 0; m < 4; ++m) { const int row = row0 + ai * 128 + m * 16; f32x4 a0, b0, a1, b1;
                    rope4(acc[ai][0][m][0], acc[ai][1][m][0], cs64 + (size_t)row * 32 + 8 * fq, a0, b0);
                    rope4(acc[ai][0][m][1], acc[ai][1][m][1], cs64 + (size_t)row * 32 + 8 * fq + 4, a1, b1);
                    *(v4u*)(KR + (size_t)row * 64 + 8 * fq) = pack8(a0, a1); *(v4u*)(KR + (size_t)row * 64 + 32 + 8 * fq) = pack8(b0, b1); asm volatile("" ::: "memory"); }
        }
    }
};
struct EpiG2q { static constexpr bool PERM = true, AFTER_DRAIN = false;
    bf16* Q; const float* ssq; const f32x2* cs64;
    __device__ __forceinline__ void operator()(const AccT& acc, const pg8::Unit& u, int wr, int wc, int fr, int fq) const {
        const int row0 = u.pm * 256 + wr * 64 + fr, tc = wc * 32 + 8 * fq;
        if (u.pn < 4) {
#pragma unroll
            for (int ai = 0; ai < 2; ++ai)
#pragma unroll
                for (int m = 0; m < 4; ++m) { const int row = row0 + ai * 128 + m * 16; const f32x4 pa = *(const f32x4*)(ssq + (size_t)row * 8), pb = *(const f32x4*)(ssq + (size_t)row * 8 + 4); const float rs = C_MLA * __builtin_amdgcn_rsqf(((((((pa.x + pa.y) + pa.z) + pa.w) + pb.x) + pb.y) + pb.z + pb.w) * (1.0f / 512.0f) + EPS_);
#pragma unroll
                    for (int bj = 0; bj < 2; ++bj) { const int nidx = u.pn * 256 + bj * 128 + tc, hh = nidx >> 7, d = nidx & 127;
                        *(v4u*)(Q + (size_t)row * 1536 + hh * 192 + d) = pack8(acc[ai][bj][m][0] * rs, acc[ai][bj][m][1] * rs); }
                    asm volatile("" ::: "memory"); }
        } else {
            const int head = 4 * (u.pn - 4) + wc;
#pragma unroll
            for (int ai = 0; ai < 2; ++ai)
#pragma unroll
                for (int m = 0; m < 4; ++m) { const int row = row0 + ai * 128 + m * 16; const f32x4 pa = *(const f32x4*)(ssq + (size_t)row * 8), pb = *(const f32x4*)(ssq + (size_t)row * 8 + 4); const float rs = C_MLA * __builtin_amdgcn_rsqf(((((((pa.x + pa.y) + pa.z) + pa.w) + pb.x) + pb.y) + pb.z + pb.w) * (1.0f / 512.0f) + EPS_); f32x4 a0, b0, a1, b1;
                    rope4(acc[ai][0][m][0] * rs, acc[ai][1][m][0] * rs, cs64 + (size_t)row * 32 + 8 * fq, a0, b0);
                    rope4(acc[ai][0][m][1] * rs, acc[ai][1][m][1] * rs, cs64 + (size_t)row * 32 + 8 * fq + 4, a1, b1);
                    *(v4u*)(Q + (size_t)row * 1536 + head * 192 + 128 + 8 * fq) = pack8(a0, a1); *(v4u*)(Q + (size_t)row * 1536 + head * 192 + 160 + 8 * fq) = pack8(b0, b1);
                    asm volatile("" ::: "memory"); }
        }
    }
};
struct EpiG2kv { static constexpr bool PERM = true, AFTER_DRAIN = false;
    bf16* KV; const float* ssq;
    __device__ __forceinline__ void operator()(const AccT& acc, const pg8::Unit& u, int wr, int wc, int fr, int fq) const {
        const int row0 = u.pm * 256 + wr * 64 + fr, tc = wc * 32 + 8 * fq;
#pragma unroll
        for (int ai = 0; ai < 2; ++ai)
#pragma unroll
            for (int m = 0; m < 4; ++m) { const int row = row0 + ai * 128 + m * 16; const f32x4 pa = *(const f32x4*)(ssq + (size_t)row * 4); const float rs = __builtin_amdgcn_rsqf((((pa.x + pa.y) + pa.z) + pa.w) * (1.0f / 256.0f) + EPS_);
#pragma unroll
                for (int bj = 0; bj < 2; ++bj) *(v4u*)(KV + (size_t)row * 2048 + u.pn * 256 + bj * 128 + tc) = pack8(acc[ai][bj][m][0] * rs, acc[ai][bj][m][1] * rs); asm volatile("" ::: "memory"); }
    }
};
struct EpiRes { static constexpr bool PERM = false, AFTER_DRAIN = false;
    const float* src; float* dst; const float* gate;
    __device__ __forceinline__ void operator()(const AccT& acc, const pg8::Unit& u, int wr, int wc, int fr, int fq) const {
        const int row0 = u.pm * 256 + wr * 64 + fr, col0 = u.pn * 256 + wc * 32 + 4 * fq;
#pragma unroll
        for (int ai = 0; ai < 2; ++ai)
#pragma unroll
            for (int m = 0; m < 4; ++m) { const int row = row0 + ai * 128 + m * 16; const float* g = gate + (size_t)(row >> 11) * 6144 + col0; const size_t off = (size_t)row * 2048 + col0;
#pragma unroll
                for (int bj = 0; bj < 2; ++bj)
#pragma unroll
                    for (int n = 0; n < 2; ++n) { const int o = bj * 128 + n * 16; *(f32x4*)(dst + off + o) = *(const f32x4*)(src + off + o) + *(const f32x4*)(g + o) * acc[ai][bj][m][n]; } asm volatile("" ::: "memory"); }
    }
};
struct EpiG4 { static constexpr bool PERM = true, AFTER_DRAIN = false;
    bf16* P1; const f32x2* cs256;
    __device__ __forceinline__ void operator()(const AccT& acc, const pg8::Unit& u, int wr, int wc, int fr, int fq) const {
        const int row0 = u.pm * 256 + wr * 64 + fr, tc = wc * 32 + 8 * fq;
#pragma unroll
        for (int ai = 0; ai < 2; ++ai)
#pragma unroll
            for (int m = 0; m < 4; ++m) { const int row = row0 + ai * 128 + m * 16; bf16* dst = P1 + (size_t)row * 12288 + u.pn * 256 + tc;
                if (u.pn < 16) {
                    const float dl2 = log1pf(-exp2f(-5.0f - (float)(u.pn & 7))) * LOG2E, rel = (float)((row & 2047) - 1024);
                    const float scl = u.pn >= 8 ? 0.0625f * ex2(-dl2 * rel) : ex2(dl2 * rel); f32x4 a0, b0, a1, b1;
                    rope4(acc[ai][0][m][0] * scl, acc[ai][1][m][0] * scl, cs256 + (size_t)row * 128 + tc, a0, b0);
                    rope4(acc[ai][0][m][1] * scl, acc[ai][1][m][1] * scl, cs256 + (size_t)row * 128 + tc + 4, a1, b1);
                    *(v4u*)dst = pack8(a0, a1); *(v4u*)(dst + 128) = pack8(b0, b1);
                } else if (u.pn < 32) {
#pragma unroll
                    for (int bj = 0; bj < 2; ++bj) *(v4u*)(dst + bj * 128) = pack8(acc[ai][bj][m][0], acc[ai][bj][m][1]);
                } else {
#pragma unroll
                    for (int bj = 0; bj < 2; ++bj) { f32x4 v0 = acc[ai][bj][m][0], v1 = acc[ai][bj][m][1];
                        v0.x = silu_f(v0.x); v0.y = silu_f(v0.y); v0.z = silu_f(v0.z); v0.w = silu_f(v0.w); v1.x = silu_f(v1.x); v1.y = silu_f(v1.y); v1.z = silu_f(v1.z); v1.w = silu_f(v1.w);
                        *(v4u*)(dst + bj * 128) = pack8(v0, v1); }
                } asm volatile("" ::: "memory"); }
    }
};
struct EpiM3 { static constexpr bool PERM = true, AFTER_DRAIN = false;
    bf16* ACT;
    __device__ __forceinline__ void operator()(const AccT& acc, const pg8::Unit& u, int wr, int wc, int fr, int fq) const {
        const int row0 = u.pm * 256 + wr * 64 + fr, tc = wc * 32 + 8 * fq;
#pragma unroll
        for (int ai = 0; ai < 2; ++ai)
#pragma unroll
            for (int m = 0; m < 4; ++m) { const int row = row0 + ai * 128 + m * 16; const f32x4 g0 = acc[ai][0][m][0], g1 = acc[ai][0][m][1], u0 = acc[ai][1][m][0], u1 = acc[ai][1][m][1]; f32x4 a0, a1;
                a0.x = silu_f(g0.x) * u0.x; a0.y = silu_f(g0.y) * u0.y; a0.z = silu_f(g0.z) * u0.z; a0.w = silu_f(g0.w) * u0.w;
                a1.x = silu_f(g1.x) * u1.x; a1.y = silu_f(g1.y) * u1.y; a1.z = silu_f(g1.z) * u1.z; a1.w = silu_f(g1.w) * u1.w;
                *(v4u*)(ACT + (size_t)row * 512 + u.pn * 128 + tc) = pack8(a0, a1); }
    }
};
struct EpiM4 { static constexpr bool PERM = true, AFTER_DRAIN = false;
    bf16* Y;
    __device__ __forceinline__ void operator()(const AccT& acc, const pg8::Unit& u, int wr, int wc, int fr, int fq) const {
        const int row0 = u.pm * 256 + wr * 64 + fr, tc = wc * 32 + 8 * fq;
#pragma unroll
        for (int ai = 0; ai < 2; ++ai)
#pragma unroll
            for (int m = 0; m < 4; ++m) { const int row = row0 + ai * 128 + m * 16;
#pragma unroll
                for (int bj = 0; bj < 2; ++bj) *(v4u*)(Y + (size_t)row * 2048 + u.pn * 256 + bj * 128 + tc) = pack8(acc[ai][bj][m][0], acc[ai][bj][m][1]); }
    }
};
__device__ __forceinline__ void moe_tables(Frame& F, int layer) {
    LAS int* tab = (LAS int*)(F.lds + MOE_TAB_OFF);
    __syncthreads();
    if (F.wave == 0) { const int lane = lane_id_opaque();
        const int cnt = lane < 32 ? (int)__hip_atomic_load(F.ctl + CW_ECNT + 64 * layer + lane, RLX_AGENT) : 0; const int nt = (cnt + 255) >> 8;
        int incl = nt;
#pragma unroll
        for (int off = 1; off < 32; off <<= 1) { const int v = __shfl_up(incl, off); if (lane >= off) incl += v; }
        const int start = incl - nt;
        if (lane < 32) { tab[128 + lane] = 256 * start; for (int i = 0; i < nt && start + i < 96; ++i) tab[start + i] = lane; }
        if (lane == 31) tab[160] = incl < 96 ? incl : 96; }
    __syncthreads();
}

#ifndef PH_MASK
#define PH_MASK 0x7FFFFFu
#endif
#ifndef PH_DUP
#define PH_DUP 0u
#endif
#define REP(k) _Pragma("unroll 1") for (int rep_ = 0; rep_ < ((((PH_DUP) >> (k)) & 1u) ? 2 : 1); ++rep_)
#define IN(k) (((PH_MASK >> (k)) & 1u) && lo <= (k) && (k) < hi)
#define SEAM(k) do { if (IN(k) && IN((k) + 1)) xcd_barrier(bar, F.wave); } while (0)
template <int LAYER, int PB> __device__ __forceinline__ void moe_phases(Frame& F, const Args& args, const XcdBarrier& bar, int lo, int hi) {
    unsigned char* ws = F.ws; LAS unsigned char* ring = F.lds + RING_OFF; const int c = (int)blockIdx.x;
    if (IN(PB)) { router_phase(F, args, (const float*)(ws + WS_XA), args.in[8] + LAYER * 2048, 2 * LAYER + 1, LAYER, true);
#if defined(ROUTER_TWICE)
        router_phase(F, args, (const float*)(ws + WS_XA), args.in[8] + LAYER * 2048, 2 * LAYER + 1, LAYER, false);
#endif
    } SEAM(PB);
    if (IN(PB + 1)) { moe_tables(F, LAYER); scatter_phase(F, (const float*)(ws + WS_XA), args.in[8] + LAYER * 2048, 2 * LAYER + 1, LAYER, true);
#if defined(SCATTER_TWICE)
        scatter_phase(F, (const float*)(ws + WS_XA), args.in[8] + LAYER * 2048, 2 * LAYER + 1, LAYER, false);
#endif
    } SEAM(PB + 1);
    if (IN(PB + 2)) {
        moe_tables(F, LAYER); const LAS int* tab = (const LAS int*)(F.lds + MOE_TAB_OFF); const int TM = tab[160], TA = (TM + 1) >> 1;
        pg8::Gemm g{2048, 2048, 2048}; pg8::MoeOrder S; S.ntn = 4; S.t0 = 0; S.nunits = TA * 4; S.gdeal = F.G; S.busy = 0; S.G = F.G; S.c = c; S.A = (const char*)(ws + WS_HG); S.W = (const char*)(ws + WS_W_GU + (size_t)LAYER * 128 * MiB);
        S.tstepA = (size_t)256 * 2048 * 2; S.tstepB = (size_t)256 * 2048 * 2; S.estep = (size_t)1024 * 2048 * 2; S.tile_expert = tab;
        EpiM3 E{(bf16*)(ws + WS_ACT)};
        pg8::gemm_phase<EpiM3, pg8::MoeOrder, true, true>(ring, g, S, E, F.wave);
#if defined(M3_TWICE)
        pg8::gemm_phase<EpiM3, pg8::MoeOrder, true, true>(ring, g, S, E, F.wave);
#endif
    } SEAM(PB + 2);
    if (IN(PB + 3)) {
        moe_tables(F, LAYER); const LAS int* tab = (const LAS int*)(F.lds + MOE_TAB_OFF); const int TM = tab[160], TA = (TM + 1) >> 1, nb3 = (TM - TA) * 4;
        { pg8::Gemm g{2048, 2048, 2048}; pg8::MoeOrder S; S.ntn = 4; S.t0 = TA; S.nunits = nb3; S.gdeal = nb3 < F.G ? nb3 : F.G; S.busy = 0; S.G = F.G; S.c = c; S.A = (const char*)(ws + WS_HG); S.W = (const char*)(ws + WS_W_GU + (size_t)LAYER * 128 * MiB);
          S.tstepA = (size_t)256 * 2048 * 2; S.tstepB = (size_t)256 * 2048 * 2; S.estep = (size_t)1024 * 2048 * 2; S.tile_expert = tab;
          EpiM3 E{(bf16*)(ws + WS_ACT)};
          pg8::gemm_phase<EpiM3, pg8::MoeOrder, true, true>(ring, g, S, E, F.wave); }
        { pg8::Gemm g{512, 512, 512}; pg8::MoeOrder S; S.ntn = 8; S.t0 = 0; S.nunits = TA * 8; S.gdeal = F.G; S.busy = (nb3 > 0 && nb3 < F.G) ? nb3 : 0; S.G = F.G; S.c = c; S.A = (const char*)(ws + WS_ACT); S.W = (const char*)(ws + WS_W_DN + (size_t)LAYER * 64 * MiB);
          S.tstepA = (size_t)256 * 512 * 2; S.tstepB = (size_t)256 * 512 * 2; S.estep = (size_t)2048 * 512 * 2; S.tile_expert = tab;
          EpiM4 E{(bf16*)(ws + WS_Y)};
          pg8::gemm_phase<EpiM4, pg8::MoeOrder, true, true>(ring, g, S, E, F.wave); }
    } SEAM(PB + 3);
    if (IN(PB + 4)) {
        moe_tables(F, LAYER); const LAS int* tab = (const LAS int*)(F.lds + MOE_TAB_OFF); const int TM = tab[160], TA = (TM + 1) >> 1;
        pg8::Gemm g{512, 512, 512}; pg8::MoeOrder S; S.ntn = 8; S.t0 = TA; S.nunits = (TM - TA) * 8; S.gdeal = F.G; S.busy = 0; S.G = F.G; S.c = c; S.A = (const char*)(ws + WS_ACT); S.W = (const char*)(ws + WS_W_DN + (size_t)LAYER * 64 * MiB);
        S.tstepA = (size_t)256 * 512 * 2; S.tstepB = (size_t)256 * 512 * 2; S.estep = (size_t)2048 * 512 * 2; S.tile_expert = tab;
        EpiM4 E{(bf16*)(ws + WS_Y)};
        pg8::gemm_phase<EpiM4, pg8::MoeOrder, true, true>(ring, g, S, E, F.wave);
#if defined(M4_TWICE)
        pg8::gemm_phase<EpiM4, pg8::MoeOrder, true, true>(ring, g, S, E, F.wave);
#endif
    } SEAM(PB + 4);
}
__global__ void __launch_bounds__(NWAVES * 64, 2) mk_fwd(Args args) {
    extern __shared__ __attribute__((aligned(16))) unsigned char lds[];
    Frame F;
    F.lds = (LAS unsigned char*)lds;
    F.MISC = (volatile LAS unsigned*)(F.lds + MISC_OFF);
    F.wave = __builtin_amdgcn_readfirstlane((int)threadIdx.x >> 6);
    F.G = gridDim.x; { const int bx = blockIdx.x; F.vcu = (F.G % 8 == 0) ? (bx % 8) * (F.G / 8) + bx / 8 : bx; }
    F.ws = args.ws; F.ctl = (gu32*)(args.ws + WS_CTL); F.out = args.out;
    for (int u = threadIdx.x; u < (LDS_BYTES - LDSCTL_OFF) / 4; u += NWAVES * 64) ((LAS unsigned*)(F.lds + LDSCTL_OFF))[u] = 0u;
    __syncthreads();
    XcdBarrier bar; bar.bar = (unsigned*)(F.ctl + CW_BAR); bar.x = 0; bar.st = nullptr;
    if (!MK_MULTI) bar = xcd_barrier_post((unsigned*)(F.ctl + CW_BAR), F.MISC + 8, F.wave);
    const int lo = args.ph_lo, hi = args.ph_hi;
    unsigned char* ws = args.ws;
    const float* MOD = (const float*)(F.ctl + CW_MOD);
    LAS unsigned char* ring = F.lds + RING_OFF;
    const int c = (int)blockIdx.x;

    if (IN(0)) REP(0) { p0a_mod_partials(F, args); } SEAM(0);
    if (IN(1)) REP(1) { p0_prologue(F, args); local_mod(F, args.in[4], 0); norm_phase<0, true>(F, args.in[0], nullptr, args.in[5], 0, 0, 0); } SEAM(1);
    if (IN(3)) REP(3) {
        pg8::Gemm g{2048, 2048, 2048}; pg8::StaticOrder S; S.init(T_, 4096, F.G, c, ws + WS_H, 2048, ws + WS_W_IN0T, 2048);
        EpiG1 E{(bf16*)(ws + WS_PROJ0), (bf16*)(ws + WS_KR), (float*)(ws + WS_SSQP), (const f32x2*)(ws + WS_TAB64)};
        pg8::gemm_phase<EpiG1, pg8::StaticOrder, true, true>(ring, g, S, E, F.wave);
    } SEAM(3);
    if (IN(4)) REP(4) {
        { pg8::Gemm g{512, 4096, 512}; pg8::StaticOrder S; S.init(T_, 1536, F.G, c, ws + WS_PROJ0 + 3072 * 2, 4096, ws + WS_W_QUPT, 512);
          EpiG2q E{(bf16*)(ws + WS_QMLA), (const float*)(ws + WS_SSQP), (const f32x2*)(ws + WS_TAB64)};
          pg8::gemm_phase<EpiG2q, pg8::StaticOrder, true, true>(ring, g, S, E, F.wave); }
        { pg8::Gemm g{256, 4096, 256}; pg8::StaticOrder S; S.init(T_, 2048, F.G, c, ws + WS_PROJ0 + 3584 * 2, 4096, ws + WS_W_KVUPT, 256);
          EpiG2kv E{(bf16*)(ws + WS_KVMLA), (const float*)(ws + WS_SSQP) + (size_t)T_ * 8};
          pg8::gemm_phase<EpiG2kv, pg8::StaticOrder, true, true>(ring, g, S, E, F.wave); }
    } SEAM(4);
    if (IN(5)) REP(5) { bool conv_left = true; WorkQ QC; wq_init(F, QC, F.ctl + CW_QC1, CONV_N1 / 32, 18, lane_id_opaque()); mla_phase(F, args, QC, conv_left); sb_phase(F, args, QC, conv_left); } SEAM(5);
    if (IN(6)) REP(6) {
        pg8::Gemm g{2048, 2048, 2048}; pg8::StaticOrder S; S.init(T_, 2048, F.G, c, ws + WS_ATTO, 2048, ws + WS_W_OUT0T, 2048);
        EpiRes E{args.in[0], (float*)(ws + WS_XA), MOD + (size_t)(0 * 4) * 6144 + 4096};
        pg8::gemm_phase<EpiRes, pg8::StaticOrder, true, true>(ring, g, S, E, F.wave);
    } SEAM(6);
    moe_phases<0, 7>(F, args, bar, lo, hi);
    if (IN(12)) REP(12) { norm_phase<2>(F, (const float*)(ws + WS_XA), (float*)(ws + WS_XB), args.in[5] + 2048, 2, 1, 0); } SEAM(12);
    if (IN(13)) REP(13) {
        pg8::Gemm g{2048, 2048, 2048}; pg8::StaticOrder S; S.init(T_, 12288, F.G, c, ws + WS_H, 2048, ws + WS_W_IN1T, 2048);
        EpiG4 E{(bf16*)(ws + WS_PROJ1), (const f32x2*)(ws + WS_TAB256)};
        pg8::gemm_phase<EpiG4, pg8::StaticOrder, true, true>(ring, g, S, E, F.wave);
    } SEAM(13);
    if (IN(14)) REP(14) { ret_phase(F, args); } SEAM(14);
    if (IN(15)) REP(15) { retnorm_phase(F); } SEAM(15);
    if (IN(16)) REP(16) {
        pg8::Gemm g{4096, 4096, 4096}; pg8::StaticOrder S; S.init(T_, 2048, F.G, c, ws + WS_A5, 4096, ws + WS_W_OUT1T, 4096);
        EpiRes E{(const float*)(ws + WS_XB), (float*)(ws + WS_XA), MOD + (size_t)(2 * 4) * 6144 + 4096};
        pg8::gemm_phase<EpiRes, pg8::StaticOrder, true, true>(ring, g, S, E, F.wave);
    } SEAM(16);
    moe_phases<1, 17>(F, args, bar, lo, hi);
    if (IN(22)) REP(22) { norm_phase<3>(F, (const float*)(ws + WS_XA), nullptr, args.in[24], 0, 3, 1); }
}
#undef IN
#undef SEAM

extern "C" void kernel_launch(void* const* d_in, const int* in_sizes, int n_in, void* d_out, int out_size, void* d_ws, size_t ws_size, hipStream_t stream) {
    static int grid = 0;
    if (grid == 0) {
        if (n_in != 25 || in_sizes[0] != T_ * D_ || out_size != T_ * D_ || ws_size < WS_END) { fprintf(stderr, "kernel_launch: unexpected shapes (n_in %d, in0 %d, out %d, ws %zu < %zu); nothing launched\n", n_in, n_in > 0 ? in_sizes[0] : -1, out_size, ws_size, (size_t)WS_END); grid = -1; return; }
        int dev = 0, cus = 0, per_cu = 0;
        if (hipGetDevice(&dev) != hipSuccess || hipDeviceGetAttribute(&cus, hipDeviceAttributeMultiprocessorCount, dev) != hipSuccess) { fprintf(stderr, "kernel_launch: device query failed\n"); grid = -1; return; }
        if (hipFuncSetAttribute((const void*)mk_fwd, hipFuncAttributeMaxDynamicSharedMemorySize, LDS_BYTES) != hipSuccess) { fprintf(stderr, "kernel_launch: hipFuncSetAttribute failed\n"); grid = -1; return; }
        if (hipOccupancyMaxActiveBlocksPerMultiprocessor(&per_cu, (const void*)mk_fwd, NWAVES * 64, LDS_BYTES) != hipSuccess || per_cu < 1) fprintf(stderr, "kernel_launch: note: occupancy query reports %d workgroups per CU\n", per_cu);
        (void)hipGetLastError();
        grid = cus;
    }
    if (grid < 0) return;
    if (hipMemsetAsync((char*)d_ws + WS_CTL, 0, CTL_ZERO_BYTES, stream) != hipSuccess) { fprintf(stderr, "kernel_launch: memset failed\n"); return; }
    Args a{};
    for (int i = 0; i < 25; ++i) a.in[i] = (const float*)d_in[i];
    a.out = (float*)d_out; a.ws = (unsigned char*)d_ws;
#if MK_MULTI
    for (int p = 0; p < 23; ++p) { a.ph_lo = p; a.ph_hi = p + 1; hipLaunchKernelGGL(mk_fwd, dim3(grid), dim3(NWAVES * 64), LDS_BYTES, stream, a); }
#else
    a.ph_lo = 0; a.ph_hi = 23;
    hipLaunchKernelGGL(mk_fwd, dim3(grid), dim3(NWAVES * 64), LDS_BYTES, stream, a);
#endif
    const hipError_t le = hipPeekAtLastError();
    if (le != hipSuccess) fprintf(stderr, "kernel_launch: launch failed: %s\n", hipGetErrorName(le));
}
```

```cpp
#include <hip/hip_runtime.h>
#include <cstdio>
#include <cstdint>

#ifndef MK_MULTI
#define MK_MULTI 0
#endif

namespace pg8 {
#define PG8_LAS __attribute__((address_space(3)))
typedef unsigned short bf16_t;
typedef short bf16x8 __attribute__((ext_vector_type(8)));
typedef float f32x4 __attribute__((ext_vector_type(4)));
typedef unsigned u32x4 __attribute__((ext_vector_type(4)));
constexpr int BM = 256, BK = 64, HALF = 128, HTB = HALF * BK * 2  , STAGE_BYTES = 8 * HTB, NXCD = 8, WGM = 8;

__host__ __device__ __forceinline__ int lds_byte(int r, int c) { const int st = (r >> 4) * 2 + (c >> 5), rr = r & 15, cc = c & 31, ob = rr * 64 + cc * 2; return st * 1024 + (ob ^ (((ob >> 9) & 1) << 5)); }
__host__ __device__ __forceinline__ void stage_rc(int b, int& R, int& C) { const int st = b / 1024, sb = b % 1024, swz = sb ^ (((sb >> 9) & 1) << 5); R = (st >> 1) * 16 + swz / 64; C = (st & 1) * 32 + (swz % 64) / 2; }
__host__ __device__ __forceinline__ int perm32(int rho) { const int n = rho >> 4, i = rho & 15; return 8 * (i >> 2) + 4 * n + (i & 3); }

struct Unit { int pm, pn; const char* a; const char* b; };
struct Gemm { int K, lda, ldb; };

struct StaticOrder {
    int nM, nN, nwg, G, c; const char* A; const char* Bt; size_t tstepA, tstepB;
    __device__ void init(int M, int N, int G_, int c_, const void* A_, int lda, const void* Bt_, int ldb) { nM = M / BM; nN = N / BM; nwg = nM * nN; G = G_; c = c_; A = (const char*)A_; Bt = (const char*)Bt_; tstepA = (size_t)BM * lda * 2; tstepB = (size_t)BM * ldb * 2; }
    __device__ bool next(int i, Unit& u) const {
        const long L = (long)i * G + c; if (L >= nwg) return false;
        int wgid = (int)L; { const int q = nwg / NXCD, r = nwg % NXCD, xcd = wgid % NXCD, off = wgid / NXCD; wgid = (xcd < r ? xcd * (q + 1) : r * (q + 1) + (xcd - r) * q) + off; }
        const int nig = WGM * nN, gid = wgid / nig, fm = gid * WGM, gsz = (nM - fm) < WGM ? (nM - fm) : WGM;
        u.pm = fm + ((wgid % nig) % gsz); u.pn = (wgid % nig) / gsz; u.a = A + (size_t)u.pm * tstepA; u.b = Bt + (size_t)u.pn * tstepB; return true;
    }
    __device__ __forceinline__ void a_ready(const Unit&) const {}
    __device__ __forceinline__ void done(const Unit&) const {}
};
struct MoeOrder {
    int ntn, t0, nunits, gdeal, busy, G, c; const char* A; const char* W; size_t tstepA, tstepB, estep; const PG8_LAS int* tile_expert;
    __device__ bool next(int i, Unit& u) const {
        int L;
        if (busy == 0) { if (c >= gdeal) return false; L = i * gdeal + c; }
        else { const int nfree = G - busy;
            if (c >= busy) { const int cap = 3 * nfree < nunits ? 3 * nfree : nunits; if (i >= 3) return false; L = i * nfree + (c - busy); if (L >= cap) return false; }
            else { L = 3 * nfree + i * busy + c; } }
        if (L >= nunits) return false;
        const int mt = t0 + L / ntn, pn = L % ntn, e = tile_expert[mt];
        u.pm = mt; u.pn = pn; u.a = A + (size_t)mt * tstepA; u.b = W + (size_t)e * estep + (size_t)pn * tstepB; return true;
    }
    __device__ __forceinline__ void a_ready(const Unit&) const {}
    __device__ __forceinline__ void done(const Unit&) const {}
};

template <class Epi, class Sched, bool ALIGN_EPI = false, bool SP2 = false>
__device__ __forceinline__ void gemm_phase(PG8_LAS unsigned char* lds, const Gemm g, const Sched& S, const Epi& E, const int wave_id) {
    int lane; asm volatile("v_mbcnt_lo_u32_b32 %0, -1, 0\n\tv_mbcnt_hi_u32_b32 %0, -1, %0" : "=v"(lane));
    const int wid = wave_id, tid = wid * 64 + lane, wr = wid >> 2, wc = wid & 3, fr = lane & 15, fq = lane >> 4;
    const int K = g.K, nt = K / BK;
    unsigned voffA[2], voffB[2];
#pragma unroll
    for (int i = 0; i < 2; ++i) { int R, C; stage_rc(tid * 16 + i * 8192, R, C); const int Rb = Epi::PERM ? ((R & ~31) + perm32(R & 31)) : R;
        voffA[i] = (unsigned)(R * g.lda + C) * 2u; voffB[i] = (unsigned)(Rb * g.ldb + C) * 2u; }
    const size_t kstep = (size_t)(BK * 2);
    const size_t hstepA = (size_t)HALF * g.lda * 2, hstepB = (size_t)HALF * g.ldb * 2;
    const unsigned ldsw = (unsigned)wid * 1024u;
    const int aoff = lds_byte(wr * 64 + fr, fq * 8), boff = lds_byte(wc * 32 + fr, fq * 8);
#define PG8_SA(b, h) (((b) * 2 + (h)) * HTB)
#define PG8_SB(b, h) ((4 + (b) * 2 + (h)) * HTB)
#define PG8_STAGE(bufoff, gbase, voff) do { _Pragma("unroll") for (int _i = 0; _i < 2; ++_i) \
        __builtin_amdgcn_global_load_lds((const unsigned*)((const char*)(gbase) + (voff)[_i]), (PG8_LAS unsigned*)(lds + (bufoff) + ldsw + _i * 8192), 16, 0, 0); } while (0)
#define PG8_LDA(dst, b, h) do { _Pragma("unroll") for (int m = 0; m < 4; ++m) _Pragma("unroll") for (int k = 0; k < 2; ++k) dst[m][k] = *(const PG8_LAS bf16x8*)(lds + PG8_SA(b, h) + aoff + m * 2048 + k * 1024); } while (0)
#define PG8_LDB(dst, b, h) do { _Pragma("unroll") for (int n = 0; n < 2; ++n) _Pragma("unroll") for (int k = 0; k < 2; ++k) dst[n][k] = *(const PG8_LAS bf16x8*)(lds + PG8_SB(b, h) + boff + n * 2048 + k * 1024); } while (0)
#define PG8_MMA(ai, bj, At, Bt) do { __builtin_amdgcn_s_setprio(1); _Pragma("unroll") for (int m = 0; m < 4; ++m) _Pragma("unroll") for (int n = 0; n < 2; ++n) _Pragma("unroll") for (int k = 0; k < 2; ++k) \
        acc[ai][bj][m][n] = __builtin_amdgcn_mfma_f32_16x16x32_bf16(Bt[n][k], At[m][k], acc[ai][bj][m][n], 0, 0, 0); __builtin_amdgcn_s_setprio(0); } while (0)
#define PG8_WAIT_V(n) asm volatile("s_waitcnt vmcnt(" #n ")" ::: "memory")
#define PG8_WAIT_L(n) asm volatile("s_waitcnt lgkmcnt(" #n ")" ::: "memory")
#define PG8_BAR __builtin_amdgcn_s_barrier()
#define PG8_SCHED __builtin_amdgcn_sched_barrier(0)
    Unit cur, nxt; int ui = 0;
    if (!S.next(0, cur)) return;
    f32x4 acc[2][2][4][2];
#pragma unroll
    for (int a = 0; a < 2; ++a)
#pragma unroll
        for (int b = 0; b < 2; ++b)
#pragma unroll
            for (int m = 0; m < 4; ++m)
#pragma unroll
                for (int n = 0; n < 2; ++n) acc[a][b][m][n] = (f32x4){0.f, 0.f, 0.f, 0.f};
    bf16x8 At[4][2], B0[2][2], B1[2][2];
    const char* cA = cur.a; const char* cB = cur.b;
    S.a_ready(cur);
    if constexpr (SP2) {
        PG8_STAGE(PG8_SB(0, 0), cB, voffB); PG8_STAGE(PG8_SB(0, 1), cB + hstepB, voffB); PG8_STAGE(PG8_SA(0, 0), cA, voffA); PG8_STAGE(PG8_SA(0, 1), cA + hstepA, voffA);
        if (wr == 1) PG8_BAR;
        PG8_WAIT_V(2); PG8_BAR;
        PG8_STAGE(PG8_SB(1, 0), cB + kstep, voffB); PG8_STAGE(PG8_SA(1, 0), cA + kstep, voffA); PG8_STAGE(PG8_SB(1, 1), cB + hstepB + kstep, voffB);
        PG8_WAIT_V(6); PG8_BAR;
    } else {
        PG8_STAGE(PG8_SB(0, 0), cB, voffB); PG8_STAGE(PG8_SA(0, 0), cA, voffA); PG8_STAGE(PG8_SB(0, 1), cB + hstepB, voffB); PG8_STAGE(PG8_SA(0, 1), cA + hstepA, voffA);
        if (wr == 1) PG8_BAR;
        PG8_WAIT_V(4); PG8_BAR;
        PG8_STAGE(PG8_SB(1, 0), cB + kstep, voffB); PG8_STAGE(PG8_SA(1, 0), cA + kstep, voffA); PG8_STAGE(PG8_SB(1, 1), cB + hstepB + kstep, voffB);
        PG8_WAIT_V(6); PG8_BAR;
    }
    for (;;) {
        const bool has_next = S.next(ui + 1, nxt);
        const char* nA = has_next ? nxt.a : cA; const char* nB = has_next ? nxt.b : cB;
        for (int t = 0; t < nt; t += 2) {
            const bool last = (t == nt - 2);
            const char* a1 = cA + (size_t)(t + 1) * kstep;
            const char* a2 = last ? nA : cA + (size_t)(t + 2) * kstep; const char* b2 = last ? nB : cB + (size_t)(t + 2) * kstep;
            const char* a3 = a2 + kstep; const char* b3 = b2 + kstep;
            if (last && has_next) S.a_ready(nxt);
            if constexpr (SP2) {
            PG8_LDB(B0, 0, 0); PG8_LDB(B1, 0, 1); PG8_SCHED; PG8_LDA(At, 0, 0); PG8_STAGE(PG8_SA(1, 1), a1 + hstepA, voffA);
            PG8_WAIT_V(8); PG8_WAIT_L(0); PG8_BAR; PG8_MMA(0, 0, At, B0); PG8_MMA(0, 1, At, B1); PG8_BAR; PG8_SCHED;
            PG8_LDA(At, 0, 1); PG8_STAGE(PG8_SB(0, 0), b2, voffB); PG8_STAGE(PG8_SB(0, 1), b2 + hstepB, voffB); PG8_STAGE(PG8_SA(0, 0), a2, voffA);
            PG8_WAIT_V(8); PG8_WAIT_L(0); PG8_BAR; PG8_MMA(1, 0, At, B0); PG8_MMA(1, 1, At, B1); PG8_BAR; PG8_SCHED;
            PG8_LDB(B0, 1, 0); PG8_LDB(B1, 1, 1); PG8_SCHED; PG8_LDA(At, 1, 0); PG8_STAGE(PG8_SA(0, 1), a2 + hstepA, voffA);
            PG8_WAIT_V(8); PG8_WAIT_L(0); PG8_BAR; PG8_MMA(0, 0, At, B0); PG8_MMA(0, 1, At, B1); PG8_BAR; PG8_SCHED;
            PG8_LDA(At, 1, 1); PG8_STAGE(PG8_SB(1, 0), b3, voffB); PG8_STAGE(PG8_SB(1, 1), b3 + hstepB, voffB); PG8_STAGE(PG8_SA(1, 0), a3, voffA);
            PG8_WAIT_V(8); PG8_WAIT_L(0); PG8_BAR; PG8_MMA(1, 0, At, B0); PG8_MMA(1, 1, At, B1); PG8_BAR; PG8_SCHED;
            } else {
            PG8_LDB(B0, 0, 0); PG8_SCHED; PG8_LDA(At, 0, 0); PG8_STAGE(PG8_SA(1, 1), a1 + hstepA, voffA);
            PG8_WAIT_L(8); PG8_BAR; PG8_WAIT_L(0); PG8_MMA(0, 0, At, B0); PG8_BAR; PG8_SCHED;
            PG8_LDB(B1, 0, 1); PG8_STAGE(PG8_SB(0, 0), b2, voffB);
            PG8_BAR; PG8_WAIT_L(0); PG8_MMA(0, 1, At, B1); PG8_BAR;
            PG8_LDA(At, 0, 1); PG8_STAGE(PG8_SA(0, 0), a2, voffA);
            PG8_BAR; PG8_WAIT_L(0); PG8_MMA(1, 0, At, B0); PG8_BAR; PG8_SCHED;
            PG8_STAGE(PG8_SB(0, 1), b2 + hstepB, voffB);
            PG8_WAIT_V(6); PG8_BAR; PG8_MMA(1, 1, At, B1); PG8_BAR;
            PG8_LDB(B0, 1, 0); PG8_SCHED; PG8_LDA(At, 1, 0); PG8_STAGE(PG8_SA(0, 1), a2 + hstepA, voffA);
            PG8_WAIT_L(8); PG8_BAR; PG8_WAIT_L(0); PG8_MMA(0, 0, At, B0); PG8_BAR; PG8_SCHED;
            PG8_LDB(B1, 1, 1); PG8_STAGE(PG8_SB(1, 0), b3, voffB);
            PG8_BAR; PG8_WAIT_L(0); PG8_MMA(0, 1, At, B1); PG8_BAR;
            PG8_LDA(At, 1, 1); PG8_STAGE(PG8_SA(1, 0), a3, voffA);
            PG8_BAR; PG8_WAIT_L(0); PG8_MMA(1, 0, At, B0); PG8_BAR; PG8_SCHED;
            PG8_STAGE(PG8_SB(1, 1), b3 + hstepB, voffB);
            PG8_WAIT_V(6); PG8_BAR; PG8_MMA(1, 1, At, B1); PG8_BAR;
            }
        }
        if constexpr (ALIGN_EPI) { if (wr == 0) PG8_BAR; }
        if constexpr (!Epi::AFTER_DRAIN) { E(acc, cur, wr, wc, fr, fq); S.done(cur); }
        if (!has_next) break;
#pragma unroll
        for (int a = 0; a < 2; ++a)
#pragma unroll
            for (int b = 0; b < 2; ++b)
#pragma unroll
                for (int m = 0; m < 4; ++m)
#pragma unroll
                    for (int n = 0; n < 2; ++n) acc[a][b][m][n] = (f32x4){0.f, 0.f, 0.f, 0.f};
        cur = nxt; cA = nA; cB = nB; ++ui;
        if constexpr (ALIGN_EPI) { if (wr == 1) PG8_BAR; }
    }
    PG8_WAIT_V(0);
    if constexpr (!ALIGN_EPI) { if (wr == 0) PG8_BAR; }
    PG8_BAR;
    if constexpr (Epi::AFTER_DRAIN) { E.fused(acc, cur, wr, wc, fr, fq, lds, wid, lane); S.done(cur); }
#undef PG8_SA
#undef PG8_SB
#undef PG8_STAGE
#undef PG8_LDA
#undef PG8_LDB
#undef PG8_MMA
#undef PG8_WAIT_V
#undef PG8_WAIT_L
#undef PG8_BAR
#undef PG8_SCHED
}
}

constexpr int NWAVES = 8;
constexpr int T_ = 8192, D_ = 2048, NB_ = 4, S_ = 2048;
constexpr float EPS_ = 1e-6f;
constexpr float LOG2E = 1.4426950408889634f;
constexpr float C_SB = 0.08838834764831845f * LOG2E;
constexpr float C_MLA = 0.07216878364870323f * LOG2E;
constexpr int NPH = 22;

constexpr size_t MiB = 1u << 20;
constexpr size_t WS_CTL = 0, CTL_ZERO_BYTES = 1 * MiB;
constexpr size_t WS_TAB64 = 2 * MiB, WS_TAB256 = 4 * MiB, WS_WR = 12 * MiB, WS_ROUTE = 13 * MiB;
constexpr size_t WS_W_IN0T = 16 * MiB, WS_W_QUPT = 32 * MiB, WS_W_KVUPT = 34 * MiB, WS_W_OUT0T = 36 * MiB, WS_W_IN1T = 44 * MiB, WS_W_OUT1T = 92 * MiB;
constexpr size_t WS_W_GU = 108 * MiB, WS_W_DN = 364 * MiB;
constexpr size_t WS_XA = 492 * MiB, WS_XB = 556 * MiB, WS_H = 620 * MiB;
constexpr size_t WS_PROJ0 = 652 * MiB, WS_QMLA = 716 * MiB, WS_KVMLA = 740 * MiB, WS_KR = 772 * MiB, WS_ATTO = 774 * MiB;
constexpr size_t WS_PROJ1 = 652 * MiB;
constexpr size_t WS_HG = 844 * MiB, WS_ACT = 940 * MiB, WS_Y = 964 * MiB;
constexpr size_t WS_RETO = 844 * MiB, WS_A5 = 908 * MiB;
constexpr size_t WS_MODP = 1060 * MiB;
constexpr size_t WS_RS = 13 * MiB + 256 * 1024;
constexpr size_t WS_SSQP = 13 * MiB + 512 * 1024;
constexpr size_t WS_END = 1064 * MiB;
constexpr int CW_TMO = 0, CW_CODE = 1;
constexpr int CW_BAR = 4096;
constexpr int CW_QMLA = 8192, CW_QSB = 8256, CW_QRET = 8320, CW_QC1 = 8384, CW_QC2 = 8416;
constexpr int CW_ECNT = 8448, CW_ECUR = 8576;
constexpr int CW_MOD = 16384;
constexpr int CW_SSQQ = 114688, CW_SSQKV = 122880;
static_assert((CW_SSQKV + 8192) * 4 <= (int)CTL_ZERO_BYTES, "CTL words inside the memset region");
constexpr int RING_OFF = 0, RING_BYTES = 147456;
constexpr int LDSCTL_OFF = RING_BYTES, MISC_OFF = LDSCTL_OFF + 320;
constexpr int MOE_TAB_OFF = LDSCTL_OFF + 1024;
constexpr int LDS_BYTES = 155648;
static_assert(MOE_TAB_OFF + 1024 <= LDS_BYTES, "LDS map");

#define GAS __attribute__((address_space(1)))
#define LAS __attribute__((address_space(3)))
typedef unsigned short bf16;
typedef unsigned v4u __attribute__((ext_vector_type(4)));
typedef unsigned v2u __attribute__((ext_vector_type(2)));
typedef float f32x4 __attribute__((ext_vector_type(4)));
typedef float f32x2 __attribute__((ext_vector_type(2)));
typedef float f32x16 __attribute__((ext_vector_type(16)));
typedef short bf16x8 __attribute__((ext_vector_type(8)));
typedef short s16x4 __attribute__((ext_vector_type(4)));
typedef short v4i16_t __attribute__((ext_vector_type(4)));
typedef GAS unsigned gu32;
#define RLX_AGENT __ATOMIC_RELAXED, __HIP_MEMORY_SCOPE_AGENT
#define LDS_WAIT() asm volatile("s_waitcnt lgkmcnt(0)" ::: "memory")
#define VM_WAIT() asm volatile("s_waitcnt vmcnt(0)" ::: "memory")
typedef __bf16 bf16x2_t __attribute__((ext_vector_type(2)));
__device__ __forceinline__ unsigned pk2(float lo, float hi) { f32x2 v = {lo, hi}; bf16x2_t b = __builtin_convertvector(v, bf16x2_t); return __builtin_bit_cast(unsigned, b); }
__device__ __forceinline__ float bf_lo(unsigned w) { return __uint_as_float(w << 16); }
__device__ __forceinline__ float bf_hi(unsigned w) { return __uint_as_float(w & 0xffff0000u); }
__device__ __forceinline__ float ex2(float x) { return __builtin_amdgcn_exp2f(x); }
__device__ __forceinline__ float lg2(float x) { return __builtin_amdgcn_logf(x); }
__device__ __forceinline__ float silu_f(float v) { return v / (1.0f + __expf(-v)); }
__device__ __forceinline__ int lane_id_opaque() { int l; asm volatile("v_mbcnt_lo_u32_b32 %0, -1, 0\n\tv_mbcnt_hi_u32_b32 %0, -1, %0" : "=v"(l)); return l; }

#define XB_TMO      128
#define XB_XCNT(j)  (256  + 64 * (j))
#define XB_XSUB(j)  (1280 + 64 * (j))
#define XB_XGEN(j)  (2304 + 64 * (j))
#define XB_TOP      3328
#define XB_TOPGEN   3392
#define XCD_BAR_WORDS 3456
#define XB_SPIN_CAP (1u << 18)
__device__ __forceinline__ unsigned xb_ld(unsigned* p)              { return __hip_atomic_load(p, __ATOMIC_RELAXED, __HIP_MEMORY_SCOPE_AGENT); }
__device__ __forceinline__ unsigned xb_add(unsigned* p, unsigned v) { return __hip_atomic_fetch_add(p, v, __ATOMIC_RELAXED, __HIP_MEMORY_SCOPE_AGENT); }
__device__ __forceinline__ unsigned xb_xcc_id() { return (unsigned)__builtin_amdgcn_s_getreg((3 << 11) | 20) & 0xFu; }
#define XB_SPIN(cond, bar) do { unsigned _sp = 0; while (cond) { __builtin_amdgcn_s_sleep(1); \
    if ((++_sp & 255u) == 0u) { if (xb_ld(&(bar)[XB_TMO])) break; if (_sp > XB_SPIN_CAP) { atomicAdd(&(bar)[XB_TMO], 1u); break; } } } } while (0)
struct XcdBarrier { unsigned* bar; unsigned x; volatile LAS unsigned* st; };
__device__ __forceinline__ XcdBarrier xcd_barrier_post(unsigned* bar, volatile LAS unsigned* st, int wave) {
    XcdBarrier b; b.bar = bar; b.x = xb_xcc_id(); b.st = st;
    if (wave == 0 && lane_id_opaque() == 0) (void)xb_add(&bar[XB_XCNT(b.x)], 1u);
    return b;
}
__device__ __forceinline__ void xcd_barrier_complete(unsigned* bar, unsigned x, unsigned& nloc, unsigned& nx) {
    const unsigned G = gridDim.x * gridDim.y * gridDim.z;
    unsigned sum, cnt, mine, sp = 0u;
    for (;;) {
        sum = 0u; cnt = 0u; mine = 0u;
#pragma unroll
        for (unsigned j = 0; j < 16; ++j) { const unsigned c = xb_ld(&bar[XB_XCNT(j)]); sum += c; cnt += (c > 0u) ? 1u : 0u; mine = (j == x) ? c : mine; }
        if (sum == G) break;
        __builtin_amdgcn_s_sleep(1);
        if ((++sp & 255u) == 0u) { if (xb_ld(&bar[XB_TMO])) break; if (sp > XB_SPIN_CAP) { atomicAdd(&bar[XB_TMO], 1u); break; } }
    }
    nloc = mine > 0u ? mine : 1u; nx = cnt > 0u ? cnt : 1u;
}
__device__ __forceinline__ void xcd_barrier(const XcdBarrier& b, int wave) {
    asm volatile("s_waitcnt vmcnt(0)" ::: "memory");
    __syncthreads();
    if (wave == 0 && lane_id_opaque() == 0) {
        unsigned* bar = b.bar;
        __builtin_amdgcn_s_waitcnt(0);
        unsigned nloc = b.st[0], nx = b.st[1];
        if (nloc == 0u) { xcd_barrier_complete(bar, b.x, nloc, nx); b.st[0] = nloc; b.st[1] = nx; }
        const unsigned old = xb_add(&bar[XB_XSUB(b.x)], 1u);
        const unsigned gen = old / nloc;
        if (old + 1u == (gen + 1u) * nloc) {
            __builtin_amdgcn_fence(__ATOMIC_RELEASE, "agent");
            asm volatile("s_waitcnt vmcnt(0)" ::: "memory");
            const unsigned og = xb_add(&bar[XB_TOP], 1u);
            const unsigned tg = og / nx;
            if (og + 1u == (tg + 1u) * nx) xb_add(&bar[XB_TOPGEN], 1u);
            else XB_SPIN(xb_ld(&bar[XB_TOPGEN]) == tg, bar);
            __builtin_amdgcn_fence(__ATOMIC_ACQUIRE, "agent");
            xb_add(&bar[XB_XGEN(b.x)], 1u);
            asm volatile("s_waitcnt vmcnt(0)" ::: "memory");
        } else {
            XB_SPIN(xb_ld(&bar[XB_XGEN(b.x)]) == gen, bar);
            __builtin_amdgcn_fence(__ATOMIC_ACQUIRE, "agent");
            asm volatile("s_waitcnt vmcnt(0)" ::: "memory");
        }
    }
    __syncthreads();
}

struct Frame {
    LAS unsigned char* lds;
    volatile LAS unsigned* MISC;
    gu32* ctl;
    unsigned char* ws;
    int wave;
    int vcu, G;
    float* out;
};
struct Args { const float* in[25]; float* out; unsigned char* ws; int ph_lo, ph_hi; };
__device__ __forceinline__ float wave_sum(float v) {
#pragma unroll
    for (int o = 1; o < 64; o <<= 1) v += __shfl_xor(v, o);
    return v;
}
#define PHASE_IDS(F) const int lane = lane_id_opaque(), wave = (F).wave, tid = wave * 64 + lane; (void)lane; (void)wave; (void)tid
struct ConvSrc { const float* W; int ldn; bf16* WT; int ldk; const float* scale; };
__device__ __forceinline__ void conv_load(const ConvSrc& c, int lane, f32x4 (&v)[8]) {
    const float* src = c.W + (size_t)(8 * (lane >> 3)) * c.ldn + 4 * (lane & 7);
#pragma unroll
    for (int t = 0; t < 8; ++t) v[t] = __builtin_nontemporal_load((const f32x4*)(src + (size_t)t * c.ldn));
}
__device__ __forceinline__ void conv_store(const ConvSrc& c, int lane, f32x4 (&v)[8]) {
    if (c.scale) { const f32x4 s0 = *(const f32x4*)(c.scale + 8 * (lane >> 3)), s1 = *(const f32x4*)(c.scale + 8 * (lane >> 3) + 4);
        v[0] *= s0.x; v[1] *= s0.y; v[2] *= s0.z; v[3] *= s0.w; v[4] *= s1.x; v[5] *= s1.y; v[6] *= s1.z; v[7] *= s1.w; }
    bf16* dst = c.WT + (size_t)(4 * (lane & 7)) * c.ldk + 8 * (lane >> 3);
#pragma unroll
    for (int j = 0; j < 4; ++j) { v4u o; o.x = pk2(v[0][j], v[1][j]); o.y = pk2(v[2][j], v[3][j]); o.z = pk2(v[4][j], v[5][j]); o.w = pk2(v[6][j], v[7][j]); __builtin_nontemporal_store(o, (v4u*)(dst + (size_t)j * c.ldk)); }
}
constexpr int CONV_N0 = 122 * 32 + 48 * 8 + 64 * 4, CONV_N1 = 64 * 32 + 384 * 32 + 32 * 1024 + 32 * 512, CONV_N2 = 64 * 64 + 32 * 1024 + 32 * 512;
__device__ __forceinline__ ConvSrc conv_moe_gu(const Args& A, unsigned char* ws, int le, int r) {
    const int nb = r / 32, kb = r % 32, t = nb >> 3, hf = (nb >> 2) & 1, jb = nb & 3;
    return ConvSrc{(hf ? A.in[22] : A.in[21]) + (size_t)le * 2048 * 512 + (size_t)(64 * kb) * 512 + 128 * t + 32 * jb, 512, (bf16*)(ws + WS_W_GU) + (size_t)le * 1024 * 2048 + (size_t)(32 * nb) * 2048 + 64 * kb, 2048, nullptr};
}
__device__ __forceinline__ ConvSrc conv_moe_dn(const Args& A, unsigned char* ws, int le, int r) {
    const int nb = r / 8, kb = r % 8;
    return ConvSrc{A.in[23] + (size_t)le * 512 * 2048 + (size_t)(64 * kb) * 2048 + 32 * nb, 2048, (bf16*)(ws + WS_W_DN) + (size_t)le * 2048 * 512 + (size_t)(32 * nb) * 512 + 64 * kb, 512, nullptr};
}
template <int STREAM> __device__ __forceinline__ ConvSrc conv_item(const Args& A, unsigned char* ws, int it) {
    if (STREAM == 0) {
        if (it < 122 * 32) { const int t = it / 32, kb = it % 32; const int dnb = t < 120 ? t : (t == 120 ? 120 : 124), sc = t < 120 ? 32 * t : (t == 120 ? 3840 : 3872);
            return ConvSrc{A.in[9] + (size_t)(64 * kb) * 3904 + sc, 3904, (bf16*)(ws + WS_W_IN0T) + (size_t)(32 * dnb) * 2048 + 64 * kb, 2048, nullptr}; }
        it -= 122 * 32;
        if (it < 48 * 8) { const int nb = it / 8, kb = it % 8; int sc;
            if (nb < 32) sc = (nb >> 2) * 192 + 32 * (nb & 3);
            else { const int t = (nb - 32) >> 3, blk = (nb - 32) & 7, hf = blk >> 2, hh = blk & 3; sc = (4 * t + hh) * 192 + 128 + 32 * hf; }
            return ConvSrc{A.in[11] + (size_t)(64 * kb) * 1536 + sc, 1536, (bf16*)(ws + WS_W_QUPT) + (size_t)(32 * nb) * 512 + 64 * kb, 512, A.in[10] + 64 * kb}; }
        it -= 48 * 8;
        { const int nb = it / 4, kb = it % 4;
            return ConvSrc{A.in[13] + (size_t)(64 * kb) * 2048 + 32 * nb, 2048, (bf16*)(ws + WS_W_KVUPT) + (size_t)(32 * nb) * 256 + 64 * kb, 256, A.in[12] + 64 * kb}; }
    } else if (STREAM == 1) {
        if (it < 64 * 32) { const int nb = it / 32, kb = it % 32;
            return ConvSrc{A.in[14] + (size_t)(64 * kb) * 2048 + 32 * nb, 2048, (bf16*)(ws + WS_W_OUT0T) + (size_t)(32 * nb) * 2048 + 64 * kb, 2048, nullptr}; }
        it -= 64 * 32;
        if (it < 384 * 32) { const int nb = it / 32, kb = it % 32;
            return ConvSrc{A.in[15] + (size_t)(64 * kb) * 12288 + 32 * nb, 12288, (bf16*)(ws + WS_W_IN1T) + (size_t)(32 * nb) * 2048 + 64 * kb, 2048, nullptr}; }
        it -= 384 * 32;
        if (it < 32 * 1024) return conv_moe_gu(A, ws, it / 1024, it % 1024);
        it -= 32 * 1024;
        return conv_moe_dn(A, ws, it / 512, it % 512);
    } else {
        if (it < 64 * 64) { const int nb = it / 64, kb = it % 64;
            return ConvSrc{A.in[16] + (size_t)(64 * kb) * 2048 + 32 * nb, 2048, (bf16*)(ws + WS_W_OUT1T) + (size_t)(32 * nb) * 4096 + 64 * kb, 4096, nullptr}; }
        it -= 64 * 64;
        if (it < 32 * 1024) return conv_moe_gu(A, ws, 32 + it / 1024, it % 1024);
        it -= 32 * 1024;
        return conv_moe_dn(A, ws, 32 + it / 512, it % 512);
    }
}
template <int STREAM> __device__ __forceinline__ void conv_burst(Frame& F, const Args& A, int lane, int gw, int NGW, int& cur, int n) {
    constexpr int N = STREAM == 0 ? CONV_N0 : (STREAM == 1 ? CONV_N1 : CONV_N2);
#pragma unroll 1
    while (n > 0) {
        const int i0 = gw + NGW * cur; if (i0 >= N) break;
        const int i1 = i0 + NGW; const bool two = n > 1 && i1 < N;
        const ConvSrc c0 = conv_item<STREAM>(A, F.ws, i0); f32x4 v0[8], v1[8];
        conv_load(c0, lane, v0);
        if (two) { const ConvSrc c1 = conv_item<STREAM>(A, F.ws, i1); conv_load(c1, lane, v1); conv_store(c0, lane, v0); conv_store(c1, lane, v1); cur += 2; n -= 2; }
        else { conv_store(c0, lane, v0); cur += 1; n -= 1; }
    }
}

__device__ __forceinline__ void p0a_mod_partials(Frame& F, const Args& A) {
    PHASE_IDS(F);
    const int gw = F.vcu * NWAVES + wave, NGW = F.G * NWAVES;
    LAS float* cond = (LAS float*)(F.lds + RING_OFF);
    for (int i = tid; i < NB_ * D_; i += 512) cond[i] = silu_f(A.in[1][i]);
    __syncthreads();
    float* MODP = (float*)(F.ws + WS_MODP);
    for (int u = gw; u < 768; u += NGW) {
        const int j = u / 192, r = u % 192, nc = r / 8, kc = r % 8, layer = j >> 1;
        const float* W = ((j & 1) ? A.in[6] : A.in[3]) + (size_t)layer * 2048 * 6144 + (size_t)(kc * 256) * 6144 + nc * 256 + 4 * lane;
        f32x4 acc[4];
#pragma unroll
        for (int b = 0; b < 4; ++b) acc[b] = (f32x4){0.f, 0.f, 0.f, 0.f};
#pragma unroll 16
        for (int k = 0; k < 256; ++k) { const f32x4 w = *(const f32x4*)(W + (size_t)k * 6144);
#pragma unroll
            for (int b = 0; b < 4; ++b) acc[b] += cond[b * 2048 + kc * 256 + k] * w; }
#pragma unroll
        for (int b = 0; b < 4; ++b) *(f32x4*)(MODP + ((size_t)(kc * 16 + j * 4 + b)) * 6144 + nc * 256 + 4 * lane) = acc[b];
    }
}
__device__ __forceinline__ void p0_prologue(Frame& F, const Args& A) {
    PHASE_IDS(F);
    const int gw = F.vcu * NWAVES + wave, NGW = F.G * NWAVES;
    const int gt = F.vcu * 512 + tid, NGT = F.G * 512;
    { float* MOD = (float*)(F.ctl + CW_MOD); const float* MODP = (const float*)(F.ws + WS_MODP);
      for (int idx = gt; idx < 16 * 6144; idx += NGT) { const int j = idx / (4 * 6144), n = idx % 6144; float a = ((j & 1) ? A.in[7] : A.in[4])[(j >> 1) * 6144 + n];
#pragma unroll
          for (int kc = 0; kc < 8; ++kc) a += MODP[(size_t)kc * 16 * 6144 + idx];
          MOD[idx] = a; } }
    { int cur = 0; conv_burst<0>(F, A, lane, gw, NGW, cur, 1 << 20); }
    { const int* pos = (const int*)A.in[2]; f32x2* t64 = (f32x2*)(F.ws + WS_TAB64); f32x2* t256 = (f32x2*)(F.ws + WS_TAB256);
      for (int idx = gt; idx < T_ * 160; idx += NGT) { const int m = idx / 160, i = idx % 160; const double p = (double)pos[m];
          double fr; if (i < 32) fr = exp(-9.210340371976184 * (double)i / 32.0); else fr = exp(-9.210340371976184 * (double)(i - 32) / 128.0);
          double sn, cs; sincos(p * fr, &sn, &cs); const f32x2 v = {(float)cs, (float)sn};
          if (i < 32) t64[m * 32 + i] = v; else t256[m * 128 + (i - 32)] = v; } }
    { float* WR = (float*)(F.ws + WS_WR);
      for (int idx = gt; idx < 2 * 512 * 36 * 4; idx += NGT) { const int q = idx & 3, c = (idx >> 2) % 36, kq = ((idx >> 2) / 36) % 512, l = (idx >> 2) / (36 * 512); const int k = 4 * kq + q;
          WR[idx] = c < 4 ? A.in[17][(size_t)l * 2048 * 4 + k * 4 + c] : A.in[19][(size_t)l * 2048 * 32 + k * 32 + (c - 4)]; } }
}

__device__ __forceinline__ void local_mod(Frame& F, const float* bias, int j) {
    PHASE_IDS(F);
    const float* MODP = (const float*)(F.ws + WS_MODP); LAS f32x4* lm = (LAS f32x4*)(F.lds + RING_OFF);
    __syncthreads();
    for (int q = tid; q < 4096; q += 512) { const int b = q >> 10, n = 4 * (q & 1023); f32x4 a = *(const f32x4*)(bias + n);
#pragma unroll
        for (int kc = 0; kc < 8; ++kc) a += *(const f32x4*)(MODP + ((size_t)(kc * 16 + j * 4 + b)) * 6144 + n);
        lm[q] = a; }
    __syncthreads();
}
template <int MODE, bool LM = false> __device__ __forceinline__ void norm_phase(Frame& F, const float* src, float* xdst, const float* gvec, int jn, int jg, int layer_moe) {
    PHASE_IDS(F);
    const int gw = F.vcu * NWAVES + wave, NGW = F.G * NWAVES;
    const float* MOD = (const float*)(F.ctl + CW_MOD);
    bf16* H = (bf16*)(F.ws + WS_H);
    const bf16* Y = (const bf16*)(F.ws + WS_Y);
    const int* RT = (const int*)(F.ws + WS_ROUTE);
    for (int row = gw; row < T_; row += NGW) {
        const int b = row >> 11;
        f32x4 v[8]; float ss = 0.f;
        const f32x4* xr = (const f32x4*)(src + (size_t)row * D_) + lane;
#pragma unroll
        for (int j = 0; j < 8; ++j) v[j] = xr[64 * j];
        if (MODE >= 2) {
            const int* rt = RT + (size_t)row * 8; const int p0 = rt[4], p1 = rt[5]; const float w0 = __int_as_float(rt[2]), w1 = __int_as_float(rt[3]);
            const v2u* y0 = (const v2u*)(Y + (size_t)p0 * D_) + lane; const v2u* y1 = (const v2u*)(Y + (size_t)p1 * D_) + lane;
            const f32x4* gt = (const f32x4*)(MOD + (size_t)(jg * 4 + b) * 6144 + 4096) + lane;
#pragma unroll
            for (int j = 0; j < 8; ++j) { const v2u a = y0[64 * j], c = y1[64 * j]; const f32x4 g = gt[64 * j];
                f32x4 m; m.x = w0 * bf_lo(a.x) + w1 * bf_lo(c.x); m.y = w0 * bf_hi(a.x) + w1 * bf_hi(c.x); m.z = w0 * bf_lo(a.y) + w1 * bf_lo(c.y); m.w = w0 * bf_hi(a.y) + w1 * bf_hi(c.y);
                v[j] += g * m; }
            if (MODE == 2) { f32x4* xo = (f32x4*)(xdst + (size_t)row * D_) + lane;
#pragma unroll
                for (int j = 0; j < 8; ++j) xo[64 * j] = v[j]; }
        }
#pragma unroll
        for (int j = 0; j < 8; ++j) ss += (v[j].x * v[j].x + v[j].y * v[j].y) + (v[j].z * v[j].z + v[j].w * v[j].w);
        const float rstd = 1.0f / sqrtf(wave_sum(ss) * (1.0f / D_) + EPS_);
        const f32x4* gv = (const f32x4*)gvec + lane;
        if (MODE == 3) { f32x4* o = (f32x4*)(F.out + (size_t)row * D_) + lane;
#pragma unroll
            for (int j = 0; j < 8; ++j) o[64 * j] = v[j] * rstd * gv[64 * j];
        } else {
            v2u* o = (v2u*)(H + (size_t)row * D_) + lane;
            if (LM) { const LAS f32x4* sh = (const LAS f32x4*)(F.lds + RING_OFF) + b * 1024 + lane; const LAS f32x4* sc = sh + 512;
#pragma unroll
                for (int j = 0; j < 8; ++j) { const f32x4 h = v[j] * rstd * gv[64 * j] * (1.0f + sc[64 * j]) + sh[64 * j]; v2u w; w.x = pk2(h.x, h.y); w.y = pk2(h.z, h.w); o[64 * j] = w; }
            } else { const f32x4* sh = (const f32x4*)(MOD + (size_t)(jn * 4 + b) * 6144) + lane; const f32x4* sc = sh + 512;
#pragma unroll
                for (int j = 0; j < 8; ++j) { const f32x4 h = v[j] * rstd * gv[64 * j] * (1.0f + sc[64 * j]) + sh[64 * j]; v2u w; w.x = pk2(h.x, h.y); w.y = pk2(h.z, h.w); o[64 * j] = w; } }
        }
    }
}

__device__ __forceinline__ void router_phase(Frame& F, const Args& A, const float* X, const float* gvec, int jn, int layer, bool first) {
    const float* MOD = (const float*)(F.ctl + CW_MOD);
    const f32x4* WR4 = (const f32x4*)(F.ws + WS_WR) + (size_t)layer * 512 * 36;
    int* RT = (int*)(F.ws + WS_ROUTE); float* RS = (float*)(F.ws + WS_RS);
    LAS f32x4* hs = (LAS f32x4*)(F.lds + RING_OFF);
    LAS f32x4* wsm = (LAS f32x4*)(F.lds + RING_OFF + 40960);
    LAS f32x4* shs = (LAS f32x4*)(F.lds + RING_OFF + 81920);
    LAS float* rs = (LAS float*)(F.lds + RING_OFF + 83968);
    LAS float* lg = (LAS float*)(F.lds + RING_OFF + 84224);
    PHASE_IDS(F);
    const int r = tid >> 4, kp = tid & 15, kpart = lane & 15, cg = lane >> 4;
    int wpos[5];
#pragma unroll
    for (int i = 0; i < 5; ++i) { const int idx = tid + 512 * i; wpos[i] = idx + idx / 36; }
    for (int tile = F.vcu; tile < T_ / 32; tile += F.G) {
        const int row0 = tile * 32, b = row0 >> 11;
        const f32x4* sh = (const f32x4*)(MOD + (size_t)(jn * 4 + b) * 6144); const f32x4* sc = sh + 512; const f32x4* gv = (const f32x4*)gvec;
        const f32x4* xr = (const f32x4*)(X + (size_t)(row0 + r) * D_);
        float acc[4][9], accq[9], ss = 0.f;
#pragma unroll
        for (int c = 0; c < 9; ++c) { accq[c] = 0.f;
#pragma unroll
            for (int rr = 0; rr < 4; ++rr) acc[rr][c] = 0.f; }
        f32x4 xq[4], gq[4], sq[4], wq[5];
#define RT_LOAD(ch) do { _Pragma("unroll") for (int g = 0; g < 4; ++g) { const int q = (ch) * 64 + kp + 16 * g; xq[g] = xr[q]; gq[g] = gv[q] * (1.0f + sc[q]); if (r == 0) sq[g] = sh[q]; } \
            _Pragma("unroll") for (int i = 0; i < 5; ++i) { const int idx = tid + 512 * i; if (idx < 2304) wq[i] = WR4[(size_t)(ch) * 2304 + idx]; } } while (0)
        RT_LOAD(0);
#pragma unroll 1
        for (int ch = 0; ch < 8; ++ch) {
#pragma unroll
            for (int g = 0; g < 4; ++g) { const f32x4 x = xq[g]; ss += (x.x * x.x + x.y * x.y) + (x.z * x.z + x.w * x.w); hs[r * 65 + kp + 16 * g] = x * gq[g]; if (r == 0) shs[kp + 16 * g] = sq[g]; }
#pragma unroll
            for (int i = 0; i < 5; ++i) if (tid + 512 * i < 2304) wsm[wpos[i]] = wq[i];
            __syncthreads();
            if (ch + 1 < 8) RT_LOAD(ch + 1);
#pragma unroll 1
            for (int g = 0; g < 4; ++g) { const int kq = kpart + 16 * g; f32x4 h4[4];
#pragma unroll
                for (int rr = 0; rr < 4; ++rr) h4[rr] = hs[(wave * 4 + rr) * 65 + kq];
                const f32x4 q4 = shs[kq];
#pragma unroll
                for (int c = 0; c < 9; ++c) { const f32x4 w4 = wsm[kq * 37 + 9 * cg + c];
#pragma unroll
                    for (int rr = 0; rr < 4; ++rr) acc[rr][c] += (h4[rr].x * w4.x + h4[rr].y * w4.y) + (h4[rr].z * w4.z + h4[rr].w * w4.w);
                    if (wave == 0) accq[c] += (q4.x * w4.x + q4.y * w4.y) + (q4.z * w4.z + q4.w * w4.w); } }
            __syncthreads();
        }
#undef RT_LOAD
#pragma unroll
        for (int rr = 0; rr < 4; ++rr)
#pragma unroll
            for (int c = 0; c < 9; ++c) { float a = acc[rr][c]; a += __shfl_xor(a, 1); a += __shfl_xor(a, 2); a += __shfl_xor(a, 4); a += __shfl_xor(a, 8); if (kpart == 0) lg[(wave * 4 + rr) * 36 + 9 * cg + c] = a; }
        if (wave == 0) {
#pragma unroll
            for (int c = 0; c < 9; ++c) { float a = accq[c]; a += __shfl_xor(a, 1); a += __shfl_xor(a, 2); a += __shfl_xor(a, 4); a += __shfl_xor(a, 8); if (kpart == 0) lg[1152 + 9 * cg + c] = a; } }
        ss += __shfl_xor(ss, 1); ss += __shfl_xor(ss, 2); ss += __shfl_xor(ss, 4); ss += __shfl_xor(ss, 8);
        if (kp == 0) rs[r] = 1.0f / sqrtf(ss * (1.0f / D_) + EPS_);
        __syncthreads();
        if (tid < 32) { const int row = row0 + tid; const LAS float* l = lg + tid * 36; const LAS float* q = lg + 1152; const float* bg = A.in[18] + layer * 4; const float* be = A.in[20] + layer * 32; const float rstd = rs[tid];
            if (first) RS[row] = rstd;
            float g[4]; int gi = 0; float gm;
#pragma unroll
            for (int i = 0; i < 4; ++i) g[i] = rstd * l[i] + q[i] + bg[i];
            gm = g[0];
#pragma unroll
            for (int i = 1; i < 4; ++i) if (g[i] > gm) { gm = g[i]; gi = i; }
            float gs = 0.f;
#pragma unroll
            for (int i = 0; i < 4; ++i) gs += __expf(g[i] - gm);
            const float gw = 1.0f / gs;
            float e[8];
#pragma unroll
            for (int i = 0; i < 8; ++i) e[i] = rstd * l[4 + 8 * gi + i] + q[4 + 8 * gi + i] + be[8 * gi + i];
            int i0 = 0; float m0 = e[0];
#pragma unroll
            for (int i = 1; i < 8; ++i) if (e[i] > m0) { m0 = e[i]; i0 = i; }
            int i1 = -1; float m1 = -3.0e38f;
#pragma unroll
            for (int i = 0; i < 8; ++i) if (i != i0 && e[i] > m1) { m1 = e[i]; i1 = i; }
            const float p1 = __expf(m1 - m0), w0 = gw / (1.0f + p1), w1 = gw * p1 / (1.0f + p1);
            const int e0 = 8 * gi + i0, e1 = 8 * gi + i1;
            int* rt = RT + (size_t)row * 8; rt[0] = e0; rt[1] = e1; rt[2] = __float_as_int(w0); rt[3] = __float_as_int(w1);
            if (first) { atomicAdd((unsigned*)(F.ctl + CW_ECNT + 64 * layer + e0), 1u); atomicAdd((unsigned*)(F.ctl + CW_ECNT + 64 * layer + e1), 1u); }
        }
        __syncthreads();
    }
}

__device__ __forceinline__ void scatter_phase(Frame& F, const float* X, const float* gvec, int jn, int layer, bool first) {
    LAS int* tab = (LAS int*)(F.lds + MOE_TAB_OFF);
    PHASE_IDS(F);
    const int gw = F.vcu * NWAVES + wave, NGW = F.G * NWAVES;
    const float* MOD = (const float*)(F.ctl + CW_MOD);
    int* RT = (int*)(F.ws + WS_ROUTE); const float* RS = (const float*)(F.ws + WS_RS); bf16* HG = (bf16*)(F.ws + WS_HG);
    int myp0 = 0, myp1 = 0;
    { const int tok_l = gw + NGW * lane;
      if (tok_l < T_) { int* rt = RT + (size_t)tok_l * 8;
          if (first) { const int e0 = rt[0], e1 = rt[1];
              myp0 = tab[128 + e0] + (int)atomicAdd((unsigned*)(F.ctl + CW_ECUR + 64 * layer + e0), 1u);
              myp1 = tab[128 + e1] + (int)atomicAdd((unsigned*)(F.ctl + CW_ECUR + 64 * layer + e1), 1u);
              rt[4] = myp0; rt[5] = myp1; }
          else { myp0 = rt[4]; myp1 = rt[5]; } } }
    for (int i = 0; gw + NGW * i < T_; ++i) {
        const int tok = gw + NGW * i;
        const int p0 = __shfl(myp0, i), p1 = __shfl(myp1, i);
        const f32x4* xr = (const f32x4*)(X + (size_t)tok * D_) + lane; f32x4 v[8];
#pragma unroll
        for (int j = 0; j < 8; ++j) v[j] = xr[64 * j];
        const float rstd = RS[tok]; const int b = tok >> 11;
        const f32x4* sh = (const f32x4*)(MOD + (size_t)(jn * 4 + b) * 6144) + lane; const f32x4* sc = sh + 512; const f32x4* gv = (const f32x4*)gvec + lane;
        v2u* d0 = (v2u*)(HG + (size_t)p0 * D_) + lane; v2u* d1 = (v2u*)(HG + (size_t)p1 * D_) + lane;
#pragma unroll
        for (int j = 0; j < 8; ++j) { const f32x4 h = v[j] * rstd * gv[64 * j] * (1.0f + sc[64 * j]) + sh[64 * j]; v2u w; w.x = pk2(h.x, h.y); w.y = pk2(h.z, h.w); d0[64 * j] = w; d1[64 * j] = w; }
    }
}

__device__ __forceinline__ void retnorm_phase(Frame& F) {
    PHASE_IDS(F);
    const int gw = F.vcu * NWAVES + wave, NGW = F.G * NWAVES;
    const bf16* O = (const bf16*)(F.ws + WS_RETO); const bf16* P1 = (const bf16*)(F.ws + WS_PROJ1); bf16* A5 = (bf16*)(F.ws + WS_A5);
    for (int row = gw; row < T_; row += NGW) {
        const v4u* o = (const v4u*)(O + (size_t)row * 4096) + lane; const v4u* g = (const v4u*)(P1 + (size_t)row * 12288 + 8192) + lane; v4u* a = (v4u*)(A5 + (size_t)row * 4096) + lane;
#pragma unroll
        for (int h = 0; h < 8; ++h) { const v4u x = o[64 * h], s = g[64 * h];
            float f[8] = {bf_lo(x.x), bf_hi(x.x), bf_lo(x.y), bf_hi(x.y), bf_lo(x.z), bf_hi(x.z), bf_lo(x.w), bf_hi(x.w)};
            float ss = 0.f;
#pragma unroll
            for (int i = 0; i < 8; ++i) ss += f[i] * f[i];
            const float rstd = 1.0f / sqrtf(wave_sum(ss) * (1.0f / 512.0f) + EPS_);
            v4u w; w.x = pk2(f[0] * rstd * bf_lo(s.x), f[1] * rstd * bf_hi(s.x)); w.y = pk2(f[2] * rstd * bf_lo(s.y), f[3] * rstd * bf_hi(s.y));
            w.z = pk2(f[4] * rstd * bf_lo(s.z), f[5] * rstd * bf_hi(s.z)); w.w = pk2(f[6] * rstd * bf_lo(s.w), f[7] * rstd * bf_hi(s.w));
            a[64 * h] = w; }
    }
}
#ifndef ATT_REP
#define ATT_REP 1
#endif
#ifndef RET_REP
#define RET_REP 1
#endif
#ifndef ATT_KPF
#define ATT_KPF 4
#endif
constexpr int ATT_VST = 320;
__device__ __forceinline__ s16x4 vtr(const LAS unsigned char* p) { return __builtin_bit_cast(s16x4, __builtin_amdgcn_ds_read_tr16_b64_v4i16((LAS v4i16_t*)p)); }
__device__ __forceinline__ float xhalf(float v) { return __shfl_xor(v, 32); }

template <int DQK, int MODE>
__device__ __forceinline__ void attn_unit(LAS unsigned char* lds, const bf16* Qp, int qpitch, const bf16* Kp, int kpitch, const bf16* K2p, int k2pitch,
                                          const bf16* Vp, int vpitch, bf16* Op, int opitch, int q0, float dlog2, int tid_, int wave, int lane_, volatile LAS unsigned* flg) {
    const int lane = lane_id_opaque(), tid = wave * 64 + lane; (void)tid_; (void)lane_;
    constexpr int RB = DQK * 2, SW = (DQK == 192) ? 7 : 15, KB = 64 * RB, STG = KB + 16384;
    constexpr int NIK = KB / 8192, NI = NIK + 2;
    constexpr int NKS = DQK / 16;
    static_assert(3 * STG <= RING_BYTES, "three stages in the ring");
    const int r = lane & 31, h = lane >> 5, qrow = q0 + 32 * wave + r;
    bf16x8 qf[NKS];
    { const bf16* qp = Qp + (size_t)qrow * qpitch + 8 * h;
#pragma unroll
      for (int ks = 0; ks < NKS; ++ks) qf[ks] = *(const bf16x8*)(qp + 16 * ks); }
    f32x16 o[4];
#pragma unroll
    for (int db = 0; db < 4; ++db)
#pragma unroll
        for (int i = 0; i < 16; ++i) o[db][i] = 0.f;
    float m_run = -1.0e30f, l_run = 0.f, carry = 0.f;
    const int ntiles = (q0 + 256) >> 6;
    constexpr bool KLIN = (DQK != 192); constexpr int NKG = KLIN ? 1 : NIK;
    unsigned kgo[NKG], vgo0; bool krope[NKG];
#pragma unroll
    for (int j = 0; j < NKG; ++j) { const int pos = (j * 8 + wave) * 1024 + lane * 16, row = pos / RB, c = ((pos % RB) >> 4) ^ (row & SW);
        krope[j] = (DQK == 192) && c >= 16;
        kgo[j] = krope[j] ? (unsigned)(row * k2pitch * 2 + (c - 16) * 16) : (unsigned)(row * kpitch * 2 + c * 16); }
    { const int pos = wave * 1024 + lane * 16, row = pos >> 8, ch = ((pos & 255) >> 4) ^ (((row & 3) << 2) | ((row >> 2) & 3)); vgo0 = (unsigned)(row * vpitch * 2 + ch * 16); }
#define ATT_DMA(kt, stg) do { const size_t key0_ = (size_t)(kt) * 64; \
        const char* kb_ = (const char*)Kp + key0_ * kpitch * 2; const char* k2_ = (const char*)K2p + key0_ * k2pitch * 2; const char* vb_ = (const char*)Vp + key0_ * vpitch * 2; \
        LAS unsigned char* st_ = lds + (stg) * STG + wave * 1024; \
        _Pragma("unroll") for (int j_ = 0; j_ < NIK; ++j_) { const char* g_ = KLIN ? kb_ + kgo[0] + (size_t)j_ * (8192 / RB) * kpitch * 2 : ((krope[KLIN ? 0 : j_] ? k2_ : kb_) + kgo[KLIN ? 0 : j_]); \
            __builtin_amdgcn_global_load_lds((const unsigned*)g_, (LAS unsigned*)(st_ + j_ * 8192), 16, 0, 0); } \
        _Pragma("unroll") for (int j_ = 0; j_ < 2; ++j_) __builtin_amdgcn_global_load_lds((const unsigned*)(vb_ + vgo0 + (size_t)j_ * 32 * vpitch * 2), (LAS unsigned*)(st_ + KB + j_ * 8192), 16, 0, 0); } while (0)
    if (MODE == 1 && tid < 16) flg[tid] = 0u;
    ATT_DMA(ntiles - 1, 0);
    ATT_DMA(ntiles > 1 ? ntiles - 2 : 0, 1);
    const int q4 = (lane & 15) >> 2, p4 = lane & 3, blk = (lane >> 4) & 1, x4 = 2 * blk + (p4 >> 1);
    constexpr int NKO = (SW + 1) / 2;
    const int krow = r * RB, kxy = (r & SW) ^ h;
    const int vlo_off = 256 * (4 * h + q4) + 16 * (x4 ^ h) + 8 * (p4 & 1), vhi_off = 256 * (4 * h + q4 + 8) + 16 * (x4 ^ (h + 2)) + 8 * (p4 & 1);
    for (int it = 0; it < ntiles; ++it) {
        const int kt = ntiles - 1 - it;
        int y_ = kxy, q4_ = q4; asm volatile("" : "+v"(y_), "+v"(q4_));
        const bool wdone = (MODE == 1) && __all(carry < -140.0f);
        if (MODE == 1 && lane == 0) flg[8 * (it & 1) + wave] = wdone ? 1u : 0u;
        asm volatile("s_waitcnt vmcnt(%0)" :: "n"(NI) : "memory");
        asm volatile("s_waitcnt lgkmcnt(0)" ::: "memory");
        __builtin_amdgcn_s_barrier();
        asm volatile("" ::: "memory");
        if (MODE == 1) { v4u fa, fb; const unsigned fad = (unsigned)(size_t)(flg + 8 * (it & 1));
            asm volatile("ds_read_b128 %0, %2\n\tds_read_b128 %1, %2 offset:16\n\ts_waitcnt lgkmcnt(0)" : "=&v"(fa), "=&v"(fb) : "v"(fad) : "memory");
            if ((fa.x & fa.y & fa.z & fa.w & fb.x & fb.y & fb.z & fb.w) != 0u) break; }
        { const int ktn = kt >= 2 ? kt - 2 : 0; ATT_DMA(ktn, (it + 2) % 3); }
        if (!wdone && 64 * kt <= q0 + 32 * wave + 31) {
            const LAS unsigned char* Kb = lds + (it % 3) * STG; const LAS unsigned char* Vb = Kb + KB;
            f32x16 s[2];
            const int kbase = 64 * kt + 4 * h;
            const bool diag = 64 * kt + 63 > q0 + 32 * wave;
            unsigned va[8];
#pragma unroll
            for (int db = 0; db < 4; ++db) { va[db] = (unsigned)(size_t)(Vb + vlo_off + 64 * (db ^ q4_)); va[4 + db] = (unsigned)(size_t)(Vb + vhi_off + 64 * (db ^ q4_)); }
            s16x4 lo_[2][4], hi_[2][4];
#define ATT_VRD(buf, sidx) do { _Pragma("unroll") for (int db = 0; db < 4; ++db) { \
                    asm volatile("ds_read_b64_tr_b16 %0, %1 offset:%c2" : "=&v"(lo_[buf][db]) : "v"(va[db]), "i"(4096 * (sidx)) : "memory"); \
                    asm volatile("ds_read_b64_tr_b16 %0, %1 offset:%c2" : "=&v"(hi_[buf][db]) : "v"(va[4 + db]), "i"(4096 * (sidx)) : "memory"); } } while (0)
#define ATT_VMM(buf, sidx) do { const int kb_ = (sidx) >> 1, ss_ = (sidx) & 1; \
                v4u pw; pw.x = pk2(s[kb_][8 * ss_ + 0], s[kb_][8 * ss_ + 1]); pw.y = pk2(s[kb_][8 * ss_ + 2], s[kb_][8 * ss_ + 3]); pw.z = pk2(s[kb_][8 * ss_ + 4], s[kb_][8 * ss_ + 5]); pw.w = pk2(s[kb_][8 * ss_ + 6], s[kb_][8 * ss_ + 7]); \
                const bf16x8 pf = __builtin_bit_cast(bf16x8, pw); \
                _Pragma("unroll") for (int db = 0; db < 4; ++db) { \
                    const bf16x8 vf = __builtin_shufflevector(lo_[buf][db], hi_[buf][db], 0, 1, 2, 3, 4, 5, 6, 7); \
                    o[db] = __builtin_amdgcn_mfma_f32_32x32x16_bf16(vf, pf, o[db], 0, 0, 0); } } while (0)
#define ATT_PVN(first, count) do { ATT_VRD(0, first); \
                _Pragma("unroll") for (int i_ = 0; i_ < (count); ++i_) { \
                    if (i_ + 1 < (count)) { if (i_ & 1) ATT_VRD(0, (first) + i_ + 1); else ATT_VRD(1, (first) + i_ + 1); asm volatile("s_waitcnt lgkmcnt(8)" ::: "memory"); } \
                    else asm volatile("s_waitcnt lgkmcnt(0)" ::: "memory"); \
                    __builtin_amdgcn_sched_barrier(0); \
                    if (i_ & 1) ATT_VMM(1, (first) + i_); else ATT_VMM(0, (first) + i_); \
                    __builtin_amdgcn_sched_barrier(0); } } while (0)
#pragma unroll
            for (int kb = 0; kb < 2; ++kb) {
#pragma unroll
                for (int i = 0; i < 16; ++i) s[kb][i] = 0.f;
                const LAS unsigned char* kp = Kb + 32 * kb * RB;
#define ATT_KF(ks) (*(const LAS bf16x8*)(kp + krow + (((2 * ((ks) % NKO)) ^ y_) << 4) + (((2 * (ks)) & ~SW) << 4)))
                bf16x8 fa = ATT_KF(0), fb = ATT_KF(1);
#pragma unroll
                for (int g2 = 0; g2 < NKS / 2; ++g2) {
                    bf16x8 na = fa, nb = fb;
                    if (g2 + 1 < NKS / 2) { na = ATT_KF(2 * g2 + 2); nb = ATT_KF(2 * g2 + 3); }
                    __builtin_amdgcn_sched_barrier(0);
                    s[kb] = __builtin_amdgcn_mfma_f32_32x32x16_bf16(fa, qf[2 * g2], s[kb], 0, 0, 0); s[kb] = __builtin_amdgcn_mfma_f32_32x32x16_bf16(fb, qf[2 * g2 + 1], s[kb], 0, 0, 0);
                    __builtin_amdgcn_sched_barrier(0);
                    fa = na; fb = nb;
                }
#undef ATT_KF
                if (MODE == 2) {
                    if (diag) {
#pragma unroll
                        for (int i = 0; i < 16; ++i) { const int key = kbase + 32 * kb + (i & 3) + 8 * (i >> 2); s[kb][i] = key <= qrow ? s[kb][i] : 0.f; } }
                    ATT_PVN(2 * kb, 2);
                }
            }
            if (MODE == 0) {
                float tmax = -1.0e30f;
#pragma unroll
                for (int kb = 0; kb < 2; ++kb)
#pragma unroll
                    for (int i = 0; i < 16; ++i) { const int key = kbase + 32 * kb + (i & 3) + 8 * (i >> 2); const float v = (!diag || key <= qrow) ? s[kb][i] : -1.0e30f; s[kb][i] = v; tmax = fmaxf(tmax, v); }
                tmax = fmaxf(tmax, xhalf(tmax));
                const float m_new = fmaxf(m_run, tmax), alpha = ex2(m_run - m_new); m_run = m_new;
                float ps = 0.f;
#pragma unroll
                for (int kb = 0; kb < 2; ++kb)
#pragma unroll
                    for (int i = 0; i < 16; ++i) { const float p = ex2(s[kb][i] - m_new); s[kb][i] = p; ps += p; }
                l_run = l_run * alpha + ps;
#pragma unroll
                for (int db = 0; db < 4; ++db)
#pragma unroll
                    for (int i = 0; i < 16; ++i) o[db][i] *= alpha;
            } else if (MODE == 1) {
                float lkv[2][16], gs[2][4], go[2][4];
#pragma unroll
                for (int kb = 0; kb < 2; ++kb)
#pragma unroll
                    for (int g = 0; g < 4; ++g) { float t = 0.f;
#pragma unroll
                        for (int j = 0; j < 4; ++j) { const int i = 4 * g + j, key = kbase + 32 * kb + 8 * g + j; const float z = s[kb][i];
                            const bool vis = key < qrow;
                            const float lk = vis ? -(fmaxf(z, 0.f) + lg2(1.0f + ex2(-fabsf(z)))) : 0.f;
                            lkv[kb][i] = lk; s[kb][i] = vis ? z + lk : -1.0e30f; t += lk; }
                        gs[kb][g] = t; }
#pragma unroll
                for (int kb = 0; kb < 2; ++kb)
#pragma unroll
                    for (int g = 0; g < 4; ++g) go[kb][g] = xhalf(gs[kb][g]);
                float R = carry;
#pragma unroll
                for (int kb = 1; kb >= 0; --kb)
#pragma unroll
                    for (int g = 3; g >= 0; --g) {
                        float run = R + (h == 0 ? go[kb][g] : 0.f);
#pragma unroll
                        for (int j = 3; j >= 0; --j) { const int i = 4 * g + j; const float a = ex2(s[kb][i] + run); run += lkv[kb][i]; s[kb][i] = a; }
                        R += gs[kb][g] + go[kb][g];
                    }
                carry = R;
            }
            if (MODE != 2) { ATT_PVN(0, 4); }
#undef ATT_PVN
#undef ATT_VMM
#undef ATT_VRD
        }
    }
#undef ATT_DMA
    asm volatile("s_waitcnt vmcnt(0) lgkmcnt(0)" ::: "memory");
    __builtin_amdgcn_s_barrier();
    asm volatile("" ::: "memory");
    float inv = 1.0f;
    if (MODE == 0) { const float lt = l_run + xhalf(l_run); inv = 1.0f / lt; }
    bf16* op = Op + (size_t)qrow * opitch + 4 * h;
#pragma unroll
    for (int db = 0; db < 4; ++db)
#pragma unroll
        for (int g = 0; g < 4; ++g) { v2u w; w.x = pk2(o[db][4 * g] * inv, o[db][4 * g + 1] * inv); w.y = pk2(o[db][4 * g + 2] * inv, o[db][4 * g + 3] * inv); *(v2u*)(op + 32 * db + 8 * g) = w; }
}

struct WorkQ { gu32* q; int total; int slot; unsigned nxt; };
__device__ __forceinline__ void wq_init(Frame& F, WorkQ& Q, gu32* q, int total, int slot, int lane) {
    Q.q = q; Q.total = total; Q.slot = slot; Q.nxt = 0u;
    if (F.wave == 0 && lane == 0) Q.nxt = __hip_atomic_fetch_add(q, 1u, RLX_AGENT);
}
__device__ __forceinline__ bool wq_take(Frame& F, WorkQ& Q, int lane, int& u) {
    if (F.wave == 0 && lane == 0) F.MISC[Q.slot] = Q.nxt;
    __syncthreads();
    u = (int)F.MISC[Q.slot];
    __syncthreads();
    if (u >= Q.total) return false;
    if (F.wave == 0 && lane == 0) Q.nxt = __hip_atomic_fetch_add(Q.q, 1u, RLX_AGENT);
    return true;
}
template <int STREAM> __device__ __forceinline__ bool conv_batch(Frame& F, const Args& A, WorkQ& Q, int lane, int wave) {
    int b; if (!wq_take(F, Q, lane, b)) return false;
    const int i0 = 32 * b + 4 * wave;
    const ConvSrc c0 = conv_item<STREAM>(A, F.ws, i0), c1 = conv_item<STREAM>(A, F.ws, i0 + 1), c2 = conv_item<STREAM>(A, F.ws, i0 + 2), c3 = conv_item<STREAM>(A, F.ws, i0 + 3);
    f32x4 v0[8], v1[8], v2[8], v3[8];
    conv_load(c0, lane, v0); conv_load(c1, lane, v1); conv_load(c2, lane, v2); conv_load(c3, lane, v3);
    conv_store(c0, lane, v0); conv_store(c1, lane, v1); conv_store(c2, lane, v2); conv_store(c3, lane, v3);
    return true;
}
__device__ __forceinline__ void mla_phase(Frame& F, const Args& A, WorkQ& QC, bool& conv_left) {
    PHASE_IDS(F);
    WorkQ QU; wq_init(F, QU, F.ctl + CW_QMLA, 256, 16, lane);
    if (F.vcu & 1) { for (int i = 0; i < 8 && conv_left; ++i) conv_left = conv_batch<1>(F, A, QC, lane, wave); }
    const bf16* Q = (const bf16*)(F.ws + WS_QMLA); const bf16* KV = (const bf16*)(F.ws + WS_KVMLA); const bf16* KR = (const bf16*)(F.ws + WS_KR); bf16* O = (bf16*)(F.ws + WS_ATTO);
    int u;
    while (wq_take(F, QU, lane, u)) {
        const int qb = 7 - (u >> 5), bh = u & 31, b = bh >> 3, h = bh & 7; const size_t r0 = (size_t)b * S_;
#pragma unroll 1
        for (int rep_ = 0; rep_ < ATT_REP; ++rep_)
        attn_unit<192, 0>(F.lds + RING_OFF, Q + r0 * 1536 + h * 192, 1536, KV + r0 * 2048 + h * 256, 2048, KR + r0 * 64, 64, KV + r0 * 2048 + h * 256 + 128, 2048,
                          O + r0 * 2048 + 1024 + h * 128, 2048, qb * 256, 0.f, tid, wave, lane, F.MISC + 32);
        for (int i = 0; i < 4 && conv_left; ++i) conv_left = conv_batch<1>(F, A, QC, lane, wave);
    }
}
__device__ __forceinline__ void sb_phase(Frame& F, const Args& A, WorkQ& QC, bool& conv_left) {
    PHASE_IDS(F);
    WorkQ QU; wq_init(F, QU, F.ctl + CW_QSB, 256, 17, lane);
    const bf16* P0 = (const bf16*)(F.ws + WS_PROJ0); bf16* O = (bf16*)(F.ws + WS_ATTO);
    int u;
    while (wq_take(F, QU, lane, u)) {
        const int qb = 7 - (u >> 5), bh = u & 31, b = bh >> 3, h = bh & 7; const size_t r0 = (size_t)b * S_;
#pragma unroll 1
        for (int rep_ = 0; rep_ < ATT_REP; ++rep_)
        attn_unit<128, 1>(F.lds + RING_OFF, P0 + r0 * 4096 + h * 128, 4096, P0 + r0 * 4096 + 1024 + h * 128, 4096, nullptr, 0, P0 + r0 * 4096 + 2048 + h * 128, 4096,
                          O + r0 * 2048 + h * 128, 2048, qb * 256, 0.f, tid, wave, lane, F.MISC + 32);
        for (int i = 0; i < 4 && conv_left; ++i) conv_left = conv_batch<1>(F, A, QC, lane, wave);
    }
    while (conv_left) conv_left = conv_batch<1>(F, A, QC, lane, wave);
}
__device__ __forceinline__ void ret_phase(Frame& F, const Args& A) {
    PHASE_IDS(F);
    WorkQ QC; wq_init(F, QC, F.ctl + CW_QC2, CONV_N2 / 32, 18, lane); bool conv_left = true;
    WorkQ QU; wq_init(F, QU, F.ctl + CW_QRET, 1024, 16, lane);
    if (F.vcu & 1) conv_left = conv_batch<2>(F, A, QC, lane, wave);
    const bf16* P1 = (const bf16*)(F.ws + WS_PROJ1); bf16* O = (bf16*)(F.ws + WS_RETO);
    int u;
    while (wq_take(F, QU, lane, u)) {
        const int qb = 7 - (u >> 7), rem = u & 127, eq = rem >> 5, bh = rem & 31, b = bh >> 3, h = bh & 7; const size_t r0 = (size_t)b * S_;
        const float dlog2 = log1pf(-exp2f(-5.0f - (float)h)) * LOG2E;
#pragma unroll 1
        for (int rep_ = 0; rep_ < RET_REP; ++rep_)
        attn_unit<256, 2>(F.lds + RING_OFF, P1 + r0 * 12288 + h * 256, 12288, P1 + r0 * 12288 + 2048 + h * 256, 12288, nullptr, 0, P1 + r0 * 12288 + 4096 + h * 512 + eq * 128, 12288,
                          O + r0 * 4096 + h * 512 + eq * 128, 4096, qb * 256, dlog2, tid, wave, lane, F.MISC + 32);
        for (int i = 0; i < 2 && conv_left; ++i) conv_left = conv_batch<2>(F, A, QC, lane, wave);
    }
    while (conv_left) conv_left = conv_batch<2>(F, A, QC, lane, wave);
}
typedef f32x4 AccT[2][2][4][2];
__device__ __forceinline__ v4u pack8(const f32x4& a, const f32x4& b) { v4u w; w.x = pk2(a.x, a.y); w.y = pk2(a.z, a.w); w.z = pk2(b.x, b.y); w.w = pk2(b.z, b.w); return w; }
__device__ __forceinline__ float sq4(const f32x4& a) { return (a.x * a.x + a.y * a.y) + (a.z * a.z + a.w * a.w); }
__device__ __forceinline__ void rope4(const f32x4& x1, const f32x4& x2, const f32x2* cs, f32x4& o1, f32x4& o2) {
    const f32x4 c01 = *(const f32x4*)cs, c23 = *(const f32x4*)(cs + 2);
    o1.x = x1.x * c01.x - x2.x * c01.y; o2.x = x1.x * c01.y + x2.x * c01.x;
    o1.y = x1.y * c01.z - x2.y * c01.w; o2.y = x1.y * c01.w + x2.y * c01.z;
    o1.z = x1.z * c23.x - x2.z * c23.y; o2.z = x1.z * c23.y + x2.z * c23.x;
    o1.w = x1.w * c23.z - x2.w * c23.w; o2.w = x1.w * c23.w + x2.w * c23.z;
}
struct EpiG1 { static constexpr bool PERM = true, AFTER_DRAIN = false;
    bf16* P0; bf16* KR; float* ssqp; const f32x2* cs64;
    __device__ __forceinline__ void operator()(const AccT& acc, const pg8::Unit& u, int wr, int wc, int fr, int fq) const {
        const int row0 = u.pm * 256 + wr * 64 + fr, tc = wc * 32 + 8 * fq;
        if (u.pn < 15) {
            const float scl = u.pn < 4 ? C_SB : 1.0f;
#pragma unroll
            for (int ai = 0; ai < 2; ++ai)
#pragma unroll
                for (int m = 0; m < 4; ++m) { const int row = row0 + ai * 128 + m * 16; float ss = 0.f;
#pragma unroll
                    for (int bj = 0; bj < 2; ++bj) { const f32x4 v0 = acc[ai][bj][m][0], v1 = acc[ai][bj][m][1]; ss += sq4(v0) + sq4(v1);
                        *(v4u*)(P0 + (size_t)row * 4096 + u.pn * 256 + bj * 128 + tc) = pack8(v0 * scl, v1 * scl); }
                    if (u.pn >= 12) { ss += __shfl_xor(ss, 16); ss += __shfl_xor(ss, 32); if (fq == 0) { if (u.pn < 14) ssqp[(size_t)row * 8 + 4 * (u.pn - 12) + wc] = ss; else ssqp[(size_t)T_ * 8 + (size_t)row * 4 + wc] = ss; } } }
        } else if (wc == 0) {
#pragma unroll
            for (int ai = 0; ai < 2; ++ai)
#pragma unroll
                for (int m = 0; m < 4; ++m) { const int row = row0 + ai * 128 + m * 16; f32x4 a0, b0, a1, b1;
                    rope4(acc[ai][0][m][0], acc[ai][1][m][0], cs64 + (size_t)row * 32 + 8 * fq, a0, b0);
                    rope4(acc[ai][0][m][1], acc[ai][1][m][1], cs64 + (size_t)row * 32 + 8 * fq + 4, a1, b1);
                    *(v4u*)(KR + (size_t)row * 64 + 8 * fq) = pack8(a0, a1); *(v4u*)(KR + (size_t)row * 64 + 32 + 8 * fq) = pack8(b0, b1); asm volatile("" ::: "memory"); }
        }
    }
};
struct EpiG2q { static constexpr bool PERM = true, AFTER_DRAIN = false;
    bf16* Q; const float* ssq; const f32x2* cs64;
    __device__ __forceinline__ void operator()(const AccT& acc, const pg8::Unit& u, int wr, int wc, int fr, int fq) const {
        const int row0 = u.pm * 256 + wr * 64 + fr, tc = wc * 32 + 8 * fq;
        if (u.pn < 4) {
#pragma unroll
            for (int ai = 0; ai < 2; ++ai)
#pragma unroll
                for (int m = 0; m < 4; ++m) { const int row = row0 + ai * 128 + m * 16; const f32x4 pa = *(const f32x4*)(ssq + (size_t)row * 8), pb = *(const f32x4*)(ssq + (size_t)row * 8 + 4); const float rs = C_MLA * __builtin_amdgcn_rsqf(((((((pa.x + pa.y) + pa.z) + pa.w) + pb.x) + pb.y) + pb.z + pb.w) * (1.0f / 512.0f) + EPS_);
#pragma unroll
                    for (int bj = 0; bj < 2; ++bj) { const int nidx = u.pn * 256 + bj * 128 + tc, hh = nidx >> 7, d = nidx & 127;
                        *(v4u*)(Q + (size_t)row * 1536 + hh * 192 + d) = pack8(acc[ai][bj][m][0] * rs, acc[ai][bj][m][1] * rs); }
                    asm volatile("" ::: "memory"); }
        } else {
            const int head = 4 * (u.pn - 4) + wc;
#pragma unroll
            for (int ai = 0; ai < 2; ++ai)
#pragma unroll
                for (int m = 0; m < 4; ++m) { const int row = row0 + ai * 128 + m * 16; const f32x4 pa = *(const f32x4*)(ssq + (size_t)row * 8), pb = *(const f32x4*)(ssq + (size_t)row * 8 + 4); const float rs = C_MLA * __builtin_amdgcn_rsqf(((((((pa.x + pa.y) + pa.z) + pa.w) + pb.x) + pb.y) + pb.z + pb.w) * (1.0f / 512.0f) + EPS_); f32x4 a0, b0, a1, b1;
                    rope4(acc[ai][0][m][0] * rs, acc[ai][1][m][0] * rs, cs64 + (size_t)row * 32 + 8 * fq, a0, b0);
                    rope4(acc[ai][0][m][1] * rs, acc[ai][1][m][1] * rs, cs64 + (size_t)row * 32 + 8 * fq + 4, a1, b1);
                    *(v4u*)(Q + (size_t)row * 1536 + head * 192 + 128 + 8 * fq) = pack8(a0, a1); *(v4u*)(Q + (size_t)row * 1536 + head * 192 + 160 + 8 * fq) = pack8(b0, b1);
                    asm volatile("" ::: "memory"); }
        }
    }
};
struct EpiG2kv { static constexpr bool PERM = true, AFTER_DRAIN = false;
    bf16* KV; const float* ssq;
    __device__ __forceinline__ void operator()(const AccT& acc, const pg8::Unit& u, int wr, int wc, int fr, int fq) const {
        const int row0 = u.pm * 256 + wr * 64 + fr, tc = wc * 32 + 8 * fq;
#pragma unroll
        for (int ai = 0; ai < 2; ++ai)
#pragma unroll
            for (int m = 0; m < 4; ++m) { const int row = row0 + ai * 128 + m * 16; const f32x4 pa = *(const f32x4*)(ssq + (size_t)row * 4); const float rs = __builtin_amdgcn_rsqf((((pa.x + pa.y) + pa.z) + pa.w) * (1.0f / 256.0f) + EPS_);
#pragma unroll
                for (int bj = 0; bj < 2; ++bj) *(v4u*)(KV + (size_t)row * 2048 + u.pn * 256 + bj * 128 + tc) = pack8(acc[ai][bj][m][0] * rs, acc[ai][bj][m][1] * rs); asm volatile("" ::: "memory"); }
    }
};
struct EpiRes { static constexpr bool PERM = false, AFTER_DRAIN = false;
    const float* src; float* dst; const float* gate;
    __device__ __forceinline__ void operator()(const AccT& acc, const pg8::Unit& u, int wr, int wc, int fr, int fq) const {
        const int row0 = u.pm * 256 + wr * 64 + fr, col0 = u.pn * 256 + wc * 32 + 4 * fq;
#pragma unroll
        for (int ai = 0; ai < 2; ++ai)
#pragma unroll
            for (int m = 0; m < 4; ++m) { const int row = row0 + ai * 128 + m * 16; const float* g = gate + (size_t)(row >> 11) * 6144 + col0; const size_t off = (size_t)row * 2048 + col0;
#pragma unroll
                for (int bj = 0; bj < 2; ++bj)
#pragma unroll
                    for (int n = 0; n < 2; ++n) { const int o = bj * 128 + n * 16; *(f32x4*)(dst + off + o) = *(const f32x4*)(src + off + o) + *(const f32x4*)(g + o) * acc[ai][bj][m][n]; } asm volatile("" ::: "memory"); }
    }
};
struct EpiG4 { static constexpr bool PERM = true, AFTER_DRAIN = false;
    bf16* P1; const f32x2* cs256;
    __device__ __forceinline__ void operator()(const AccT& acc, const pg8::Unit& u, int wr, int wc, int fr, int fq) const {
        const int row0 = u.pm * 256 + wr * 64 + fr, tc = wc * 32 + 8 * fq;
#pragma unroll
        for (int ai = 0; ai < 2; ++ai)
#pragma unroll
            for (int m = 0; m < 4; ++m) { const int row = row0 + ai * 128 + m * 16; bf16* dst = P1 + (size_t)row * 12288 + u.pn * 256 + tc;
                if (u.pn < 16) {
                    const float dl2 = log1pf(-exp2f(-5.0f - (float)(u.pn & 7))) * LOG2E, rel = (float)((row & 2047) - 1024);
                    const float scl = u.pn >= 8 ? 0.0625f * ex2(-dl2 * rel) : ex2(dl2 * rel); f32x4 a0, b0, a1, b1;
                    rope4(acc[ai][0][m][0] * scl, acc[ai][1][m][0] * scl, cs256 + (size_t)row * 128 + tc, a0, b0);
                    rope4(acc[ai][0][m][1] * scl, acc[ai][1][m][1] * scl, cs256 + (size_t)row * 128 + tc + 4, a1, b1);
                    *(v4u*)dst = pack8(a0, a1); *(v4u*)(dst + 128) = pack8(b0, b1);
                } else if (u.pn < 32) {
#pragma unroll
                    for (int bj = 0; bj < 2; ++bj) *(v4u*)(dst + bj * 128) = pack8(acc[ai][bj][m][0], acc[ai][bj][m][1]);
                } else {
#pragma unroll
                    for (int bj = 0; bj < 2; ++bj) { f32x4 v0 = acc[ai][bj][m][0], v1 = acc[ai][bj][m][1];
                        v0.x = silu_f(v0.x); v0.y = silu_f(v0.y); v0.z = silu_f(v0.z); v0.w = silu_f(v0.w); v1.x = silu_f(v1.x); v1.y = silu_f(v1.y); v1.z = silu_f(v1.z); v1.w = silu_f(v1.w);
                        *(v4u*)(dst + bj * 128) = pack8(v0, v1); }
                } asm volatile("" ::: "memory"); }
    }
};
struct EpiM3 { static constexpr bool PERM = true, AFTER_DRAIN = false;
    bf16* ACT;
    __device__ __forceinline__ void operator()(const AccT& acc, const pg8::Unit& u, int wr, int wc, int fr, int fq) const {
        const int row0 = u.pm * 256 + wr * 64 + fr, tc = wc * 32 + 8 * fq;
#pragma unroll
        for (int ai = 0; ai < 2; ++ai)
#pragma unroll
            for (int m = 0; m < 4; ++m) { const int row = row0 + ai * 128 + m * 16; const f32x4 g0 = acc[ai][0][m][0], g1 = acc[ai][0][m][1], u0 = acc[ai][1][m][0], u1 = acc[ai][1][m][1]; f32x4 a0, a1;
                a0.x = silu_f(g0.x) * u0.x; a0.y = silu_f(g0.y) * u0.y; a0.z = silu_f(g0.z) * u0.z; a0.w = silu_f(g0.w) * u0.w;
                a1.x = silu_f(g1.x) * u1.x; a1.y = silu_f(g1.y) * u1.y; a1.z = silu_f(g1.z) * u1.z; a1.w = silu_f(g1.w) * u1.w;
                *(v4u*)(ACT + (size_t)row * 512 + u.pn * 128 + tc) = pack8(a0, a1); }
    }
};
struct EpiM4 { static constexpr bool PERM = true, AFTER_DRAIN = false;
    bf16* Y;
    __device__ __forceinline__ void operator()(const AccT& acc, const pg8::Unit& u, int wr, int wc, int fr, int fq) const {
        const int row0 = u.pm * 256 + wr * 64 + fr, tc = wc * 32 + 8 * fq;
#pragma unroll
        for (int ai = 0; ai < 2; ++ai)
#pragma unroll
            for (int m = 0; m < 4; ++m) { const int row = row0 + ai * 128 + m * 16;
#pragma unroll
                for (int bj = 0; bj < 2; ++bj) *(v4u*)(Y + (size_t)row * 2048 + u.pn * 256 + bj * 128 + tc) = pack8(acc[ai][bj][m][0], acc[ai][bj][m][1]); }
    }
};
__device__ __forceinline__ void moe_tables(Frame& F, int layer) {
    LAS int* tab = (LAS int*)(F.lds + MOE_TAB_OFF);
    __syncthreads();
    if (F.wave == 0) { const int lane = lane_id_opaque();
        const int cnt = lane < 32 ? (int)__hip_atomic_load(F.ctl + CW_ECNT + 64 * layer + lane, RLX_AGENT) : 0; const int nt = (cnt + 255) >> 8;
        int incl = nt;
#pragma unroll
        for (int off = 1; off < 32; off <<= 1) { const int v = __shfl_up(incl, off); if (lane >= off) incl += v; }
        const int start = incl - nt;
        if (lane < 32) { tab[128 + lane] = 256 * start; for (int i = 0; i < nt && start + i < 96; ++i) tab[start + i] = lane; }
        if (lane == 31) tab[160] = incl < 96 ? incl : 96; }
    __syncthreads();
}

#ifndef PH_MASK
#define PH_MASK 0x7FFFFFu
#endif
#ifndef PH_DUP
#define PH_DUP 0u
#endif
#define REP(k) _Pragma("unroll 1") for (int rep_ = 0; rep_ < ((((PH_DUP) >> (k)) & 1u) ? 2 : 1); ++rep_)
#define IN(k) (((PH_MASK >> (k)) & 1u) && lo <= (k) && (k) < hi)
#define SEAM(k) do { if (IN(k) && IN((k) + 1)) xcd_barrier(bar, F.wave); } while (0)
template <int LAYER, int PB> __device__ __forceinline__ void moe_phases(Frame& F, const Args& args, const XcdBarrier& bar, int lo, int hi) {
    unsigned char* ws = F.ws; LAS unsigned char* ring = F.lds + RING_OFF; const int c = (int)blockIdx.x;
    if (IN(PB)) { router_phase(F, args, (const float*)(ws + WS_XA), args.in[8] + LAYER * 2048, 2 * LAYER + 1, LAYER, true);
#if defined(ROUTER_TWICE)
        router_phase(F, args, (const float*)(ws + WS_XA), args.in[8] + LAYER * 2048, 2 * LAYER + 1, LAYER, false);
#endif
    } SEAM(PB);
    if (IN(PB + 1)) { moe_tables(F, LAYER); scatter_phase(F, (const float*)(ws + WS_XA), args.in[8] + LAYER * 2048, 2 * LAYER + 1, LAYER, true);
#if defined(SCATTER_TWICE)
        scatter_phase(F, (const float*)(ws + WS_XA), args.in[8] + LAYER * 2048, 2 * LAYER + 1, LAYER, false);
#endif
    } SEAM(PB + 1);
    if (IN(PB + 2)) {
        moe_tables(F, LAYER); const LAS int* tab = (const LAS int*)(F.lds + MOE_TAB_OFF); const int TM = tab[160], TA = (TM + 1) >> 1;
        pg8::Gemm g{2048, 2048, 2048}; pg8::MoeOrder S; S.ntn = 4; S.t0 = 0; S.nunits = TA * 4; S.gdeal = F.G; S.busy = 0; S.G = F.G; S.c = c; S.A = (const char*)(ws + WS_HG); S.W = (const char*)(ws + WS_W_GU + (size_t)LAYER * 128 * MiB);
        S.tstepA = (size_t)256 * 2048 * 2; S.tstepB = (size_t)256 * 2048 * 2; S.estep = (size_t)1024 * 2048 * 2; S.tile_expert = tab;
        EpiM3 E{(bf16*)(ws + WS_ACT)};
        pg8::gemm_phase<EpiM3, pg8::MoeOrder, true, true>(ring, g, S, E, F.wave);
#if defined(M3_TWICE)
        pg8::gemm_phase<EpiM3, pg8::MoeOrder, true, true>(ring, g, S, E, F.wave);
#endif
    } SEAM(PB + 2);
    if (IN(PB + 3)) {
        moe_tables(F, LAYER); const LAS int* tab = (const LAS int*)(F.lds + MOE_TAB_OFF); const int TM = tab[160], TA = (TM + 1) >> 1, nb3 = (TM - TA) * 4;
        { pg8::Gemm g{2048, 2048, 2048}; pg8::MoeOrder S; S.ntn = 4; S.t0 = TA; S.nunits = nb3; S.gdeal = nb3 < F.G ? nb3 : F.G; S.busy = 0; S.G = F.G; S.c = c; S.A = (const char*)(ws + WS_HG); S.W = (const char*)(ws + WS_W_GU + (size_t)LAYER * 128 * MiB);
          S.tstepA = (size_t)256 * 2048 * 2; S.tstepB = (size_t)256 * 2048 * 2; S.estep = (size_t)1024 * 2048 * 2; S.tile_expert = tab;
          EpiM3 E{(bf16*)(ws + WS_ACT)};
          pg8::gemm_phase<EpiM3, pg8::MoeOrder, true, true>(ring, g, S, E, F.wave); }
        { pg8::Gemm g{512, 512, 512}; pg8::MoeOrder S; S.ntn = 8; S.t0 = 0; S.nunits = TA * 8; S.gdeal = F.G; S.busy = (nb3 > 0 && nb3 < F.G) ? nb3 : 0; S.G = F.G; S.c = c; S.A = (const char*)(ws + WS_ACT); S.W = (const char*)(ws + WS_W_DN + (size_t)LAYER * 64 * MiB);
          S.tstepA = (size_t)256 * 512 * 2; S.tstepB = (size_t)256 * 512 * 2; S.estep = (size_t)2048 * 512 * 2; S.tile_expert = tab;
          EpiM4 E{(bf16*)(ws + WS_Y)};
          pg8::gemm_phase<EpiM4, pg8::MoeOrder, true, true>(ring, g, S, E, F.wave); }
    } SEAM(PB + 3);
    if (IN(PB + 4)) {
        moe_tables(F, LAYER); const LAS int* tab = (const LAS int*)(F.lds + MOE_TAB_OFF); const int TM = tab[160], TA = (TM + 1) >> 1;
        pg8::Gemm g{512, 512, 512}; pg8::MoeOrder S; S.ntn = 8; S.t0 = TA; S.nunits = (TM - TA) * 8; S.gdeal = F.G; S.busy = 0; S.G = F.G; S.c = c; S.A = (const char*)(ws + WS_ACT); S.W = (const char*)(ws + WS_W_DN + (size_t)LAYER * 64 * MiB);
        S.tstepA = (size_t)256 * 512 * 2; S.tstepB = (size_t)256 * 512 * 2; S.estep = (size_t)2048 * 512 * 2; S.tile_expert = tab;
        EpiM4 E{(bf16*)(ws + WS_Y)};
        pg8::gemm_phase<EpiM4, pg8::MoeOrder, true, true>(ring, g, S, E, F.wave);
#if defined(M4_TWICE)
        pg8::gemm_phase<EpiM4, pg8::MoeOrder, true, true>(ring, g, S, E, F.wave);
#endif
    } SEAM(PB + 4);
}
__global__ void __launch_bounds__(NWAVES * 64, 2) mk_fwd(Args args) {
    extern __shared__ __attribute__((aligned(16))) unsigned char lds[];
    Frame F;
    F.lds = (LAS unsigned char*)lds;
    F.MISC = (volatile LAS unsigned*)(F.lds + MISC_OFF);
    F.wave = __builtin_amdgcn_readfirstlane((int)threadIdx.x >> 6);
    F.G = gridDim.x; { const int bx = blockIdx.x; F.vcu = (F.G % 8 == 0) ? (bx % 8) * (F.G / 8) + bx / 8 : bx; }
    F.ws = args.ws; F.ctl = (gu32*)(args.ws + WS_CTL); F.out = args.out;
    for (int u = threadIdx.x; u < (LDS_BYTES - LDSCTL_OFF) / 4; u += NWAVES * 64) ((LAS unsigned*)(F.lds + LDSCTL_OFF))[u] = 0u;
    __syncthreads();
    XcdBarrier bar; bar.bar = (unsigned*)(F.ctl + CW_BAR); bar.x = 0; bar.st = nullptr;
    if (!MK_MULTI) bar = xcd_barrier_post((unsigned*)(F.ctl + CW_BAR), F.MISC + 8, F.wave);
    const int lo = args.ph_lo, hi = args.ph_hi;
    unsigned char* ws = args.ws;
    const float* MOD = (const float*)(F.ctl + CW_MOD);
    LAS unsigned char* ring = F.lds + RING_OFF;
    const int c = (int)blockIdx.x;

    if (IN(0)) REP(0) { p0a_mod_partials(F, args); } SEAM(0);
    if (IN(1)) REP(1) { p0_prologue(F, args); local_mod(F, args.in[4], 0); norm_phase<0, true>(F, args.in[0], nullptr, args.in[5], 0, 0, 0); } SEAM(1);
    if (IN(3)) REP(3) {
        pg8::Gemm g{2048, 2048, 2048}; pg8::StaticOrder S; S.init(T_, 4096, F.G, c, ws + WS_H, 2048, ws + WS_W_IN0T, 2048);
        EpiG1 E{(bf16*)(ws + WS_PROJ0), (bf16*)(ws + WS_KR), (float*)(ws + WS_SSQP), (const f32x2*)(ws + WS_TAB64)};
        pg8::gemm_phase<EpiG1, pg8::StaticOrder, true, true>(ring, g, S, E, F.wave);
    } SEAM(3);
    if (IN(4)) REP(4) {
        { pg8::Gemm g{512, 4096, 512}; pg8::StaticOrder S; S.init(T_, 1536, F.G, c, ws + WS_PROJ0 + 3072 * 2, 4096, ws + WS_W_QUPT, 512);
          EpiG2q E{(bf16*)(ws + WS_QMLA), (const float*)(ws + WS_SSQP), (const f32x2*)(ws + WS_TAB64)};
          pg8::gemm_phase<EpiG2q, pg8::StaticOrder, true, true>(ring, g, S, E, F.wave); }
        { pg8::Gemm g{256, 4096, 256}; pg8::StaticOrder S; S.init(T_, 2048, F.G, c, ws + WS_PROJ0 + 3584 * 2, 4096, ws + WS_W_KVUPT, 256);
          EpiG2kv E{(bf16*)(ws + WS_KVMLA), (const float*)(ws + WS_SSQP) + (size_t)T_ * 8};
          pg8::gemm_phase<EpiG2kv, pg8::StaticOrder, true, true>(ring, g, S, E, F.wave); }
    } SEAM(4);
    if (IN(5)) REP(5) { bool conv_left = true; WorkQ QC; wq_init(F, QC, F.ctl + CW_QC1, CONV_N1 / 32, 18, lane_id_opaque()); mla_phase(F, args, QC, conv_left); sb_phase(F, args, QC, conv_left); } SEAM(5);
    if (IN(6)) REP(6) {
        pg8::Gemm g{2048, 2048, 2048}; pg8::StaticOrder S; S.init(T_, 2048, F.G, c, ws + WS_ATTO, 2048, ws + WS_W_OUT0T, 2048);
        EpiRes E{args.in[0], (float*)(ws + WS_XA), MOD + (size_t)(0 * 4) * 6144 + 4096};
        pg8::gemm_phase<EpiRes, pg8::StaticOrder, true, true>(ring, g, S, E, F.wave);
    } SEAM(6);
    moe_phases<0, 7>(F, args, bar, lo, hi);
    if (IN(12)) REP(12) { norm_phase<2>(F, (const float*)(ws + WS_XA), (float*)(ws + WS_XB), args.in[5] + 2048, 2, 1, 0); } SEAM(12);
    if (IN(13)) REP(13) {
        pg8::Gemm g{2048, 2048, 2048}; pg8::StaticOrder S; S.init(T_, 12288, F.G, c, ws + WS_H, 2048, ws + WS_W_IN1T, 2048);
        EpiG4 E{(bf16*)(ws + WS_PROJ1), (const f32x2*)(ws + WS_TAB256)};
        pg8::gemm_phase<EpiG4, pg8::StaticOrder, true, true>(ring, g, S, E, F.wave);
    } SEAM(13);
    if (IN(14)) REP(14) { ret_phase(F, args); } SEAM(14);
    if (IN(15)) REP(15) { retnorm_phase(F); } SEAM(15);
    if (IN(16)) REP(16) {
        pg8::Gemm g{4096, 4096, 4096}; pg8::StaticOrder S; S.init(T_, 2048, F.G, c, ws + WS_A5, 4096, ws + WS_W_OUT1T, 4096);
        EpiRes E{(const float*)(ws + WS_XB), (float*)(ws + WS_XA), MOD + (size_t)(2 * 4) * 6144 + 4096};
        pg8::gemm_phase<EpiRes, pg8::StaticOrder, true, true>(ring, g, S, E, F.wave);
    } SEAM(16);
    moe_phases<1, 17>(F, args, bar, lo, hi);
    if (IN(22)) REP(22) { norm_phase<3>(F, (const float*)(ws + WS_XA), nullptr, args.in[24], 0, 3, 1); }
}
#undef IN
#undef SEAM

extern "C" void kernel_launch(void* const* d_in, const int* in_sizes, int n_in, void* d_out, int out_size, void* d_ws, size_t ws_size, hipStream_t stream) {
    static int grid = 0;
    if (grid == 0) {
        if (n_in != 25 || in_sizes[0] != T_ * D_ || out_size != T_ * D_ || ws_size < WS_END) { fprintf(stderr, "kernel_launch: unexpected shapes (n_in %d, in0 %d, out %d, ws %zu < %zu); nothing launched\n", n_in, n_in > 0 ? in_sizes[0] : -1, out_size, ws_size, (size_t)WS_END); grid = -1; return; }
        int dev = 0, cus = 0, per_cu = 0;
        if (hipGetDevice(&dev) != hipSuccess || hipDeviceGetAttribute(&cus, hipDeviceAttributeMultiprocessorCount, dev) != hipSuccess) { fprintf(stderr, "kernel_launch: device query failed\n"); grid = -1; return; }
        if (hipFuncSetAttribute((const void*)mk_fwd, hipFuncAttributeMaxDynamicSharedMemorySize, LDS_BYTES) != hipSuccess) { fprintf(stderr, "kernel_launch: hipFuncSetAttribute failed\n"); grid = -1; return; }
        if (hipOccupancyMaxActiveBlocksPerMultiprocessor(&per_cu, (const void*)mk_fwd, NWAVES * 64, LDS_BYTES) != hipSuccess || per_cu < 1) fprintf(stderr, "kernel_launch: note: occupancy query reports %d workgroups per CU\n", per_cu);
        (void)hipGetLastError();
        grid = cus;
    }
    if (grid < 0) return;
    if (hipMemsetAsync((char*)d_ws + WS_CTL, 0, CTL_ZERO_BYTES, stream) != hipSuccess) { fprintf(stderr, "kernel_launch: memset failed\n"); return; }
    Args a{};
    for (int i = 0; i < 25; ++i) a.in[i] = (const float*)d_in[i];
    a.out = (float*)d_out; a.ws = (unsigned char*)d_ws;
#if MK_MULTI
    for (int p = 0; p < 23; ++p) { a.ph_lo = p; a.ph_hi = p + 1; hipLaunchKernelGGL(mk_fwd, dim3(grid), dim3(NWAVES * 64), LDS_BYTES, stream, a); }
#else
    a.ph_lo = 0; a.ph_hi = 23;
    hipLaunchKernelGGL(mk_fwd, dim3(grid), dim3(NWAVES * 64), LDS_BYTES, stream, a);
#endif
    const hipError_t le = hipPeekAtLastError();
    if (le != hipSuccess) fprintf(stderr, "kernel_launch: launch failed: %s\n", hipGetErrorName(le));
}
```

```cpp
#include <hip/hip_runtime.h>
#include <cstdio>
#include <cstdint>

#ifndef MK_MULTI
#define MK_MULTI 0
#endif

namespace pg8 {
#define PG8_LAS __attribute__((address_space(3)))
typedef unsigned short bf16_t;
typedef short bf16x8 __attribute__((ext_vector_type(8)));
typedef float f32x4 __attribute__((ext_vector_type(4)));
typedef unsigned u32x4 __attribute__((ext_vector_type(4)));
constexpr int BM = 256, BK = 64, HALF = 128, HTB = HALF * BK * 2  , STAGE_BYTES = 8 * HTB, NXCD = 8, WGM = 8;

__host__ __device__ __forceinline__ int lds_byte(int r, int c) { const int st = (r >> 4) * 2 + (c >> 5), rr = r & 15, cc = c & 31, ob = rr * 64 + cc * 2; return st * 1024 + (ob ^ (((ob >> 9) & 1) << 5)); }
__host__ __device__ __forceinline__ void stage_rc(int b, int& R, int& C) { const int st = b / 1024, sb = b % 1024, swz = sb ^ (((sb >> 9) & 1) << 5); R = (st >> 1) * 16 + swz / 64; C = (st & 1) * 32 + (swz % 64) / 2; }
__host__ __device__ __forceinline__ int perm32(int rho) { const int n = rho >> 4, i = rho & 15; return 8 * (i >> 2) + 4 * n + (i & 3); }

struct Unit { int pm, pn; const char* a; const char* b; };
struct Gemm { int K, lda, ldb; };

struct StaticOrder {
    int nM, nN, nwg, G, c; const char* A; const char* Bt; size_t tstepA, tstepB;
    __device__ void init(int M, int N, int G_, int c_, const void* A_, int lda, const void* Bt_, int ldb) { nM = M / BM; nN = N / BM; nwg = nM * nN; G = G_; c = c_; A = (const char*)A_; Bt = (const char*)Bt_; tstepA = (size_t)BM * lda * 2; tstepB = (size_t)BM * ldb * 2; }
    __device__ bool next(int i, Unit& u) const {
        const long L = (long)i * G + c; if (L >= nwg) return false;
        int wgid = (int)L; { const int q = nwg / NXCD, r = nwg % NXCD, xcd = wgid % NXCD, off = wgid / NXCD; wgid = (xcd < r ? xcd * (q + 1) : r * (q + 1) + (xcd - r) * q) + off; }
        const int nig = WGM * nN, gid = wgid / nig, fm = gid * WGM, gsz = (nM - fm) < WGM ? (nM - fm) : WGM;
        u.pm = fm + ((wgid % nig) % gsz); u.pn = (wgid % nig) / gsz; u.a = A + (size_t)u.pm * tstepA; u.b = Bt + (size_t)u.pn * tstepB; return true;
    }
    __device__ __forceinline__ void a_ready(const Unit&) const {}
    __device__ __forceinline__ void done(const Unit&) const {}
};
struct MoeOrder {
    int ntn, t0, nunits, gdeal, busy, G, c; const char* A; const char* W; size_t tstepA, tstepB, estep; const PG8_LAS int* tile_expert;
    __device__ bool next(int i, Unit& u) const {
        int L;
        if (busy == 0) { if (c >= gdeal) return false; L = i * gdeal + c; }
        else { const int nfree = G - busy;
            if (c >= busy) { const int cap = 3 * nfree < nunits ? 3 * nfree : nunits; if (i >= 3) return false; L = i * nfree + (c - busy); if (L >= cap) return false; }
            else { L = 3 * nfree + i * busy + c; } }
        if (L >= nunits) return false;
        const int mt = t0 + L / ntn, pn = L % ntn, e = tile_expert[mt];
        u.pm = mt; u.pn = pn; u.a = A + (size_t)mt * tstepA; u.b = W + (size_t)e * estep + (size_t)pn * tstepB; return true;
    }
    __device__ __forceinline__ void a_ready(const Unit&) const {}
    __device__ __forceinline__ void done(const Unit&) const {}
};

template <class Epi, class Sched, bool ALIGN_EPI = false, bool SP2 = false>
__device__ __forceinline__ void gemm_phase(PG8_LAS unsigned char* lds, const Gemm g, const Sched& S, const Epi& E, const int wave_id) {
    int lane; asm volatile("v_mbcnt_lo_u32_b32 %0, -1, 0\n\tv_mbcnt_hi_u32_b32 %0, -1, %0" : "=v"(lane));
    const int wid = wave_id, tid = wid * 64 + lane, wr = wid >> 2, wc = wid & 3, fr = lane & 15, fq = lane >> 4;
    const int K = g.K, nt = K / BK;
    unsigned voffA[2], voffB[2];
#pragma unroll
    for (int i = 0; i < 2; ++i) { int R, C; stage_rc(tid * 16 + i * 8192, R, C); const int Rb = Epi::PERM ? ((R & ~31) + perm32(R & 31)) : R;
        voffA[i] = (unsigned)(R * g.lda + C) * 2u; voffB[i] = (unsigned)(Rb * g.ldb + C) * 2u; }
    const size_t kstep = (size_t)(BK * 2);
    const size_t hstepA = (size_t)HALF * g.lda * 2, hstepB = (size_t)HALF * g.ldb * 2;
    const unsigned ldsw = (unsigned)wid * 1024u;
    const int aoff = lds_byte(wr * 64 + fr, fq * 8), boff = lds_byte(wc * 32 + fr, fq * 8);
#define PG8_SA(b, h) (((b) * 2 + (h)) * HTB)
#define PG8_SB(b, h) ((4 + (b) * 2 + (h)) * HTB)
#define PG8_STAGE(bufoff, gbase, voff) do { _Pragma("unroll") for (int _i = 0; _i < 2; ++_i) \
        __builtin_amdgcn_global_load_lds((const unsigned*)((const char*)(gbase) + (voff)[_i]), (PG8_LAS unsigned*)(lds + (bufoff) + ldsw + _i * 8192), 16, 0, 0); } while (0)
#define PG8_LDA(dst, b, h) do { _Pragma("unroll") for (int m = 0; m < 4; ++m) _Pragma("unroll") for (int k = 0; k < 2; ++k) dst[m][k] = *(const PG8_LAS bf16x8*)(lds + PG8_SA(b, h) + aoff + m * 2048 + k * 1024); } while (0)
#define PG8_LDB(dst, b, h) do { _Pragma("unroll") for (int n = 0; n < 2; ++n) _Pragma("unroll") for (int k = 0; k < 2; ++k) dst[n][k] = *(const PG8_LAS bf16x8*)(lds + PG8_SB(b, h) + boff + n * 2048 + k * 1024); } while (0)
#define PG8_MMA(ai, bj, At, Bt) do { __builtin_amdgcn_s_setprio(1); _Pragma("unroll") for (int m = 0; m < 4; ++m) _Pragma("unroll") for (int n = 0; n < 2; ++n) _Pragma("unroll") for (int k = 0; k < 2; ++k) \
        acc[ai][bj][m][n] = __builtin_amdgcn_mfma_f32_16x16x32_bf16(Bt[n][k], At[m][k], acc[ai][bj][m][n], 0, 0, 0); __builtin_amdgcn_s_setprio(0); } while (0)
#define PG8_WAIT_V(n) asm volatile("s_waitcnt vmcnt(" #n ")" ::: "memory")
#define PG8_WAIT_L(n) asm volatile("s_waitcnt lgkmcnt(" #n ")" ::: "memory")
#define PG8_BAR __builtin_amdgcn_s_barrier()
#define PG8_SCHED __builtin_amdgcn_sched_barrier(0)
    Unit cur, nxt; int ui = 0;
    if (!S.next(0, cur)) return;
    f32x4 acc[2][2][4][2];
#pragma unroll
    for (int a = 0; a < 2; ++a)
#pragma unroll
        for (int b = 0; b < 2; ++b)
#pragma unroll
            for (int m = 0; m < 4; ++m)
#pragma unroll
                for (int n = 0; n < 2; ++n) acc[a][b][m][n] = (f32x4){0.f, 0.f, 0.f, 0.f};
    bf16x8 At[4][2], B0[2][2], B1[2][2];
    const char* cA = cur.a; const char* cB = cur.b;
    S.a_ready(cur);
    if constexpr (SP2) {
        PG8_STAGE(PG8_SB(0, 0), cB, voffB); PG8_STAGE(PG8_SB(0, 1), cB + hstepB, voffB); PG8_STAGE(PG8_SA(0, 0), cA, voffA); PG8_STAGE(PG8_SA(0, 1), cA + hstepA, voffA);
        if (wr == 1) PG8_BAR;
        PG8_WAIT_V(2); PG8_BAR;
        PG8_STAGE(PG8_SB(1, 0), cB + kstep, voffB); PG8_STAGE(PG8_SA(1, 0), cA + kstep, voffA); PG8_STAGE(PG8_SB(1, 1), cB + hstepB + kstep, voffB);
        PG8_WAIT_V(6); PG8_BAR;
    } else {
        PG8_STAGE(PG8_SB(0, 0), cB, voffB); PG8_STAGE(PG8_SA(0, 0), cA, voffA); PG8_STAGE(PG8_SB(0, 1), cB + hstepB, voffB); PG8_STAGE(PG8_SA(0, 1), cA + hstepA, voffA);
        if (wr == 1) PG8_BAR;
        PG8_WAIT_V(4); PG8_BAR;
        PG8_STAGE(PG8_SB(1, 0), cB + kstep, voffB); PG8_STAGE(PG8_SA(1, 0), cA + kstep, voffA); PG8_STAGE(PG8_SB(1, 1), cB + hstepB + kstep, voffB);
        PG8_WAIT_V(6); PG8_BAR;
    }
    for (;;) {
        const bool has_next = S.next(ui + 1, nxt);
        const char* nA = has_next ? nxt.a : cA; const char* nB = has_next ? nxt.b : cB;
        for (int t = 0; t < nt; t += 2) {
            const bool last = (t == nt - 2);
            const char* a1 = cA + (size_t)(t + 1) * kstep;
            const char* a2 = last ? nA : cA + (size_t)(t + 2) * kstep; const char* b2 = last ? nB : cB + (size_t)(t + 2) * kstep;
            const char* a3 = a2 + kstep; const char* b3 = b2 + kstep;
            if (last && has_next) S.a_ready(nxt);
            if constexpr (SP2) {
            PG8_LDB(B0, 0, 0); PG8_LDB(B1, 0, 1); PG8_SCHED; PG8_LDA(At, 0, 0); PG8_STAGE(PG8_SA(1, 1), a1 + hstepA, voffA);
            PG8_WAIT_V(8); PG8_WAIT_L(0); PG8_BAR; PG8_MMA(0, 0, At, B0); PG8_MMA(0, 1, At, B1); PG8_BAR; PG8_SCHED;
            PG8_LDA(At, 0, 1); PG8_STAGE(PG8_SB(0, 0), b2, voffB); PG8_STAGE(PG8_SB(0, 1), b2 + hstepB, voffB); PG8_STAGE(PG8_SA(0, 0), a2, voffA);
            PG8_WAIT_V(8); PG8_WAIT_L(0); PG8_BAR; PG8_MMA(1, 0, At, B0); PG8_MMA(1, 1, At, B1); PG8_BAR; PG8_SCHED;
            PG8_LDB(B0, 1, 0); PG8_LDB(B1, 1, 1); PG8_SCHED; PG8_LDA(At, 1, 0); PG8_STAGE(PG8_SA(0, 1), a2 + hstepA, voffA);
            PG8_WAIT_V(8); PG8_WAIT_L(0); PG8_BAR; PG8_MMA(0, 0, At, B0); PG8_MMA(0, 1, At, B1); PG8_BAR; PG8_SCHED;
            PG8_LDA(At, 1, 1); PG8_STAGE(PG8_SB(1, 0), b3, voffB); PG8_STAGE(PG8_SB(1, 1), b3 + hstepB, voffB); PG8_STAGE(PG8_SA(1, 0), a3, voffA);
            PG8_WAIT_V(8); PG8_WAIT_L(0); PG8_BAR; PG8_MMA(1, 0, At, B0); PG8_MMA(1, 1, At, B1); PG8_BAR; PG8_SCHED;
            } else {
            PG8_LDB(B0, 0, 0); PG8_SCHED; PG8_LDA(At, 0, 0); PG8_STAGE(PG8_SA(1, 1), a1 + hstepA, voffA);
            PG8_WAIT_L(8); PG8_BAR; PG8_WAIT_L(0); PG8_MMA(0, 0, At, B0); PG8_BAR; PG8_SCHED;
            PG8_LDB(B1, 0, 1); PG8_STAGE(PG8_SB(0, 0), b2, voffB);
            PG8_BAR; PG8_WAIT_L(0); PG8_MMA(0, 1, At, B1); PG8_BAR;
            PG8_LDA(At, 0, 1); PG8_STAGE(PG8_SA(0, 0), a2, voffA);
            PG8_BAR; PG8_WAIT_L(0); PG8_MMA(1, 0, At, B0); PG8_BAR; PG8_SCHED;
            PG8_STAGE(PG8_SB(0, 1), b2 + hstepB, voffB);
            PG8_WAIT_V(6); PG8_BAR; PG8_MMA(1, 1, At, B1); PG8_BAR;
            PG8_LDB(B0, 1, 0); PG8_SCHED; PG8_LDA(At, 1, 0); PG8_STAGE(PG8_SA(0, 1), a2 + hstepA, voffA);
            PG8_WAIT_L(8); PG8_BAR; PG8_WAIT_L(0); PG8_MMA(0, 0, At, B0); PG8_BAR; PG8_SCHED;
            PG8_LDB(B1, 1, 1); PG8_STAGE(PG8_SB(1, 0), b3, voffB);
            PG8_BAR; PG8_WAIT_L(0); PG8_MMA(0, 1, At, B1); PG8_BAR;
            PG8_LDA(At, 1, 1); PG8_STAGE(PG8_SA(1, 0), a3, voffA);
            PG8_BAR; PG8_WAIT_L(0); PG8_MMA(1, 0, At, B0); PG8_BAR; PG8_SCHED;
            PG8_STAGE(PG8_SB(1, 1), b3 + hstepB, voffB);
            PG8_WAIT_V(6); PG8_BAR; PG8_MMA(1, 1, At, B1); PG8_BAR;
            }
        }
        if constexpr (ALIGN_EPI) { if (wr == 0) PG8_BAR; }
        if constexpr (!Epi::AFTER_DRAIN) { E(acc, cur, wr, wc, fr, fq); S.done(cur); }
        if (!has_next) break;
#pragma unroll
        for (int a = 0; a < 2; ++a)
#pragma unroll
            for (int b = 0; b < 2; ++b)
#pragma unroll
                for (int m = 0; m < 4; ++m)
#pragma unroll
                    for (int n = 0; n < 2; ++n) acc[a][b][m][n] = (f32x4){0.f, 0.f, 0.f, 0.f};
        cur = nxt; cA = nA; cB = nB; ++ui;
        if constexpr (ALIGN_EPI) { if (wr == 1) PG8_BAR; }
    }
    PG8_WAIT_V(0);
    if constexpr (!ALIGN_EPI) { if (wr == 0) PG8_BAR; }
    PG8_BAR;
    if constexpr (Epi::AFTER_DRAIN) { E.fused(acc, cur, wr, wc, fr, fq, lds, wid, lane); S.done(cur); }
#undef PG8_SA
#undef PG8_SB
#undef PG8_STAGE
#undef PG8_LDA
#undef PG8_LDB
#undef PG8_MMA
#undef PG8_WAIT_V
#undef PG8_WAIT_L
#undef PG8_BAR
#undef PG8_SCHED
}
}

constexpr int NWAVES = 8;
constexpr int T_ = 8192, D_ = 2048, NB_ = 4, S_ = 2048;
constexpr float EPS_ = 1e-6f;
constexpr float LOG2E = 1.4426950408889634f;
constexpr float C_SB = 0.08838834764831845f * LOG2E;
constexpr float C_MLA = 0.07216878364870323f * LOG2E;
constexpr int NPH = 22;

constexpr size_t MiB = 1u << 20;
constexpr size_t WS_CTL = 0, CTL_ZERO_BYTES = 1 * MiB;
constexpr size_t WS_TAB64 = 2 * MiB, WS_TAB256 = 4 * MiB, WS_WR = 12 * MiB, WS_ROUTE = 13 * MiB;
constexpr size_t WS_W_IN0T = 16 * MiB, WS_W_QUPT = 32 * MiB, WS_W_KVUPT = 34 * MiB, WS_W_OUT0T = 36 * MiB, WS_W_IN1T = 44 * MiB, WS_W_OUT1T = 92 * MiB;
constexpr size_t WS_W_GU = 108 * MiB, WS_W_DN = 364 * MiB;
constexpr size_t WS_XA = 492 * MiB, WS_XB = 556 * MiB, WS_H = 620 * MiB;
constexpr size_t WS_PROJ0 = 652 * MiB, WS_QMLA = 716 * MiB, WS_KVMLA = 740 * MiB, WS_KR = 772 * MiB, WS_ATTO = 774 * MiB;
constexpr size_t WS_PROJ1 = 652 * MiB;
constexpr size_t WS_HG = 844 * MiB, WS_ACT = 940 * MiB, WS_Y = 964 * MiB;
constexpr size_t WS_RETO = 844 * MiB, WS_A5 = 908 * MiB;
constexpr size_t WS_MODP = 1060 * MiB;
constexpr size_t WS_RS = 13 * MiB + 256 * 1024;
constexpr size_t WS_SSQP = 13 * MiB + 512 * 1024;
constexpr size_t WS_END = 1064 * MiB;
constexpr int CW_TMO = 0, CW_CODE = 1;
constexpr int CW_BAR = 4096;
constexpr int CW_QMLA = 8192, CW_QSB = 8256, CW_QRET = 8320, CW_QC1 = 8384, CW_QC2 = 8416;
constexpr int CW_ECNT = 8448, CW_ECUR = 8576;
constexpr int CW_MOD = 16384;
constexpr int CW_SSQQ = 114688, CW_SSQKV = 122880;
static_assert((CW_SSQKV + 8192) * 4 <= (int)CTL_ZERO_BYTES, "CTL words inside the memset region");
constexpr int RING_OFF = 0, RING_BYTES = 147456;
constexpr int LDSCTL_OFF = RING_BYTES, MISC_OFF = LDSCTL_OFF + 320;
constexpr int MOE_TAB_OFF = LDSCTL_OFF + 1024;
constexpr int LDS_BYTES = 155648;
static_assert(MOE_TAB_OFF + 1024 <= LDS_BYTES, "LDS map");

#define GAS __attribute__((address_space(1)))
#define LAS __attribute__((address_space(3)))
typedef unsigned short bf16;
typedef unsigned v4u __attribute__((ext_vector_type(4)));
typedef unsigned v2u __attribute__((ext_vector_type(2)));
typedef float f32x4 __attribute__((ext_vector_type(4)));
typedef float f32x2 __attribute__((ext_vector_type(2)));
typedef float f32x16 __attribute__((ext_vector_type(16)));
typedef short bf16x8 __attribute__((ext_vector_type(8)));
typedef short s16x4 __attribute__((ext_vector_type(4)));
typedef short v4i16_t __attribute__((ext_vector_type(4)));
typedef GAS unsigned gu32;
#define RLX_AGENT __ATOMIC_RELAXED, __HIP_MEMORY_SCOPE_AGENT
#define LDS_WAIT() asm volatile("s_waitcnt lgkmcnt(0)" ::: "memory")
#define VM_WAIT() asm volatile("s_waitcnt vmcnt(0)" ::: "memory")
typedef __bf16 bf16x2_t __attribute__((ext_vector_type(2)));
__device__ __forceinline__ unsigned pk2(float lo, float hi) { f32x2 v = {lo, hi}; bf16x2_t b = __builtin_convertvector(v, bf16x2_t); return __builtin_bit_cast(unsigned, b); }
__device__ __forceinline__ float bf_lo(unsigned w) { return __uint_as_float(w << 16); }
__device__ __forceinline__ float bf_hi(unsigned w) { return __uint_as_float(w & 0xffff0000u); }
__device__ __forceinline__ float ex2(float x) { return __builtin_amdgcn_exp2f(x); }
__device__ __forceinline__ float lg2(float x) { return __builtin_amdgcn_logf(x); }
__device__ __forceinline__ float silu_f(float v) { return v / (1.0f + __expf(-v)); }
__device__ __forceinline__ int lane_id_opaque() { int l; asm volatile("v_mbcnt_lo_u32_b32 %0, -1, 0\n\tv_mbcnt_hi_u32_b32 %0, -1, %0" : "=v"(l)); return l; }

#define XB_TMO      128
#define XB_XCNT(j)  (256  + 64 * (j))
#define XB_XSUB(j)  (1280 + 64 * (j))
#define XB_XGEN(j)  (2304 + 64 * (j))
#define XB_TOP      3328
#define XB_TOPGEN   3392
#define XCD_BAR_WORDS 3456
#define XB_SPIN_CAP (1u << 18)
__device__ __forceinline__ unsigned xb_ld(unsigned* p)              { return __hip_atomic_load(p, __ATOMIC_RELAXED, __HIP_MEMORY_SCOPE_AGENT); }
__device__ __forceinline__ unsigned xb_add(unsigned* p, unsigned v) { return __hip_atomic_fetch_add(p, v, __ATOMIC_RELAXED, __HIP_MEMORY_SCOPE_AGENT); }
__device__ __forceinline__ unsigned xb_xcc_id() { return (unsigned)__builtin_amdgcn_s_getreg((3 << 11) | 20) & 0xFu; }
#define XB_SPIN(cond, bar) do { unsigned _sp = 0; while (cond) { __builtin_amdgcn_s_sleep(1); \
    if ((++_sp & 255u) == 0u) { if (xb_ld(&(bar)[XB_TMO])) break; if (_sp > XB_SPIN_CAP) { atomicAdd(&(bar)[XB_TMO], 1u); break; } } } } while (0)
struct XcdBarrier { unsigned* bar; unsigned x; volatile LAS unsigned* st; };
__device__ __forceinline__ XcdBarrier xcd_barrier_post(unsigned* bar, volatile LAS unsigned* st, int wave) {
    XcdBarrier b; b.bar = bar; b.x = xb_xcc_id(); b.st = st;
    if (wave == 0 && lane_id_opaque() == 0) (void)xb_add(&bar[XB_XCNT(b.x)], 1u);
    return b;
}
__device__ __forceinline__ void xcd_barrier_complete(unsigned* bar, unsigned x, unsigned& nloc, unsigned& nx) {
    const unsigned G = gridDim.x * gridDim.y * gridDim.z;
    unsigned sum, cnt, mine, sp = 0u;
    for (;;) {
        sum = 0u; cnt = 0u; mine = 0u;
#pragma unroll
        for (unsigned j = 0; j < 16; ++j) { const unsigned c = xb_ld(&bar[XB_XCNT(j)]); sum += c; cnt += (c > 0u) ? 1u : 0u; mine = (j == x) ? c : mine; }
        if (sum == G) break;
        __builtin_amdgcn_s_sleep(1);
        if ((++sp & 255u) == 0u) { if (xb_ld(&bar[XB_TMO])) break; if (sp > XB_SPIN_CAP) { atomicAdd(&bar[XB_TMO], 1u); break; } }
    }
    nloc = mine > 0u ? mine : 1u; nx = cnt > 0u ? cnt : 1u;
}
__device__ __forceinline__ void xcd_barrier(const XcdBarrier& b, int wave) {
    asm volatile("s_waitcnt vmcnt(0)" ::: "memory");
    __syncthreads();
    if (wave == 0 && lane_id_opaque() == 0) {
        unsigned* bar = b.bar;
        __builtin_amdgcn_s_waitcnt(0);
        unsigned nloc = b.st[0], nx = b.st[1];
        if (nloc == 0u) { xcd_barrier_complete(bar, b.x, nloc, nx); b.st[0] = nloc; b.st[1] = nx; }
        const unsigned old = xb_add(&bar[XB_XSUB(b.x)], 1u);
        const unsigned gen = old / nloc;
        if (old + 1u == (gen + 1u) * nloc) {
            __builtin_amdgcn_fence(__ATOMIC_RELEASE, "agent");
            asm volatile("s_waitcnt vmcnt(0)" ::: "memory");
            const unsigned og = xb_add(&bar[XB_TOP], 1u);
            const unsigned tg = og / nx;
            if (og + 1u == (tg + 1u) * nx) xb_add(&bar[XB_TOPGEN], 1u);
            else XB_SPIN(xb_ld(&bar[XB_TOPGEN]) == tg, bar);
            __builtin_amdgcn_fence(__ATOMIC_ACQUIRE, "agent");
            xb_add(&bar[XB_XGEN(b.x)], 1u);
            asm volatile("s_waitcnt vmcnt(0)" ::: "memory");
        } else {
            XB_SPIN(xb_ld(&bar[XB_XGEN(b.x)]) == gen, bar);
            __builtin_amdgcn_fence(__ATOMIC_ACQUIRE, "agent");
            asm volatile("s_waitcnt vmcnt(0)" ::: "memory");
        }
    }
    __syncthreads();
}

struct Frame {
    LAS unsigned char* lds;
    volatile LAS unsigned* MISC;
    gu32* ctl;
    unsigned char* ws;
    int wave;
    int vcu, G;
    float* out;
};
struct Args { const float* in[25]; float* out; unsigned char* ws; int ph_lo, ph_hi; };
__device__ __forceinline__ float wave_sum(float v) {
#pragma unroll
    for (int o = 1; o < 64; o <<= 1) v += __shfl_xor(v, o);
    return v;
}
#define PHASE_IDS(F) const int lane = lane_id_opaque(), wave = (F).wave, tid = wave * 64 + lane; (void)lane; (void)wave; (void)tid
struct ConvSrc { const float* W; int ldn; bf16* WT; int ldk; const float* scale; };
__device__ __forceinline__ void conv_load(const ConvSrc& c, int lane, f32x4 (&v)[8]) {
    const float* src = c.W + (size_t)(8 * (lane >> 3)) * c.ldn + 4 * (lane & 7);
#pragma unroll
    for (int t = 0; t < 8; ++t) v[t] = __builtin_nontemporal_load((const f32x4*)(src + (size_t)t * c.ldn));
}
__device__ __forceinline__ void conv_store(const ConvSrc& c, int lane, f32x4 (&v)[8]) {
    if (c.scale) { const f32x4 s0 = *(const f32x4*)(c.scale + 8 * (lane >> 3)), s1 = *(const f32x4*)(c.scale + 8 * (lane >> 3) + 4);
        v[0] *= s0.x; v[1] *= s0.y; v[2] *= s0.z; v[3] *= s0.w; v[4] *= s1.x; v[5] *= s1.y; v[6] *= s1.z; v[7] *= s1.w; }
    bf16* dst = c.WT + (size_t)(4 * (lane & 7)) * c.ldk + 8 * (lane >> 3);
#pragma unroll
    for (int j = 0; j < 4; ++j) { v4u o; o.x = pk2(v[0][j], v[1][j]); o.y = pk2(v[2][j], v[3][j]); o.z = pk2(v[4][j], v[5][j]); o.w = pk2(v[6][j], v[7][j]); __builtin_nontemporal_store(o, (v4u*)(dst + (size_t)j * c.ldk)); }
}
constexpr int CONV_N0 = 122 * 32 + 48 * 8 + 64 * 4, CONV_N1 = 64 * 32 + 384 * 32 + 32 * 1024 + 32 * 512, CONV_N2 = 64 * 64 + 32 * 1024 + 32 * 512;
__device__ __forceinline__ ConvSrc conv_moe_gu(const Args& A, unsigned char* ws, int le, int r) {
    const int nb = r / 32, kb = r % 32, t = nb >> 3, hf = (nb >> 2) & 1, jb = nb & 3;
    return ConvSrc{(hf ? A.in[22] : A.in[21]) + (size_t)le * 2048 * 512 + (size_t)(64 * kb) * 512 + 128 * t + 32 * jb, 512, (bf16*)(ws + WS_W_GU) + (size_t)le * 1024 * 2048 + (size_t)(32 * nb) * 2048 + 64 * kb, 2048, nullptr};
}
__device__ __forceinline__ ConvSrc conv_moe_dn(const Args& A, unsigned char* ws, int le, int r) {
    const int nb = r / 8, kb = r % 8;
    return ConvSrc{A.in[23] + (size_t)le * 512 * 2048 + (size_t)(64 * kb) * 2048 + 32 * nb, 2048, (bf16*)(ws + WS_W_DN) + (size_t)le * 2048 * 512 + (size_t)(32 * nb) * 512 + 64 * kb, 512, nullptr};
}
template <int STREAM> __device__ __forceinline__ ConvSrc conv_item(const Args& A, unsigned char* ws, int it) {
    if (STREAM == 0) {
        if (it < 122 * 32) { const int t = it / 32, kb = it % 32; const int dnb = t < 120 ? t : (t == 120 ? 120 : 124), sc = t < 120 ? 32 * t : (t == 120 ? 3840 : 3872);
            return ConvSrc{A.in[9] + (size_t)(64 * kb) * 3904 + sc, 3904, (bf16*)(ws + WS_W_IN0T) + (size_t)(32 * dnb) * 2048 + 64 * kb, 2048, nullptr}; }
        it -= 122 * 32;
        if (it < 48 * 8) { const int nb = it / 8, kb = it % 8; int sc;
            if (nb < 32) sc = (nb >> 2) * 192 + 32 * (nb & 3);
            else { const int t = (nb - 32) >> 3, blk = (nb - 32) & 7, hf = blk >> 2, hh = blk & 3; sc = (4 * t + hh) * 192 + 128 + 32 * hf; }
            return ConvSrc{A.in[11] + (size_t)(64 * kb) * 1536 + sc, 1536, (bf16*)(ws + WS_W_QUPT) + (size_t)(32 * nb) * 512 + 64 * kb, 512, A.in[10] + 64 * kb}; }
        it -= 48 * 8;
        { const int nb = it / 4, kb = it % 4;
            return ConvSrc{A.in[13] + (size_t)(64 * kb) * 2048 + 32 * nb, 2048, (bf16*)(ws + WS_W_KVUPT) + (size_t)(32 * nb) * 256 + 64 * kb, 256, A.in[12] + 64 * kb}; }
    } else if (STREAM == 1) {
        if (it < 64 * 32) { const int nb = it / 32, kb = it % 32;
            return ConvSrc{A.in[14] + (size_t)(64 * kb) * 2048 + 32 * nb, 2048, (bf16*)(ws + WS_W_OUT0T) + (size_t)(32 * nb) * 2048 + 64 * kb, 2048, nullptr}; }
        it -= 64 * 32;
        if (it < 384 * 32) { const int nb = it / 32, kb = it % 32;
            return ConvSrc{A.in[15] + (size_t)(64 * kb) * 12288 + 32 * nb, 12288, (bf16*)(ws + WS_W_IN1T) + (size_t)(32 * nb) * 2048 + 64 * kb, 2048, nullptr}; }
        it -= 384 * 32;
        if (it < 32 * 1024) return conv_moe_gu(A, ws, it / 1024, it % 1024);
        it -= 32 * 1024;
        return conv_moe_dn(A, ws, it / 512, it % 512);
    } else {
        if (it < 64 * 64) { const int nb = it / 64, kb = it % 64;
            return ConvSrc{A.in[16] + (size_t)(64 * kb) * 2048 + 32 * nb, 2048, (bf16*)(ws + WS_W_OUT1T) + (size_t)(32 * nb) * 4096 + 64 * kb, 4096, nullptr}; }
        it -= 64 * 64;
        if (it < 32 * 1024) return conv_moe_gu(A, ws, 32 + it / 1024, it % 1024);
        it -= 32 * 1024;
        return conv_moe_dn(A, ws, 32 + it / 512, it % 512);
    }
}
template <int STREAM> __device__ __forceinline__ void conv_burst(Frame& F, const Args& A, int lane, int gw, int NGW, int& cur, int n) {
    constexpr int N = STREAM == 0 ? CONV_N0 : (STREAM == 1 ? CONV_N1 : CONV_N2);
#pragma unroll 1
    while (n > 0) {
        const int i0 = gw + NGW * cur; if (i0 >= N) break;
        const int i1 = i0 + NGW; const bool two = n > 1 && i1 < N;
        const ConvSrc c0 = conv_item<STREAM>(A, F.ws, i0); f32x4 v0[8], v1[8];
        conv_load(c0, lane, v0);
        if (two) { const ConvSrc c1 = conv_item<STREAM>(A, F.ws, i1); conv_load(c1, lane, v1); conv_store(c0, lane, v0); conv_store(c1, lane, v1); cur += 2; n -= 2; }
        else { conv_store(c0, lane, v0); cur += 1; n -= 1; }
    }
}

__device__ __forceinline__ void p0a_mod_partials(Frame& F, const Args& A) {
    PHASE_IDS(F);
    const int gw = F.vcu * NWAVES + wave, NGW = F.G * NWAVES;
    LAS float* cond = (LAS float*)(F.lds + RING_OFF);
    for (int i = tid; i < NB_ * D_; i += 512) cond[i] = silu_f(A.in[1][i]);
    __syncthreads();
    float* MODP = (float*)(F.ws + WS_MODP);
    for (int u = gw; u < 768; u += NGW) {
        const int j = u / 192, r = u % 192, nc = r / 8, kc = r % 8, layer = j >> 1;
        const float* W = ((j & 1) ? A.in[6] : A.in[3]) + (size_t)layer * 2048 * 6144 + (size_t)(kc * 256) * 6144 + nc * 256 + 4 * lane;
        f32x4 acc[4];
#pragma unroll
        for (int b = 0; b < 4; ++b) acc[b] = (f32x4){0.f, 0.f, 0.f, 0.f};
#pragma unroll 16
        for (int k = 0; k < 256; ++k) { const f32x4 w = *(const f32x4*)(W + (size_t)k * 6144);
#pragma unroll
            for (int b = 0; b < 4; ++b) acc[b] += cond[b * 2048 + kc * 256 + k] * w; }
#pragma unroll
        for (int b = 0; b < 4; ++b) *(f32x4*)(MODP + ((size_t)(kc * 16 + j * 4 + b)) * 6144 + nc * 256 + 4 * lane) = acc[b];
    }
}
__device__ __forceinline__ void p0_prologue(Frame& F, const Args& A) {
    PHASE_IDS(F);
    const int gw = F.vcu * NWAVES + wave, NGW = F.G * NWAVES;
    const int gt = F.vcu * 512 + tid, NGT = F.G * 512;
    { float* MOD = (float*)(F.ctl + CW_MOD); const float* MODP = (const float*)(F.ws + WS_MODP);
      for (int idx = gt; idx < 16 * 6144; idx += NGT) { const int j = idx / (4 * 6144), n = idx % 6144; float a = ((j & 1) ? A.in[7] : A.in[4])[(j >> 1) * 6144 + n];
#pragma unroll
          for (int kc = 0; kc < 8; ++kc) a += MODP[(size_t)kc * 16 * 6144 + idx];
          MOD[idx] = a; } }
    { int cur = 0; conv_burst<0>(F, A, lane, gw, NGW, cur, 1 << 20); }
    { const int* pos = (const int*)A.in[2]; f32x2* t64 = (f32x2*)(F.ws + WS_TAB64); f32x2* t256 = (f32x2*)(F.ws + WS_TAB256);
      for (int idx = gt; idx < T_ * 160; idx += NGT) { const int m = idx / 160, i = idx % 160; const double p = (double)pos[m];
          double fr; if (i < 32) fr = exp(-9.210340371976184 * (double)i / 32.0); else fr = exp(-9.210340371976184 * (double)(i - 32) / 128.0);
          double sn, cs; sincos(p * fr, &sn, &cs); const f32x2 v = {(float)cs, (float)sn};
          if (i < 32) t64[m * 32 + i] = v; else t256[m * 128 + (i - 32)] = v; } }
    { float* WR = (float*)(F.ws + WS_WR);
      for (int idx = gt; idx < 2 * 512 * 36 * 4; idx += NGT) { const int q = idx & 3, c = (idx >> 2) % 36, kq = ((idx >> 2) / 36) % 512, l = (idx >> 2) / (36 * 512); const int k = 4 * kq + q;
          WR[idx] = c < 4 ? A.in[17][(size_t)l * 2048 * 4 + k * 4 + c] : A.in[19][(size_t)l * 2048 * 32 + k * 32 + (c - 4)]; } }
}

__device__ __forceinline__ void local_mod(Frame& F, const float* bias, int j) {
    PHASE_IDS(F);
    const float* MODP = (const float*)(F.ws + WS_MODP); LAS f32x4* lm = (LAS f32x4*)(F.lds + RING_OFF);
    __syncthreads();
    for (int q = tid; q < 4096; q += 512) { const int b = q >> 10, n = 4 * (q & 1023); f32x4 a = *(const f32x4*)(bias + n);
#pragma unroll
        for (int kc = 0; kc < 8; ++kc) a += *(const f32x4*)(MODP + ((size_t)(kc * 16 + j * 4 + b)) * 6144 + n);
        lm[q] = a; }
    __syncthreads();
}
template <int MODE, bool LM = false> __device__ __forceinline__ void norm_phase(Frame& F, const float* src, float* xdst, const float* gvec, int jn, int jg, int layer_moe) {
    PHASE_IDS(F);
    const int gw = F.vcu * NWAVES + wave, NGW = F.G * NWAVES;
    const float* MOD = (const float*)(F.ctl + CW_MOD);
    bf16* H = (bf16*)(F.ws + WS_H);
    const bf16* Y = (const bf16*)(F.ws + WS_Y);
    const int* RT = (const int*)(F.ws + WS_ROUTE);
    v4u ra = {0u, 0u, 0u, 0u}, rb = {0u, 0u, 0u, 0u};
    if (MODE >= 2) { const int row_l = gw + NGW * lane; if (row_l < T_) { const v4u* rp = (const v4u*)(RT + (size_t)row_l * 8); ra = rp[0]; rb = rp[1]; } }
    for (int row = gw, ri = 0; row < T_; row += NGW, ++ri) {
        const int b = row >> 11;
        f32x4 v[8]; float ss = 0.f;
        const f32x4* xr = (const f32x4*)(src + (size_t)row * D_) + lane;
#pragma unroll
        for (int j = 0; j < 8; ++j) v[j] = xr[64 * j];
        if (MODE >= 2) {
            const int p0 = __shfl((int)rb.x, ri), p1 = __shfl((int)rb.y, ri); const float w0 = __int_as_float(__shfl((int)ra.z, ri)), w1 = __int_as_float(__shfl((int)ra.w, ri));
            const v2u* y0 = (const v2u*)(Y + (size_t)p0 * D_) + lane; const v2u* y1 = (const v2u*)(Y + (size_t)p1 * D_) + lane;
            const f32x4* gt = (const f32x4*)(MOD + (size_t)(jg * 4 + b) * 6144 + 4096) + lane;
#pragma unroll
            for (int j = 0; j < 8; ++j) { const v2u a = y0[64 * j], c = y1[64 * j]; const f32x4 g = gt[64 * j];
                f32x4 m; m.x = w0 * bf_lo(a.x) + w1 * bf_lo(c.x); m.y = w0 * bf_hi(a.x) + w1 * bf_hi(c.x); m.z = w0 * bf_lo(a.y) + w1 * bf_lo(c.y); m.w = w0 * bf_hi(a.y) + w1 * bf_hi(c.y);
                v[j] += g * m; }
            if (MODE == 2) { f32x4* xo = (f32x4*)(xdst + (size_t)row * D_) + lane;
#pragma unroll
                for (int j = 0; j < 8; ++j) xo[64 * j] = v[j]; }
        }
#pragma unroll
        for (int j = 0; j < 8; ++j) ss += (v[j].x * v[j].x + v[j].y * v[j].y) + (v[j].z * v[j].z + v[j].w * v[j].w);
        const float rstd = 1.0f / sqrtf(wave_sum(ss) * (1.0f / D_) + EPS_);
        const f32x4* gv = (const f32x4*)gvec + lane;
        if (MODE == 3) { f32x4* o = (f32x4*)(F.out + (size_t)row * D_) + lane;
#pragma unroll
            for (int j = 0; j < 8; ++j) o[64 * j] = v[j] * rstd * gv[64 * j];
        } else {
            v2u* o = (v2u*)(H + (size_t)row * D_) + lane;
            if (LM) { const LAS f32x4* sh = (const LAS f32x4*)(F.lds + RING_OFF) + b * 1024 + lane; const LAS f32x4* sc = sh + 512;
#pragma unroll
                for (int j = 0; j < 8; ++j) { const f32x4 h = v[j] * rstd * gv[64 * j] * (1.0f + sc[64 * j]) + sh[64 * j]; v2u w; w.x = pk2(h.x, h.y); w.y = pk2(h.z, h.w); o[64 * j] = w; }
            } else { const f32x4* sh = (const f32x4*)(MOD + (size_t)(jn * 4 + b) * 6144) + lane; const f32x4* sc = sh + 512;
#pragma unroll
                for (int j = 0; j < 8; ++j) { const f32x4 h = v[j] * rstd * gv[64 * j] * (1.0f + sc[64 * j]) + sh[64 * j]; v2u w; w.x = pk2(h.x, h.y); w.y = pk2(h.z, h.w); o[64 * j] = w; } }
        }
    }
}

__device__ __forceinline__ void router_phase(Frame& F, const Args& A, const float* X, const float* gvec, int jn, int layer, bool first) {
    const float* MOD = (const float*)(F.ctl + CW_MOD);
    const f32x4* WR4 = (const f32x4*)(F.ws + WS_WR) + (size_t)layer * 512 * 36;
    int* RT = (int*)(F.ws + WS_ROUTE); float* RS = (float*)(F.ws + WS_RS);
    LAS f32x4* hs = (LAS f32x4*)(F.lds + RING_OFF);
    LAS f32x4* wsm = (LAS f32x4*)(F.lds + RING_OFF + 40960);
    LAS f32x4* shs = (LAS f32x4*)(F.lds + RING_OFF + 81920);
    LAS float* rs = (LAS float*)(F.lds + RING_OFF + 83968);
    LAS float* lg = (LAS float*)(F.lds + RING_OFF + 84224);
    PHASE_IDS(F);
    const int r = tid >> 4, kp = tid & 15, kpart = lane & 15, cg = lane >> 4;
    int wpos[5];
#pragma unroll
    for (int i = 0; i < 5; ++i) { const int idx = tid + 512 * i; wpos[i] = idx + idx / 36; }
    for (int tile = F.vcu; tile < T_ / 32; tile += F.G) {
        const int row0 = tile * 32, b = row0 >> 11;
        const f32x4* sh = (const f32x4*)(MOD + (size_t)(jn * 4 + b) * 6144); const f32x4* sc = sh + 512; const f32x4* gv = (const f32x4*)gvec;
        const f32x4* xr = (const f32x4*)(X + (size_t)(row0 + r) * D_);
        float acc[4][9], accq[9], ss = 0.f;
#pragma unroll
        for (int c = 0; c < 9; ++c) { accq[c] = 0.f;
#pragma unroll
            for (int rr = 0; rr < 4; ++rr) acc[rr][c] = 0.f; }
        f32x4 xq[4], gq[4], sq[4], wq[5];
#define RT_LOAD(ch) do { _Pragma("unroll") for (int g = 0; g < 4; ++g) { const int q = (ch) * 64 + kp + 16 * g; xq[g] = xr[q]; gq[g] = gv[q] * (1.0f + sc[q]); if (r == 0) sq[g] = sh[q]; } \
            _Pragma("unroll") for (int i = 0; i < 5; ++i) { const int idx = tid + 512 * i; if (idx < 2304) wq[i] = WR4[(size_t)(ch) * 2304 + idx]; } } while (0)
        RT_LOAD(0);
#pragma unroll 1
        for (int ch = 0; ch < 8; ++ch) {
#pragma unroll
            for (int g = 0; g < 4; ++g) { const f32x4 x = xq[g]; ss += (x.x * x.x + x.y * x.y) + (x.z * x.z + x.w * x.w); hs[r * 65 + kp + 16 * g] = x * gq[g]; if (r == 0) shs[kp + 16 * g] = sq[g]; }
#pragma unroll
            for (int i = 0; i < 5; ++i) if (tid + 512 * i < 2304) wsm[wpos[i]] = wq[i];
            __syncthreads();
            if (ch + 1 < 8) RT_LOAD(ch + 1);
#pragma unroll 1
            for (int g = 0; g < 4; ++g) { const int kq = kpart + 16 * g; f32x4 h4[4];
#pragma unroll
                for (int rr = 0; rr < 4; ++rr) h4[rr] = hs[(wave * 4 + rr) * 65 + kq];
                const f32x4 q4 = shs[kq];
#pragma unroll
                for (int c = 0; c < 9; ++c) { const f32x4 w4 = wsm[kq * 37 + 9 * cg + c];
#pragma unroll
                    for (int rr = 0; rr < 4; ++rr) acc[rr][c] += (h4[rr].x * w4.x + h4[rr].y * w4.y) + (h4[rr].z * w4.z + h4[rr].w * w4.w);
                    if (wave == 0) accq[c] += (q4.x * w4.x + q4.y * w4.y) + (q4.z * w4.z + q4.w * w4.w); } }
            __syncthreads();
        }
#undef RT_LOAD
#pragma unroll
        for (int rr = 0; rr < 4; ++rr)
#pragma unroll
            for (int c = 0; c < 9; ++c) { float a = acc[rr][c]; a += __shfl_xor(a, 1); a += __shfl_xor(a, 2); a += __shfl_xor(a, 4); a += __shfl_xor(a, 8); if (kpart == 0) lg[(wave * 4 + rr) * 36 + 9 * cg + c] = a; }
        if (wave == 0) {
#pragma unroll
            for (int c = 0; c < 9; ++c) { float a = accq[c]; a += __shfl_xor(a, 1); a += __shfl_xor(a, 2); a += __shfl_xor(a, 4); a += __shfl_xor(a, 8); if (kpart == 0) lg[1152 + 9 * cg + c] = a; } }
        ss += __shfl_xor(ss, 1); ss += __shfl_xor(ss, 2); ss += __shfl_xor(ss, 4); ss += __shfl_xor(ss, 8);
        if (kp == 0) rs[r] = 1.0f / sqrtf(ss * (1.0f / D_) + EPS_);
        __syncthreads();
        if (tid < 32) { const int row = row0 + tid; const LAS float* l = lg + tid * 36; const LAS float* q = lg + 1152; const float* bg = A.in[18] + layer * 4; const float* be = A.in[20] + layer * 32; const float rstd = rs[tid];
            if (first) RS[row] = rstd;
            float g[4]; int gi = 0; float gm;
#pragma unroll
            for (int i = 0; i < 4; ++i) g[i] = rstd * l[i] + q[i] + bg[i];
            gm = g[0];
#pragma unroll
            for (int i = 1; i < 4; ++i) if (g[i] > gm) { gm = g[i]; gi = i; }
            float gs = 0.f;
#pragma unroll
            for (int i = 0; i < 4; ++i) gs += __expf(g[i] - gm);
            const float gw = 1.0f / gs;
            float e[8];
#pragma unroll
            for (int i = 0; i < 8; ++i) e[i] = rstd * l[4 + 8 * gi + i] + q[4 + 8 * gi + i] + be[8 * gi + i];
            int i0 = 0; float m0 = e[0];
#pragma unroll
            for (int i = 1; i < 8; ++i) if (e[i] > m0) { m0 = e[i]; i0 = i; }
            int i1 = -1; float m1 = -3.0e38f;
#pragma unroll
            for (int i = 0; i < 8; ++i) if (i != i0 && e[i] > m1) { m1 = e[i]; i1 = i; }
            const float p1 = __expf(m1 - m0), w0 = gw / (1.0f + p1), w1 = gw * p1 / (1.0f + p1);
            const int e0 = 8 * gi + i0, e1 = 8 * gi + i1;
            int* rt = RT + (size_t)row * 8; rt[0] = e0; rt[1] = e1; rt[2] = __float_as_int(w0); rt[3] = __float_as_int(w1);
            if (first) { atomicAdd((unsigned*)(F.ctl + CW_ECNT + 64 * layer + e0), 1u); atomicAdd((unsigned*)(F.ctl + CW_ECNT + 64 * layer + e1), 1u); }
        }
        __syncthreads();
    }
}

__device__ __forceinline__ void scatter_phase(Frame& F, const float* X, const float* gvec, int jn, int layer, bool first) {
    LAS int* tab = (LAS int*)(F.lds + MOE_TAB_OFF);
    PHASE_IDS(F);
    const int gw = F.vcu * NWAVES + wave, NGW = F.G * NWAVES;
    const float* MOD = (const float*)(F.ctl + CW_MOD);
    int* RT = (int*)(F.ws + WS_ROUTE); const float* RS = (const float*)(F.ws + WS_RS); bf16* HG = (bf16*)(F.ws + WS_HG);
    int myp0 = 0, myp1 = 0;
    { const int tok_l = gw + NGW * lane;
      if (tok_l < T_) { int* rt = RT + (size_t)tok_l * 8;
          if (first) { const int e0 = rt[0], e1 = rt[1];
              myp0 = tab[128 + e0] + (int)atomicAdd((unsigned*)(F.ctl + CW_ECUR + 64 * layer + e0), 1u);
              myp1 = tab[128 + e1] + (int)atomicAdd((unsigned*)(F.ctl + CW_ECUR + 64 * layer + e1), 1u);
              rt[4] = myp0; rt[5] = myp1; }
          else { myp0 = rt[4]; myp1 = rt[5]; } } }
    for (int i = 0; gw + NGW * i < T_; ++i) {
        const int tok = gw + NGW * i;
        const int p0 = __shfl(myp0, i), p1 = __shfl(myp1, i);
        const f32x4* xr = (const f32x4*)(X + (size_t)tok * D_) + lane; f32x4 v[8];
#pragma unroll
        for (int j = 0; j < 8; ++j) v[j] = xr[64 * j];
        const float rstd = RS[tok]; const int b = tok >> 11;
        const f32x4* sh = (const f32x4*)(MOD + (size_t)(jn * 4 + b) * 6144) + lane; const f32x4* sc = sh + 512; const f32x4* gv = (const f32x4*)gvec + lane;
        v2u* d0 = (v2u*)(HG + (size_t)p0 * D_) + lane; v2u* d1 = (v2u*)(HG + (size_t)p1 * D_) + lane;
#pragma unroll
        for (int j = 0; j < 8; ++j) { const f32x4 h = v[j] * rstd * gv[64 * j] * (1.0f + sc[64 * j]) + sh[64 * j]; v2u w; w.x = pk2(h.x, h.y); w.y = pk2(h.z, h.w); d0[64 * j] = w; d1[64 * j] = w; }
    }
}

__device__ __forceinline__ void retnorm_phase(Frame& F) {
    PHASE_IDS(F);
    const int gw = F.vcu * NWAVES + wave, NGW = F.G * NWAVES;
    const bf16* O = (const bf16*)(F.ws + WS_RETO); const bf16* P1 = (const bf16*)(F.ws + WS_PROJ1); bf16* A5 = (bf16*)(F.ws + WS_A5);
    for (int row = gw; row < T_; row += NGW) {
        const v4u* o = (const v4u*)(O + (size_t)row * 4096) + lane; const v4u* g = (const v4u*)(P1 + (size_t)row * 12288 + 8192) + lane; v4u* a = (v4u*)(A5 + (size_t)row * 4096) + lane;
#pragma unroll
        for (int h = 0; h < 8; ++h) { const v4u x = o[64 * h], s = g[64 * h];
            float f[8] = {bf_lo(x.x), bf_hi(x.x), bf_lo(x.y), bf_hi(x.y), bf_lo(x.z), bf_hi(x.z), bf_lo(x.w), bf_hi(x.w)};
            float ss = 0.f;
#pragma unroll
            for (int i = 0; i < 8; ++i) ss += f[i] * f[i];
            const float rstd = 1.0f / sqrtf(wave_sum(ss) * (1.0f / 512.0f) + EPS_);
            v4u w; w.x = pk2(f[0] * rstd * bf_lo(s.x), f[1] * rstd * bf_hi(s.x)); w.y = pk2(f[2] * rstd * bf_lo(s.y), f[3] * rstd * bf_hi(s.y));
            w.z = pk2(f[4] * rstd * bf_lo(s.z), f[5] * rstd * bf_hi(s.z)); w.w = pk2(f[6] * rstd * bf_lo(s.w), f[7] * rstd * bf_hi(s.w));
            a[64 * h] = w; }
    }
}
#ifndef ATT_REP
#define ATT_REP 1
#endif
#ifndef RET_REP
#define RET_REP 1
#endif
#ifndef ATT_KPF
#define ATT_KPF 4
#endif
constexpr int ATT_VST = 320;
__device__ __forceinline__ s16x4 vtr(const LAS unsigned char* p) { return __builtin_bit_cast(s16x4, __builtin_amdgcn_ds_read_tr16_b64_v4i16((LAS v4i16_t*)p)); }
__device__ __forceinline__ float xhalf(float v) { return __shfl_xor(v, 32); }

template <int DQK, int MODE>
__device__ __forceinline__ void attn_unit(LAS unsigned char* lds, const bf16* Qp, int qpitch, const bf16* Kp, int kpitch, const bf16* K2p, int k2pitch,
                                          const bf16* Vp, int vpitch, bf16* Op, int opitch, int q0, float dlog2, int tid_, int wave, int lane_, volatile LAS unsigned* flg) {
    const int lane = lane_id_opaque(), tid = wave * 64 + lane; (void)tid_; (void)lane_;
    constexpr int RB = DQK * 2, SW = (DQK == 192) ? 7 : 15, KB = 64 * RB, STG = KB + 16384;
    constexpr int NIK = KB / 8192, NI = NIK + 2;
    constexpr int NKS = DQK / 16;
    static_assert(3 * STG <= RING_BYTES, "three stages in the ring");
    const int r = lane & 31, h = lane >> 5, qrow = q0 + 32 * wave + r;
    bf16x8 qf[NKS];
    { const bf16* qp = Qp + (size_t)qrow * qpitch + 8 * h;
#pragma unroll
      for (int ks = 0; ks < NKS; ++ks) qf[ks] = *(const bf16x8*)(qp + 16 * ks); }
    f32x16 o[4];
#pragma unroll
    for (int db = 0; db < 4; ++db)
#pragma unroll
        for (int i = 0; i < 16; ++i) o[db][i] = 0.f;
    float m_run = -1.0e30f, l_run = 0.f, carry = 0.f;
    const int ntiles = (q0 + 256) >> 6;
    constexpr bool KLIN = (DQK != 192); constexpr int NKG = KLIN ? 1 : NIK;
    unsigned kgo[NKG], vgo0; bool krope[NKG];
#pragma unroll
    for (int j = 0; j < NKG; ++j) { const int pos = (j * 8 + wave) * 1024 + lane * 16, row = pos / RB, c = ((pos % RB) >> 4) ^ (row & SW);
        krope[j] = (DQK == 192) && c >= 16;
        kgo[j] = krope[j] ? (unsigned)(row * k2pitch * 2 + (c - 16) * 16) : (unsigned)(row * kpitch * 2 + c * 16); }
    { const int pos = wave * 1024 + lane * 16, row = pos >> 8, ch = ((pos & 255) >> 4) ^ (((row & 3) << 2) | ((row >> 2) & 3)); vgo0 = (unsigned)(row * vpitch * 2 + ch * 16); }
#define ATT_DMA(kt, stg) do { const size_t key0_ = (size_t)(kt) * 64; \
        const char* kb_ = (const char*)Kp + key0_ * kpitch * 2; const char* k2_ = (const char*)K2p + key0_ * k2pitch * 2; const char* vb_ = (const char*)Vp + key0_ * vpitch * 2; \
        LAS unsigned char* st_ = lds + (stg) * STG + wave * 1024; \
        _Pragma("unroll") for (int j_ = 0; j_ < NIK; ++j_) { const char* g_ = KLIN ? kb_ + kgo[0] + (size_t)j_ * (8192 / RB) * kpitch * 2 : ((krope[KLIN ? 0 : j_] ? k2_ : kb_) + kgo[KLIN ? 0 : j_]); \
            __builtin_amdgcn_global_load_lds((const unsigned*)g_, (LAS unsigned*)(st_ + j_ * 8192), 16, 0, 0); } \
        _Pragma("unroll") for (int j_ = 0; j_ < 2; ++j_) __builtin_amdgcn_global_load_lds((const unsigned*)(vb_ + vgo0 + (size_t)j_ * 32 * vpitch * 2), (LAS unsigned*)(st_ + KB + j_ * 8192), 16, 0, 0); } while (0)
    if (MODE == 1 && tid < 16) flg[tid] = 0u;
    ATT_DMA(ntiles - 1, 0);
    ATT_DMA(ntiles > 1 ? ntiles - 2 : 0, 1);
    const int q4 = (lane & 15) >> 2, p4 = lane & 3, blk = (lane >> 4) & 1, x4 = 2 * blk + (p4 >> 1);
    constexpr int NKO = (SW + 1) / 2;
    const int krow = r * RB, kxy = (r & SW) ^ h;
    const int vlo_off = 256 * (4 * h + q4) + 16 * (x4 ^ h) + 8 * (p4 & 1), vhi_off = 256 * (4 * h + q4 + 8) + 16 * (x4 ^ (h + 2)) + 8 * (p4 & 1);
    for (int it = 0; it < ntiles; ++it) {
        const int kt = ntiles - 1 - it;
        int y_ = kxy, q4_ = q4; asm volatile("" : "+v"(y_), "+v"(q4_));
        const bool wdone = (MODE == 1) && __all(carry < -140.0f);
        if (MODE == 1 && lane == 0) flg[8 * (it & 1) + wave] = wdone ? 1u : 0u;
        asm volatile("s_waitcnt vmcnt(%0)" :: "n"(NI) : "memory");
        asm volatile("s_waitcnt lgkmcnt(0)" ::: "memory");
        __builtin_amdgcn_s_barrier();
        asm volatile("" ::: "memory");
        if (MODE == 1) { v4u fa, fb; const unsigned fad = (unsigned)(size_t)(flg + 8 * (it & 1));
            asm volatile("ds_read_b128 %0, %2\n\tds_read_b128 %1, %2 offset:16\n\ts_waitcnt lgkmcnt(0)" : "=&v"(fa), "=&v"(fb) : "v"(fad) : "memory");
            if ((fa.x & fa.y & fa.z & fa.w & fb.x & fb.y & fb.z & fb.w) != 0u) break; }
        { const int ktn = kt >= 2 ? kt - 2 : 0; ATT_DMA(ktn, (it + 2) % 3); }
        if (!wdone && 64 * kt <= q0 + 32 * wave + 31) {
            const LAS unsigned char* Kb = lds + (it % 3) * STG; const LAS unsigned char* Vb = Kb + KB;
            f32x16 s[2];
            const int kbase = 64 * kt + 4 * h;
            const bool diag = 64 * kt + 63 > q0 + 32 * wave;
            unsigned va[8];
#pragma unroll
            for (int db = 0; db < 4; ++db) { va[db] = (unsigned)(size_t)(Vb + vlo_off + 64 * (db ^ q4_)); va[4 + db] = (unsigned)(size_t)(Vb + vhi_off + 64 * (db ^ q4_)); }
            s16x4 lo_[2][4], hi_[2][4];
#define ATT_VRD(buf, sidx) do { _Pragma("unroll") for (int db = 0; db < 4; ++db) { \
                    asm volatile("ds_read_b64_tr_b16 %0, %1 offset:%c2" : "=&v"(lo_[buf][db]) : "v"(va[db]), "i"(4096 * (sidx)) : "memory"); \
                    asm volatile("ds_read_b64_tr_b16 %0, %1 offset:%c2" : "=&v"(hi_[buf][db]) : "v"(va[4 + db]), "i"(4096 * (sidx)) : "memory"); } } while (0)
#define ATT_VMM(buf, sidx) do { const int kb_ = (sidx) >> 1, ss_ = (sidx) & 1; \
                v4u pw; pw.x = pk2(s[kb_][8 * ss_ + 0], s[kb_][8 * ss_ + 1]); pw.y = pk2(s[kb_][8 * ss_ + 2], s[kb_][8 * ss_ + 3]); pw.z = pk2(s[kb_][8 * ss_ + 4], s[kb_][8 * ss_ + 5]); pw.w = pk2(s[kb_][8 * ss_ + 6], s[kb_][8 * ss_ + 7]); \
                const bf16x8 pf = __builtin_bit_cast(bf16x8, pw); \
                _Pragma("unroll") for (int db = 0; db < 4; ++db) { \
                    const bf16x8 vf = __builtin_shufflevector(lo_[buf][db], hi_[buf][db], 0, 1, 2, 3, 4, 5, 6, 7); \
                    o[db] = __builtin_amdgcn_mfma_f32_32x32x16_bf16(vf, pf, o[db], 0, 0, 0); } } while (0)
#define ATT_PVN(first, count) do { ATT_VRD(0, first); \
                _Pragma("unroll") for (int i_ = 0; i_ < (count); ++i_) { \
                    if (i_ + 1 < (count)) { if (i_ & 1) ATT_VRD(0, (first) + i_ + 1); else ATT_VRD(1, (first) + i_ + 1); asm volatile("s_waitcnt lgkmcnt(8)" ::: "memory"); } \
                    else asm volatile("s_waitcnt lgkmcnt(0)" ::: "memory"); \
                    __builtin_amdgcn_sched_barrier(0); \
                    if (i_ & 1) ATT_VMM(1, (first) + i_); else ATT_VMM(0, (first) + i_); \
                    __builtin_amdgcn_sched_barrier(0); } } while (0)
#pragma unroll
            for (int kb = 0; kb < 2; ++kb) {
#pragma unroll
                for (int i = 0; i < 16; ++i) s[kb][i] = 0.f;
                const LAS unsigned char* kp = Kb + 32 * kb * RB;
#define ATT_KF(ks) (*(const LAS bf16x8*)(kp + krow + (((2 * ((ks) % NKO)) ^ y_) << 4) + (((2 * (ks)) & ~SW) << 4)))
                bf16x8 fa = ATT_KF(0), fb = ATT_KF(1);
#pragma unroll
                for (int g2 = 0; g2 < NKS / 2; ++g2) {
                    bf16x8 na = fa, nb = fb;
                    if (g2 + 1 < NKS / 2) { na = ATT_KF(2 * g2 + 2); nb = ATT_KF(2 * g2 + 3); }
                    __builtin_amdgcn_sched_barrier(0);
                    s[kb] = __builtin_amdgcn_mfma_f32_32x32x16_bf16(fa, qf[2 * g2], s[kb], 0, 0, 0); s[kb] = __builtin_amdgcn_mfma_f32_32x32x16_bf16(fb, qf[2 * g2 + 1], s[kb], 0, 0, 0);
                    __builtin_amdgcn_sched_barrier(0);
                    fa = na; fb = nb;
                }
#undef ATT_KF
                if (MODE == 2) {
                    if (diag) {
#pragma unroll
                        for (int i = 0; i < 16; ++i) { const int key = kbase + 32 * kb + (i & 3) + 8 * (i >> 2); s[kb][i] = key <= qrow ? s[kb][i] : 0.f; } }
                    ATT_PVN(2 * kb, 2);
                }
            }
            if (MODE == 0) {
                float tmax = -1.0e30f;
#pragma unroll
                for (int kb = 0; kb < 2; ++kb)
#pragma unroll
                    for (int i = 0; i < 16; ++i) { const int key = kbase + 32 * kb + (i & 3) + 8 * (i >> 2); const float v = (!diag || key <= qrow) ? s[kb][i] : -1.0e30f; s[kb][i] = v; tmax = fmaxf(tmax, v); }
                tmax = fmaxf(tmax, xhalf(tmax));
                const float m_new = fmaxf(m_run, tmax), alpha = ex2(m_run - m_new); m_run = m_new;
                float ps = 0.f;
#pragma unroll
                for (int kb = 0; kb < 2; ++kb)
#pragma unroll
                    for (int i = 0; i < 16; ++i) { const float p = ex2(s[kb][i] - m_new); s[kb][i] = p; ps += p; }
                l_run = l_run * alpha + ps;
#pragma unroll
                for (int db = 0; db < 4; ++db)
#pragma unroll
                    for (int i = 0; i < 16; ++i) o[db][i] *= alpha;
            } else if (MODE == 1) {
                float lkv[2][16], gs[2][4], go[2][4];
#pragma unroll
                for (int kb = 0; kb < 2; ++kb)
#pragma unroll
                    for (int g = 0; g < 4; ++g) { float t = 0.f;
#pragma unroll
                        for (int j = 0; j < 4; ++j) { const int i = 4 * g + j, key = kbase + 32 * kb + 8 * g + j; const float z = s[kb][i];
                            const bool vis = key < qrow;
                            const float lk = vis ? -(fmaxf(z, 0.f) + lg2(1.0f + ex2(-fabsf(z)))) : 0.f;
                            lkv[kb][i] = lk; s[kb][i] = vis ? z + lk : -1.0e30f; t += lk; }
                        gs[kb][g] = t; }
#pragma unroll
                for (int kb = 0; kb < 2; ++kb)
#pragma unroll
                    for (int g = 0; g < 4; ++g) go[kb][g] = xhalf(gs[kb][g]);
                float R = carry;
#pragma unroll
                for (int kb = 1; kb >= 0; --kb)
#pragma unroll
                    for (int g = 3; g >= 0; --g) {
                        float run = R + (h == 0 ? go[kb][g] : 0.f);
#pragma unroll
                        for (int j = 3; j >= 0; --j) { const int i = 4 * g + j; const float a = ex2(s[kb][i] + run); run += lkv[kb][i]; s[kb][i] = a; }
                        R += gs[kb][g] + go[kb][g];
                    }
                carry = R;
            }
            if (MODE != 2) { ATT_PVN(0, 4); }
#undef ATT_PVN
#undef ATT_VMM
#undef ATT_VRD
        }
    }
#undef ATT_DMA
    asm volatile("s_waitcnt vmcnt(0) lgkmcnt(0)" ::: "memory");
    __builtin_amdgcn_s_barrier();
    asm volatile("" ::: "memory");
    float inv = 1.0f;
    if (MODE == 0) { const float lt = l_run + xhalf(l_run); inv = 1.0f / lt; }
    bf16* op = Op + (size_t)qrow * opitch + 4 * h;
#pragma unroll
    for (int db = 0; db < 4; ++db)
#pragma unroll
        for (int g = 0; g < 4; ++g) { v2u w; w.x = pk2(o[db][4 * g] * inv, o[db][4 * g + 1] * inv); w.y = pk2(o[db][4 * g + 2] * inv, o[db][4 * g + 3] * inv); *(v2u*)(op + 32 * db + 8 * g) = w; }
}

struct WorkQ { gu32* q; int total; int slot; unsigned nxt; };
__device__ __forceinline__ void wq_init(Frame& F, WorkQ& Q, gu32* q, int total, int slot, int lane) {
    Q.q = q; Q.total = total; Q.slot = slot; Q.nxt = 0u;
    if (F.wave == 0 && lane == 0) Q.nxt = __hip_atomic_fetch_add(q, 1u, RLX_AGENT);
}
__device__ __forceinline__ bool wq_take(Frame& F, WorkQ& Q, int lane, int& u) {
    if (F.wave == 0 && lane == 0) F.MISC[Q.slot] = Q.nxt;
    __syncthreads();
    u = (int)F.MISC[Q.slot];
    __syncthreads();
    if (u >= Q.total) return false;
    if (F.wave == 0 && lane == 0) Q.nxt = __hip_atomic_fetch_add(Q.q, 1u, RLX_AGENT);
    return true;
}
template <int STREAM> __device__ __forceinline__ bool conv_batch(Frame& F, const Args& A, WorkQ& Q, int lane, int wave) {
    int b; if (!wq_take(F, Q, lane, b)) return false;
    const int i0 = 32 * b + 4 * wave;
    const ConvSrc c0 = conv_item<STREAM>(A, F.ws, i0), c1 = conv_item<STREAM>(A, F.ws, i0 + 1), c2 = conv_item<STREAM>(A, F.ws, i0 + 2), c3 = conv_item<STREAM>(A, F.ws, i0 + 3);
    f32x4 v0[8], v1[8], v2[8], v3[8];
    conv_load(c0, lane, v0); conv_load(c1, lane, v1); conv_load(c2, lane, v2); conv_load(c3, lane, v3);
    conv_store(c0, lane, v0); conv_store(c1, lane, v1); conv_store(c2, lane, v2); conv_store(c3, lane, v3);
    return true;
}
__device__ __forceinline__ void mla_phase(Frame& F, const Args& A, WorkQ& QC, bool& conv_left) {
    PHASE_IDS(F);
    WorkQ QU; wq_init(F, QU, F.ctl + CW_QMLA, 256, 16, lane);
    if (F.vcu & 1) { for (int i = 0; i < 8 && conv_left; ++i) conv_left = conv_batch<1>(F, A, QC, lane, wave); }
    const bf16* Q = (const bf16*)(F.ws + WS_QMLA); const bf16* KV = (const bf16*)(F.ws + WS_KVMLA); const bf16* KR = (const bf16*)(F.ws + WS_KR); bf16* O = (bf16*)(F.ws + WS_ATTO);
    int u;
    while (wq_take(F, QU, lane, u)) {
        const int qb = 7 - (u >> 5), bh = u & 31, b = bh >> 3, h = bh & 7; const size_t r0 = (size_t)b * S_;
#pragma unroll 1
        for (int rep_ = 0; rep_ < ATT_REP; ++rep_)
        attn_unit<192, 0>(F.lds + RING_OFF, Q + r0 * 1536 + h * 192, 1536, KV + r0 * 2048 + h * 256, 2048, KR + r0 * 64, 64, KV + r0 * 2048 + h * 256 + 128, 2048,
                          O + r0 * 2048 + 1024 + h * 128, 2048, qb * 256, 0.f, tid, wave, lane, F.MISC + 32);
        for (int i = 0; i < 4 && conv_left; ++i) conv_left = conv_batch<1>(F, A, QC, lane, wave);
    }
}
__device__ __forceinline__ void sb_phase(Frame& F, const Args& A, WorkQ& QC, bool& conv_left) {
    PHASE_IDS(F);
    WorkQ QU; wq_init(F, QU, F.ctl + CW_QSB, 256, 17, lane);
    const bf16* P0 = (const bf16*)(F.ws + WS_PROJ0); bf16* O = (bf16*)(F.ws + WS_ATTO);
    int u;
    while (wq_take(F, QU, lane, u)) {
        const int qb = 7 - (u >> 5), bh = u & 31, b = bh >> 3, h = bh & 7; const size_t r0 = (size_t)b * S_;
#pragma unroll 1
        for (int rep_ = 0; rep_ < ATT_REP; ++rep_)
        attn_unit<128, 1>(F.lds + RING_OFF, P0 + r0 * 4096 + h * 128, 4096, P0 + r0 * 4096 + 1024 + h * 128, 4096, nullptr, 0, P0 + r0 * 4096 + 2048 + h * 128, 4096,
                          O + r0 * 2048 + h * 128, 2048, qb * 256, 0.f, tid, wave, lane, F.MISC + 32);
        for (int i = 0; i < 4 && conv_left; ++i) conv_left = conv_batch<1>(F, A, QC, lane, wave);
    }
    while (conv_left) conv_left = conv_batch<1>(F, A, QC, lane, wave);
}
__device__ __forceinline__ void ret_phase(Frame& F, const Args& A) {
    PHASE_IDS(F);
    WorkQ QC; wq_init(F, QC, F.ctl + CW_QC2, CONV_N2 / 32, 18, lane); bool conv_left = true;
    WorkQ QU; wq_init(F, QU, F.ctl + CW_QRET, 1024, 16, lane);
    if (F.vcu & 1) conv_left = conv_batch<2>(F, A, QC, lane, wave);
    const bf16* P1 = (const bf16*)(F.ws + WS_PROJ1); bf16* O = (bf16*)(F.ws + WS_RETO);
    int u;
    while (wq_take(F, QU, lane, u)) {
        const int qb = 7 - (u >> 7), rem = u & 127, eq = rem >> 5, bh = rem & 31, b = bh >> 3, h = bh & 7; const size_t r0 = (size_t)b * S_;
        const float dlog2 = log1pf(-exp2f(-5.0f - (float)h)) * LOG2E;
#pragma unroll 1
        for (int rep_ = 0; rep_ < RET_REP; ++rep_)
        attn_unit<256, 2>(F.lds + RING_OFF, P1 + r0 * 12288 + h * 256, 12288, P1 + r0 * 12288 + 2048 + h * 256, 12288, nullptr, 0, P1 + r0 * 12288 + 4096 + h * 512 + eq * 128, 12288,
                          O + r0 * 4096 + h * 512 + eq * 128, 4096, qb * 256, dlog2, tid, wave, lane, F.MISC + 32);
        for (int i = 0; i < 2 && conv_left; ++i) conv_left = conv_batch<2>(F, A, QC, lane, wave);
    }
    while (conv_left) conv_left = conv_batch<2>(F, A, QC, lane, wave);
}
typedef f32x4 AccT[2][2][4][2];
__device__ __forceinline__ v4u pack8(const f32x4& a, const f32x4& b) { v4u w; w.x = pk2(a.x, a.y); w.y = pk2(a.z, a.w); w.z = pk2(b.x, b.y); w.w = pk2(b.z, b.w); return w; }
__device__ __forceinline__ float sq4(const f32x4& a) { return (a.x * a.x + a.y * a.y) + (a.z * a.z + a.w * a.w); }
__device__ __forceinline__ void rope4(const f32x4& x1, const f32x4& x2, const f32x2* cs, f32x4& o1, f32x4& o2) {
    const f32x4 c01 = *(const f32x4*)cs, c23 = *(const f32x4*)(cs + 2);
    o1.x = x1.x * c01.x - x2.x * c01.y; o2.x = x1.x * c01.y + x2.x * c01.x;
    o1.y = x1.y * c01.z - x2.y * c01.w; o2.y = x1.y * c01.w + x2.y * c01.z;
    o1.z = x1.z * c23.x - x2.z * c23.y; o2.z = x1.z * c23.y + x2.z * c23.x;
    o1.w = x1.w * c23.z - x2.w * c23.w; o2.w = x1.w * c23.w + x2.w * c23.z;
}
struct EpiG1 { static constexpr bool PERM = true, AFTER_DRAIN = false;
    bf16* P0; bf16* KR; float* ssqp; const f32x2* cs64;
    __device__ __forceinline__ void operator()(const AccT& acc, const pg8::Unit& u, int wr, int wc, int fr, int fq) const {
        const int row0 = u.pm * 256 + wr * 64 + fr, tc = wc * 32 + 8 * fq;
        if (u.pn < 15) {
            const float scl = u.pn < 4 ? C_SB : 1.0f;
#pragma unroll
            for (int ai = 0; ai < 2; ++ai)
#pragma unroll
                for (int m = 0; m < 4; ++m) { const int row = row0 + ai * 128 + m * 16; float ss = 0.f;
#pragma unroll
                    for (int bj = 0; bj < 2; ++bj) { const f32x4 v0 = acc[ai][bj][m][0], v1 = acc[ai][bj][m][1]; ss += sq4(v0) + sq4(v1);
                        *(v4u*)(P0 + (size_t)row * 4096 + u.pn * 256 + bj * 128 + tc) = pack8(v0 * scl, v1 * scl); }
                    if (u.pn >= 12) { ss += __shfl_xor(ss, 16); ss += __shfl_xor(ss, 32); if (fq == 0) { if (u.pn < 14) ssqp[(size_t)row * 8 + 4 * (u.pn - 12) + wc] = ss; else ssqp[(size_t)T_ * 8 + (size_t)row * 4 + wc] = ss; } } }
        } else if (wc == 0) {
#pragma unroll
            for (int ai = 0; ai < 2; ++ai)
#pragma unroll
                for (int m = 0; m < 4; ++m) { const int row = row0 + ai * 128 + m * 16; f32x4 a0, b0, a1, b1;
                    rope4(acc[ai][0][m][0], acc[ai][1][m][0], cs64 + (size_t)row * 32 + 8 * fq, a0, b0);
                    rope4(acc[ai][0][m][1], acc[ai][1][m][1], cs64 + (size_t)row * 32 + 8 * fq + 4, a1, b1);
                    *(v4u*)(KR + (size_t)row * 64 + 8 * fq) = pack8(a0, a1); *(v4u*)(KR + (size_t)row * 64 + 32 + 8 * fq) = pack8(b0, b1); asm volatile("" ::: "memory"); }
        }
    }
};
struct EpiG2q { static constexpr bool PERM = true, AFTER_DRAIN = false;
    bf16* Q; const float* ssq; const f32x2* cs64;
    __device__ __forceinline__ void operator()(const AccT& acc, const pg8::Unit& u, int wr, int wc, int fr, int fq) const {
        const int row0 = u.pm * 256 + wr * 64 + fr, tc = wc * 32 + 8 * fq;
        if (u.pn < 4) {
#pragma unroll
            for (int ai = 0; ai < 2; ++ai)
#pragma unroll
                for (int m = 0; m < 4; ++m) { const int row = row0 + ai * 128 + m * 16; const f32x4 pa = *(const f32x4*)(ssq + (size_t)row * 8), pb = *(const f32x4*)(ssq + (size_t)row * 8 + 4); const float rs = C_MLA * __builtin_amdgcn_rsqf(((((((pa.x + pa.y) + pa.z) + pa.w) + pb.x) + pb.y) + pb.z + pb.w) * (1.0f / 512.0f) + EPS_);
#pragma unroll
                    for (int bj = 0; bj < 2; ++bj) { const int nidx = u.pn * 256 + bj * 128 + tc, hh = nidx >> 7, d = nidx & 127;
                        *(v4u*)(Q + (size_t)row * 1536 + hh * 192 + d) = pack8(acc[ai][bj][m][0] * rs, acc[ai][bj][m][1] * rs); }
                    asm volatile("" ::: "memory"); }
        } else {
            const int head = 4 * (u.pn - 4) + wc;
#pragma unroll
            for (int ai = 0; ai < 2; ++ai)
#pragma unroll
                for (int m = 0; m < 4; ++m) { const int row = row0 + ai * 128 + m * 16; const f32x4 pa = *(const f32x4*)(ssq + (size_t)row * 8), pb = *(const f32x4*)(ssq + (size_t)row * 8 + 4); const float rs = C_MLA * __builtin_amdgcn_rsqf(((((((pa.x + pa.y) + pa.z) + pa.w) + pb.x) + pb.y) + pb.z + pb.w) * (1.0f / 512.0f) + EPS_); f32x4 a0, b0, a1, b1;
                    rope4(acc[ai][0][m][0] * rs, acc[ai][1][m][0] * rs, cs64 + (size_t)row * 32 + 8 * fq, a0, b0);
                    rope4(acc[ai][0][m][1] * rs, acc[ai][1][m][1] * rs, cs64 + (size_t)row * 32 + 8 * fq + 4, a1, b1);
                    *(v4u*)(Q + (size_t)row * 1536 + head * 192 + 128 + 8 * fq) = pack8(a0, a1); *(v4u*)(Q + (size_t)row * 1536 + head * 192 + 160 + 8 * fq) = pack8(b0, b1);
                    asm volatile("" ::: "memory"); }
        }
    }
};
struct EpiG2kv { static constexpr bool PERM = true, AFTER_DRAIN = false;
    bf16* KV; const float* ssq;
    __device__ __forceinline__ void operator()(const AccT& acc, const pg8::Unit& u, int wr, int wc, int fr, int fq) const {
        const int row0 = u.pm * 256 + wr * 64 + fr, tc = wc * 32 + 8 * fq;
#pragma unroll
        for (int ai = 0; ai < 2; ++ai)
#pragma unroll
            for (int m = 0; m < 4; ++m) { const int row = row0 + ai * 128 + m * 16; const f32x4 pa = *(const f32x4*)(ssq + (size_t)row * 4); const float rs = __builtin_amdgcn_rsqf((((pa.x + pa.y) + pa.z) + pa.w) * (1.0f / 256.0f) + EPS_);
#pragma unroll
                for (int bj = 0; bj < 2; ++bj) *(v4u*)(KV + (size_t)row * 2048 + u.pn * 256 + bj * 128 + tc) = pack8(acc[ai][bj][m][0] * rs, acc[ai][bj][m][1] * rs); asm volatile("" ::: "memory"); }
    }
};
struct EpiRes { static constexpr bool PERM = false, AFTER_DRAIN = false;
    const float* src; float* dst; const float* gate;
    __device__ __forceinline__ void operator()(const AccT& acc, const pg8::Unit& u, int wr, int wc, int fr, int fq) const {
        const int row0 = u.pm * 256 + wr * 64 + fr, col0 = u.pn * 256 + wc * 32 + 4 * fq;
#pragma unroll
        for (int ai = 0; ai < 2; ++ai)
#pragma unroll
            for (int m = 0; m < 4; ++m) { const int row = row0 + ai * 128 + m * 16; const float* g = gate + (size_t)(row >> 11) * 6144 + col0; const size_t off = (size_t)row * 2048 + col0;
#pragma unroll
                for (int bj = 0; bj < 2; ++bj)
#pragma unroll
                    for (int n = 0; n < 2; ++n) { const int o = bj * 128 + n * 16; *(f32x4*)(dst + off + o) = *(const f32x4*)(src + off + o) + *(const f32x4*)(g + o) * acc[ai][bj][m][n]; } asm volatile("" ::: "memory"); }
    }
};
struct EpiG4 { static constexpr bool PERM = true, AFTER_DRAIN = false;
    bf16* P1; const f32x2* cs256;
    __device__ __forceinline__ void operator()(const AccT& acc, const pg8::Unit& u, int wr, int wc, int fr, int fq) const {
        const int row0 = u.pm * 256 + wr * 64 + fr, tc = wc * 32 + 8 * fq;
#pragma unroll
        for (int ai = 0; ai < 2; ++ai)
#pragma unroll
            for (int m = 0; m < 4; ++m) { const int row = row0 + ai * 128 + m * 16; bf16* dst = P1 + (size_t)row * 12288 + u.pn * 256 + tc;
                if (u.pn < 16) {
                    const float dl2 = log1pf(-exp2f(-5.0f - (float)(u.pn & 7))) * LOG2E, rel = (float)((row & 2047) - 1024);
                    const float scl = u.pn >= 8 ? 0.0625f * ex2(-dl2 * rel) : ex2(dl2 * rel); f32x4 a0, b0, a1, b1;
                    rope4(acc[ai][0][m][0] * scl, acc[ai][1][m][0] * scl, cs256 + (size_t)row * 128 + tc, a0, b0);
                    rope4(acc[ai][0][m][1] * scl, acc[ai][1][m][1] * scl, cs256 + (size_t)row * 128 + tc + 4, a1, b1);
                    *(v4u*)dst = pack8(a0, a1); *(v4u*)(dst + 128) = pack8(b0, b1);
                } else if (u.pn < 32) {
#pragma unroll
                    for (int bj = 0; bj < 2; ++bj) *(v4u*)(dst + bj * 128) = pack8(acc[ai][bj][m][0], acc[ai][bj][m][1]);
                } else {
#pragma unroll
                    for (int bj = 0; bj < 2; ++bj) { f32x4 v0 = acc[ai][bj][m][0], v1 = acc[ai][bj][m][1];
                        v0.x = silu_f(v0.x); v0.y = silu_f(v0.y); v0.z = silu_f(v0.z); v0.w = silu_f(v0.w); v1.x = silu_f(v1.x); v1.y = silu_f(v1.y); v1.z = silu_f(v1.z); v1.w = silu_f(v1.w);
                        *(v4u*)(dst + bj * 128) = pack8(v0, v1); }
                } asm volatile("" ::: "memory"); }
    }
};
struct EpiM3 { static constexpr bool PERM = true, AFTER_DRAIN = false;
    bf16* ACT;
    __device__ __forceinline__ void operator()(const AccT& acc, const pg8::Unit& u, int wr, int wc, int fr, int fq) const {
        const int row0 = u.pm * 256 + wr * 64 + fr, tc = wc * 32 + 8 * fq;
#pragma unroll
        for (int ai = 0; ai < 2; ++ai)
#pragma unroll
            for (int m = 0; m < 4; ++m) { const int row = row0 + ai * 128 + m * 16; const f32x4 g0 = acc[ai][0][m][0], g1 = acc[ai][0][m][1], u0 = acc[ai][1][m][0], u1 = acc[ai][1][m][1]; f32x4 a0, a1;
                a0.x = silu_f(g0.x) * u0.x; a0.y = silu_f(g0.y) * u0.y; a0.z = silu_f(g0.z) * u0.z; a0.w = silu_f(g0.w) * u0.w;
                a1.x = silu_f(g1.x) * u1.x; a1.y = silu_f(g1.y) * u1.y; a1.z = silu_f(g1.z) * u1.z; a1.w = silu_f(g1.w) * u1.w;
                *(v4u*)(ACT + (size_t)row * 512 + u.pn * 128 + tc) = pack8(a0, a1); }
    }
};
struct EpiM4 { static constexpr bool PERM = true, AFTER_DRAIN = false;
    bf16* Y;
    __device__ __forceinline__ void operator()(const AccT& acc, const pg8::Unit& u, int wr, int wc, int fr, int fq) const {
        const int row0 = u.pm * 256 + wr * 64 + fr, tc = wc * 32 + 8 * fq;
#pragma unroll
        for (int ai = 0; ai < 2; ++ai)
#pragma unroll
            for (int m = 0; m < 4; ++m) { const int row = row0 + ai * 128 + m * 16;
#pragma unroll
                for (int bj = 0; bj < 2; ++bj) *(v4u*)(Y + (size_t)row * 2048 + u.pn * 256 + bj * 128 + tc) = pack8(acc[ai][bj][m][0], acc[ai][bj][m][1]); }
    }
};
__device__ __forceinline__ void moe_tables(Frame& F, int layer) {
    LAS int* tab = (LAS int*)(F.lds + MOE_TAB_OFF);
    __syncthreads();
    if (F.wave == 0) { const int lane = lane_id_opaque();
        const int cnt = lane < 32 ? (int)__hip_atomic_load(F.ctl + CW_ECNT + 64 * layer + lane, RLX_AGENT) : 0; const int nt = (cnt + 255) >> 8;
        int incl = nt;
#pragma unroll
        for (int off = 1; off < 32; off <<= 1) { const int v = __shfl_up(incl, off); if (lane >= off) incl += v; }
        const int start = incl - nt;
        if (lane < 32) { tab[128 + lane] = 256 * start; for (int i = 0; i < nt && start + i < 96; ++i) tab[start + i] = lane; }
        if (lane == 31) tab[160] = incl < 96 ? incl : 96; }
    __syncthreads();
}

#ifndef PH_MASK
#define PH_MASK 0x7FFFFFu
#endif
#ifndef PH_DUP
#define PH_DUP 0u
#endif
#define REP(k) _Pragma("unroll 1") for (int rep_ = 0; rep_ < ((((PH_DUP) >> (k)) & 1u) ? 2 : 1); ++rep_)
#define IN(k) (((PH_MASK >> (k)) & 1u) && lo <= (k) && (k) < hi)
#define SEAM(k) do { if (IN(k) && IN((k) + 1)) xcd_barrier(bar, F.wave); } while (0)
template <int LAYER, int PB> __device__ __forceinline__ void moe_phases(Frame& F, const Args& args, const XcdBarrier& bar, int lo, int hi) {
    unsigned char* ws = F.ws; LAS unsigned char* ring = F.lds + RING_OFF; const int c = (int)blockIdx.x;
    if (IN(PB)) { router_phase(F, args, (const float*)(ws + WS_XA), args.in[8] + LAYER * 2048, 2 * LAYER + 1, LAYER, true);
#if defined(ROUTER_TWICE)
        router_phase(F, args, (const float*)(ws + WS_XA), args.in[8] + LAYER * 2048, 2 * LAYER + 1, LAYER, false);
#endif
    } SEAM(PB);
    if (IN(PB + 1)) { moe_tables(F, LAYER); scatter_phase(F, (const float*)(ws + WS_XA), args.in[8] + LAYER * 2048, 2 * LAYER + 1, LAYER, true);
#if defined(SCATTER_TWICE)
        scatter_phase(F, (const float*)(ws + WS_XA), args.in[8] + LAYER * 2048, 2 * LAYER + 1, LAYER, false);
#endif
    } SEAM(PB + 1);
    if (IN(PB + 2)) {
        moe_tables(F, LAYER); const LAS int* tab = (const LAS int*)(F.lds + MOE_TAB_OFF); const int TM = tab[160], TA = (TM + 1) >> 1;
        pg8::Gemm g{2048, 2048, 2048}; pg8::MoeOrder S; S.ntn = 4; S.t0 = 0; S.nunits = TA * 4; S.gdeal = F.G; S.busy = 0; S.G = F.G; S.c = c; S.A = (const char*)(ws + WS_HG); S.W = (const char*)(ws + WS_W_GU + (size_t)LAYER * 128 * MiB);
        S.tstepA = (size_t)256 * 2048 * 2; S.tstepB = (size_t)256 * 2048 * 2; S.estep = (size_t)1024 * 2048 * 2; S.tile_expert = tab;
        EpiM3 E{(bf16*)(ws + WS_ACT)};
        pg8::gemm_phase<EpiM3, pg8::MoeOrder, true, true>(ring, g, S, E, F.wave);
#if defined(M3_TWICE)
        pg8::gemm_phase<EpiM3, pg8::MoeOrder, true, true>(ring, g, S, E, F.wave);
#endif
    } SEAM(PB + 2);
    if (IN(PB + 3)) {
        moe_tables(F, LAYER); const LAS int* tab = (const LAS int*)(F.lds + MOE_TAB_OFF); const int TM = tab[160], TA = (TM + 1) >> 1, nb3 = (TM - TA) * 4;
        { pg8::Gemm g{2048, 2048, 2048}; pg8::MoeOrder S; S.ntn = 4; S.t0 = TA; S.nunits = nb3; S.gdeal = nb3 < F.G ? nb3 : F.G; S.busy = 0; S.G = F.G; S.c = c; S.A = (const char*)(ws + WS_HG); S.W = (const char*)(ws + WS_W_GU + (size_t)LAYER * 128 * MiB);
          S.tstepA = (size_t)256 * 2048 * 2; S.tstepB = (size_t)256 * 2048 * 2; S.estep = (size_t)1024 * 2048 * 2; S.tile_expert = tab;
          EpiM3 E{(bf16*)(ws + WS_ACT)};
          pg8::gemm_phase<EpiM3, pg8::MoeOrder, true, true>(ring, g, S, E, F.wave); }
        { pg8::Gemm g{512, 512, 512}; pg8::MoeOrder S; S.ntn = 8; S.t0 = 0; S.nunits = TA * 8; S.gdeal = F.G; S.busy = (nb3 > 0 && nb3 < F.G) ? nb3 : 0; S.G = F.G; S.c = c; S.A = (const char*)(ws + WS_ACT); S.W = (const char*)(ws + WS_W_DN + (size_t)LAYER * 64 * MiB);
          S.tstepA = (size_t)256 * 512 * 2; S.tstepB = (size_t)256 * 512 * 2; S.estep = (size_t)2048 * 512 * 2; S.tile_expert = tab;
          EpiM4 E{(bf16*)(ws + WS_Y)};
          pg8::gemm_phase<EpiM4, pg8::MoeOrder, true, true>(ring, g, S, E, F.wave); }
    } SEAM(PB + 3);
    if (IN(PB + 4)) {
        moe_tables(F, LAYER); const LAS int* tab = (const LAS int*)(F.lds + MOE_TAB_OFF); const int TM = tab[160], TA = (TM + 1) >> 1;
        pg8::Gemm g{512, 512, 512}; pg8::MoeOrder S; S.ntn = 8; S.t0 = TA; S.nunits = (TM - TA) * 8; S.gdeal = F.G; S.busy = 0; S.G = F.G; S.c = c; S.A = (const char*)(ws + WS_ACT); S.W = (const char*)(ws + WS_W_DN + (size_t)LAYER * 64 * MiB);
        S.tstepA = (size_t)256 * 512 * 2; S.tstepB = (size_t)256 * 512 * 2; S.estep = (size_t)2048 * 512 * 2; S.tile_expert = tab;
        EpiM4 E{(bf16*)(ws + WS_Y)};
        pg8::gemm_phase<EpiM4, pg8::MoeOrder, true, true>(ring, g, S, E, F.wave);
#if defined(M4_TWICE)
        pg8::gemm_phase<EpiM4, pg8::MoeOrder, true, true>(ring, g, S, E, F.wave);
#endif
    } SEAM(PB + 4);
}
__global__ void __launch_bounds__(NWAVES * 64, 2) mk_fwd(Args args) {
    extern __shared__ __attribute__((aligned(16))) unsigned char lds[];
    Frame F;
    F.lds = (LAS unsigned char*)lds;
    F.MISC = (volatile LAS unsigned*)(F.lds + MISC_OFF);
    F.wave = __builtin_amdgcn_readfirstlane((int)threadIdx.x >> 6);
    F.G = gridDim.x; { const int bx = blockIdx.x; F.vcu = (F.G % 8 == 0) ? (bx % 8) * (F.G / 8) + bx / 8 : bx; }
    F.ws = args.ws; F.ctl = (gu32*)(args.ws + WS_CTL); F.out = args.out;
    for (int u = threadIdx.x; u < (LDS_BYTES - LDSCTL_OFF) / 4; u += NWAVES * 64) ((LAS unsigned*)(F.lds + LDSCTL_OFF))[u] = 0u;
    __syncthreads();
    XcdBarrier bar; bar.bar = (unsigned*)(F.ctl + CW_BAR); bar.x = 0; bar.st = nullptr;
    if (!MK_MULTI) bar = xcd_barrier_post((unsigned*)(F.ctl + CW_BAR), F.MISC + 8, F.wave);
    const int lo = args.ph_lo, hi = args.ph_hi;
    unsigned char* ws = args.ws;
    const float* MOD = (const float*)(F.ctl + CW_MOD);
    LAS unsigned char* ring = F.lds + RING_OFF;
    const int c = (int)blockIdx.x;

    if (IN(0)) REP(0) { p0a_mod_partials(F, args); } SEAM(0);
    if (IN(1)) REP(1) { p0_prologue(F, args); local_mod(F, args.in[4], 0); norm_phase<0, true>(F, args.in[0], nullptr, args.in[5], 0, 0, 0); } SEAM(1);
    if (IN(3)) REP(3) {
        pg8::Gemm g{2048, 2048, 2048}; pg8::StaticOrder S; S.init(T_, 4096, F.G, c, ws + WS_H, 2048, ws + WS_W_IN0T, 2048);
        EpiG1 E{(bf16*)(ws + WS_PROJ0), (bf16*)(ws + WS_KR), (float*)(ws + WS_SSQP), (const f32x2*)(ws + WS_TAB64)};
        pg8::gemm_phase<EpiG1, pg8::StaticOrder, true, true>(ring, g, S, E, F.wave);
    } SEAM(3);
    if (IN(4)) REP(4) {
        { pg8::Gemm g{512, 4096, 512}; pg8::StaticOrder S; S.init(T_, 1536, F.G, c, ws + WS_PROJ0 + 3072 * 2, 4096, ws + WS_W_QUPT, 512);
          EpiG2q E{(bf16*)(ws + WS_QMLA), (const float*)(ws + WS_SSQP), (const f32x2*)(ws + WS_TAB64)};
          pg8::gemm_phase<EpiG2q, pg8::StaticOrder, true, true>(ring, g, S, E, F.wave); }
        { pg8::Gemm g{256, 4096, 256}; pg8::StaticOrder S; S.init(T_, 2048, F.G, c, ws + WS_PROJ0 + 3584 * 2, 4096, ws + WS_W_KVUPT, 256);
          EpiG2kv E{(bf16*)(ws + WS_KVMLA), (const float*)(ws + WS_SSQP) + (size_t)T_ * 8};
          pg8::gemm_phase<EpiG2kv, pg8::StaticOrder, true, true>(ring, g, S, E, F.wave); }
    } SEAM(4);
    if (IN(5)) REP(5) { bool conv_left = true; WorkQ QC; wq_init(F, QC, F.ctl + CW_QC1, CONV_N1 / 32, 18, lane_id_opaque()); mla_phase(F, args, QC, conv_left); sb_phase(F, args, QC, conv_left); } SEAM(5);
    if (IN(6)) REP(6) {
        pg8::Gemm g{2048, 2048, 2048}; pg8::StaticOrder S; S.init(T_, 2048, F.G, c, ws + WS_ATTO, 2048, ws + WS_W_OUT0T, 2048);
        EpiRes E{args.in[0], (float*)(ws + WS_XA), MOD + (size_t)(0 * 4) * 6144 + 4096};
        pg8::gemm_phase<EpiRes, pg8::StaticOrder, true, true>(ring, g, S, E, F.wave);
    } SEAM(6);
    moe_phases<0, 7>(F, args, bar, lo, hi);
    if (IN(12)) REP(12) { norm_phase<2>(F, (const float*)(ws + WS_XA), (float*)(ws + WS_XB), args.in[5] + 2048, 2, 1, 0); } SEAM(12);
    if (IN(13)) REP(13) {
        pg8::Gemm g{2048, 2048, 2048}; pg8::StaticOrder S; S.init(T_, 12288, F.G, c, ws + WS_H, 2048, ws + WS_W_IN1T, 2048);
        EpiG4 E{(bf16*)(ws + WS_PROJ1), (const f32x2*)(ws + WS_TAB256)};
        pg8::gemm_phase<EpiG4, pg8::StaticOrder, true, true>(ring, g, S, E, F.wave);
    } SEAM(13);
    if (IN(14)) REP(14) { ret_phase(F, args); } SEAM(14);
    if (IN(15)) REP(15) { retnorm_phase(F); } SEAM(15);
    if (IN(16)) REP(16) {
        pg8::Gemm g{4096, 4096, 4096}; pg8::StaticOrder S; S.init(T_, 2048, F.G, c, ws + WS_A5, 4096, ws + WS_W_OUT1T, 4096);
        EpiRes E{(const float*)(ws + WS_XB), (float*)(ws + WS_XA), MOD + (size_t)(2 * 4) * 6144 + 4096};
        pg8::gemm_phase<EpiRes, pg8::StaticOrder, true, true>(ring, g, S, E, F.wave);
    } SEAM(16);
    moe_phases<1, 17>(F, args, bar, lo, hi);
    if (IN(22)) REP(22) { norm_phase<3>(F, (const float*)(ws + WS_XA), nullptr, args.in[24], 0, 3, 1); }
}
#undef IN
#undef SEAM

extern "C" void kernel_launch(void* const* d_in, const int* in_sizes, int n_in, void* d_out, int out_size, void* d_ws, size_t ws_size, hipStream_t stream) {
    static int grid = 0;
    if (grid == 0) {
        if (n_in != 25 || in_sizes[0] != T_ * D_ || out_size != T_ * D_ || ws_size < WS_END) { fprintf(stderr, "kernel_launch: unexpected shapes (n_in %d, in0 %d, out %d, ws %zu < %zu); nothing launched\n", n_in, n_in > 0 ? in_sizes[0] : -1, out_size, ws_size, (size_t)WS_END); grid = -1; return; }
        int dev = 0, cus = 0, per_cu = 0;
        if (hipGetDevice(&dev) != hipSuccess || hipDeviceGetAttribute(&cus, hipDeviceAttributeMultiprocessorCount, dev) != hipSuccess) { fprintf(stderr, "kernel_launch: device query failed\n"); grid = -1; return; }
        if (hipFuncSetAttribute((const void*)mk_fwd, hipFuncAttributeMaxDynamicSharedMemorySize, LDS_BYTES) != hipSuccess) { fprintf(stderr, "kernel_launch: hipFuncSetAttribute failed\n"); grid = -1; return; }
        if (hipOccupancyMaxActiveBlocksPerMultiprocessor(&per_cu, (const void*)mk_fwd, NWAVES * 64, LDS_BYTES) != hipSuccess || per_cu < 1) fprintf(stderr, "kernel_launch: note: occupancy query reports %d workgroups per CU\n", per_cu);
        (void)hipGetLastError();
        grid = cus;
    }
    if (grid < 0) return;
    if (hipMemsetAsync((char*)d_ws + WS_CTL, 0, CTL_ZERO_BYTES, stream) != hipSuccess) { fprintf(stderr, "kernel_launch: memset failed\n"); return; }
    Args a{};
    for (int i = 0; i < 25; ++i) a.in[i] = (const float*)d_in[i];
    a.out = (float*)d_out; a.ws = (unsigned char*)d_ws;
#if MK_MULTI
    for (int p = 0; p < 23; ++p) { a.ph_lo = p; a.ph_hi = p + 1; hipLaunchKernelGGL(mk_fwd, dim3(grid), dim3(NWAVES * 64), LDS_BYTES, stream, a); }
#else
    a.ph_lo = 0; a.ph_hi = 23;
    hipLaunchKernelGGL(mk_fwd, dim3(grid), dim3(NWAVES * 64), LDS_BYTES, stream, a);
#endif
    const hipError_t le = hipPeekAtLastError();
    if (le != hipSuccess) fprintf(stderr, "kernel_launch: launch failed: %s\n", hipGetErrorName(le));
}
```

```cpp
#include <hip/hip_runtime.h>
#include <cstdio>
#include <cstdint>

#ifndef MK_MULTI
#define MK_MULTI 0
#endif

namespace pg8 {
#define PG8_LAS __attribute__((address_space(3)))
typedef unsigned short bf16_t;
typedef short bf16x8 __attribute__((ext_vector_type(8)));
typedef float f32x4 __attribute__((ext_vector_type(4)));
typedef unsigned u32x4 __attribute__((ext_vector_type(4)));
constexpr int BM = 256, BK = 64, HALF = 128, HTB = HALF * BK * 2  , STAGE_BYTES = 8 * HTB, NXCD = 8, WGM = 8;

__host__ __device__ __forceinline__ int lds_byte(int r, int c) { const int st = (r >> 4) * 2 + (c >> 5), rr = r & 15, cc = c & 31, ob = rr * 64 + cc * 2; return st * 1024 + (ob ^ (((ob >> 9) & 1) << 5)); }
__host__ __device__ __forceinline__ void stage_rc(int b, int& R, int& C) { const int st = b / 1024, sb = b % 1024, swz = sb ^ (((sb >> 9) & 1) << 5); R = (st >> 1) * 16 + swz / 64; C = (st & 1) * 32 + (swz % 64) / 2; }
__host__ __device__ __forceinline__ int perm32(int rho) { const int n = rho >> 4, i = rho & 15; return 8 * (i >> 2) + 4 * n + (i & 3); }

struct Unit { int pm, pn; const char* a; const char* b; };
struct Gemm { int K, lda, ldb; };

struct StaticOrder {
    int nM, nN, nwg, G, c; const char* A; const char* Bt; size_t tstepA, tstepB;
    __device__ void init(int M, int N, int G_, int c_, const void* A_, int lda, const void* Bt_, int ldb) { nM = M / BM; nN = N / BM; nwg = nM * nN; G = G_; c = c_; A = (const char*)A_; Bt = (const char*)Bt_; tstepA = (size_t)BM * lda * 2; tstepB = (size_t)BM * ldb * 2; }
    __device__ bool next(int i, Unit& u) const {
        const long L = (long)i * G + c; if (L >= nwg) return false;
        int wgid = (int)L; { const int q = nwg / NXCD, r = nwg % NXCD, xcd = wgid % NXCD, off = wgid / NXCD; wgid = (xcd < r ? xcd * (q + 1) : r * (q + 1) + (xcd - r) * q) + off; }
        const int nig = WGM * nN, gid = wgid / nig, fm = gid * WGM, gsz = (nM - fm) < WGM ? (nM - fm) : WGM;
        u.pm = fm + ((wgid % nig) % gsz); u.pn = (wgid % nig) / gsz; u.a = A + (size_t)u.pm * tstepA; u.b = Bt + (size_t)u.pn * tstepB; return true;
    }
    __device__ __forceinline__ void a_ready(const Unit&) const {}
    __device__ __forceinline__ void done(const Unit&) const {}
};
struct MoeOrder {
    int ntn, t0, nunits, gdeal, busy, G, c; const char* A; const char* W; size_t tstepA, tstepB, estep; const PG8_LAS int* tile_expert;
    __device__ bool next(int i, Unit& u) const {
        int L;
        if (busy == 0) { if (c >= gdeal) return false; L = i * gdeal + c; }
        else { const int nfree = G - busy;
            if (c >= busy) { const int cap = 3 * nfree < nunits ? 3 * nfree : nunits; if (i >= 3) return false; L = i * nfree + (c - busy); if (L >= cap) return false; }
            else { L = 3 * nfree + i * busy + c; } }
        if (L >= nunits) return false;
        const int mt = t0 + L / ntn, pn = L % ntn, e = tile_expert[mt];
        u.pm = mt; u.pn = pn; u.a = A + (size_t)mt * tstepA; u.b = W + (size_t)e * estep + (size_t)pn * tstepB; return true;
    }
    __device__ __forceinline__ void a_ready(const Unit&) const {}
    __device__ __forceinline__ void done(const Unit&) const {}
};

template <class Epi, class Sched, bool ALIGN_EPI = false, bool SP2 = false>
__device__ __forceinline__ void gemm_phase(PG8_LAS unsigned char* lds, const Gemm g, const Sched& S, const Epi& E, const int wave_id) {
    int lane; asm volatile("v_mbcnt_lo_u32_b32 %0, -1, 0\n\tv_mbcnt_hi_u32_b32 %0, -1, %0" : "=v"(lane));
    const int wid = wave_id, tid = wid * 64 + lane, wr = wid >> 2, wc = wid & 3, fr = lane & 15, fq = lane >> 4;
    const int K = g.K, nt = K / BK;
    unsigned voffA[2], voffB[2];
#pragma unroll
    for (int i = 0; i < 2; ++i) { int R, C; stage_rc(tid * 16 + i * 8192, R, C); const int Rb = Epi::PERM ? ((R & ~31) + perm32(R & 31)) : R;
        voffA[i] = (unsigned)(R * g.lda + C) * 2u; voffB[i] = (unsigned)(Rb * g.ldb + C) * 2u; }
    const size_t kstep = (size_t)(BK * 2);
    const size_t hstepA = (size_t)HALF * g.lda * 2, hstepB = (size_t)HALF * g.ldb * 2;
    const unsigned ldsw = (unsigned)wid * 1024u;
    const int aoff = lds_byte(wr * 64 + fr, fq * 8), boff = lds_byte(wc * 32 + fr, fq * 8);
#define PG8_SA(b, h) (((b) * 2 + (h)) * HTB)
#define PG8_SB(b, h) ((4 + (b) * 2 + (h)) * HTB)
#define PG8_STAGE(bufoff, gbase, voff) do { _Pragma("unroll") for (int _i = 0; _i < 2; ++_i) \
        __builtin_amdgcn_global_load_lds((const unsigned*)((const char*)(gbase) + (voff)[_i]), (PG8_LAS unsigned*)(lds + (bufoff) + ldsw + _i * 8192), 16, 0, 0); } while (0)
#define PG8_LDA(dst, b, h) do { _Pragma("unroll") for (int m = 0; m < 4; ++m) _Pragma("unroll") for (int k = 0; k < 2; ++k) dst[m][k] = *(const PG8_LAS bf16x8*)(lds + PG8_SA(b, h) + aoff + m * 2048 + k * 1024); } while (0)
#define PG8_LDB(dst, b, h) do { _Pragma("unroll") for (int n = 0; n < 2; ++n) _Pragma("unroll") for (int k = 0; k < 2; ++k) dst[n][k] = *(const PG8_LAS bf16x8*)(lds + PG8_SB(b, h) + boff + n * 2048 + k * 1024); } while (0)
#define PG8_MMA(ai, bj, At, Bt) do { __builtin_amdgcn_s_setprio(1); _Pragma("unroll") for (int m = 0; m < 4; ++m) _Pragma("unroll") for (int n = 0; n < 2; ++n) _Pragma("unroll") for (int k = 0; k < 2; ++k) \
        acc[ai][bj][m][n] = __builtin_amdgcn_mfma_f32_16x16x32_bf16(Bt[n][k], At[m][k], acc[ai][bj][m][n], 0, 0, 0); __builtin_amdgcn_s_setprio(0); } while (0)
#define PG8_WAIT_V(n) asm volatile("s_waitcnt vmcnt(" #n ")" ::: "memory")
#define PG8_WAIT_L(n) asm volatile("s_waitcnt lgkmcnt(" #n ")" ::: "memory")
#define PG8_BAR __builtin_amdgcn_s_barrier()
#define PG8_SCHED __builtin_amdgcn_sched_barrier(0)
    Unit cur, nxt; int ui = 0;
    if (!S.next(0, cur)) return;
    f32x4 acc[2][2][4][2];
#pragma unroll
    for (int a = 0; a < 2; ++a)
#pragma unroll
        for (int b = 0; b < 2; ++b)
#pragma unroll
            for (int m = 0; m < 4; ++m)
#pragma unroll
                for (int n = 0; n < 2; ++n) acc[a][b][m][n] = (f32x4){0.f, 0.f, 0.f, 0.f};
    bf16x8 At[4][2], B0[2][2], B1[2][2];
    const char* cA = cur.a; const char* cB = cur.b;
    S.a_ready(cur);
    if constexpr (SP2) {
        PG8_STAGE(PG8_SB(0, 0), cB, voffB); PG8_STAGE(PG8_SB(0, 1), cB + hstepB, voffB); PG8_STAGE(PG8_SA(0, 0), cA, voffA); PG8_STAGE(PG8_SA(0, 1), cA + hstepA, voffA);
        if (wr == 1) PG8_BAR;
        PG8_WAIT_V(2); PG8_BAR;
        PG8_STAGE(PG8_SB(1, 0), cB + kstep, voffB); PG8_STAGE(PG8_SA(1, 0), cA + kstep, voffA); PG8_STAGE(PG8_SB(1, 1), cB + hstepB + kstep, voffB);
        PG8_WAIT_V(6); PG8_BAR;
    } else {
        PG8_STAGE(PG8_SB(0, 0), cB, voffB); PG8_STAGE(PG8_SA(0, 0), cA, voffA); PG8_STAGE(PG8_SB(0, 1), cB + hstepB, voffB); PG8_STAGE(PG8_SA(0, 1), cA + hstepA, voffA);
        if (wr == 1) PG8_BAR;
        PG8_WAIT_V(4); PG8_BAR;
        PG8_STAGE(PG8_SB(1, 0), cB + kstep, voffB); PG8_STAGE(PG8_SA(1, 0), cA + kstep, voffA); PG8_STAGE(PG8_SB(1, 1), cB + hstepB + kstep, voffB);
        PG8_WAIT_V(6); PG8_BAR;
    }
    for (;;) {
        const bool has_next = S.next(ui + 1, nxt);
        const char* nA = has_next ? nxt.a : cA; const char* nB = has_next ? nxt.b : cB;
        for (int t = 0; t < nt; t += 2) {
            const bool last = (t == nt - 2);
            const char* a1 = cA + (size_t)(t + 1) * kstep;
            const char* a2 = last ? nA : cA + (size_t)(t + 2) * kstep; const char* b2 = last ? nB : cB + (size_t)(t + 2) * kstep;
            const char* a3 = a2 + kstep; const char* b3 = b2 + kstep;
            if (last && has_next) S.a_ready(nxt);
            if constexpr (SP2) {
            PG8_LDB(B0, 0, 0); PG8_LDB(B1, 0, 1); PG8_SCHED; PG8_LDA(At, 0, 0); PG8_STAGE(PG8_SA(1, 1), a1 + hstepA, voffA);
            PG8_WAIT_V(8); PG8_WAIT_L(0); PG8_BAR; PG8_MMA(0, 0, At, B0); PG8_MMA(0, 1, At, B1); PG8_BAR; PG8_SCHED;
            PG8_LDA(At, 0, 1); PG8_STAGE(PG8_SB(0, 0), b2, voffB); PG8_STAGE(PG8_SB(0, 1), b2 + hstepB, voffB); PG8_STAGE(PG8_SA(0, 0), a2, voffA);
            PG8_WAIT_V(8); PG8_WAIT_L(0); PG8_BAR; PG8_MMA(1, 0, At, B0); PG8_MMA(1, 1, At, B1); PG8_BAR; PG8_SCHED;
            PG8_LDB(B0, 1, 0); PG8_LDB(B1, 1, 1); PG8_SCHED; PG8_LDA(At, 1, 0); PG8_STAGE(PG8_SA(0, 1), a2 + hstepA, voffA);
            PG8_WAIT_V(8); PG8_WAIT_L(0); PG8_BAR; PG8_MMA(0, 0, At, B0); PG8_MMA(0, 1, At, B1); PG8_BAR; PG8_SCHED;
            PG8_LDA(At, 1, 1); PG8_STAGE(PG8_SB(1, 0), b3, voffB); PG8_STAGE(PG8_SB(1, 1), b3 + hstepB, voffB); PG8_STAGE(PG8_SA(1, 0), a3, voffA);
            PG8_WAIT_V(8); PG8_WAIT_L(0); PG8_BAR; PG8_MMA(1, 0, At, B0); PG8_MMA(1, 1, At, B1); PG8_BAR; PG8_SCHED;
            } else {
            PG8_LDB(B0, 0, 0); PG8_SCHED; PG8_LDA(At, 0, 0); PG8_STAGE(PG8_SA(1, 1), a1 + hstepA, voffA);
            PG8_WAIT_L(8); PG8_BAR; PG8_WAIT_L(0); PG8_MMA(0, 0, At, B0); PG8_BAR; PG8_SCHED;
            PG8_LDB(B1, 0, 1); PG8_STAGE(PG8_SB(0, 0), b2, voffB);
            PG8_BAR; PG8_WAIT_L(0); PG8_MMA(0, 1, At, B1); PG8_BAR;
            PG8_LDA(At, 0, 1); PG8_STAGE(PG8_SA(0, 0), a2, voffA);
            PG8_BAR; PG8_WAIT_L(0); PG8_MMA(1, 0, At, B0); PG8_BAR; PG8_SCHED;
            PG8_STAGE(PG8_SB(0, 1), b2 + hstepB, voffB);
            PG8_WAIT_V(6); PG8_BAR; PG8_MMA(1, 1, At, B1); PG8_BAR;
            PG8_LDB(B0, 1, 0); PG8_SCHED; PG8_LDA(At, 1, 0); PG8_STAGE(PG8_SA(0, 1), a2 + hstepA, voffA);
            PG8_WAIT_L(8); PG8_BAR; PG8_WAIT_L(0); PG8_MMA(0, 0, At, B0); PG8_BAR; PG8_SCHED;
            PG8_LDB(B1, 1, 1); PG8_STAGE(PG8_SB(1, 0), b3, voffB);
            PG8_BAR; PG8_WAIT_L(0); PG8_MMA(0, 1, At, B1); PG8_BAR;
            PG8_LDA(At, 1, 1); PG8_STAGE(PG8_SA(1, 0), a3, voffA);
            PG8_BAR; PG8_WAIT_L(0); PG8_MMA(1, 0, At, B0); PG8_BAR; PG8_SCHED;
            PG8_STAGE(PG8_SB(1, 1), b3 + hstepB, voffB);
            PG8_WAIT_V(6); PG8_BAR; PG8_MMA(1, 1, At, B1); PG8_BAR;
            }
        }
        if constexpr (ALIGN_EPI) { if (wr == 0) PG8_BAR; }
        if constexpr (!Epi::AFTER_DRAIN) { E(acc, cur, wr, wc, fr, fq); S.done(cur); }
        if (!has_next) break;
#pragma unroll
        for (int a = 0; a < 2; ++a)
#pragma unroll
            for (int b = 0; b < 2; ++b)
#pragma unroll
                for (int m = 0; m < 4; ++m)
#pragma unroll
                    for (int n = 0; n < 2; ++n) acc[a][b][m][n] = (f32x4){0.f, 0.f, 0.f, 0.f};
        cur = nxt; cA = nA; cB = nB; ++ui;
        if constexpr (ALIGN_EPI) { if (wr == 1) PG8_BAR; }
    }
    PG8_WAIT_V(0);
    if constexpr (!ALIGN_EPI) { if (wr == 0) PG8_BAR; }
    PG8_BAR;
    if constexpr (Epi::AFTER_DRAIN) { E.fused(acc, cur, wr, wc, fr, fq, lds, wid, lane); S.done(cur); }
#undef PG8_SA
#undef PG8_SB
#undef PG8_STAGE
#undef PG8_LDA
#undef PG8_LDB
#undef PG8_MMA
#undef PG8_WAIT_V
#undef PG8_WAIT_L
#undef PG8_BAR
#undef PG8_SCHED
}
}

constexpr int NWAVES = 8;
constexpr int T_ = 8192, D_ = 2048, NB_ = 4, S_ = 2048;
constexpr float EPS_ = 1e-6f;
constexpr float LOG2E = 1.4426950408889634f;
constexpr float C_SB = 0.08838834764831845f * LOG2E;
constexpr float C_MLA = 0.07216878364870323f * LOG2E;
constexpr int NPH = 22;

constexpr size_t MiB = 1u << 20;
constexpr size_t WS_CTL = 0, CTL_ZERO_BYTES = 1 * MiB;
constexpr size_t WS_TAB64 = 2 * MiB, WS_TAB256 = 4 * MiB, WS_WR = 12 * MiB, WS_ROUTE = 13 * MiB;
constexpr size_t WS_W_IN0T = 16 * MiB, WS_W_QUPT = 32 * MiB, WS_W_KVUPT = 34 * MiB, WS_W_OUT0T = 36 * MiB, WS_W_IN1T = 44 * MiB, WS_W_OUT1T = 92 * MiB;
constexpr size_t WS_W_GU = 108 * MiB, WS_W_DN = 364 * MiB;
constexpr size_t WS_XA = 492 * MiB, WS_XB = 556 * MiB, WS_H = 620 * MiB;
constexpr size_t WS_PROJ0 = 652 * MiB, WS_QMLA = 716 * MiB, WS_KVMLA = 740 * MiB, WS_KR = 772 * MiB, WS_ATTO = 774 * MiB;
constexpr size_t WS_PROJ1 = 652 * MiB;
constexpr size_t WS_HG = 844 * MiB, WS_ACT = 940 * MiB, WS_Y = 964 * MiB;
constexpr size_t WS_RETO = 844 * MiB, WS_A5 = 908 * MiB;
constexpr size_t WS_MODP = 1060 * MiB;
constexpr size_t WS_RS = 13 * MiB + 256 * 1024;
constexpr size_t WS_SSQP = 13 * MiB + 512 * 1024;
constexpr size_t WS_END = 1068 * MiB;
constexpr int CW_TMO = 0, CW_CODE = 1;
constexpr int CW_BAR = 4096;
constexpr int CW_QMLA = 8192, CW_QSB = 8256, CW_QRET = 8320, CW_QC1 = 8384, CW_QC2 = 8416;
constexpr int CW_ECNT = 8448, CW_ECUR = 8576;
constexpr int CW_MOD = 16384;
constexpr int CW_SSQQ = 114688, CW_SSQKV = 122880;
static_assert((CW_SSQKV + 8192) * 4 <= (int)CTL_ZERO_BYTES, "CTL words inside the memset region");
constexpr int RING_OFF = 0, RING_BYTES = 147456;
constexpr int LDSCTL_OFF = RING_BYTES, MISC_OFF = LDSCTL_OFF + 320;
constexpr int MOE_TAB_OFF = LDSCTL_OFF + 1024;
constexpr int LDS_BYTES = 155648;
static_assert(MOE_TAB_OFF + 1024 <= LDS_BYTES, "LDS map");

#define GAS __attribute__((address_space(1)))
#define LAS __attribute__((address_space(3)))
typedef unsigned short bf16;
typedef unsigned v4u __attribute__((ext_vector_type(4)));
typedef unsigned v2u __attribute__((ext_vector_type(2)));
typedef float f32x4 __attribute__((ext_vector_type(4)));
typedef float f32x2 __attribute__((ext_vector_type(2)));
typedef float f32x16 __attribute__((ext_vector_type(16)));
typedef short bf16x8 __attribute__((ext_vector_type(8)));
typedef short s16x4 __attribute__((ext_vector_type(4)));
typedef short v4i16_t __attribute__((ext_vector_type(4)));
typedef GAS unsigned gu32;
#define RLX_AGENT __ATOMIC_RELAXED, __HIP_MEMORY_SCOPE_AGENT
#define LDS_WAIT() asm volatile("s_waitcnt lgkmcnt(0)" ::: "memory")
#define VM_WAIT() asm volatile("s_waitcnt vmcnt(0)" ::: "memory")
typedef __bf16 bf16x2_t __attribute__((ext_vector_type(2)));
__device__ __forceinline__ unsigned pk2(float lo, float hi) { f32x2 v = {lo, hi}; bf16x2_t b = __builtin_convertvector(v, bf16x2_t); return __builtin_bit_cast(unsigned, b); }
__device__ __forceinline__ float bf_lo(unsigned w) { return __uint_as_float(w << 16); }
__device__ __forceinline__ float bf_hi(unsigned w) { return __uint_as_float(w & 0xffff0000u); }
__device__ __forceinline__ float ex2(float x) { return __builtin_amdgcn_exp2f(x); }
__device__ __forceinline__ float lg2(float x) { return __builtin_amdgcn_logf(x); }
__device__ __forceinline__ float silu_f(float v) { return v / (1.0f + __expf(-v)); }
__device__ __forceinline__ int lane_id_opaque() { int l; asm volatile("v_mbcnt_lo_u32_b32 %0, -1, 0\n\tv_mbcnt_hi_u32_b32 %0, -1, %0" : "=v"(l)); return l; }

#define XB_TMO      128
#define XB_XCNT(j)  (256  + 64 * (j))
#define XB_XSUB(j)  (1280 + 64 * (j))
#define XB_XGEN(j)  (2304 + 64 * (j))
#define XB_TOP      3328
#define XB_TOPGEN   3392
#define XCD_BAR_WORDS 3456
#define XB_SPIN_CAP (1u << 18)
__device__ __forceinline__ unsigned xb_ld(unsigned* p)              { return __hip_atomic_load(p, __ATOMIC_RELAXED, __HIP_MEMORY_SCOPE_AGENT); }
__device__ __forceinline__ unsigned xb_add(unsigned* p, unsigned v) { return __hip_atomic_fetch_add(p, v, __ATOMIC_RELAXED, __HIP_MEMORY_SCOPE_AGENT); }
__device__ __forceinline__ unsigned xb_xcc_id() { return (unsigned)__builtin_amdgcn_s_getreg((3 << 11) | 20) & 0xFu; }
#define XB_SPIN(cond, bar) do { unsigned _sp = 0; while (cond) { __builtin_amdgcn_s_sleep(1); \
    if ((++_sp & 255u) == 0u) { if (xb_ld(&(bar)[XB_TMO])) break; if (_sp > XB_SPIN_CAP) { atomicAdd(&(bar)[XB_TMO], 1u); break; } } } } while (0)
struct XcdBarrier { unsigned* bar; unsigned x; volatile LAS unsigned* st; };
__device__ __forceinline__ XcdBarrier xcd_barrier_post(unsigned* bar, volatile LAS unsigned* st, int wave) {
    XcdBarrier b; b.bar = bar; b.x = xb_xcc_id(); b.st = st;
    if (wave == 0 && lane_id_opaque() == 0) (void)xb_add(&bar[XB_XCNT(b.x)], 1u);
    return b;
}
__device__ __forceinline__ void xcd_barrier_complete(unsigned* bar, unsigned x, unsigned& nloc, unsigned& nx) {
    const unsigned G = gridDim.x * gridDim.y * gridDim.z;
    unsigned sum, cnt, mine, sp = 0u;
    for (;;) {
        sum = 0u; cnt = 0u; mine = 0u;
#pragma unroll
        for (unsigned j = 0; j < 16; ++j) { const unsigned c = xb_ld(&bar[XB_XCNT(j)]); sum += c; cnt += (c > 0u) ? 1u : 0u; mine = (j == x) ? c : mine; }
        if (sum == G) break;
        __builtin_amdgcn_s_sleep(1);
        if ((++sp & 255u) == 0u) { if (xb_ld(&bar[XB_TMO])) break; if (sp > XB_SPIN_CAP) { atomicAdd(&bar[XB_TMO], 1u); break; } }
    }
    nloc = mine > 0u ? mine : 1u; nx = cnt > 0u ? cnt : 1u;
}
__device__ __forceinline__ void xcd_barrier(const XcdBarrier& b, int wave) {
    asm volatile("s_waitcnt vmcnt(0)" ::: "memory");
    __syncthreads();
    if (wave == 0 && lane_id_opaque() == 0) {
        unsigned* bar = b.bar;
        __builtin_amdgcn_s_waitcnt(0);
        unsigned nloc = b.st[0], nx = b.st[1];
        if (nloc == 0u) { xcd_barrier_complete(bar, b.x, nloc, nx); b.st[0] = nloc; b.st[1] = nx; }
        const unsigned old = xb_add(&bar[XB_XSUB(b.x)], 1u);
        const unsigned gen = old / nloc;
        if (old + 1u == (gen + 1u) * nloc) {
            __builtin_amdgcn_fence(__ATOMIC_RELEASE, "agent");
            asm volatile("s_waitcnt vmcnt(0)" ::: "memory");
            const unsigned og = xb_add(&bar[XB_TOP], 1u);
            const unsigned tg = og / nx;
            if (og + 1u == (tg + 1u) * nx) xb_add(&bar[XB_TOPGEN], 1u);
            else XB_SPIN(xb_ld(&bar[XB_TOPGEN]) == tg, bar);
            __builtin_amdgcn_fence(__ATOMIC_ACQUIRE, "agent");
            xb_add(&bar[XB_XGEN(b.x)], 1u);
            asm volatile("s_waitcnt vmcnt(0)" ::: "memory");
        } else {
            XB_SPIN(xb_ld(&bar[XB_XGEN(b.x)]) == gen, bar);
            __builtin_amdgcn_fence(__ATOMIC_ACQUIRE, "agent");
            asm volatile("s_waitcnt vmcnt(0)" ::: "memory");
        }
    }
    __syncthreads();
}

struct Frame {
    LAS unsigned char* lds;
    volatile LAS unsigned* MISC;
    gu32* ctl;
    unsigned char* ws;
    int wave;
    int vcu, G;
    float* out;
};
struct Args { const float* in[25]; float* out; unsigned char* ws; int ph_lo, ph_hi; };
__device__ __forceinline__ float wave_sum(float v) {
#pragma unroll
    for (int o = 1; o < 64; o <<= 1) v += __shfl_xor(v, o);
    return v;
}
#define PHASE_IDS(F) const int lane = lane_id_opaque(), wave = (F).wave, tid = wave * 64 + lane; (void)lane; (void)wave; (void)tid
struct ConvSrc { const float* W; int ldn; bf16* WT; int ldk; const float* scale; };
__device__ __forceinline__ void conv_load(const ConvSrc& c, int lane, f32x4 (&v)[8]) {
    const float* src = c.W + (size_t)(8 * (lane >> 3)) * c.ldn + 4 * (lane & 7);
#pragma unroll
    for (int t = 0; t < 8; ++t) v[t] = __builtin_nontemporal_load((const f32x4*)(src + (size_t)t * c.ldn));
}
__device__ __forceinline__ void conv_store(const ConvSrc& c, int lane, f32x4 (&v)[8]) {
    if (c.scale) { const f32x4 s0 = *(const f32x4*)(c.scale + 8 * (lane >> 3)), s1 = *(const f32x4*)(c.scale + 8 * (lane >> 3) + 4);
        v[0] *= s0.x; v[1] *= s0.y; v[2] *= s0.z; v[3] *= s0.w; v[4] *= s1.x; v[5] *= s1.y; v[6] *= s1.z; v[7] *= s1.w; }
    bf16* dst = c.WT + (size_t)(4 * (lane & 7)) * c.ldk + 8 * (lane >> 3);
#pragma unroll
    for (int j = 0; j < 4; ++j) { v4u o; o.x = pk2(v[0][j], v[1][j]); o.y = pk2(v[2][j], v[3][j]); o.z = pk2(v[4][j], v[5][j]); o.w = pk2(v[6][j], v[7][j]); __builtin_nontemporal_store(o, (v4u*)(dst + (size_t)j * c.ldk)); }
}
constexpr int CONV_N0 = 122 * 32 + 48 * 8 + 64 * 4, CONV_N1 = 64 * 32 + 384 * 32 + 32 * 1024 + 32 * 512, CONV_N2 = 64 * 64 + 32 * 1024 + 32 * 512;
__device__ __forceinline__ ConvSrc conv_moe_gu(const Args& A, unsigned char* ws, int le, int r) {
    const int nb = r / 32, kb = r % 32, t = nb >> 3, hf = (nb >> 2) & 1, jb = nb & 3;
    return ConvSrc{(hf ? A.in[22] : A.in[21]) + (size_t)le * 2048 * 512 + (size_t)(64 * kb) * 512 + 128 * t + 32 * jb, 512, (bf16*)(ws + WS_W_GU) + (size_t)le * 1024 * 2048 + (size_t)(32 * nb) * 2048 + 64 * kb, 2048, nullptr};
}
__device__ __forceinline__ ConvSrc conv_moe_dn(const Args& A, unsigned char* ws, int le, int r) {
    const int nb = r / 8, kb = r % 8;
    return ConvSrc{A.in[23] + (size_t)le * 512 * 2048 + (size_t)(64 * kb) * 2048 + 32 * nb, 2048, (bf16*)(ws + WS_W_DN) + (size_t)le * 2048 * 512 + (size_t)(32 * nb) * 512 + 64 * kb, 512, nullptr};
}
template <int STREAM> __device__ __forceinline__ ConvSrc conv_item(const Args& A, unsigned char* ws, int it) {
    if (STREAM == 0) {
        if (it < 122 * 32) { const int t = it / 32, kb = it % 32; const int dnb = t < 120 ? t : (t == 120 ? 120 : 124), sc = t < 120 ? 32 * t : (t == 120 ? 3840 : 3872);
            return ConvSrc{A.in[9] + (size_t)(64 * kb) * 3904 + sc, 3904, (bf16*)(ws + WS_W_IN0T) + (size_t)(32 * dnb) * 2048 + 64 * kb, 2048, nullptr}; }
        it -= 122 * 32;
        if (it < 48 * 8) { const int nb = it / 8, kb = it % 8; int sc;
            if (nb < 32) sc = (nb >> 2) * 192 + 32 * (nb & 3);
            else { const int t = (nb - 32) >> 3, blk = (nb - 32) & 7, hf = blk >> 2, hh = blk & 3; sc = (4 * t + hh) * 192 + 128 + 32 * hf; }
            return ConvSrc{A.in[11] + (size_t)(64 * kb) * 1536 + sc, 1536, (bf16*)(ws + WS_W_QUPT) + (size_t)(32 * nb) * 512 + 64 * kb, 512, A.in[10] + 64 * kb}; }
        it -= 48 * 8;
        { const int nb = it / 4, kb = it % 4;
            return ConvSrc{A.in[13] + (size_t)(64 * kb) * 2048 + 32 * nb, 2048, (bf16*)(ws + WS_W_KVUPT) + (size_t)(32 * nb) * 256 + 64 * kb, 256, A.in[12] + 64 * kb}; }
    } else if (STREAM == 1) {
        if (it < 64 * 32) { const int nb = it / 32, kb = it % 32;
            return ConvSrc{A.in[14] + (size_t)(64 * kb) * 2048 + 32 * nb, 2048, (bf16*)(ws + WS_W_OUT0T) + (size_t)(32 * nb) * 2048 + 64 * kb, 2048, nullptr}; }
        it -= 64 * 32;
        if (it < 384 * 32) { const int nb = it / 32, kb = it % 32;
            return ConvSrc{A.in[15] + (size_t)(64 * kb) * 12288 + 32 * nb, 12288, (bf16*)(ws + WS_W_IN1T) + (size_t)(32 * nb) * 2048 + 64 * kb, 2048, nullptr}; }
        it -= 384 * 32;
        if (it < 32 * 1024) return conv_moe_gu(A, ws, it / 1024, it % 1024);
        it -= 32 * 1024;
        return conv_moe_dn(A, ws, it / 512, it % 512);
    } else {
        if (it < 64 * 64) { const int nb = it / 64, kb = it % 64;
            return ConvSrc{A.in[16] + (size_t)(64 * kb) * 2048 + 32 * nb, 2048, (bf16*)(ws + WS_W_OUT1T) + (size_t)(32 * nb) * 4096 + 64 * kb, 4096, nullptr}; }
        it -= 64 * 64;
        if (it < 32 * 1024) return conv_moe_gu(A, ws, 32 + it / 1024, it % 1024);
        it -= 32 * 1024;
        return conv_moe_dn(A, ws, 32 + it / 512, it % 512);
    }
}
template <int STREAM> __device__ __forceinline__ void conv_burst(Frame& F, const Args& A, int lane, int gw, int NGW, int& cur, int n) {
    constexpr int N = STREAM == 0 ? CONV_N0 : (STREAM == 1 ? CONV_N1 : CONV_N2);
#pragma unroll 1
    while (n > 0) {
        const int i0 = gw + NGW * cur; if (i0 >= N) break;
        const int i1 = i0 + NGW; const bool two = n > 1 && i1 < N;
        const ConvSrc c0 = conv_item<STREAM>(A, F.ws, i0); f32x4 v0[8], v1[8];
        conv_load(c0, lane, v0);
        if (two) { const ConvSrc c1 = conv_item<STREAM>(A, F.ws, i1); conv_load(c1, lane, v1); conv_store(c0, lane, v0); conv_store(c1, lane, v1); cur += 2; n -= 2; }
        else { conv_store(c0, lane, v0); cur += 1; n -= 1; }
    }
}

__device__ __forceinline__ void p0a_mod_partials(Frame& F, const Args& A) {
    PHASE_IDS(F);
    const int gw = F.vcu * NWAVES + wave, NGW = F.G * NWAVES;
    LAS float* cond = (LAS float*)(F.lds + RING_OFF);
    for (int i = tid; i < NB_ * D_; i += 512) cond[i] = silu_f(A.in[1][i]);
    __syncthreads();
    float* MODP = (float*)(F.ws + WS_MODP);
    for (int u = gw; u < 1536; u += NGW) {
        const int j = u / 384, r = u % 384, nc = r / 16, kc = r % 16, layer = j >> 1;
        const float* W = ((j & 1) ? A.in[6] : A.in[3]) + (size_t)layer * 2048 * 6144 + (size_t)(kc * 128) * 6144 + nc * 256 + 4 * lane;
        f32x4 acc[4];
#pragma unroll
        for (int b = 0; b < 4; ++b) acc[b] = (f32x4){0.f, 0.f, 0.f, 0.f};
#pragma unroll 32
        for (int k = 0; k < 128; ++k) { const f32x4 w = *(const f32x4*)(W + (size_t)k * 6144);
#pragma unroll
            for (int b = 0; b < 4; ++b) acc[b] += cond[b * 2048 + kc * 128 + k] * w; }
#pragma unroll
        for (int b = 0; b < 4; ++b) *(f32x4*)(MODP + ((size_t)(kc * 16 + j * 4 + b)) * 6144 + nc * 256 + 4 * lane) = acc[b];
    }
}
__device__ __forceinline__ void p0_prologue(Frame& F, const Args& A) {
    PHASE_IDS(F);
    const int gw = F.vcu * NWAVES + wave, NGW = F.G * NWAVES;
    const int gt = F.vcu * 512 + tid, NGT = F.G * 512;
    { float* MOD = (float*)(F.ctl + CW_MOD); const float* MODP = (const float*)(F.ws + WS_MODP);
      for (int idx = gt; idx < 16 * 6144; idx += NGT) { const int j = idx / (4 * 6144), n = idx % 6144; float a = ((j & 1) ? A.in[7] : A.in[4])[(j >> 1) * 6144 + n];
#pragma unroll
          for (int kc = 0; kc < 16; ++kc) a += MODP[(size_t)kc * 16 * 6144 + idx];
          MOD[idx] = a; } }
    { int cur = 0; conv_burst<0>(F, A, lane, gw, NGW, cur, 1 << 20); }
    { const int* pos = (const int*)A.in[2]; f32x2* t64 = (f32x2*)(F.ws + WS_TAB64); f32x2* t256 = (f32x2*)(F.ws + WS_TAB256);
      for (int idx = gt; idx < T_ * 160; idx += NGT) { const int m = idx / 160, i = idx % 160; const double p = (double)pos[m];
          double fr; if (i < 32) fr = exp(-9.210340371976184 * (double)i / 32.0); else fr = exp(-9.210340371976184 * (double)(i - 32) / 128.0);
          double sn, cs; sincos(p * fr, &sn, &cs); const f32x2 v = {(float)cs, (float)sn};
          if (i < 32) t64[m * 32 + i] = v; else t256[m * 128 + (i - 32)] = v; } }
    { float* WR = (float*)(F.ws + WS_WR);
      for (int idx = gt; idx < 2 * 512 * 36 * 4; idx += NGT) { const int q = idx & 3, c = (idx >> 2) % 36, kq = ((idx >> 2) / 36) % 512, l = (idx >> 2) / (36 * 512); const int k = 4 * kq + q;
          WR[idx] = c < 4 ? A.in[17][(size_t)l * 2048 * 4 + k * 4 + c] : A.in[19][(size_t)l * 2048 * 32 + k * 32 + (c - 4)]; } }
}

__device__ __forceinline__ void local_mod(Frame& F, const float* bias, int j) {
    PHASE_IDS(F);
    const float* MODP = (const float*)(F.ws + WS_MODP); LAS f32x4* lm = (LAS f32x4*)(F.lds + RING_OFF);
    __syncthreads();
    for (int q = tid; q < 4096; q += 512) { const int b = q >> 10, n = 4 * (q & 1023); f32x4 a = *(const f32x4*)(bias + n);
#pragma unroll
        for (int kc = 0; kc < 16; ++kc) a += *(const f32x4*)(MODP + ((size_t)(kc * 16 + j * 4 + b)) * 6144 + n);
        lm[q] = a; }
    __syncthreads();
}
template <int MODE, bool LM = false> __device__ __forceinline__ void norm_phase(Frame& F, const float* src, float* xdst, const float* gvec, int jn, int jg, int layer_moe) {
    PHASE_IDS(F);
    const int gw = F.vcu * NWAVES + wave, NGW = F.G * NWAVES;
    const float* MOD = (const float*)(F.ctl + CW_MOD);
    bf16* H = (bf16*)(F.ws + WS_H);
    const bf16* Y = (const bf16*)(F.ws + WS_Y);
    const int* RT = (const int*)(F.ws + WS_ROUTE);
    v4u ra = {0u, 0u, 0u, 0u}, rb = {0u, 0u, 0u, 0u};
    if (MODE >= 2) { const int row_l = gw + NGW * lane; if (row_l < T_) { const v4u* rp = (const v4u*)(RT + (size_t)row_l * 8); ra = rp[0]; rb = rp[1]; } }
    for (int row = gw, ri = 0; row < T_; row += NGW, ++ri) {
        const int b = row >> 11;
        f32x4 v[8]; float ss = 0.f;
        const f32x4* xr = (const f32x4*)(src + (size_t)row * D_) + lane;
#pragma unroll
        for (int j = 0; j < 8; ++j) v[j] = xr[64 * j];
        if (MODE >= 2) {
            const int p0 = __shfl((int)rb.x, ri), p1 = __shfl((int)rb.y, ri); const float w0 = __int_as_float(__shfl((int)ra.z, ri)), w1 = __int_as_float(__shfl((int)ra.w, ri));
            const v2u* y0 = (const v2u*)(Y + (size_t)p0 * D_) + lane; const v2u* y1 = (const v2u*)(Y + (size_t)p1 * D_) + lane;
            const f32x4* gt = (const f32x4*)(MOD + (size_t)(jg * 4 + b) * 6144 + 4096) + lane;
#pragma unroll
            for (int j = 0; j < 8; ++j) { const v2u a = y0[64 * j], c = y1[64 * j]; const f32x4 g = gt[64 * j];
                f32x4 m; m.x = w0 * bf_lo(a.x) + w1 * bf_lo(c.x); m.y = w0 * bf_hi(a.x) + w1 * bf_hi(c.x); m.z = w0 * bf_lo(a.y) + w1 * bf_lo(c.y); m.w = w0 * bf_hi(a.y) + w1 * bf_hi(c.y);
                v[j] += g * m; }
            if (MODE == 2) { f32x4* xo = (f32x4*)(xdst + (size_t)row * D_) + lane;
#pragma unroll
                for (int j = 0; j < 8; ++j) xo[64 * j] = v[j]; }
        }
#pragma unroll
        for (int j = 0; j < 8; ++j) ss += (v[j].x * v[j].x + v[j].y * v[j].y) + (v[j].z * v[j].z + v[j].w * v[j].w);
        const float rstd = 1.0f / sqrtf(wave_sum(ss) * (1.0f / D_) + EPS_);
        const f32x4* gv = (const f32x4*)gvec + lane;
        if (MODE == 3) { f32x4* o = (f32x4*)(F.out + (size_t)row * D_) + lane;
#pragma unroll
            for (int j = 0; j < 8; ++j) o[64 * j] = v[j] * rstd * gv[64 * j];
        } else {
            v2u* o = (v2u*)(H + (size_t)row * D_) + lane;
            if (LM) { const LAS f32x4* sh = (const LAS f32x4*)(F.lds + RING_OFF) + b * 1024 + lane; const LAS f32x4* sc = sh + 512;
#pragma unroll
                for (int j = 0; j < 8; ++j) { const f32x4 h = v[j] * rstd * gv[64 * j] * (1.0f + sc[64 * j]) + sh[64 * j]; v2u w; w.x = pk2(h.x, h.y); w.y = pk2(h.z, h.w); o[64 * j] = w; }
            } else { const f32x4* sh = (const f32x4*)(MOD + (size_t)(jn * 4 + b) * 6144) + lane; const f32x4* sc = sh + 512;
#pragma unroll
                for (int j = 0; j < 8; ++j) { const f32x4 h = v[j] * rstd * gv[64 * j] * (1.0f + sc[64 * j]) + sh[64 * j]; v2u w; w.x = pk2(h.x, h.y); w.y = pk2(h.z, h.w); o[64 * j] = w; } }
        }
    }
}

__device__ __forceinline__ void router_phase(Frame& F, const Args& A, const float* X, const float* gvec, int jn, int layer, bool first) {
    const float* MOD = (const float*)(F.ctl + CW_MOD);
    const f32x4* WR4 = (const f32x4*)(F.ws + WS_WR) + (size_t)layer * 512 * 36;
    int* RT = (int*)(F.ws + WS_ROUTE); float* RS = (float*)(F.ws + WS_RS);
    LAS f32x4* hs = (LAS f32x4*)(F.lds + RING_OFF);
    LAS f32x4* wsm = (LAS f32x4*)(F.lds + RING_OFF + 40960);
    LAS f32x4* shs = (LAS f32x4*)(F.lds + RING_OFF + 81920);
    LAS float* rs = (LAS float*)(F.lds + RING_OFF + 83968);
    LAS float* lg = (LAS float*)(F.lds + RING_OFF + 84224);
    PHASE_IDS(F);
    const int r = tid >> 4, kp = tid & 15, kpart = lane & 15, cg = lane >> 4;
    int wpos[5];
#pragma unroll
    for (int i = 0; i < 5; ++i) { const int idx = tid + 512 * i; wpos[i] = idx + idx / 36; }
    for (int tile = F.vcu; tile < T_ / 32; tile += F.G) {
        const int row0 = tile * 32, b = row0 >> 11;
        const f32x4* sh = (const f32x4*)(MOD + (size_t)(jn * 4 + b) * 6144); const f32x4* sc = sh + 512; const f32x4* gv = (const f32x4*)gvec;
        const f32x4* xr = (const f32x4*)(X + (size_t)(row0 + r) * D_);
        float acc[4][9], accq[9], ss = 0.f;
#pragma unroll
        for (int c = 0; c < 9; ++c) { accq[c] = 0.f;
#pragma unroll
            for (int rr = 0; rr < 4; ++rr) acc[rr][c] = 0.f; }
        f32x4 xq[4], gq[4], sq[4], wq[5];
#define RT_LOAD(ch) do { _Pragma("unroll") for (int g = 0; g < 4; ++g) { const int q = (ch) * 64 + kp + 16 * g; xq[g] = xr[q]; gq[g] = gv[q] * (1.0f + sc[q]); if (r == 0) sq[g] = sh[q]; } \
            _Pragma("unroll") for (int i = 0; i < 5; ++i) { const int idx = tid + 512 * i; if (idx < 2304) wq[i] = WR4[(size_t)(ch) * 2304 + idx]; } } while (0)
        RT_LOAD(0);
#pragma unroll 1
        for (int ch = 0; ch < 8; ++ch) {
#pragma unroll
            for (int g = 0; g < 4; ++g) { const f32x4 x = xq[g]; ss += (x.x * x.x + x.y * x.y) + (x.z * x.z + x.w * x.w); hs[r * 65 + kp + 16 * g] = x * gq[g]; if (r == 0) shs[kp + 16 * g] = sq[g]; }
#pragma unroll
            for (int i = 0; i < 5; ++i) if (tid + 512 * i < 2304) wsm[wpos[i]] = wq[i];
            __syncthreads();
            if (ch + 1 < 8) RT_LOAD(ch + 1);
#pragma unroll 1
            for (int g = 0; g < 4; ++g) { const int kq = kpart + 16 * g; f32x4 h4[4];
#pragma unroll
                for (int rr = 0; rr < 4; ++rr) h4[rr] = hs[(wave * 4 + rr) * 65 + kq];
                const f32x4 q4 = shs[kq];
#pragma unroll
                for (int c = 0; c < 9; ++c) { const f32x4 w4 = wsm[kq * 37 + 9 * cg + c];
#pragma unroll
                    for (int rr = 0; rr < 4; ++rr) acc[rr][c] += (h4[rr].x * w4.x + h4[rr].y * w4.y) + (h4[rr].z * w4.z + h4[rr].w * w4.w);
                    if (wave == 0) accq[c] += (q4.x * w4.x + q4.y * w4.y) + (q4.z * w4.z + q4.w * w4.w); } }
            __syncthreads();
        }
#undef RT_LOAD
#pragma unroll
        for (int rr = 0; rr < 4; ++rr)
#pragma unroll
            for (int c = 0; c < 9; ++c) { float a = acc[rr][c]; a += __shfl_xor(a, 1); a += __shfl_xor(a, 2); a += __shfl_xor(a, 4); a += __shfl_xor(a, 8); if (kpart == 0) lg[(wave * 4 + rr) * 36 + 9 * cg + c] = a; }
        if (wave == 0) {
#pragma unroll
            for (int c = 0; c < 9; ++c) { float a = accq[c]; a += __shfl_xor(a, 1); a += __shfl_xor(a, 2); a += __shfl_xor(a, 4); a += __shfl_xor(a, 8); if (kpart == 0) lg[1152 + 9 * cg + c] = a; } }
        ss += __shfl_xor(ss, 1); ss += __shfl_xor(ss, 2); ss += __shfl_xor(ss, 4); ss += __shfl_xor(ss, 8);
        if (kp == 0) rs[r] = 1.0f / sqrtf(ss * (1.0f / D_) + EPS_);
        __syncthreads();
        if (tid < 32) { const int row = row0 + tid; const LAS float* l = lg + tid * 36; const LAS float* q = lg + 1152; const float* bg = A.in[18] + layer * 4; const float* be = A.in[20] + layer * 32; const float rstd = rs[tid];
            if (first) RS[row] = rstd;
            float g[4]; int gi = 0; float gm;
#pragma unroll
            for (int i = 0; i < 4; ++i) g[i] = rstd * l[i] + q[i] + bg[i];
            gm = g[0];
#pragma unroll
            for (int i = 1; i < 4; ++i) if (g[i] > gm) { gm = g[i]; gi = i; }
            float gs = 0.f;
#pragma unroll
            for (int i = 0; i < 4; ++i) gs += __expf(g[i] - gm);
            const float gw = 1.0f / gs;
            float e[8];
#pragma unroll
            for (int i = 0; i < 8; ++i) e[i] = rstd * l[4 + 8 * gi + i] + q[4 + 8 * gi + i] + be[8 * gi + i];
            int i0 = 0; float m0 = e[0];
#pragma unroll
            for (int i = 1; i < 8; ++i) if (e[i] > m0) { m0 = e[i]; i0 = i; }
            int i1 = -1; float m1 = -3.0e38f;
#pragma unroll
            for (int i = 0; i < 8; ++i) if (i != i0 && e[i] > m1) { m1 = e[i]; i1 = i; }
            const float p1 = __expf(m1 - m0), w0 = gw / (1.0f + p1), w1 = gw * p1 / (1.0f + p1);
            const int e0 = 8 * gi + i0, e1 = 8 * gi + i1;
            int* rt = RT + (size_t)row * 8; rt[0] = e0; rt[1] = e1; rt[2] = __float_as_int(w0); rt[3] = __float_as_int(w1);
            if (first) { atomicAdd((unsigned*)(F.ctl + CW_ECNT + 64 * layer + e0), 1u); atomicAdd((unsigned*)(F.ctl + CW_ECNT + 64 * layer + e1), 1u); }
        }
        __syncthreads();
    }
}

__device__ __forceinline__ void scatter_phase(Frame& F, const float* X, const float* gvec, int jn, int layer, bool first) {
    LAS int* tab = (LAS int*)(F.lds + MOE_TAB_OFF);
    PHASE_IDS(F);
    const int gw = F.vcu * NWAVES + wave, NGW = F.G * NWAVES;
    const float* MOD = (const float*)(F.ctl + CW_MOD);
    int* RT = (int*)(F.ws + WS_ROUTE); const float* RS = (const float*)(F.ws + WS_RS); bf16* HG = (bf16*)(F.ws + WS_HG);
    int myp0 = 0, myp1 = 0;
    { const int tok_l = gw + NGW * lane;
      if (tok_l < T_) { int* rt = RT + (size_t)tok_l * 8;
          if (first) { const int e0 = rt[0], e1 = rt[1];
              myp0 = tab[128 + e0] + (int)atomicAdd((unsigned*)(F.ctl + CW_ECUR + 64 * layer + e0), 1u);
              myp1 = tab[128 + e1] + (int)atomicAdd((unsigned*)(F.ctl + CW_ECUR + 64 * layer + e1), 1u);
              rt[4] = myp0; rt[5] = myp1; }
          else { myp0 = rt[4]; myp1 = rt[5]; } } }
    for (int i = 0; gw + NGW * i < T_; ++i) {
        const int tok = gw + NGW * i;
        const int p0 = __shfl(myp0, i), p1 = __shfl(myp1, i);
        const f32x4* xr = (const f32x4*)(X + (size_t)tok * D_) + lane; f32x4 v[8];
#pragma unroll
        for (int j = 0; j < 8; ++j) v[j] = xr[64 * j];
        const float rstd = RS[tok]; const int b = tok >> 11;
        const f32x4* sh = (const f32x4*)(MOD + (size_t)(jn * 4 + b) * 6144) + lane; const f32x4* sc = sh + 512; const f32x4* gv = (const f32x4*)gvec + lane;
        v2u* d0 = (v2u*)(HG + (size_t)p0 * D_) + lane; v2u* d1 = (v2u*)(HG + (size_t)p1 * D_) + lane;
#pragma unroll
        for (int j = 0; j < 8; ++j) { const f32x4 h = v[j] * rstd * gv[64 * j] * (1.0f + sc[64 * j]) + sh[64 * j]; v2u w; w.x = pk2(h.x, h.y); w.y = pk2(h.z, h.w); d0[64 * j] = w; d1[64 * j] = w; }
    }
}

__device__ __forceinline__ void retnorm_phase(Frame& F) {
    PHASE_IDS(F);
    const int gw = F.vcu * NWAVES + wave, NGW = F.G * NWAVES;
    const bf16* O = (const bf16*)(F.ws + WS_RETO); const bf16* P1 = (const bf16*)(F.ws + WS_PROJ1); bf16* A5 = (bf16*)(F.ws + WS_A5);
    for (int row = gw; row < T_; row += NGW) {
        const v4u* o = (const v4u*)(O + (size_t)row * 4096) + lane; const v4u* g = (const v4u*)(P1 + (size_t)row * 12288 + 8192) + lane; v4u* a = (v4u*)(A5 + (size_t)row * 4096) + lane;
#pragma unroll
        for (int h = 0; h < 8; ++h) { const v4u x = o[64 * h], s = g[64 * h];
            float f[8] = {bf_lo(x.x), bf_hi(x.x), bf_lo(x.y), bf_hi(x.y), bf_lo(x.z), bf_hi(x.z), bf_lo(x.w), bf_hi(x.w)};
            float ss = 0.f;
#pragma unroll
            for (int i = 0; i < 8; ++i) ss += f[i] * f[i];
            const float rstd = 1.0f / sqrtf(wave_sum(ss) * (1.0f / 512.0f) + EPS_);
            v4u w; w.x = pk2(f[0] * rstd * bf_lo(s.x), f[1] * rstd * bf_hi(s.x)); w.y = pk2(f[2] * rstd * bf_lo(s.y), f[3] * rstd * bf_hi(s.y));
            w.z = pk2(f[4] * rstd * bf_lo(s.z), f[5] * rstd * bf_hi(s.z)); w.w = pk2(f[6] * rstd * bf_lo(s.w), f[7] * rstd * bf_hi(s.w));
            a[64 * h] = w; }
    }
}
#ifndef ATT_REP
#define ATT_REP 1
#endif
#ifndef RET_REP
#define RET_REP 1
#endif
#ifndef ATT_KPF
#define ATT_KPF 4
#endif
constexpr int ATT_VST = 320;
__device__ __forceinline__ s16x4 vtr(const LAS unsigned char* p) { return __builtin_bit_cast(s16x4, __builtin_amdgcn_ds_read_tr16_b64_v4i16((LAS v4i16_t*)p)); }
__device__ __forceinline__ float xhalf(float v) { return __shfl_xor(v, 32); }

template <int DQK, int MODE>
__device__ __forceinline__ void attn_unit(LAS unsigned char* lds, const bf16* Qp, int qpitch, const bf16* Kp, int kpitch, const bf16* K2p, int k2pitch,
                                          const bf16* Vp, int vpitch, bf16* Op, int opitch, int q0, float dlog2, int tid_, int wave, int lane_, volatile LAS unsigned* flg) {
    const int lane = lane_id_opaque(), tid = wave * 64 + lane; (void)tid_; (void)lane_;
    constexpr int RB = DQK * 2, SW = (DQK == 192) ? 7 : 15, KB = 64 * RB, STG = KB + 16384;
    constexpr int NIK = KB / 8192, NI = NIK + 2;
    constexpr int NKS = DQK / 16;
    static_assert(3 * STG <= RING_BYTES, "three stages in the ring");
    const int r = lane & 31, h = lane >> 5, qrow = q0 + 32 * wave + r;
    bf16x8 qf[NKS];
    { const bf16* qp = Qp + (size_t)qrow * qpitch + 8 * h;
#pragma unroll
      for (int ks = 0; ks < NKS; ++ks) qf[ks] = *(const bf16x8*)(qp + 16 * ks); }
    f32x16 o[4];
#pragma unroll
    for (int db = 0; db < 4; ++db)
#pragma unroll
        for (int i = 0; i < 16; ++i) o[db][i] = 0.f;
    float m_run = -1.0e30f, l_run = 0.f, carry = 0.f;
    const int ntiles = (q0 + 256) >> 6;
    constexpr bool KLIN = (DQK != 192); constexpr int NKG = KLIN ? 1 : NIK;
    unsigned kgo[NKG], vgo0; bool krope[NKG];
#pragma unroll
    for (int j = 0; j < NKG; ++j) { const int pos = (j * 8 + wave) * 1024 + lane * 16, row = pos / RB, c = ((pos % RB) >> 4) ^ (row & SW);
        krope[j] = (DQK == 192) && c >= 16;
        kgo[j] = krope[j] ? (unsigned)(row * k2pitch * 2 + (c - 16) * 16) : (unsigned)(row * kpitch * 2 + c * 16); }
    { const int pos = wave * 1024 + lane * 16, row = pos >> 8, ch = ((pos & 255) >> 4) ^ (((row & 3) << 2) | ((row >> 2) & 3)); vgo0 = (unsigned)(row * vpitch * 2 + ch * 16); }
#define ATT_DMA(kt, stg) do { const size_t key0_ = (size_t)(kt) * 64; \
        const char* kb_ = (const char*)Kp + key0_ * kpitch * 2; const char* k2_ = (const char*)K2p + key0_ * k2pitch * 2; const char* vb_ = (const char*)Vp + key0_ * vpitch * 2; \
        LAS unsigned char* st_ = lds + (stg) * STG + wave * 1024; \
        _Pragma("unroll") for (int j_ = 0; j_ < NIK; ++j_) { const char* g_ = KLIN ? kb_ + kgo[0] + (size_t)j_ * (8192 / RB) * kpitch * 2 : ((krope[KLIN ? 0 : j_] ? k2_ : kb_) + kgo[KLIN ? 0 : j_]); \
            __builtin_amdgcn_global_load_lds((const unsigned*)g_, (LAS unsigned*)(st_ + j_ * 8192), 16, 0, 0); } \
        _Pragma("unroll") for (int j_ = 0; j_ < 2; ++j_) __builtin_amdgcn_global_load_lds((const unsigned*)(vb_ + vgo0 + (size_t)j_ * 32 * vpitch * 2), (LAS unsigned*)(st_ + KB + j_ * 8192), 16, 0, 0); } while (0)
    if (MODE == 1 && tid < 16) flg[tid] = 0u;
    ATT_DMA(ntiles - 1, 0);
    ATT_DMA(ntiles > 1 ? ntiles - 2 : 0, 1);
    const int q4 = (lane & 15) >> 2, p4 = lane & 3, blk = (lane >> 4) & 1, x4 = 2 * blk + (p4 >> 1);
    constexpr int NKO = (SW + 1) / 2;
    const int krow = r * RB, kxy = (r & SW) ^ h;
    const int vlo_off = 256 * (4 * h + q4) + 16 * (x4 ^ h) + 8 * (p4 & 1), vhi_off = 256 * (4 * h + q4 + 8) + 16 * (x4 ^ (h + 2)) + 8 * (p4 & 1);
    for (int it = 0; it < ntiles; ++it) {
        const int kt = ntiles - 1 - it;
        int y_ = kxy, q4_ = q4; asm volatile("" : "+v"(y_), "+v"(q4_));
        const bool wdone = (MODE == 1) && __all(carry < -140.0f);
        if (MODE == 1 && lane == 0) flg[8 * (it & 1) + wave] = wdone ? 1u : 0u;
        asm volatile("s_waitcnt vmcnt(%0)" :: "n"(NI) : "memory");
        asm volatile("s_waitcnt lgkmcnt(0)" ::: "memory");
        __builtin_amdgcn_s_barrier();
        asm volatile("" ::: "memory");
        if (MODE == 1) { v4u fa, fb; const unsigned fad = (unsigned)(size_t)(flg + 8 * (it & 1));
            asm volatile("ds_read_b128 %0, %2\n\tds_read_b128 %1, %2 offset:16\n\ts_waitcnt lgkmcnt(0)" : "=&v"(fa), "=&v"(fb) : "v"(fad) : "memory");
            if ((fa.x & fa.y & fa.z & fa.w & fb.x & fb.y & fb.z & fb.w) != 0u) break; }
        { const int ktn = kt >= 2 ? kt - 2 : 0; ATT_DMA(ktn, (it + 2) % 3); }
        if (!wdone && 64 * kt <= q0 + 32 * wave + 31) {
            const LAS unsigned char* Kb = lds + (it % 3) * STG; const LAS unsigned char* Vb = Kb + KB;
            f32x16 s[2];
            const int kbase = 64 * kt + 4 * h;
            const bool diag = 64 * kt + 63 > q0 + 32 * wave;
            unsigned va[8];
#pragma unroll
            for (int db = 0; db < 4; ++db) { va[db] = (unsigned)(size_t)(Vb + vlo_off + 64 * (db ^ q4_)); va[4 + db] = (unsigned)(size_t)(Vb + vhi_off + 64 * (db ^ q4_)); }
            s16x4 lo_[2][4], hi_[2][4];
#define ATT_VRD(buf, sidx) do { _Pragma("unroll") for (int db = 0; db < 4; ++db) { \
                    asm volatile("ds_read_b64_tr_b16 %0, %1 offset:%c2" : "=&v"(lo_[buf][db]) : "v"(va[db]), "i"(4096 * (sidx)) : "memory"); \
                    asm volatile("ds_read_b64_tr_b16 %0, %1 offset:%c2" : "=&v"(hi_[buf][db]) : "v"(va[4 + db]), "i"(4096 * (sidx)) : "memory"); } } while (0)
#define ATT_VMM(buf, sidx) do { const int kb_ = (sidx) >> 1, ss_ = (sidx) & 1; \
                v4u pw; pw.x = pk2(s[kb_][8 * ss_ + 0], s[kb_][8 * ss_ + 1]); pw.y = pk2(s[kb_][8 * ss_ + 2], s[kb_][8 * ss_ + 3]); pw.z = pk2(s[kb_][8 * ss_ + 4], s[kb_][8 * ss_ + 5]); pw.w = pk2(s[kb_][8 * ss_ + 6], s[kb_][8 * ss_ + 7]); \
                const bf16x8 pf = __builtin_bit_cast(bf16x8, pw); \
                _Pragma("unroll") for (int db = 0; db < 4; ++db) { \
                    const bf16x8 vf = __builtin_shufflevector(lo_[buf][db], hi_[buf][db], 0, 1, 2, 3, 4, 5, 6, 7); \
                    o[db] = __builtin_amdgcn_mfma_f32_32x32x16_bf16(vf, pf, o[db], 0, 0, 0); } } while (0)
#define ATT_PVN(first, count) do { ATT_VRD(0, first); \
                _Pragma("unroll") for (int i_ = 0; i_ < (count); ++i_) { \
                    if (i_ + 1 < (count)) { if (i_ & 1) ATT_VRD(0, (first) + i_ + 1); else ATT_VRD(1, (first) + i_ + 1); asm volatile("s_waitcnt lgkmcnt(8)" ::: "memory"); } \
                    else asm volatile("s_waitcnt lgkmcnt(0)" ::: "memory"); \
                    __builtin_amdgcn_sched_barrier(0); \
                    if (i_ & 1) ATT_VMM(1, (first) + i_); else ATT_VMM(0, (first) + i_); \
                    __builtin_amdgcn_sched_barrier(0); } } while (0)
#pragma unroll
            for (int kb = 0; kb < 2; ++kb) {
#pragma unroll
                for (int i = 0; i < 16; ++i) s[kb][i] = 0.f;
                const LAS unsigned char* kp = Kb + 32 * kb * RB;
#define ATT_KF(ks) (*(const LAS bf16x8*)(kp + krow + (((2 * ((ks) % NKO)) ^ y_) << 4) + (((2 * (ks)) & ~SW) << 4)))
                bf16x8 fa = ATT_KF(0), fb = ATT_KF(1);
#pragma unroll
                for (int g2 = 0; g2 < NKS / 2; ++g2) {
                    bf16x8 na = fa, nb = fb;
                    if (g2 + 1 < NKS / 2) { na = ATT_KF(2 * g2 + 2); nb = ATT_KF(2 * g2 + 3); }
                    __builtin_amdgcn_sched_barrier(0);
                    s[kb] = __builtin_amdgcn_mfma_f32_32x32x16_bf16(fa, qf[2 * g2], s[kb], 0, 0, 0); s[kb] = __builtin_amdgcn_mfma_f32_32x32x16_bf16(fb, qf[2 * g2 + 1], s[kb], 0, 0, 0);
                    __builtin_amdgcn_sched_barrier(0);
                    fa = na; fb = nb;
                }
#undef ATT_KF
                if (MODE == 2) {
                    if (diag) {
#pragma unroll
                        for (int i = 0; i < 16; ++i) { const int key = kbase + 32 * kb + (i & 3) + 8 * (i >> 2); s[kb][i] = key <= qrow ? s[kb][i] : 0.f; } }
                    ATT_PVN(2 * kb, 2);
                }
            }
            if (MODE == 0) {
                float tmax = -1.0e30f;
#pragma unroll
                for (int kb = 0; kb < 2; ++kb)
#pragma unroll
                    for (int i = 0; i < 16; ++i) { const int key = kbase + 32 * kb + (i & 3) + 8 * (i >> 2); const float v = (!diag || key <= qrow) ? s[kb][i] : -1.0e30f; s[kb][i] = v; tmax = fmaxf(tmax, v); }
                tmax = fmaxf(tmax, xhalf(tmax));
                const float m_new = fmaxf(m_run, tmax), alpha = ex2(m_run - m_new); m_run = m_new;
                float ps = 0.f;
#pragma unroll
                for (int kb = 0; kb < 2; ++kb)
#pragma unroll
                    for (int i = 0; i < 16; ++i) { const float p = ex2(s[kb][i] - m_new); s[kb][i] = p; ps += p; }
                l_run = l_run * alpha + ps;
#pragma unroll
                for (int db = 0; db < 4; ++db)
#pragma unroll
                    for (int i = 0; i < 16; ++i) o[db][i] *= alpha;
            } else if (MODE == 1) {
                float lkv[2][16], gs[2][4], go[2][4];
#pragma unroll
                for (int kb = 0; kb < 2; ++kb)
#pragma unroll
                    for (int g = 0; g < 4; ++g) { float t = 0.f;
#pragma unroll
                        for (int j = 0; j < 4; ++j) { const int i = 4 * g + j, key = kbase + 32 * kb + 8 * g + j; const float z = s[kb][i];
                            const bool vis = key < qrow;
                            const float lk = vis ? -(fmaxf(z, 0.f) + lg2(1.0f + ex2(-fabsf(z)))) : 0.f;
                            lkv[kb][i] = lk; s[kb][i] = vis ? z + lk : -1.0e30f; t += lk; }
                        gs[kb][g] = t; }
#pragma unroll
                for (int kb = 0; kb < 2; ++kb)
#pragma unroll
                    for (int g = 0; g < 4; ++g) go[kb][g] = xhalf(gs[kb][g]);
                float R = carry;
#pragma unroll
                for (int kb = 1; kb >= 0; --kb)
#pragma unroll
                    for (int g = 3; g >= 0; --g) {
                        float run = R + (h == 0 ? go[kb][g] : 0.f);
#pragma unroll
                        for (int j = 3; j >= 0; --j) { const int i = 4 * g + j; const float a = ex2(s[kb][i] + run); run += lkv[kb][i]; s[kb][i] = a; }
                        R += gs[kb][g] + go[kb][g];
                    }
                carry = R;
            }
            if (MODE != 2) { ATT_PVN(0, 4); }
#undef ATT_PVN
#undef ATT_VMM
#undef ATT_VRD
        }
    }
#undef ATT_DMA
    asm volatile("s_waitcnt vmcnt(0) lgkmcnt(0)" ::: "memory");
    __builtin_amdgcn_s_barrier();
    asm volatile("" ::: "memory");
    float inv = 1.0f;
    if (MODE == 0) { const float lt = l_run + xhalf(l_run); inv = 1.0f / lt; }
    bf16* op = Op + (size_t)qrow * opitch + 4 * h;
#pragma unroll
    for (int db = 0; db < 4; ++db)
#pragma unroll
        for (int g = 0; g < 4; ++g) { v2u w; w.x = pk2(o[db][4 * g] * inv, o[db][4 * g + 1] * inv); w.y = pk2(o[db][4 * g + 2] * inv, o[db][4 * g + 3] * inv); *(v2u*)(op + 32 * db + 8 * g) = w; }
}

struct WorkQ { gu32* q; int total; int slot; unsigned nxt; };
__device__ __forceinline__ void wq_init(Frame& F, WorkQ& Q, gu32* q, int total, int slot, int lane) {
    Q.q = q; Q.total = total; Q.slot = slot; Q.nxt = 0u;
    if (F.wave == 0 && lane == 0) Q.nxt = __hip_atomic_fetch_add(q, 1u, RLX_AGENT);
}
__device__ __forceinline__ bool wq_take(Frame& F, WorkQ& Q, int lane, int& u) {
    if (F.wave == 0 && lane == 0) F.MISC[Q.slot] = Q.nxt;
    __syncthreads();
    u = (int)F.MISC[Q.slot];
    __syncthreads();
    if (u >= Q.total) return false;
    if (F.wave == 0 && lane == 0) Q.nxt = __hip_atomic_fetch_add(Q.q, 1u, RLX_AGENT);
    return true;
}
template <int STREAM> __device__ __forceinline__ bool conv_batch(Frame& F, const Args& A, WorkQ& Q, int lane, int wave) {
    int b; if (!wq_take(F, Q, lane, b)) return false;
    const int i0 = 32 * b + 4 * wave;
    const ConvSrc c0 = conv_item<STREAM>(A, F.ws, i0), c1 = conv_item<STREAM>(A, F.ws, i0 + 1), c2 = conv_item<STREAM>(A, F.ws, i0 + 2), c3 = conv_item<STREAM>(A, F.ws, i0 + 3);
    f32x4 v0[8], v1[8], v2[8], v3[8];
    conv_load(c0, lane, v0); conv_load(c1, lane, v1); conv_load(c2, lane, v2); conv_load(c3, lane, v3);
    conv_store(c0, lane, v0); conv_store(c1, lane, v1); conv_store(c2, lane, v2); conv_store(c3, lane, v3);
    return true;
}
__device__ __forceinline__ void mla_phase(Frame& F, const Args& A, WorkQ& QC, bool& conv_left) {
    PHASE_IDS(F);
    WorkQ QU; wq_init(F, QU, F.ctl + CW_QMLA, 256, 16, lane);
    if (F.vcu & 1) { for (int i = 0; i < 8 && conv_left; ++i) conv_left = conv_batch<1>(F, A, QC, lane, wave); }
    const bf16* Q = (const bf16*)(F.ws + WS_QMLA); const bf16* KV = (const bf16*)(F.ws + WS_KVMLA); const bf16* KR = (const bf16*)(F.ws + WS_KR); bf16* O = (bf16*)(F.ws + WS_ATTO);
    int u;
    while (wq_take(F, QU, lane, u)) {
        const int qb = 7 - (u >> 5), bh = u & 31, b = bh >> 3, h = bh & 7; const size_t r0 = (size_t)b * S_;
#pragma unroll 1
        for (int rep_ = 0; rep_ < ATT_REP; ++rep_)
        attn_unit<192, 0>(F.lds + RING_OFF, Q + r0 * 1536 + h * 192, 1536, KV + r0 * 2048 + h * 256, 2048, KR + r0 * 64, 64, KV + r0 * 2048 + h * 256 + 128, 2048,
                          O + r0 * 2048 + 1024 + h * 128, 2048, qb * 256, 0.f, tid, wave, lane, F.MISC + 32);
        for (int i = 0; i < 4 && conv_left; ++i) conv_left = conv_batch<1>(F, A, QC, lane, wave);
    }
}
__device__ __forceinline__ void sb_phase(Frame& F, const Args& A, WorkQ& QC, bool& conv_left) {
    PHASE_IDS(F);
    WorkQ QU; wq_init(F, QU, F.ctl + CW_QSB, 256, 17, lane);
    const bf16* P0 = (const bf16*)(F.ws + WS_PROJ0); bf16* O = (bf16*)(F.ws + WS_ATTO);
    int u;
    while (wq_take(F, QU, lane, u)) {
        const int qb = 7 - (u >> 5), bh = u & 31, b = bh >> 3, h = bh & 7; const size_t r0 = (size_t)b * S_;
#pragma unroll 1
        for (int rep_ = 0; rep_ < ATT_REP; ++rep_)
        attn_unit<128, 1>(F.lds + RING_OFF, P0 + r0 * 4096 + h * 128, 4096, P0 + r0 * 4096 + 1024 + h * 128, 4096, nullptr, 0, P0 + r0 * 4096 + 2048 + h * 128, 4096,
                          O + r0 * 2048 + h * 128, 2048, qb * 256, 0.f, tid, wave, lane, F.MISC + 32);
        for (int i = 0; i < 4 && conv_left; ++i) conv_left = conv_batch<1>(F, A, QC, lane, wave);
    }
    while (conv_left) conv_left = conv_batch<1>(F, A, QC, lane, wave);
}
__device__ __forceinline__ void ret_phase(Frame& F, const Args& A) {
    PHASE_IDS(F);
    WorkQ QC; wq_init(F, QC, F.ctl + CW_QC2, CONV_N2 / 32, 18, lane); bool conv_left = true;
    WorkQ QU; wq_init(F, QU, F.ctl + CW_QRET, 1024, 16, lane);
    if (F.vcu & 1) conv_left = conv_batch<2>(F, A, QC, lane, wave);
    const bf16* P1 = (const bf16*)(F.ws + WS_PROJ1); bf16* O = (bf16*)(F.ws + WS_RETO);
    int u;
    while (wq_take(F, QU, lane, u)) {
        const int qb = 7 - (u >> 7), rem = u & 127, eq = rem >> 5, bh = rem & 31, b = bh >> 3, h = bh & 7; const size_t r0 = (size_t)b * S_;
        const float dlog2 = log1pf(-exp2f(-5.0f - (float)h)) * LOG2E;
#pragma unroll 1
        for (int rep_ = 0; rep_ < RET_REP; ++rep_)
        attn_unit<256, 2>(F.lds + RING_OFF, P1 + r0 * 12288 + h * 256, 12288, P1 + r0 * 12288 + 2048 + h * 256, 12288, nullptr, 0, P1 + r0 * 12288 + 4096 + h * 512 + eq * 128, 12288,
                          O + r0 * 4096 + h * 512 + eq * 128, 4096, qb * 256, dlog2, tid, wave, lane, F.MISC + 32);
        for (int i = 0; i < 2 && conv_left; ++i) conv_left = conv_batch<2>(F, A, QC, lane, wave);
    }
    while (conv_left) conv_left = conv_batch<2>(F, A, QC, lane, wave);
}
typedef f32x4 AccT[2][2][4][2];
__device__ __forceinline__ v4u pack8(const f32x4& a, const f32x4& b) { v4u w; w.x = pk2(a.x, a.y); w.y = pk2(a.z, a.w); w.z = pk2(b.x, b.y); w.w = pk2(b.z, b.w); return w; }
__device__ __forceinline__ float sq4(const f32x4& a) { return (a.x * a.x + a.y * a.y) + (a.z * a.z + a.w * a.w); }
__device__ __forceinline__ void rope4(const f32x4& x1, const f32x4& x2, const f32x2* cs, f32x4& o1, f32x4& o2) {
    const f32x4 c01 = *(const f32x4*)cs, c23 = *(const f32x4*)(cs + 2);
    o1.x = x1.x * c01.x - x2.x * c01.y; o2.x = x1.x * c01.y + x2.x * c01.x;
    o1.y = x1.y * c01.z - x2.y * c01.w; o2.y = x1.y * c01.w + x2.y * c01.z;
    o1.z = x1.z * c23.x - x2.z * c23.y; o2.z = x1.z * c23.y + x2.z * c23.x;
    o1.w = x1.w * c23.z - x2.w * c23.w; o2.w = x1.w * c23.w + x2.w * c23.z;
}
struct EpiG1 { static constexpr bool PERM = true, AFTER_DRAIN = false;
    bf16* P0; bf16* KR; float* ssqp; const f32x2* cs64;
    __device__ __forceinline__ void operator()(const AccT& acc, const pg8::Unit& u, int wr, int wc, int fr, int fq) const {
        const int row0 = u.pm * 256 + wr * 64 + fr, tc = wc * 32 + 8 * fq;
        if (u.pn < 15) {
            const float scl = u.pn < 4 ? C_SB : 1.0f;
#pragma unroll
            for (int ai = 0; ai < 2; ++ai)
#pragma unroll
                for (int m = 0; m < 4; ++m) { const int row = row0 + ai * 128 + m * 16; float ss = 0.f;
#pragma unroll
                    for (int bj = 0; bj < 2; ++bj) { const f32x4 v0 = acc[ai][bj][m][0], v1 = acc[ai][bj][m][1]; ss += sq4(v0) + sq4(v1);
                        *(v4u*)(P0 + (size_t)row * 4096 + u.pn * 256 + bj * 128 + tc) = pack8(v0 * scl, v1 * scl); }
                    if (u.pn >= 12) { ss += __shfl_xor(ss, 16); ss += __shfl_xor(ss, 32); if (fq == 0) { if (u.pn < 14) ssqp[(size_t)row * 8 + 4 * (u.pn - 12) + wc] = ss; else ssqp[(size_t)T_ * 8 + (size_t)row * 4 + wc] = ss; } } }
        } else if (wc == 0) {
#pragma unroll
            for (int ai = 0; ai < 2; ++ai)
#pragma unroll
                for (int m = 0; m < 4; ++m) { const int row = row0 + ai * 128 + m * 16; f32x4 a0, b0, a1, b1;
                    rope4(acc[ai][0][m][0], acc[ai][1][m][0], cs64 + (size_t)row * 32 + 8 * fq, a0, b0);
                    rope4(acc[ai][0][m][1], acc[ai][1][m][1], cs64 + (size_t)row * 32 + 8 * fq + 4, a1, b1);
                    *(v4u*)(KR + (size_t)row * 64 + 8 * fq) = pack8(a0, a1); *(v4u*)(KR + (size_t)row * 64 + 32 + 8 * fq) = pack8(b0, b1); asm volatile("" ::: "memory"); }
        }
    }
};
struct EpiG2q { static constexpr bool PERM = true, AFTER_DRAIN = false;
    bf16* Q; const float* ssq; const f32x2* cs64;
    __device__ __forceinline__ void operator()(const AccT& acc, const pg8::Unit& u, int wr, int wc, int fr, int fq) const {
        const int row0 = u.pm * 256 + wr * 64 + fr, tc = wc * 32 + 8 * fq;
        if (u.pn < 4) {
#pragma unroll
            for (int ai = 0; ai < 2; ++ai)
#pragma unroll
                for (int m = 0; m < 4; ++m) { const int row = row0 + ai * 128 + m * 16; const f32x4 pa = *(const f32x4*)(ssq + (size_t)row * 8), pb = *(const f32x4*)(ssq + (size_t)row * 8 + 4); const float rs = C_MLA * __builtin_amdgcn_rsqf(((((((pa.x + pa.y) + pa.z) + pa.w) + pb.x) + pb.y) + pb.z + pb.w) * (1.0f / 512.0f) + EPS_);
#pragma unroll
                    for (int bj = 0; bj < 2; ++bj) { const int nidx = u.pn * 256 + bj * 128 + tc, hh = nidx >> 7, d = nidx & 127;
                        *(v4u*)(Q + (size_t)row * 1536 + hh * 192 + d) = pack8(acc[ai][bj][m][0] * rs, acc[ai][bj][m][1] * rs); }
                    asm volatile("" ::: "memory"); }
        } else {
            const int head = 4 * (u.pn - 4) + wc;
#pragma unroll
            for (int ai = 0; ai < 2; ++ai)
#pragma unroll
                for (int m = 0; m < 4; ++m) { const int row = row0 + ai * 128 + m * 16; const f32x4 pa = *(const f32x4*)(ssq + (size_t)row * 8), pb = *(const f32x4*)(ssq + (size_t)row * 8 + 4); const float rs = C_MLA * __builtin_amdgcn_rsqf(((((((pa.x + pa.y) + pa.z) + pa.w) + pb.x) + pb.y) + pb.z + pb.w) * (1.0f / 512.0f) + EPS_); f32x4 a0, b0, a1, b1;
                    rope4(acc[ai][0][m][0] * rs, acc[ai][1][m][0] * rs, cs64 + (size_t)row * 32 + 8 * fq, a0, b0);
                    rope4(acc[ai][0][m][1] * rs, acc[ai][1][m][1] * rs, cs64 + (size_t)row * 32 + 8 * fq + 4, a1, b1);
                    *(v4u*)(Q + (size_t)row * 1536 + head * 192 + 128 + 8 * fq) = pack8(a0, a1); *(v4u*)(Q + (size_t)row * 1536 + head * 192 + 160 + 8 * fq) = pack8(b0, b1);
                    asm volatile("" ::: "memory"); }
        }
    }
};
struct EpiG2kv { static constexpr bool PERM = true, AFTER_DRAIN = false;
    bf16* KV; const float* ssq;
    __device__ __forceinline__ void operator()(const AccT& acc, const pg8::Unit& u, int wr, int wc, int fr, int fq) const {
        const int row0 = u.pm * 256 + wr * 64 + fr, tc = wc * 32 + 8 * fq;
#pragma unroll
        for (int ai = 0; ai < 2; ++ai)
#pragma unroll
            for (int m = 0; m < 4; ++m) { const int row = row0 + ai * 128 + m * 16; const f32x4 pa = *(const f32x4*)(ssq + (size_t)row * 4); const float rs = __builtin_amdgcn_rsqf((((pa.x + pa.y) + pa.z) + pa.w) * (1.0f / 256.0f) + EPS_);
#pragma unroll
                for (int bj = 0; bj < 2; ++bj) *(v4u*)(KV + (size_t)row * 2048 + u.pn * 256 + bj * 128 + tc) = pack8(acc[ai][bj][m][0] * rs, acc[ai][bj][m][1] * rs); asm volatile("" ::: "memory"); }
    }
};
struct EpiRes { static constexpr bool PERM = false, AFTER_DRAIN = false;
    const float* src; float* dst; const float* gate;
    __device__ __forceinline__ void operator()(const AccT& acc, const pg8::Unit& u, int wr, int wc, int fr, int fq) const {
        const int row0 = u.pm * 256 + wr * 64 + fr, col0 = u.pn * 256 + wc * 32 + 4 * fq;
#pragma unroll
        for (int ai = 0; ai < 2; ++ai)
#pragma unroll
            for (int m = 0; m < 4; ++m) { const int row = row0 + ai * 128 + m * 16; const float* g = gate + (size_t)(row >> 11) * 6144 + col0; const size_t off = (size_t)row * 2048 + col0;
#pragma unroll
                for (int bj = 0; bj < 2; ++bj)
#pragma unroll
                    for (int n = 0; n < 2; ++n) { const int o = bj * 128 + n * 16; *(f32x4*)(dst + off + o) = *(const f32x4*)(src + off + o) + *(const f32x4*)(g + o) * acc[ai][bj][m][n]; } asm volatile("" ::: "memory"); }
    }
};
struct EpiG4 { static constexpr bool PERM = true, AFTER_DRAIN = false;
    bf16* P1; const f32x2* cs256;
    __device__ __forceinline__ void operator()(const AccT& acc, const pg8::Unit& u, int wr, int wc, int fr, int fq) const {
        const int row0 = u.pm * 256 + wr * 64 + fr, tc = wc * 32 + 8 * fq;
#pragma unroll
        for (int ai = 0; ai < 2; ++ai)
#pragma unroll
            for (int m = 0; m < 4; ++m) { const int row = row0 + ai * 128 + m * 16; bf16* dst = P1 + (size_t)row * 12288 + u.pn * 256 + tc;
                if (u.pn < 16) {
                    const float dl2 = log1pf(-exp2f(-5.0f - (float)(u.pn & 7))) * LOG2E, rel = (float)((row & 2047) - 1024);
                    const float scl = u.pn >= 8 ? 0.0625f * ex2(-dl2 * rel) : ex2(dl2 * rel); f32x4 a0, b0, a1, b1;
                    rope4(acc[ai][0][m][0] * scl, acc[ai][1][m][0] * scl, cs256 + (size_t)row * 128 + tc, a0, b0);
                    rope4(acc[ai][0][m][1] * scl, acc[ai][1][m][1] * scl, cs256 + (size_t)row * 128 + tc + 4, a1, b1);
                    *(v4u*)dst = pack8(a0, a1); *(v4u*)(dst + 128) = pack8(b0, b1);
                } else if (u.pn < 32) {
#pragma unroll
                    for (int bj = 0; bj < 2; ++bj) *(v4u*)(dst + bj * 128) = pack8(acc[ai][bj][m][0], acc[ai][bj][m][1]);
                } else {
#pragma unroll
                    for (int bj = 0; bj < 2; ++bj) { f32x4 v0 = acc[ai][bj][m][0], v1 = acc[ai][bj][m][1];
                        v0.x = silu_f(v0.x); v0.y = silu_f(v0.y); v0.z = silu_f(v0.z); v0.w = silu_f(v0.w); v1.x = silu_f(v1.x); v1.y = silu_f(v1.y); v1.z = silu_f(v1.z); v1.w = silu_f(v1.w);
                        *(v4u*)(dst + bj * 128) = pack8(v0, v1); }
                } asm volatile("" ::: "memory"); }
    }
};
struct EpiM3 { static constexpr bool PERM = true, AFTER_DRAIN = false;
    bf16* ACT;
    __device__ __forceinline__ void operator()(const AccT& acc, const pg8::Unit& u, int wr, int wc, int fr, int fq) const {
        const int row0 = u.pm * 256 + wr * 64 + fr, tc = wc * 32 + 8 * fq;
#pragma unroll
        for (int ai = 0; ai < 2; ++ai)
#pragma unroll
            for (int m = 0; m < 4; ++m) { const int row = row0 + ai * 128 + m * 16; const f32x4 g0 = acc[ai][0][m][0], g1 = acc[ai][0][m][1], u0 = acc[ai][1][m][0], u1 = acc[ai][1][m][1]; f32x4 a0, a1;
                a0.x = silu_f(g0.x) * u0.x; a0.y = silu_f(g0.y) * u0.y; a0.z = silu_f(g0.z) * u0.z; a0.w = silu_f(g0.w) * u0.w;
                a1.x = silu_f(g1.x) * u1.x; a1.y = silu_f(g1.y) * u1.y; a1.z = silu_f(g1.z) * u1.z; a1.w = silu_f(g1.w) * u1.w;
                *(v4u*)(ACT + (size_t)row * 512 + u.pn * 128 + tc) = pack8(a0, a1); }
    }
};
struct EpiM4 { static constexpr bool PERM = true, AFTER_DRAIN = false;
    bf16* Y;
    __device__ __forceinline__ void operator()(const AccT& acc, const pg8::Unit& u, int wr, int wc, int fr, int fq) const {
        const int row0 = u.pm * 256 + wr * 64 + fr, tc = wc * 32 + 8 * fq;
#pragma unroll
        for (int ai = 0; ai < 2; ++ai)
#pragma unroll
            for (int m = 0; m < 4; ++m) { const int row = row0 + ai * 128 + m * 16;
#pragma unroll
                for (int bj = 0; bj < 2; ++bj) *(v4u*)(Y + (size_t)row * 2048 + u.pn * 256 + bj * 128 + tc) = pack8(acc[ai][bj][m][0], acc[ai][bj][m][1]); }
    }
};
__device__ __forceinline__ void moe_tables(Frame& F, int layer) {
    LAS int* tab = (LAS int*)(F.lds + MOE_TAB_OFF);
    __syncthreads();
    if (F.wave == 0) { const int lane = lane_id_opaque();
        const int cnt = lane < 32 ? (int)__hip_atomic_load(F.ctl + CW_ECNT + 64 * layer + lane, RLX_AGENT) : 0; const int nt = (cnt + 255) >> 8;
        int incl = nt;
#pragma unroll
        for (int off = 1; off < 32; off <<= 1) { const int v = __shfl_up(incl, off); if (lane >= off) incl += v; }
        const int start = incl - nt;
        if (lane < 32) { tab[128 + lane] = 256 * start; for (int i = 0; i < nt && start + i < 96; ++i) tab[start + i] = lane; }
        if (lane == 31) tab[160] = incl < 96 ? incl : 96; }
    __syncthreads();
}

#ifndef PH_MASK
#define PH_MASK 0x7FFFFFu
#endif
#ifndef PH_DUP
#define PH_DUP 0u
#endif
#define REP(k) _Pragma("unroll 1") for (int rep_ = 0; rep_ < ((((PH_DUP) >> (k)) & 1u) ? 2 : 1); ++rep_)
#define IN(k) (((PH_MASK >> (k)) & 1u) && lo <= (k) && (k) < hi)
#define SEAM(k) do { if (IN(k) && IN((k) + 1)) xcd_barrier(bar, F.wave); } while (0)
template <int LAYER, int PB> __device__ __forceinline__ void moe_phases(Frame& F, const Args& args, const XcdBarrier& bar, int lo, int hi) {
    unsigned char* ws = F.ws; LAS unsigned char* ring = F.lds + RING_OFF; const int c = (int)blockIdx.x;
    if (IN(PB)) { router_phase(F, args, (const float*)(ws + WS_XA), args.in[8] + LAYER * 2048, 2 * LAYER + 1, LAYER, true);
#if defined(ROUTER_TWICE)
        router_phase(F, args, (const float*)(ws + WS_XA), args.in[8] + LAYER * 2048, 2 * LAYER + 1, LAYER, false);
#endif
    } SEAM(PB);
    if (IN(PB + 1)) { moe_tables(F, LAYER); scatter_phase(F, (const float*)(ws + WS_XA), args.in[8] + LAYER * 2048, 2 * LAYER + 1, LAYER, true);
#if defined(SCATTER_TWICE)
        scatter_phase(F, (const float*)(ws + WS_XA), args.in[8] + LAYER * 2048, 2 * LAYER + 1, LAYER, false);
#endif
    } SEAM(PB + 1);
    if (IN(PB + 2)) {
        if (MK_MULTI) moe_tables(F, LAYER);     const LAS int* tab = (const LAS int*)(F.lds + MOE_TAB_OFF); const int TM = tab[160], TA = (TM + 1) >> 1;
        pg8::Gemm g{2048, 2048, 2048}; pg8::MoeOrder S; S.ntn = 4; S.t0 = 0; S.nunits = TA * 4; S.gdeal = F.G; S.busy = 0; S.G = F.G; S.c = c; S.A = (const char*)(ws + WS_HG); S.W = (const char*)(ws + WS_W_GU + (size_t)LAYER * 128 * MiB);
        S.tstepA = (size_t)256 * 2048 * 2; S.tstepB = (size_t)256 * 2048 * 2; S.estep = (size_t)1024 * 2048 * 2; S.tile_expert = tab;
        EpiM3 E{(bf16*)(ws + WS_ACT)};
        pg8::gemm_phase<EpiM3, pg8::MoeOrder, true, true>(ring, g, S, E, F.wave);
#if defined(M3_TWICE)
        pg8::gemm_phase<EpiM3, pg8::MoeOrder, true, true>(ring, g, S, E, F.wave);
#endif
    } SEAM(PB + 2);
    if (IN(PB + 3)) {
        if (MK_MULTI) moe_tables(F, LAYER);     const LAS int* tab = (const LAS int*)(F.lds + MOE_TAB_OFF); const int TM = tab[160], TA = (TM + 1) >> 1, nb3 = (TM - TA) * 4;
        { pg8::Gemm g{2048, 2048, 2048}; pg8::MoeOrder S; S.ntn = 4; S.t0 = TA; S.nunits = nb3; S.gdeal = nb3 < F.G ? nb3 : F.G; S.busy = 0; S.G = F.G; S.c = c; S.A = (const char*)(ws + WS_HG); S.W = (const char*)(ws + WS_W_GU + (size_t)LAYER * 128 * MiB);
          S.tstepA = (size_t)256 * 2048 * 2; S.tstepB = (size_t)256 * 2048 * 2; S.estep = (size_t)1024 * 2048 * 2; S.tile_expert = tab;
          EpiM3 E{(bf16*)(ws + WS_ACT)};
          pg8::gemm_phase<EpiM3, pg8::MoeOrder, true, true>(ring, g, S, E, F.wave); }
        { pg8::Gemm g{512, 512, 512}; pg8::MoeOrder S; S.ntn = 8; S.t0 = 0; S.nunits = TA * 8; S.gdeal = F.G; S.busy = (nb3 > 0 && nb3 < F.G) ? nb3 : 0; S.G = F.G; S.c = c; S.A = (const char*)(ws + WS_ACT); S.W = (const char*)(ws + WS_W_DN + (size_t)LAYER * 64 * MiB);
          S.tstepA = (size_t)256 * 512 * 2; S.tstepB = (size_t)256 * 512 * 2; S.estep = (size_t)2048 * 512 * 2; S.tile_expert = tab;
          EpiM4 E{(bf16*)(ws + WS_Y)};
          pg8::gemm_phase<EpiM4, pg8::MoeOrder, true, true>(ring, g, S, E, F.wave); }
    } SEAM(PB + 3);
    if (IN(PB + 4)) {
        if (MK_MULTI) moe_tables(F, LAYER);     const LAS int* tab = (const LAS int*)(F.lds + MOE_TAB_OFF); const int TM = tab[160], TA = (TM + 1) >> 1;
        pg8::Gemm g{512, 512, 512}; pg8::MoeOrder S; S.ntn = 8; S.t0 = TA; S.nunits = (TM - TA) * 8; S.gdeal = F.G; S.busy = 0; S.G = F.G; S.c = c; S.A = (const char*)(ws + WS_ACT); S.W = (const char*)(ws + WS_W_DN + (size_t)LAYER * 64 * MiB);
        S.tstepA = (size_t)256 * 512 * 2; S.tstepB = (size_t)256 * 512 * 2; S.estep = (size_t)2048 * 512 * 2; S.tile_expert = tab;
        EpiM4 E{(bf16*)(ws + WS_Y)};
        pg8::gemm_phase<EpiM4, pg8::MoeOrder, true, true>(ring, g, S, E, F.wave);
#if defined(M4_TWICE)
        pg8::gemm_phase<EpiM4, pg8::MoeOrder, true, true>(ring, g, S, E, F.wave);
#endif
    } SEAM(PB + 4);
}
__global__ void __launch_bounds__(NWAVES * 64, 2) mk_fwd(Args args) {
    extern __shared__ __attribute__((aligned(16))) unsigned char lds[];
    Frame F;
    F.lds = (LAS unsigned char*)lds;
    F.MISC = (volatile LAS unsigned*)(F.lds + MISC_OFF);
    F.wave = __builtin_amdgcn_readfirstlane((int)threadIdx.x >> 6);
    F.G = gridDim.x; { const int bx = blockIdx.x; F.vcu = (F.G % 8 == 0) ? (bx % 8) * (F.G / 8) + bx / 8 : bx; }
    F.ws = args.ws; F.ctl = (gu32*)(args.ws + WS_CTL); F.out = args.out;
    for (int u = threadIdx.x; u < (LDS_BYTES - LDSCTL_OFF) / 4; u += NWAVES * 64) ((LAS unsigned*)(F.lds + LDSCTL_OFF))[u] = 0u;
    __syncthreads();
    XcdBarrier bar; bar.bar = (unsigned*)(F.ctl + CW_BAR); bar.x = 0; bar.st = nullptr;
    if (!MK_MULTI) bar = xcd_barrier_post((unsigned*)(F.ctl + CW_BAR), F.MISC + 8, F.wave);
    const int lo = args.ph_lo, hi = args.ph_hi;
    unsigned char* ws = args.ws;
    const float* MOD = (const float*)(F.ctl + CW_MOD);
    LAS unsigned char* ring = F.lds + RING_OFF;
    const int c = (int)blockIdx.x;

    if (IN(0)) REP(0) { p0a_mod_partials(F, args); } SEAM(0);
    if (IN(1)) REP(1) { p0_prologue(F, args); local_mod(F, args.in[4], 0); norm_phase<0, true>(F, args.in[0], nullptr, args.in[5], 0, 0, 0); } SEAM(1);
    if (IN(3)) REP(3) {
        pg8::Gemm g{2048, 2048, 2048}; pg8::StaticOrder S; S.init(T_, 4096, F.G, c, ws + WS_H, 2048, ws + WS_W_IN0T, 2048);
        EpiG1 E{(bf16*)(ws + WS_PROJ0), (bf16*)(ws + WS_KR), (float*)(ws + WS_SSQP), (const f32x2*)(ws + WS_TAB64)};
        pg8::gemm_phase<EpiG1, pg8::StaticOrder, true, true>(ring, g, S, E, F.wave);
    } SEAM(3);
    if (IN(4)) REP(4) {
        { pg8::Gemm g{512, 4096, 512}; pg8::StaticOrder S; S.init(T_, 1536, F.G, c, ws + WS_PROJ0 + 3072 * 2, 4096, ws + WS_W_QUPT, 512);
          EpiG2q E{(bf16*)(ws + WS_QMLA), (const float*)(ws + WS_SSQP), (const f32x2*)(ws + WS_TAB64)};
          pg8::gemm_phase<EpiG2q, pg8::StaticOrder, true, true>(ring, g, S, E, F.wave); }
        { pg8::Gemm g{256, 4096, 256}; pg8::StaticOrder S; S.init(T_, 2048, F.G, c, ws + WS_PROJ0 + 3584 * 2, 4096, ws + WS_W_KVUPT, 256);
          EpiG2kv E{(bf16*)(ws + WS_KVMLA), (const float*)(ws + WS_SSQP) + (size_t)T_ * 8};
          pg8::gemm_phase<EpiG2kv, pg8::StaticOrder, true, true>(ring, g, S, E, F.wave); }
    } SEAM(4);
    if (IN(5)) REP(5) { bool conv_left = true; WorkQ QC; wq_init(F, QC, F.ctl + CW_QC1, CONV_N1 / 32, 18, lane_id_opaque()); mla_phase(F, args, QC, conv_left); sb_phase(F, args, QC, conv_left); } SEAM(5);
    if (IN(6)) REP(6) {
        pg8::Gemm g{2048, 2048, 2048}; pg8::StaticOrder S; S.init(T_, 2048, F.G, c, ws + WS_ATTO, 2048, ws + WS_W_OUT0T, 2048);
        EpiRes E{args.in[0], (float*)(ws + WS_XA), MOD + (size_t)(0 * 4) * 6144 + 4096};
        pg8::gemm_phase<EpiRes, pg8::StaticOrder, true, true>(ring, g, S, E, F.wave);
    } SEAM(6);
    moe_phases<0, 7>(F, args, bar, lo, hi);
    if (IN(12)) REP(12) { norm_phase<2>(F, (const float*)(ws + WS_XA), (float*)(ws + WS_XB), args.in[5] + 2048, 2, 1, 0); } SEAM(12);
    if (IN(13)) REP(13) {
        pg8::Gemm g{2048, 2048, 2048}; pg8::StaticOrder S; S.init(T_, 12288, F.G, c, ws + WS_H, 2048, ws + WS_W_IN1T, 2048);
        EpiG4 E{(bf16*)(ws + WS_PROJ1), (const f32x2*)(ws + WS_TAB256)};
        pg8::gemm_phase<EpiG4, pg8::StaticOrder, true, true>(ring, g, S, E, F.wave);
    } SEAM(13);
    if (IN(14)) REP(14) { ret_phase(F, args); } SEAM(14);
    if (IN(15)) REP(15) { retnorm_phase(F); } SEAM(15);
    if (IN(16)) REP(16) {
        pg8::Gemm g{4096, 4096, 4096}; pg8::StaticOrder S; S.init(T_, 2048, F.G, c, ws + WS_A5, 4096, ws + WS_W_OUT1T, 4096);
        EpiRes E{(const float*)(ws + WS_XB), (float*)(ws + WS_XA), MOD + (size_t)(2 * 4) * 6144 + 4096};
        pg8::gemm_phase<EpiRes, pg8::StaticOrder, true, true>(ring, g, S, E, F.wave);
    } SEAM(16);
    moe_phases<1, 17>(F, args, bar, lo, hi);
    if (IN(22)) REP(22) { norm_phase<3>(F, (const float*)(ws + WS_XA), nullptr, args.in[24], 0, 3, 1); }
}
#undef IN
#undef SEAM

extern "C" void kernel_launch(void* const* d_in, const int* in_sizes, int n_in, void* d_out, int out_size, void* d_ws, size_t ws_size, hipStream_t stream) {
    static int grid = 0;
    if (grid == 0) {
        if (n_in != 25 || in_sizes[0] != T_ * D_ || out_size != T_ * D_ || ws_size < WS_END) { fprintf(stderr, "kernel_launch: unexpected shapes (n_in %d, in0 %d, out %d, ws %zu < %zu); nothing launched\n", n_in, n_in > 0 ? in_sizes[0] : -1, out_size, ws_size, (size_t)WS_END); grid = -1; return; }
        int dev = 0, cus = 0, per_cu = 0;
        if (hipGetDevice(&dev) != hipSuccess || hipDeviceGetAttribute(&cus, hipDeviceAttributeMultiprocessorCount, dev) != hipSuccess) { fprintf(stderr, "kernel_launch: device query failed\n"); grid = -1; return; }
        if (hipFuncSetAttribute((const void*)mk_fwd, hipFuncAttributeMaxDynamicSharedMemorySize, LDS_BYTES) != hipSuccess) { fprintf(stderr, "kernel_launch: hipFuncSetAttribute failed\n"); grid = -1; return; }
        if (hipOccupancyMaxActiveBlocksPerMultiprocessor(&per_cu, (const void*)mk_fwd, NWAVES * 64, LDS_BYTES) != hipSuccess || per_cu < 1) fprintf(stderr, "kernel_launch: note: occupancy query reports %d workgroups per CU\n", per_cu);
        (void)hipGetLastError();
        grid = cus;
    }
    if (grid < 0) return;
    if (hipMemsetAsync((char*)d_ws + WS_CTL, 0, CTL_ZERO_BYTES, stream) != hipSuccess) { fprintf(stderr, "kernel_launch: memset failed\n"); return; }
    Args a{};
    for (int i = 0; i < 25; ++i) a.in[i] = (const float*)d_in[i];
    a.out = (float*)d_out; a.ws = (unsigned char*)d_ws;
#if MK_MULTI
    for (int p = 0; p < 23; ++p) { a.ph_lo = p; a.ph_hi = p + 1; hipLaunchKernelGGL(mk_fwd, dim3(grid), dim3(NWAVES * 64), LDS_BYTES, stream, a); }
#else
    a.ph_lo = 0; a.ph_hi = 23;
    hipLaunchKernelGGL(mk_fwd, dim3(grid), dim3(NWAVES * 64), LDS_BYTES, stream, a);
#endif
    const hipError_t le = hipPeekAtLastError();
    if (le != hipSuccess) fprintf(stderr, "kernel_launch: launch failed: %s\n", hipGetErrorName(le));
}
```

```cpp
#include <hip/hip_runtime.h>
#include <cstdio>
#include <cstdint>

#ifndef MK_MULTI
#define MK_MULTI 0
#endif

namespace pg8 {
#define PG8_LAS __attribute__((address_space(3)))
typedef unsigned short bf16_t;
typedef short bf16x8 __attribute__((ext_vector_type(8)));
typedef float f32x4 __attribute__((ext_vector_type(4)));
typedef unsigned u32x4 __attribute__((ext_vector_type(4)));
constexpr int BM = 256, BK = 64, HALF = 128, HTB = HALF * BK * 2  , STAGE_BYTES = 8 * HTB, NXCD = 8, WGM = 8;

__host__ __device__ __forceinline__ int lds_byte(int r, int c) { const int st = (r >> 4) * 2 + (c >> 5), rr = r & 15, cc = c & 31, ob = rr * 64 + cc * 2; return st * 1024 + (ob ^ (((ob >> 9) & 1) << 5)); }
__host__ __device__ __forceinline__ void stage_rc(int b, int& R, int& C) { const int st = b / 1024, sb = b % 1024, swz = sb ^ (((sb >> 9) & 1) << 5); R = (st >> 1) * 16 + swz / 64; C = (st & 1) * 32 + (swz % 64) / 2; }
__host__ __device__ __forceinline__ int perm32(int rho) { const int n = rho >> 4, i = rho & 15; return 8 * (i >> 2) + 4 * n + (i & 3); }

struct Unit { int pm, pn; const char* a; const char* b; };
struct Gemm { int K, lda, ldb; };

struct StaticOrder {
    int nM, nN, nwg, G, c; const char* A; const char* Bt; size_t tstepA, tstepB;
    __device__ void init(int M, int N, int G_, int c_, const void* A_, int lda, const void* Bt_, int ldb) { nM = M / BM; nN = N / BM; nwg = nM * nN; G = G_; c = c_; A = (const char*)A_; Bt = (const char*)Bt_; tstepA = (size_t)BM * lda * 2; tstepB = (size_t)BM * ldb * 2; }
    __device__ bool next(int i, Unit& u) const {
        const long L = (long)i * G + c; if (L >= nwg) return false;
        int wgid = (int)L; { const int q = nwg / NXCD, r = nwg % NXCD, xcd = wgid % NXCD, off = wgid / NXCD; wgid = (xcd < r ? xcd * (q + 1) : r * (q + 1) + (xcd - r) * q) + off; }
        const int nig = WGM * nN, gid = wgid / nig, fm = gid * WGM, gsz = (nM - fm) < WGM ? (nM - fm) : WGM;
        u.pm = fm + ((wgid % nig) % gsz); u.pn = (wgid % nig) / gsz; u.a = A + (size_t)u.pm * tstepA; u.b = Bt + (size_t)u.pn * tstepB; return true;
    }
    __device__ __forceinline__ void a_ready(const Unit&) const {}
    __device__ __forceinline__ void done(const Unit&) const {}
};
struct MoeOrder {
    int ntn, t0, nunits, gdeal, busy, G, c; const char* A; const char* W; size_t tstepA, tstepB, estep; const PG8_LAS int* tile_expert;
    __device__ bool next(int i, Unit& u) const {
        int L;
        if (busy == 0) { if (c >= gdeal) return false; L = i * gdeal + c; }
        else { const int nfree = G - busy;
            if (c >= busy) { const int cap = 3 * nfree < nunits ? 3 * nfree : nunits; if (i >= 3) return false; L = i * nfree + (c - busy); if (L >= cap) return false; }
            else { L = 3 * nfree + i * busy + c; } }
        if (L >= nunits) return false;
        const int mt = t0 + L / ntn, pn = L % ntn, e = tile_expert[mt];
        u.pm = mt; u.pn = pn; u.a = A + (size_t)mt * tstepA; u.b = W + (size_t)e * estep + (size_t)pn * tstepB; return true;
    }
    __device__ __forceinline__ void a_ready(const Unit&) const {}
    __device__ __forceinline__ void done(const Unit&) const {}
};

template <class Epi, class Sched, bool ALIGN_EPI = false, bool SP2 = false>
__device__ __forceinline__ void gemm_phase(PG8_LAS unsigned char* lds, const Gemm g, const Sched& S, const Epi& E, const int wave_id) {
    int lane; asm volatile("v_mbcnt_lo_u32_b32 %0, -1, 0\n\tv_mbcnt_hi_u32_b32 %0, -1, %0" : "=v"(lane));
    const int wid = wave_id, tid = wid * 64 + lane, wr = wid >> 2, wc = wid & 3, fr = lane & 15, fq = lane >> 4;
    const int K = g.K, nt = K / BK;
    unsigned voffA[2], voffB[2];
#pragma unroll
    for (int i = 0; i < 2; ++i) { int R, C; stage_rc(tid * 16 + i * 8192, R, C); const int Rb = Epi::PERM ? ((R & ~31) + perm32(R & 31)) : R;
        voffA[i] = (unsigned)(R * g.lda + C) * 2u; voffB[i] = (unsigned)(Rb * g.ldb + C) * 2u; }
    const size_t kstep = (size_t)(BK * 2);
    const size_t hstepA = (size_t)HALF * g.lda * 2, hstepB = (size_t)HALF * g.ldb * 2;
    const unsigned ldsw = (unsigned)wid * 1024u;
    const int aoff = lds_byte(wr * 64 + fr, fq * 8), boff = lds_byte(wc * 32 + fr, fq * 8);
#define PG8_SA(b, h) (((b) * 2 + (h)) * HTB)
#define PG8_SB(b, h) ((4 + (b) * 2 + (h)) * HTB)
#define PG8_STAGE(bufoff, gbase, voff) do { _Pragma("unroll") for (int _i = 0; _i < 2; ++_i) \
        __builtin_amdgcn_global_load_lds((const unsigned*)((const char*)(gbase) + (voff)[_i]), (PG8_LAS unsigned*)(lds + (bufoff) + ldsw + _i * 8192), 16, 0, 0); } while (0)
#define PG8_LDA(dst, b, h) do { _Pragma("unroll") for (int m = 0; m < 4; ++m) _Pragma("unroll") for (int k = 0; k < 2; ++k) dst[m][k] = *(const PG8_LAS bf16x8*)(lds + PG8_SA(b, h) + aoff + m * 2048 + k * 1024); } while (0)
#define PG8_LDB(dst, b, h) do { _Pragma("unroll") for (int n = 0; n < 2; ++n) _Pragma("unroll") for (int k = 0; k < 2; ++k) dst[n][k] = *(const PG8_LAS bf16x8*)(lds + PG8_SB(b, h) + boff + n * 2048 + k * 1024); } while (0)
#define PG8_MMA(ai, bj, At, Bt) do { __builtin_amdgcn_s_setprio(1); _Pragma("unroll") for (int m = 0; m < 4; ++m) _Pragma("unroll") for (int n = 0; n < 2; ++n) _Pragma("unroll") for (int k = 0; k < 2; ++k) \
        acc[ai][bj][m][n] = __builtin_amdgcn_mfma_f32_16x16x32_bf16(Bt[n][k], At[m][k], acc[ai][bj][m][n], 0, 0, 0); __builtin_amdgcn_s_setprio(0); } while (0)
#define PG8_WAIT_V(n) asm volatile("s_waitcnt vmcnt(" #n ")" ::: "memory")
#define PG8_WAIT_L(n) asm volatile("s_waitcnt lgkmcnt(" #n ")" ::: "memory")
#define PG8_BAR __builtin_amdgcn_s_barrier()
#define PG8_SCHED __builtin_amdgcn_sched_barrier(0)
    Unit cur, nxt; int ui = 0;
    if (!S.next(0, cur)) return;
    f32x4 acc[2][2][4][2];
#pragma unroll
    for (int a = 0; a < 2; ++a)
#pragma unroll
        for (int b = 0; b < 2; ++b)
#pragma unroll
            for (int m = 0; m < 4; ++m)
#pragma unroll
                for (int n = 0; n < 2; ++n) acc[a][b][m][n] = (f32x4){0.f, 0.f, 0.f, 0.f};
    bf16x8 At[4][2], B0[2][2], B1[2][2];
    const char* cA = cur.a; const char* cB = cur.b;
    S.a_ready(cur);
    if constexpr (SP2) {
        PG8_STAGE(PG8_SB(0, 0), cB, voffB); PG8_STAGE(PG8_SB(0, 1), cB + hstepB, voffB); PG8_STAGE(PG8_SA(0, 0), cA, voffA); PG8_STAGE(PG8_SA(0, 1), cA + hstepA, voffA);
        if (wr == 1) PG8_BAR;
        PG8_WAIT_V(2); PG8_BAR;
        PG8_STAGE(PG8_SB(1, 0), cB + kstep, voffB); PG8_STAGE(PG8_SA(1, 0), cA + kstep, voffA); PG8_STAGE(PG8_SB(1, 1), cB + hstepB + kstep, voffB);
        PG8_WAIT_V(6); PG8_BAR;
    } else {
        PG8_STAGE(PG8_SB(0, 0), cB, voffB); PG8_STAGE(PG8_SA(0, 0), cA, voffA); PG8_STAGE(PG8_SB(0, 1), cB + hstepB, voffB); PG8_STAGE(PG8_SA(0, 1), cA + hstepA, voffA);
        if (wr == 1) PG8_BAR;
        PG8_WAIT_V(4); PG8_BAR;
        PG8_STAGE(PG8_SB(1, 0), cB + kstep, voffB); PG8_STAGE(PG8_SA(1, 0), cA + kstep, voffA); PG8_STAGE(PG8_SB(1, 1), cB + hstepB + kstep, voffB);
        PG8_WAIT_V(6); PG8_BAR;
    }
    for (;;) {
        const bool has_next = S.next(ui + 1, nxt);
        const char* nA = has_next ? nxt.a : cA; const char* nB = has_next ? nxt.b : cB;
        for (int t = 0; t < nt; t += 2) {
            const bool last = (t == nt - 2);
            const char* a1 = cA + (size_t)(t + 1) * kstep;
            const char* a2 = last ? nA : cA + (size_t)(t + 2) * kstep; const char* b2 = last ? nB : cB + (size_t)(t + 2) * kstep;
            const char* a3 = a2 + kstep; const char* b3 = b2 + kstep;
            if (last && has_next) S.a_ready(nxt);
            if constexpr (SP2) {
            PG8_LDB(B0, 0, 0); PG8_LDB(B1, 0, 1); PG8_SCHED; PG8_LDA(At, 0, 0); PG8_STAGE(PG8_SA(1, 1), a1 + hstepA, voffA);
            PG8_WAIT_V(8); PG8_WAIT_L(0); PG8_BAR; PG8_MMA(0, 0, At, B0); PG8_MMA(0, 1, At, B1); PG8_BAR; PG8_SCHED;
            PG8_LDA(At, 0, 1); PG8_STAGE(PG8_SB(0, 0), b2, voffB); PG8_STAGE(PG8_SB(0, 1), b2 + hstepB, voffB); PG8_STAGE(PG8_SA(0, 0), a2, voffA);
            PG8_WAIT_V(8); PG8_WAIT_L(0); PG8_BAR; PG8_MMA(1, 0, At, B0); PG8_MMA(1, 1, At, B1); PG8_BAR; PG8_SCHED;
            PG8_LDB(B0, 1, 0); PG8_LDB(B1, 1, 1); PG8_SCHED; PG8_LDA(At, 1, 0); PG8_STAGE(PG8_SA(0, 1), a2 + hstepA, voffA);
            PG8_WAIT_V(8); PG8_WAIT_L(0); PG8_BAR; PG8_MMA(0, 0, At, B0); PG8_MMA(0, 1, At, B1); PG8_BAR; PG8_SCHED;
            PG8_LDA(At, 1, 1); PG8_STAGE(PG8_SB(1, 0), b3, voffB); PG8_STAGE(PG8_SB(1, 1), b3 + hstepB, voffB); PG8_STAGE(PG8_SA(1, 0), a3, voffA);
            PG8_WAIT_V(8); PG8_WAIT_L(0); PG8_BAR; PG8_MMA(1, 0, At, B0); PG8_MMA(1, 1, At, B1); PG8_BAR; PG8_SCHED;
            } else {
            PG8_LDB(B0, 0, 0); PG8_SCHED; PG8_LDA(At, 0, 0); PG8_STAGE(PG8_SA(1, 1), a1 + hstepA, voffA);
            PG8_WAIT_L(8); PG8_BAR; PG8_WAIT_L(0); PG8_MMA(0, 0, At, B0); PG8_BAR; PG8_SCHED;
            PG8_LDB(B1, 0, 1); PG8_STAGE(PG8_SB(0, 0), b2, voffB);
            PG8_BAR; PG8_WAIT_L(0); PG8_MMA(0, 1, At, B1); PG8_BAR;
            PG8_LDA(At, 0, 1); PG8_STAGE(PG8_SA(0, 0), a2, voffA);
            PG8_BAR; PG8_WAIT_L(0); PG8_MMA(1, 0, At, B0); PG8_BAR; PG8_SCHED;
            PG8_STAGE(PG8_SB(0, 1), b2 + hstepB, voffB);
            PG8_WAIT_V(6); PG8_BAR; PG8_MMA(1, 1, At, B1); PG8_BAR;
            PG8_LDB(B0, 1, 0); PG8_SCHED; PG8_LDA(At, 1, 0); PG8_STAGE(PG8_SA(0, 1), a2 + hstepA, voffA);
            PG8_WAIT_L(8); PG8_BAR; PG8_WAIT_L(0); PG8_MMA(0, 0, At, B0); PG8_BAR; PG8_SCHED;
            PG8_LDB(B1, 1, 1); PG8_STAGE(PG8_SB(1, 0), b3, voffB);
            PG8_BAR; PG8_WAIT_L(0); PG8_MMA(0, 1, At, B1); PG8_BAR;
            PG8_LDA(At, 1, 1); PG8_STAGE(PG8_SA(1, 0), a3, voffA);
            PG8_BAR; PG8_WAIT_L(0); PG8_MMA(1, 0, At, B0); PG8_BAR; PG8_SCHED;
            PG8_STAGE(PG8_SB(1, 1), b3 + hstepB, voffB);
            PG8_WAIT_V(6); PG8_BAR; PG8_MMA(1, 1, At, B1); PG8_BAR;
            }
        }
        if constexpr (ALIGN_EPI) { if (wr == 0) PG8_BAR; }
        if constexpr (!Epi::AFTER_DRAIN) { E(acc, cur, wr, wc, fr, fq); S.done(cur); }
        if (!has_next) break;
#pragma unroll
        for (int a = 0; a < 2; ++a)
#pragma unroll
            for (int b = 0; b < 2; ++b)
#pragma unroll
                for (int m = 0; m < 4; ++m)
#pragma unroll
                    for (int n = 0; n < 2; ++n) acc[a][b][m][n] = (f32x4){0.f, 0.f, 0.f, 0.f};
        cur = nxt; cA = nA; cB = nB; ++ui;
        if constexpr (ALIGN_EPI) { if (wr == 1) PG8_BAR; }
    }
    PG8_WAIT_V(0);
    if constexpr (!ALIGN_EPI) { if (wr == 0) PG8_BAR; }
    PG8_BAR;
    if constexpr (Epi::AFTER_DRAIN) { E.fused(acc, cur, wr, wc, fr, fq, lds, wid, lane); S.done(cur); }
#undef PG8_SA
#undef PG8_SB
#undef PG8_STAGE
#undef PG8_LDA
#undef PG8_LDB
#undef PG8_MMA
#undef PG8_WAIT_V
#undef PG8_WAIT_L
#undef PG8_BAR
#undef PG8_SCHED
}
}

constexpr int NWAVES = 8;
constexpr int T_ = 8192, D_ = 2048, NB_ = 4, S_ = 2048;
constexpr float EPS_ = 1e-6f;
constexpr float LOG2E = 1.4426950408889634f;
constexpr float C_SB = 0.08838834764831845f * LOG2E;
constexpr float C_MLA = 0.07216878364870323f * LOG2E;
constexpr int NPH = 22;

constexpr size_t MiB = 1u << 20;
constexpr size_t WS_CTL = 0, CTL_ZERO_BYTES = 1 * MiB;
constexpr size_t WS_TAB64 = 2 * MiB, WS_TAB256 = 4 * MiB, WS_WR = 12 * MiB, WS_ROUTE = 13 * MiB;
constexpr size_t WS_W_IN0T = 16 * MiB, WS_W_QUPT = 32 * MiB, WS_W_KVUPT = 34 * MiB, WS_W_OUT0T = 36 * MiB, WS_W_IN1T = 44 * MiB, WS_W_OUT1T = 92 * MiB;
constexpr size_t WS_W_GU = 108 * MiB, WS_W_DN = 364 * MiB;
constexpr size_t WS_XA = 492 * MiB, WS_XB = 556 * MiB, WS_H = 620 * MiB;
constexpr size_t WS_PROJ0 = 652 * MiB, WS_QMLA = 716 * MiB, WS_KVMLA = 740 * MiB, WS_KR = 772 * MiB, WS_ATTO = 774 * MiB;
constexpr size_t WS_PROJ1 = 652 * MiB;
constexpr size_t WS_HG = 844 * MiB, WS_ACT = 940 * MiB, WS_Y = 964 * MiB;
constexpr size_t WS_RETO = 844 * MiB, WS_A5 = 908 * MiB;
constexpr size_t WS_MODP = 1060 * MiB;
constexpr size_t WS_RS = 13 * MiB + 256 * 1024;
constexpr size_t WS_SSQP = 13 * MiB + 512 * 1024;
constexpr size_t WS_END = 1068 * MiB;
constexpr int CW_TMO = 0, CW_CODE = 1;
constexpr int CW_BAR = 4096;
constexpr int CW_QMLA = 8192, CW_QSB = 8256, CW_QRET = 8320, CW_QC1 = 8384, CW_QC2 = 8416;
constexpr int CW_ECNT = 8448, CW_ECUR = 8576;
constexpr int CW_MOD = 16384;
constexpr int CW_SSQQ = 114688, CW_SSQKV = 122880;
static_assert((CW_SSQKV + 8192) * 4 <= (int)CTL_ZERO_BYTES, "CTL words inside the memset region");
constexpr int RING_OFF = 0, RING_BYTES = 147456;
constexpr int LDSCTL_OFF = RING_BYTES, MISC_OFF = LDSCTL_OFF + 320;
constexpr int MOE_TAB_OFF = LDSCTL_OFF + 1024;
constexpr int LDS_BYTES = 155648;
static_assert(MOE_TAB_OFF + 1024 <= LDS_BYTES, "LDS map");

#define GAS __attribute__((address_space(1)))
#define LAS __attribute__((address_space(3)))
typedef unsigned short bf16;
typedef unsigned v4u __attribute__((ext_vector_type(4)));
typedef unsigned v2u __attribute__((ext_vector_type(2)));
typedef float f32x4 __attribute__((ext_vector_type(4)));
typedef float f32x2 __attribute__((ext_vector_type(2)));
typedef float f32x16 __attribute__((ext_vector_type(16)));
typedef short bf16x8 __attribute__((ext_vector_type(8)));
typedef short s16x4 __attribute__((ext_vector_type(4)));
typedef short v4i16_t __attribute__((ext_vector_type(4)));
typedef GAS unsigned gu32;
#define RLX_AGENT __ATOMIC_RELAXED, __HIP_MEMORY_SCOPE_AGENT
#define LDS_WAIT() asm volatile("s_waitcnt lgkmcnt(0)" ::: "memory")
#define VM_WAIT() asm volatile("s_waitcnt vmcnt(0)" ::: "memory")
typedef __bf16 bf16x2_t __attribute__((ext_vector_type(2)));
__device__ __forceinline__ unsigned pk2(float lo, float hi) { f32x2 v = {lo, hi}; bf16x2_t b = __builtin_convertvector(v, bf16x2_t); return __builtin_bit_cast(unsigned, b); }
__device__ __forceinline__ float bf_lo(unsigned w) { return __uint_as_float(w << 16); }
__device__ __forceinline__ float bf_hi(unsigned w) { return __uint_as_float(w & 0xffff0000u); }
__device__ __forceinline__ float ex2(float x) { return __builtin_amdgcn_exp2f(x); }
__device__ __forceinline__ float lg2(float x) { return __builtin_amdgcn_logf(x); }
__device__ __forceinline__ float silu_f(float v) { return v / (1.0f + __expf(-v)); }
__device__ __forceinline__ int lane_id_opaque() { int l; asm volatile("v_mbcnt_lo_u32_b32 %0, -1, 0\n\tv_mbcnt_hi_u32_b32 %0, -1, %0" : "=v"(l)); return l; }

#define XB_TMO      128
#define XB_XCNT(j)  (256  + 64 * (j))
#define XB_XSUB(j)  (1280 + 64 * (j))
#define XB_XGEN(j)  (2304 + 64 * (j))
#define XB_TOP      3328
#define XB_TOPGEN   3392
#define XCD_BAR_WORDS 3456
#define XB_SPIN_CAP (1u << 18)
__device__ __forceinline__ unsigned xb_ld(unsigned* p)              { return __hip_atomic_load(p, __ATOMIC_RELAXED, __HIP_MEMORY_SCOPE_AGENT); }
__device__ __forceinline__ unsigned xb_add(unsigned* p, unsigned v) { return __hip_atomic_fetch_add(p, v, __ATOMIC_RELAXED, __HIP_MEMORY_SCOPE_AGENT); }
__device__ __forceinline__ unsigned xb_xcc_id() { return (unsigned)__builtin_amdgcn_s_getreg((3 << 11) | 20) & 0xFu; }
#define XB_SPIN(cond, bar) do { unsigned _sp = 0; while (cond) { __builtin_amdgcn_s_sleep(1); \
    if ((++_sp & 255u) == 0u) { if (xb_ld(&(bar)[XB_TMO])) break; if (_sp > XB_SPIN_CAP) { atomicAdd(&(bar)[XB_TMO], 1u); break; } } } } while (0)
struct XcdBarrier { unsigned* bar; unsigned x; volatile LAS unsigned* st; };
__device__ __forceinline__ XcdBarrier xcd_barrier_post(unsigned* bar, volatile LAS unsigned* st, int wave) {
    XcdBarrier b; b.bar = bar; b.x = xb_xcc_id(); b.st = st;
    if (wave == 0 && lane_id_opaque() == 0) (void)xb_add(&bar[XB_XCNT(b.x)], 1u);
    return b;
}
__device__ __forceinline__ void xcd_barrier_complete(unsigned* bar, unsigned x, unsigned& nloc, unsigned& nx) {
    const unsigned G = gridDim.x * gridDim.y * gridDim.z;
    unsigned sum, cnt, mine, sp = 0u;
    for (;;) {
        sum = 0u; cnt = 0u; mine = 0u;
#pragma unroll
        for (unsigned j = 0; j < 16; ++j) { const unsigned c = xb_ld(&bar[XB_XCNT(j)]); sum += c; cnt += (c > 0u) ? 1u : 0u; mine = (j == x) ? c : mine; }
        if (sum == G) break;
        __builtin_amdgcn_s_sleep(1);
        if ((++sp & 255u) == 0u) { if (xb_ld(&bar[XB_TMO])) break; if (sp > XB_SPIN_CAP) { atomicAdd(&bar[XB_TMO], 1u); break; } }
    }
    nloc = mine > 0u ? mine : 1u; nx = cnt > 0u ? cnt : 1u;
}
__device__ __forceinline__ void xcd_barrier(const XcdBarrier& b, int wave) {
    asm volatile("s_waitcnt vmcnt(0)" ::: "memory");
    __syncthreads();
    if (wave == 0 && lane_id_opaque() == 0) {
        unsigned* bar = b.bar;
        __builtin_amdgcn_s_waitcnt(0);
        unsigned nloc = b.st[0], nx = b.st[1];
        if (nloc == 0u) { xcd_barrier_complete(bar, b.x, nloc, nx); b.st[0] = nloc; b.st[1] = nx; }
        const unsigned old = xb_add(&bar[XB_XSUB(b.x)], 1u);
        const unsigned gen = old / nloc;
        if (old + 1u == (gen + 1u) * nloc) {
            __builtin_amdgcn_fence(__ATOMIC_RELEASE, "agent");
            asm volatile("s_waitcnt vmcnt(0)" ::: "memory");
            const unsigned og = xb_add(&bar[XB_TOP], 1u);
            const unsigned tg = og / nx;
            if (og + 1u == (tg + 1u) * nx) xb_add(&bar[XB_TOPGEN], 1u);
            else XB_SPIN(xb_ld(&bar[XB_TOPGEN]) == tg, bar);
            __builtin_amdgcn_fence(__ATOMIC_ACQUIRE, "agent");
            xb_add(&bar[XB_XGEN(b.x)], 1u);
            asm volatile("s_waitcnt vmcnt(0)" ::: "memory");
        } else {
            XB_SPIN(xb_ld(&bar[XB_XGEN(b.x)]) == gen, bar);
            __builtin_amdgcn_fence(__ATOMIC_ACQUIRE, "agent");
            asm volatile("s_waitcnt vmcnt(0)" ::: "memory");
        }
    }
    __syncthreads();
}

struct Frame {
    LAS unsigned char* lds;
    volatile LAS unsigned* MISC;
    gu32* ctl;
    unsigned char* ws;
    int wave;
    int vcu, G;
    float* out;
};
struct Args { const float* in[25]; float* out; unsigned char* ws; int ph_lo, ph_hi; };
__device__ __forceinline__ float wave_sum(float v) {
#pragma unroll
    for (int o = 1; o < 64; o <<= 1) v += __shfl_xor(v, o);
    return v;
}
#define PHASE_IDS(F) const int lane = lane_id_opaque(), wave = (F).wave, tid = wave * 64 + lane; (void)lane; (void)wave; (void)tid
struct ConvSrc { const float* W; int ldn; bf16* WT; int ldk; const float* scale; };
__device__ __forceinline__ void conv_load(const ConvSrc& c, int lane, f32x4 (&v)[8]) {
    const float* src = c.W + (size_t)(8 * (lane >> 3)) * c.ldn + 4 * (lane & 7);
#pragma unroll
    for (int t = 0; t < 8; ++t) v[t] = __builtin_nontemporal_load((const f32x4*)(src + (size_t)t * c.ldn));
}
__device__ __forceinline__ void conv_store(const ConvSrc& c, int lane, f32x4 (&v)[8]) {
    if (c.scale) { const f32x4 s0 = *(const f32x4*)(c.scale + 8 * (lane >> 3)), s1 = *(const f32x4*)(c.scale + 8 * (lane >> 3) + 4);
        v[0] *= s0.x; v[1] *= s0.y; v[2] *= s0.z; v[3] *= s0.w; v[4] *= s1.x; v[5] *= s1.y; v[6] *= s1.z; v[7] *= s1.w; }
    bf16* dst = c.WT + (size_t)(4 * (lane & 7)) * c.ldk + 8 * (lane >> 3);
#pragma unroll
    for (int j = 0; j < 4; ++j) { v4u o; o.x = pk2(v[0][j], v[1][j]); o.y = pk2(v[2][j], v[3][j]); o.z = pk2(v[4][j], v[5][j]); o.w = pk2(v[6][j], v[7][j]); __builtin_nontemporal_store(o, (v4u*)(dst + (size_t)j * c.ldk)); }
}
static_assert((64 * 32 + 384 * 32 + 32 * 1024 + 32 * 512) % 128 == 0 && (64 * 64 + 32 * 1024 + 32 * 512) % 128 == 0, "conversion batches of 128 items");
constexpr int CONV_N0 = 122 * 32 + 48 * 8 + 64 * 4, CONV_N1 = 64 * 32 + 384 * 32 + 32 * 1024 + 32 * 512, CONV_N2 = 64 * 64 + 32 * 1024 + 32 * 512;
__device__ __forceinline__ ConvSrc conv_moe_gu(const Args& A, unsigned char* ws, int le, int r) {
    const int nb = r / 32, kb = r % 32, t = nb >> 3, hf = (nb >> 2) & 1, jb = nb & 3;
    return ConvSrc{(hf ? A.in[22] : A.in[21]) + (size_t)le * 2048 * 512 + (size_t)(64 * kb) * 512 + 128 * t + 32 * jb, 512, (bf16*)(ws + WS_W_GU) + (size_t)le * 1024 * 2048 + (size_t)(32 * nb) * 2048 + 64 * kb, 2048, nullptr};
}
__device__ __forceinline__ ConvSrc conv_moe_dn(const Args& A, unsigned char* ws, int le, int r) {
    const int nb = r / 8, kb = r % 8;
    return ConvSrc{A.in[23] + (size_t)le * 512 * 2048 + (size_t)(64 * kb) * 2048 + 32 * nb, 2048, (bf16*)(ws + WS_W_DN) + (size_t)le * 2048 * 512 + (size_t)(32 * nb) * 512 + 64 * kb, 512, nullptr};
}
template <int STREAM> __device__ __forceinline__ ConvSrc conv_item(const Args& A, unsigned char* ws, int it) {
    if (STREAM == 0) {
        if (it < 122 * 32) { const int t = it / 32, kb = it % 32; const int dnb = t < 120 ? t : (t == 120 ? 120 : 124), sc = t < 120 ? 32 * t : (t == 120 ? 3840 : 3872);
            return ConvSrc{A.in[9] + (size_t)(64 * kb) * 3904 + sc, 3904, (bf16*)(ws + WS_W_IN0T) + (size_t)(32 * dnb) * 2048 + 64 * kb, 2048, nullptr}; }
        it -= 122 * 32;
        if (it < 48 * 8) { const int nb = it / 8, kb = it % 8; int sc;
            if (nb < 32) sc = (nb >> 2) * 192 + 32 * (nb & 3);
            else { const int t = (nb - 32) >> 3, blk = (nb - 32) & 7, hf = blk >> 2, hh = blk & 3; sc = (4 * t + hh) * 192 + 128 + 32 * hf; }
            return ConvSrc{A.in[11] + (size_t)(64 * kb) * 1536 + sc, 1536, (bf16*)(ws + WS_W_QUPT) + (size_t)(32 * nb) * 512 + 64 * kb, 512, A.in[10] + 64 * kb}; }
        it -= 48 * 8;
        { const int nb = it / 4, kb = it % 4;
            return ConvSrc{A.in[13] + (size_t)(64 * kb) * 2048 + 32 * nb, 2048, (bf16*)(ws + WS_W_KVUPT) + (size_t)(32 * nb) * 256 + 64 * kb, 256, A.in[12] + 64 * kb}; }
    } else if (STREAM == 1) {
        if (it < 64 * 32) { const int nb = it / 32, kb = it % 32;
            return ConvSrc{A.in[14] + (size_t)(64 * kb) * 2048 + 32 * nb, 2048, (bf16*)(ws + WS_W_OUT0T) + (size_t)(32 * nb) * 2048 + 64 * kb, 2048, nullptr}; }
        it -= 64 * 32;
        if (it < 384 * 32) { const int nb = it / 32, kb = it % 32;
            return ConvSrc{A.in[15] + (size_t)(64 * kb) * 12288 + 32 * nb, 12288, (bf16*)(ws + WS_W_IN1T) + (size_t)(32 * nb) * 2048 + 64 * kb, 2048, nullptr}; }
        it -= 384 * 32;
        if (it < 32 * 1024) return conv_moe_gu(A, ws, it / 1024, it % 1024);
        it -= 32 * 1024;
        return conv_moe_dn(A, ws, it / 512, it % 512);
    } else {
        if (it < 64 * 64) { const int nb = it / 64, kb = it % 64;
            return ConvSrc{A.in[16] + (size_t)(64 * kb) * 2048 + 32 * nb, 2048, (bf16*)(ws + WS_W_OUT1T) + (size_t)(32 * nb) * 4096 + 64 * kb, 4096, nullptr}; }
        it -= 64 * 64;
        if (it < 32 * 1024) return conv_moe_gu(A, ws, 32 + it / 1024, it % 1024);
        it -= 32 * 1024;
        return conv_moe_dn(A, ws, 32 + it / 512, it % 512);
    }
}
template <int STREAM> __device__ __forceinline__ void conv_burst(Frame& F, const Args& A, int lane, int gw, int NGW, int& cur, int n) {
    constexpr int N = STREAM == 0 ? CONV_N0 : (STREAM == 1 ? CONV_N1 : CONV_N2);
#pragma unroll 1
    while (n > 0) {
        const int i0 = gw + NGW * cur; if (i0 >= N) break;
        const int i1 = i0 + NGW; const bool two = n > 1 && i1 < N;
        const ConvSrc c0 = conv_item<STREAM>(A, F.ws, i0); f32x4 v0[8], v1[8];
        conv_load(c0, lane, v0);
        if (two) { const ConvSrc c1 = conv_item<STREAM>(A, F.ws, i1); conv_load(c1, lane, v1); conv_store(c0, lane, v0); conv_store(c1, lane, v1); cur += 2; n -= 2; }
        else { conv_store(c0, lane, v0); cur += 1; n -= 1; }
    }
}

__device__ __forceinline__ void p0a_mod_partials(Frame& F, const Args& A) {
    PHASE_IDS(F);
    const int gw = F.vcu * NWAVES + wave, NGW = F.G * NWAVES;
    LAS float* cond = (LAS float*)(F.lds + RING_OFF);
    for (int i = tid; i < NB_ * D_; i += 512) cond[i] = silu_f(A.in[1][i]);
    __syncthreads();
    float* MODP = (float*)(F.ws + WS_MODP);
    for (int u = gw; u < 1536; u += NGW) {
        const int j = u / 384, r = u % 384, nc = r / 16, kc = r % 16, layer = j >> 1;
        const float* W = ((j & 1) ? A.in[6] : A.in[3]) + (size_t)layer * 2048 * 6144 + (size_t)(kc * 128) * 6144 + nc * 256 + 4 * lane;
        f32x4 acc[4];
#pragma unroll
        for (int b = 0; b < 4; ++b) acc[b] = (f32x4){0.f, 0.f, 0.f, 0.f};
#pragma unroll 32
        for (int k = 0; k < 128; ++k) { const f32x4 w = *(const f32x4*)(W + (size_t)k * 6144);
#pragma unroll
            for (int b = 0; b < 4; ++b) acc[b] += cond[b * 2048 + kc * 128 + k] * w; }
#pragma unroll
        for (int b = 0; b < 4; ++b) *(f32x4*)(MODP + ((size_t)(kc * 16 + j * 4 + b)) * 6144 + nc * 256 + 4 * lane) = acc[b];
    }
}
__device__ __forceinline__ void p0_prologue(Frame& F, const Args& A) {
    PHASE_IDS(F);
    const int gw = F.vcu * NWAVES + wave, NGW = F.G * NWAVES;
    const int gt = F.vcu * 512 + tid, NGT = F.G * 512;
    { float* MOD = (float*)(F.ctl + CW_MOD); const float* MODP = (const float*)(F.ws + WS_MODP);
      for (int idx = gt; idx < 16 * 6144; idx += NGT) { const int j = idx / (4 * 6144), n = idx % 6144; float a = ((j & 1) ? A.in[7] : A.in[4])[(j >> 1) * 6144 + n];
#pragma unroll
          for (int kc = 0; kc < 16; ++kc) a += MODP[(size_t)kc * 16 * 6144 + idx];
          MOD[idx] = a; } }
    { int cur = 0; conv_burst<0>(F, A, lane, gw, NGW, cur, 1 << 20); }
    { const int* pos = (const int*)A.in[2]; f32x2* t64 = (f32x2*)(F.ws + WS_TAB64); f32x2* t256 = (f32x2*)(F.ws + WS_TAB256);
      for (int idx = gt; idx < T_ * 160; idx += NGT) { const int m = idx / 160, i = idx % 160; const double p = (double)pos[m];
          double fr; if (i < 32) fr = exp(-9.210340371976184 * (double)i / 32.0); else fr = exp(-9.210340371976184 * (double)(i - 32) / 128.0);
          double sn, cs; sincos(p * fr, &sn, &cs); const f32x2 v = {(float)cs, (float)sn};
          if (i < 32) t64[m * 32 + i] = v; else t256[m * 128 + (i - 32)] = v; } }
    { float* WR = (float*)(F.ws + WS_WR);
      for (int idx = gt; idx < 2 * 512 * 36 * 4; idx += NGT) { const int q = idx & 3, c = (idx >> 2) % 36, kq = ((idx >> 2) / 36) % 512, l = (idx >> 2) / (36 * 512); const int k = 4 * kq + q;
          WR[idx] = c < 4 ? A.in[17][(size_t)l * 2048 * 4 + k * 4 + c] : A.in[19][(size_t)l * 2048 * 32 + k * 32 + (c - 4)]; } }
}

__device__ __forceinline__ void local_mod(Frame& F, const float* bias, int j) {
    PHASE_IDS(F);
    const float* MODP = (const float*)(F.ws + WS_MODP); LAS f32x4* lm = (LAS f32x4*)(F.lds + RING_OFF);
    __syncthreads();
    for (int q = tid; q < 4096; q += 512) { const int b = q >> 10, n = 4 * (q & 1023); f32x4 a = *(const f32x4*)(bias + n);
#pragma unroll
        for (int kc = 0; kc < 16; ++kc) a += *(const f32x4*)(MODP + ((size_t)(kc * 16 + j * 4 + b)) * 6144 + n);
        lm[q] = a; }
    __syncthreads();
}
template <int MODE, bool LM = false> __device__ __forceinline__ void norm_phase(Frame& F, const float* src, float* xdst, const float* gvec, int jn, int jg, int layer_moe) {
    PHASE_IDS(F);
    const int gw = F.vcu * NWAVES + wave, NGW = F.G * NWAVES;
    const float* MOD = (const float*)(F.ctl + CW_MOD);
    bf16* H = (bf16*)(F.ws + WS_H);
    const bf16* Y = (const bf16*)(F.ws + WS_Y);
    const int* RT = (const int*)(F.ws + WS_ROUTE);
    v4u ra = {0u, 0u, 0u, 0u}, rb = {0u, 0u, 0u, 0u};
    if (MODE >= 2) { const int row_l = gw + NGW * lane; if (row_l < T_) { const v4u* rp = (const v4u*)(RT + (size_t)row_l * 8); ra = rp[0]; rb = rp[1]; } }
    for (int row = gw, ri = 0; row < T_; row += NGW, ++ri) {
        const int b = row >> 11;
        f32x4 v[8]; float ss = 0.f;
        const f32x4* xr = (const f32x4*)(src + (size_t)row * D_) + lane;
#pragma unroll
        for (int j = 0; j < 8; ++j) v[j] = xr[64 * j];
        if (MODE >= 2) {
            const int p0 = __shfl((int)rb.x, ri), p1 = __shfl((int)rb.y, ri); const float w0 = __int_as_float(__shfl((int)ra.z, ri)), w1 = __int_as_float(__shfl((int)ra.w, ri));
            const v2u* y0 = (const v2u*)(Y + (size_t)p0 * D_) + lane; const v2u* y1 = (const v2u*)(Y + (size_t)p1 * D_) + lane;
            const f32x4* gt = (const f32x4*)(MOD + (size_t)(jg * 4 + b) * 6144 + 4096) + lane;
#pragma unroll
            for (int j = 0; j < 8; ++j) { const v2u a = y0[64 * j], c = y1[64 * j]; const f32x4 g = gt[64 * j];
                f32x4 m; m.x = w0 * bf_lo(a.x) + w1 * bf_lo(c.x); m.y = w0 * bf_hi(a.x) + w1 * bf_hi(c.x); m.z = w0 * bf_lo(a.y) + w1 * bf_lo(c.y); m.w = w0 * bf_hi(a.y) + w1 * bf_hi(c.y);
                v[j] += g * m; }
            if (MODE == 2) { f32x4* xo = (f32x4*)(xdst + (size_t)row * D_) + lane;
#pragma unroll
                for (int j = 0; j < 8; ++j) xo[64 * j] = v[j]; }
        }
#pragma unroll
        for (int j = 0; j < 8; ++j) ss += (v[j].x * v[j].x + v[j].y * v[j].y) + (v[j].z * v[j].z + v[j].w * v[j].w);
        const float rstd = 1.0f / sqrtf(wave_sum(ss) * (1.0f / D_) + EPS_);
        const f32x4* gv = (const f32x4*)gvec + lane;
        if (MODE == 3) { f32x4* o = (f32x4*)(F.out + (size_t)row * D_) + lane;
#pragma unroll
            for (int j = 0; j < 8; ++j) o[64 * j] = v[j] * rstd * gv[64 * j];
        } else {
            v2u* o = (v2u*)(H + (size_t)row * D_) + lane;
            if (LM) { const LAS f32x4* sh = (const LAS f32x4*)(F.lds + RING_OFF) + b * 1024 + lane; const LAS f32x4* sc = sh + 512;
#pragma unroll
                for (int j = 0; j < 8; ++j) { const f32x4 h = v[j] * rstd * gv[64 * j] * (1.0f + sc[64 * j]) + sh[64 * j]; v2u w; w.x = pk2(h.x, h.y); w.y = pk2(h.z, h.w); o[64 * j] = w; }
            } else { const f32x4* sh = (const f32x4*)(MOD + (size_t)(jn * 4 + b) * 6144) + lane; const f32x4* sc = sh + 512;
#pragma unroll
                for (int j = 0; j < 8; ++j) { const f32x4 h = v[j] * rstd * gv[64 * j] * (1.0f + sc[64 * j]) + sh[64 * j]; v2u w; w.x = pk2(h.x, h.y); w.y = pk2(h.z, h.w); o[64 * j] = w; } }
        }
    }
}

__device__ __forceinline__ void router_phase(Frame& F, const Args& A, const float* X, const float* gvec, int jn, int layer, bool first) {
    const float* MOD = (const float*)(F.ctl + CW_MOD);
    const f32x4* WR4 = (const f32x4*)(F.ws + WS_WR) + (size_t)layer * 512 * 36;
    int* RT = (int*)(F.ws + WS_ROUTE); float* RS = (float*)(F.ws + WS_RS);
    LAS f32x4* hs = (LAS f32x4*)(F.lds + RING_OFF);
    LAS f32x4* wsm = (LAS f32x4*)(F.lds + RING_OFF + 40960);
    LAS f32x4* shs = (LAS f32x4*)(F.lds + RING_OFF + 81920);
    LAS float* rs = (LAS float*)(F.lds + RING_OFF + 83968);
    LAS float* lg = (LAS float*)(F.lds + RING_OFF + 84224);
    PHASE_IDS(F);
    const int r = tid >> 4, kp = tid & 15, kpart = lane & 15, cg = lane >> 4;
    int wpos[5];
#pragma unroll
    for (int i = 0; i < 5; ++i) { const int idx = tid + 512 * i; wpos[i] = idx + idx / 36; }
    for (int tile = F.vcu; tile < T_ / 32; tile += F.G) {
        const int row0 = tile * 32, b = row0 >> 11;
        const f32x4* sh = (const f32x4*)(MOD + (size_t)(jn * 4 + b) * 6144); const f32x4* sc = sh + 512; const f32x4* gv = (const f32x4*)gvec;
        const f32x4* xr = (const f32x4*)(X + (size_t)(row0 + r) * D_);
        float acc[4][9], accq[9], ss = 0.f;
#pragma unroll
        for (int c = 0; c < 9; ++c) { accq[c] = 0.f;
#pragma unroll
            for (int rr = 0; rr < 4; ++rr) acc[rr][c] = 0.f; }
        f32x4 xq[4], gq[4], sq[4], wq[5];
#define RT_LOAD(ch) do { _Pragma("unroll") for (int g = 0; g < 4; ++g) { const int q = (ch) * 64 + kp + 16 * g; xq[g] = xr[q]; gq[g] = gv[q] * (1.0f + sc[q]); if (r == 0) sq[g] = sh[q]; } \
            _Pragma("unroll") for (int i = 0; i < 5; ++i) { const int idx = tid + 512 * i; if (idx < 2304) wq[i] = WR4[(size_t)(ch) * 2304 + idx]; } } while (0)
        RT_LOAD(0);
#pragma unroll 1
        for (int ch = 0; ch < 8; ++ch) {
#pragma unroll
            for (int g = 0; g < 4; ++g) { const f32x4 x = xq[g]; ss += (x.x * x.x + x.y * x.y) + (x.z * x.z + x.w * x.w); hs[r * 65 + kp + 16 * g] = x * gq[g]; if (r == 0) shs[kp + 16 * g] = sq[g]; }
#pragma unroll
            for (int i = 0; i < 5; ++i) if (tid + 512 * i < 2304) wsm[wpos[i]] = wq[i];
            __syncthreads();
            if (ch + 1 < 8) RT_LOAD(ch + 1);
#pragma unroll 1
            for (int g = 0; g < 4; ++g) { const int kq = kpart + 16 * g; f32x4 h4[4];
#pragma unroll
                for (int rr = 0; rr < 4; ++rr) h4[rr] = hs[(wave * 4 + rr) * 65 + kq];
                const f32x4 q4 = shs[kq];
#pragma unroll
                for (int c = 0; c < 9; ++c) { const f32x4 w4 = wsm[kq * 37 + 9 * cg + c];
#pragma unroll
                    for (int rr = 0; rr < 4; ++rr) acc[rr][c] += (h4[rr].x * w4.x + h4[rr].y * w4.y) + (h4[rr].z * w4.z + h4[rr].w * w4.w);
                    if (wave == 0) accq[c] += (q4.x * w4.x + q4.y * w4.y) + (q4.z * w4.z + q4.w * w4.w); } }
            __syncthreads();
        }
#undef RT_LOAD
#pragma unroll
        for (int rr = 0; rr < 4; ++rr)
#pragma unroll
            for (int c = 0; c < 9; ++c) { float a = acc[rr][c]; a += __shfl_xor(a, 1); a += __shfl_xor(a, 2); a += __shfl_xor(a, 4); a += __shfl_xor(a, 8); if (kpart == 0) lg[(wave * 4 + rr) * 36 + 9 * cg + c] = a; }
        if (wave == 0) {
#pragma unroll
            for (int c = 0; c < 9; ++c) { float a = accq[c]; a += __shfl_xor(a, 1); a += __shfl_xor(a, 2); a += __shfl_xor(a, 4); a += __shfl_xor(a, 8); if (kpart == 0) lg[1152 + 9 * cg + c] = a; } }
        ss += __shfl_xor(ss, 1); ss += __shfl_xor(ss, 2); ss += __shfl_xor(ss, 4); ss += __shfl_xor(ss, 8);
        if (kp == 0) rs[r] = 1.0f / sqrtf(ss * (1.0f / D_) + EPS_);
        __syncthreads();
        if (tid < 32) { const int row = row0 + tid; const LAS float* l = lg + tid * 36; const LAS float* q = lg + 1152; const float* bg = A.in[18] + layer * 4; const float* be = A.in[20] + layer * 32; const float rstd = rs[tid];
            if (first) RS[row] = rstd;
            float g[4]; int gi = 0; float gm;
#pragma unroll
            for (int i = 0; i < 4; ++i) g[i] = rstd * l[i] + q[i] + bg[i];
            gm = g[0];
#pragma unroll
            for (int i = 1; i < 4; ++i) if (g[i] > gm) { gm = g[i]; gi = i; }
            float gs = 0.f;
#pragma unroll
            for (int i = 0; i < 4; ++i) gs += __expf(g[i] - gm);
            const float gw = 1.0f / gs;
            float e[8];
#pragma unroll
            for (int i = 0; i < 8; ++i) e[i] = rstd * l[4 + 8 * gi + i] + q[4 + 8 * gi + i] + be[8 * gi + i];
            int i0 = 0; float m0 = e[0];
#pragma unroll
            for (int i = 1; i < 8; ++i) if (e[i] > m0) { m0 = e[i]; i0 = i; }
            int i1 = -1; float m1 = -3.0e38f;
#pragma unroll
            for (int i = 0; i < 8; ++i) if (i != i0 && e[i] > m1) { m1 = e[i]; i1 = i; }
            const float p1 = __expf(m1 - m0), w0 = gw / (1.0f + p1), w1 = gw * p1 / (1.0f + p1);
            const int e0 = 8 * gi + i0, e1 = 8 * gi + i1;
            int* rt = RT + (size_t)row * 8; rt[0] = e0; rt[1] = e1; rt[2] = __float_as_int(w0); rt[3] = __float_as_int(w1);
            if (first) { atomicAdd((unsigned*)(F.ctl + CW_ECNT + 64 * layer + e0), 1u); atomicAdd((unsigned*)(F.ctl + CW_ECNT + 64 * layer + e1), 1u); }
        }
        __syncthreads();
    }
}

__device__ __forceinline__ void scatter_phase(Frame& F, const float* X, const float* gvec, int jn, int layer, bool first) {
    LAS int* tab = (LAS int*)(F.lds + MOE_TAB_OFF);
    PHASE_IDS(F);
    const int gw = F.vcu * NWAVES + wave, NGW = F.G * NWAVES;
    const float* MOD = (const float*)(F.ctl + CW_MOD);
    int* RT = (int*)(F.ws + WS_ROUTE); const float* RS = (const float*)(F.ws + WS_RS); bf16* HG = (bf16*)(F.ws + WS_HG);
    int myp0 = 0, myp1 = 0;
    { const int tok_l = gw + NGW * lane;
      if (tok_l < T_) { int* rt = RT + (size_t)tok_l * 8;
          if (first) { const int e0 = rt[0], e1 = rt[1];
              myp0 = tab[128 + e0] + (int)atomicAdd((unsigned*)(F.ctl + CW_ECUR + 64 * layer + e0), 1u);
              myp1 = tab[128 + e1] + (int)atomicAdd((unsigned*)(F.ctl + CW_ECUR + 64 * layer + e1), 1u);
              rt[4] = myp0; rt[5] = myp1; }
          else { myp0 = rt[4]; myp1 = rt[5]; } } }
    for (int i = 0; gw + NGW * i < T_; ++i) {
        const int tok = gw + NGW * i;
        const int p0 = __shfl(myp0, i), p1 = __shfl(myp1, i);
        const f32x4* xr = (const f32x4*)(X + (size_t)tok * D_) + lane; f32x4 v[8];
#pragma unroll
        for (int j = 0; j < 8; ++j) v[j] = xr[64 * j];
        const float rstd = RS[tok]; const int b = tok >> 11;
        const f32x4* sh = (const f32x4*)(MOD + (size_t)(jn * 4 + b) * 6144) + lane; const f32x4* sc = sh + 512; const f32x4* gv = (const f32x4*)gvec + lane;
        v2u* d0 = (v2u*)(HG + (size_t)p0 * D_) + lane; v2u* d1 = (v2u*)(HG + (size_t)p1 * D_) + lane;
#pragma unroll
        for (int j = 0; j < 8; ++j) { const f32x4 h = v[j] * rstd * gv[64 * j] * (1.0f + sc[64 * j]) + sh[64 * j]; v2u w; w.x = pk2(h.x, h.y); w.y = pk2(h.z, h.w); d0[64 * j] = w; d1[64 * j] = w; }
    }
}

__device__ __forceinline__ void retnorm_phase(Frame& F) {
    PHASE_IDS(F);
    const int gw = F.vcu * NWAVES + wave, NGW = F.G * NWAVES;
    const bf16* O = (const bf16*)(F.ws + WS_RETO); const bf16* P1 = (const bf16*)(F.ws + WS_PROJ1); bf16* A5 = (bf16*)(F.ws + WS_A5);
    for (int row = gw; row < T_; row += NGW) {
        const v4u* o = (const v4u*)(O + (size_t)row * 4096) + lane; const v4u* g = (const v4u*)(P1 + (size_t)row * 12288 + 8192) + lane; v4u* a = (v4u*)(A5 + (size_t)row * 4096) + lane;
#pragma unroll
        for (int h = 0; h < 8; ++h) { const v4u x = o[64 * h], s = g[64 * h];
            float f[8] = {bf_lo(x.x), bf_hi(x.x), bf_lo(x.y), bf_hi(x.y), bf_lo(x.z), bf_hi(x.z), bf_lo(x.w), bf_hi(x.w)};
            float ss = 0.f;
#pragma unroll
            for (int i = 0; i < 8; ++i) ss += f[i] * f[i];
            const float rstd = 1.0f / sqrtf(wave_sum(ss) * (1.0f / 512.0f) + EPS_);
            v4u w; w.x = pk2(f[0] * rstd * bf_lo(s.x), f[1] * rstd * bf_hi(s.x)); w.y = pk2(f[2] * rstd * bf_lo(s.y), f[3] * rstd * bf_hi(s.y));
            w.z = pk2(f[4] * rstd * bf_lo(s.z), f[5] * rstd * bf_hi(s.z)); w.w = pk2(f[6] * rstd * bf_lo(s.w), f[7] * rstd * bf_hi(s.w));
            a[64 * h] = w; }
    }
}
#ifndef ATT_REP
#define ATT_REP 1
#endif
#ifndef RET_REP
#define RET_REP 1
#endif
#ifndef ATT_KPF
#define ATT_KPF 4
#endif
constexpr int ATT_VST = 320;
__device__ __forceinline__ s16x4 vtr(const LAS unsigned char* p) { return __builtin_bit_cast(s16x4, __builtin_amdgcn_ds_read_tr16_b64_v4i16((LAS v4i16_t*)p)); }
__device__ __forceinline__ float xhalf(float v) { return __shfl_xor(v, 32); }

template <int DQK, int MODE>
__device__ __forceinline__ void attn_unit(LAS unsigned char* lds, const bf16* Qp, int qpitch, const bf16* Kp, int kpitch, const bf16* K2p, int k2pitch,
                                          const bf16* Vp, int vpitch, bf16* Op, int opitch, int q0, float dlog2, int tid_, int wave, int lane_, volatile LAS unsigned* flg) {
    const int lane = lane_id_opaque(), tid = wave * 64 + lane; (void)tid_; (void)lane_;
    constexpr int RB = DQK * 2, SW = (DQK == 192) ? 7 : 15, KB = 64 * RB, STG = KB + 16384;
    constexpr int NIK = KB / 8192, NI = NIK + 2;
    constexpr int NKS = DQK / 16;
    static_assert(3 * STG <= RING_BYTES, "three stages in the ring");
    const int r = lane & 31, h = lane >> 5, qrow = q0 + 32 * wave + r;
    bf16x8 qf[NKS];
    { const bf16* qp = Qp + (size_t)qrow * qpitch + 8 * h;
#pragma unroll
      for (int ks = 0; ks < NKS; ++ks) qf[ks] = *(const bf16x8*)(qp + 16 * ks); }
    f32x16 o[4];
#pragma unroll
    for (int db = 0; db < 4; ++db)
#pragma unroll
        for (int i = 0; i < 16; ++i) o[db][i] = 0.f;
    float m_run = -1.0e30f, l_run = 0.f, carry = 0.f;
    const int ntiles = (q0 + 256) >> 6;
    constexpr bool KLIN = (DQK != 192); constexpr int NKG = KLIN ? 1 : NIK;
    unsigned kgo[NKG], vgo0; bool krope[NKG];
#pragma unroll
    for (int j = 0; j < NKG; ++j) { const int pos = (j * 8 + wave) * 1024 + lane * 16, row = pos / RB, c = ((pos % RB) >> 4) ^ (row & SW);
        krope[j] = (DQK == 192) && c >= 16;
        kgo[j] = krope[j] ? (unsigned)(row * k2pitch * 2 + (c - 16) * 16) : (unsigned)(row * kpitch * 2 + c * 16); }
    { const int pos = wave * 1024 + lane * 16, row = pos >> 8, ch = ((pos & 255) >> 4) ^ (((row & 3) << 2) | ((row >> 2) & 3)); vgo0 = (unsigned)(row * vpitch * 2 + ch * 16); }
#define ATT_DMA(kt, stg) do { const size_t key0_ = (size_t)(kt) * 64; \
        const char* kb_ = (const char*)Kp + key0_ * kpitch * 2; const char* k2_ = (const char*)K2p + key0_ * k2pitch * 2; const char* vb_ = (const char*)Vp + key0_ * vpitch * 2; \
        LAS unsigned char* st_ = lds + (stg) * STG + wave * 1024; \
        _Pragma("unroll") for (int j_ = 0; j_ < NIK; ++j_) { const char* g_ = KLIN ? kb_ + kgo[0] + (size_t)j_ * (8192 / RB) * kpitch * 2 : ((krope[KLIN ? 0 : j_] ? k2_ : kb_) + kgo[KLIN ? 0 : j_]); \
            __builtin_amdgcn_global_load_lds((const unsigned*)g_, (LAS unsigned*)(st_ + j_ * 8192), 16, 0, 0); } \
        _Pragma("unroll") for (int j_ = 0; j_ < 2; ++j_) __builtin_amdgcn_global_load_lds((const unsigned*)(vb_ + vgo0 + (size_t)j_ * 32 * vpitch * 2), (LAS unsigned*)(st_ + KB + j_ * 8192), 16, 0, 0); } while (0)
    if (MODE == 1 && tid < 16) flg[tid] = 0u;
    ATT_DMA(ntiles - 1, 0);
    ATT_DMA(ntiles > 1 ? ntiles - 2 : 0, 1);
    const int q4 = (lane & 15) >> 2, p4 = lane & 3, blk = (lane >> 4) & 1, x4 = 2 * blk + (p4 >> 1);
    constexpr int NKO = (SW + 1) / 2;
    const int krow = r * RB, kxy = (r & SW) ^ h;
    const int vlo_off = 256 * (4 * h + q4) + 16 * (x4 ^ h) + 8 * (p4 & 1), vhi_off = 256 * (4 * h + q4 + 8) + 16 * (x4 ^ (h + 2)) + 8 * (p4 & 1);
    for (int it = 0; it < ntiles; ++it) {
        const int kt = ntiles - 1 - it;
        int y_ = kxy, q4_ = q4; asm volatile("" : "+v"(y_), "+v"(q4_));
        const bool wdone = (MODE == 1) && __all(carry < -140.0f);
        if (MODE == 1 && lane == 0) flg[8 * (it & 1) + wave] = wdone ? 1u : 0u;
        asm volatile("s_waitcnt vmcnt(%0)" :: "n"(NI) : "memory");
        asm volatile("s_waitcnt lgkmcnt(0)" ::: "memory");
        __builtin_amdgcn_s_barrier();
        asm volatile("" ::: "memory");
        if (MODE == 1) { v4u fa, fb; const unsigned fad = (unsigned)(size_t)(flg + 8 * (it & 1));
            asm volatile("ds_read_b128 %0, %2\n\tds_read_b128 %1, %2 offset:16\n\ts_waitcnt lgkmcnt(0)" : "=&v"(fa), "=&v"(fb) : "v"(fad) : "memory");
            if ((fa.x & fa.y & fa.z & fa.w & fb.x & fb.y & fb.z & fb.w) != 0u) break; }
        { const int ktn = kt >= 2 ? kt - 2 : 0; ATT_DMA(ktn, (it + 2) % 3); }
        if (!wdone && 64 * kt <= q0 + 32 * wave + 31) {
            const LAS unsigned char* Kb = lds + (it % 3) * STG; const LAS unsigned char* Vb = Kb + KB;
            f32x16 s[2];
            const int kbase = 64 * kt + 4 * h;
            const bool diag = 64 * kt + 63 > q0 + 32 * wave;
            unsigned va[8];
#pragma unroll
            for (int db = 0; db < 4; ++db) { va[db] = (unsigned)(size_t)(Vb + vlo_off + 64 * (db ^ q4_)); va[4 + db] = (unsigned)(size_t)(Vb + vhi_off + 64 * (db ^ q4_)); }
            s16x4 lo_[2][4], hi_[2][4];
#define ATT_VRD(buf, sidx) do { _Pragma("unroll") for (int db = 0; db < 4; ++db) { \
                    asm volatile("ds_read_b64_tr_b16 %0, %1 offset:%c2" : "=&v"(lo_[buf][db]) : "v"(va[db]), "i"(4096 * (sidx)) : "memory"); \
                    asm volatile("ds_read_b64_tr_b16 %0, %1 offset:%c2" : "=&v"(hi_[buf][db]) : "v"(va[4 + db]), "i"(4096 * (sidx)) : "memory"); } } while (0)
#define ATT_VMM(buf, sidx) do { const int kb_ = (sidx) >> 1, ss_ = (sidx) & 1; \
                v4u pw; pw.x = pk2(s[kb_][8 * ss_ + 0], s[kb_][8 * ss_ + 1]); pw.y = pk2(s[kb_][8 * ss_ + 2], s[kb_][8 * ss_ + 3]); pw.z = pk2(s[kb_][8 * ss_ + 4], s[kb_][8 * ss_ + 5]); pw.w = pk2(s[kb_][8 * ss_ + 6], s[kb_][8 * ss_ + 7]); \
                const bf16x8 pf = __builtin_bit_cast(bf16x8, pw); \
                _Pragma("unroll") for (int db = 0; db < 4; ++db) { \
                    const bf16x8 vf = __builtin_shufflevector(lo_[buf][db], hi_[buf][db], 0, 1, 2, 3, 4, 5, 6, 7); \
                    o[db] = __builtin_amdgcn_mfma_f32_32x32x16_bf16(vf, pf, o[db], 0, 0, 0); } } while (0)
#define ATT_PVN(first, count) do { ATT_VRD(0, first); \
                _Pragma("unroll") for (int i_ = 0; i_ < (count); ++i_) { \
                    if (i_ + 1 < (count)) { if (i_ & 1) ATT_VRD(0, (first) + i_ + 1); else ATT_VRD(1, (first) + i_ + 1); asm volatile("s_waitcnt lgkmcnt(8)" ::: "memory"); } \
                    else asm volatile("s_waitcnt lgkmcnt(0)" ::: "memory"); \
                    __builtin_amdgcn_sched_barrier(0); \
                    if (i_ & 1) ATT_VMM(1, (first) + i_); else ATT_VMM(0, (first) + i_); \
                    __builtin_amdgcn_sched_barrier(0); } } while (0)
#pragma unroll
            for (int kb = 0; kb < 2; ++kb) {
#pragma unroll
                for (int i = 0; i < 16; ++i) s[kb][i] = 0.f;
                const LAS unsigned char* kp = Kb + 32 * kb * RB;
#define ATT_KF(ks) (*(const LAS bf16x8*)(kp + krow + (((2 * ((ks) % NKO)) ^ y_) << 4) + (((2 * (ks)) & ~SW) << 4)))
                bf16x8 fa = ATT_KF(0), fb = ATT_KF(1);
#pragma unroll
                for (int g2 = 0; g2 < NKS / 2; ++g2) {
                    bf16x8 na = fa, nb = fb;
                    if (g2 + 1 < NKS / 2) { na = ATT_KF(2 * g2 + 2); nb = ATT_KF(2 * g2 + 3); }
                    __builtin_amdgcn_sched_barrier(0);
                    s[kb] = __builtin_amdgcn_mfma_f32_32x32x16_bf16(fa, qf[2 * g2], s[kb], 0, 0, 0); s[kb] = __builtin_amdgcn_mfma_f32_32x32x16_bf16(fb, qf[2 * g2 + 1], s[kb], 0, 0, 0);
                    __builtin_amdgcn_sched_barrier(0);
                    fa = na; fb = nb;
                }
#undef ATT_KF
                if (MODE == 2) {
                    if (diag) {
#pragma unroll
                        for (int i = 0; i < 16; ++i) { const int key = kbase + 32 * kb + (i & 3) + 8 * (i >> 2); s[kb][i] = key <= qrow ? s[kb][i] : 0.f; } }
                    ATT_PVN(2 * kb, 2);
                }
            }
            if (MODE == 0) {
                float tmax = -1.0e30f;
#pragma unroll
                for (int kb = 0; kb < 2; ++kb)
#pragma unroll
                    for (int i = 0; i < 16; ++i) { const int key = kbase + 32 * kb + (i & 3) + 8 * (i >> 2); const float v = (!diag || key <= qrow) ? s[kb][i] : -1.0e30f; s[kb][i] = v; tmax = fmaxf(tmax, v); }
                tmax = fmaxf(tmax, xhalf(tmax));
                const float m_new = fmaxf(m_run, tmax), alpha = ex2(m_run - m_new); m_run = m_new;
                float ps = 0.f;
#pragma unroll
                for (int kb = 0; kb < 2; ++kb)
#pragma unroll
                    for (int i = 0; i < 16; ++i) { const float p = ex2(s[kb][i] - m_new); s[kb][i] = p; ps += p; }
                l_run = l_run * alpha + ps;
#pragma unroll
                for (int db = 0; db < 4; ++db)
#pragma unroll
                    for (int i = 0; i < 16; ++i) o[db][i] *= alpha;
            } else if (MODE == 1) {
                float lkv[2][16], gs[2][4], go[2][4];
#pragma unroll
                for (int kb = 0; kb < 2; ++kb)
#pragma unroll
                    for (int g = 0; g < 4; ++g) { float t = 0.f;
#pragma unroll
                        for (int j = 0; j < 4; ++j) { const int i = 4 * g + j, key = kbase + 32 * kb + 8 * g + j; const float z = s[kb][i];
                            const bool vis = key < qrow;
                            const float lk = vis ? -(fmaxf(z, 0.f) + lg2(1.0f + ex2(-fabsf(z)))) : 0.f;
                            lkv[kb][i] = lk; s[kb][i] = vis ? z + lk : -1.0e30f; t += lk; }
                        gs[kb][g] = t; }
#pragma unroll
                for (int kb = 0; kb < 2; ++kb)
#pragma unroll
                    for (int g = 0; g < 4; ++g) go[kb][g] = xhalf(gs[kb][g]);
                float R = carry;
#pragma unroll
                for (int kb = 1; kb >= 0; --kb)
#pragma unroll
                    for (int g = 3; g >= 0; --g) {
                        float run = R + (h == 0 ? go[kb][g] : 0.f);
#pragma unroll
                        for (int j = 3; j >= 0; --j) { const int i = 4 * g + j; const float a = ex2(s[kb][i] + run); run += lkv[kb][i]; s[kb][i] = a; }
                        R += gs[kb][g] + go[kb][g];
                    }
                carry = R;
            }
            if (MODE != 2) { ATT_PVN(0, 4); }
#undef ATT_PVN
#undef ATT_VMM
#undef ATT_VRD
        }
    }
#undef ATT_DMA
    asm volatile("s_waitcnt vmcnt(0) lgkmcnt(0)" ::: "memory");
    __builtin_amdgcn_s_barrier();
    asm volatile("" ::: "memory");
    float inv = 1.0f;
    if (MODE == 0) { const float lt = l_run + xhalf(l_run); inv = 1.0f / lt; }
    bf16* op = Op + (size_t)qrow * opitch + 4 * h;
#pragma unroll
    for (int db = 0; db < 4; ++db)
#pragma unroll
        for (int g = 0; g < 4; ++g) { v2u w; w.x = pk2(o[db][4 * g] * inv, o[db][4 * g + 1] * inv); w.y = pk2(o[db][4 * g + 2] * inv, o[db][4 * g + 3] * inv); *(v2u*)(op + 32 * db + 8 * g) = w; }
}

struct WorkQ { gu32* q; int total; int slot; unsigned nxt; };
__device__ __forceinline__ void wq_init(Frame& F, WorkQ& Q, gu32* q, int total, int slot, int lane) {
    Q.q = q; Q.total = total; Q.slot = slot; Q.nxt = 0u;
    if (F.wave == 0 && lane == 0) Q.nxt = __hip_atomic_fetch_add(q, 1u, RLX_AGENT);
}
__device__ __forceinline__ bool wq_take(Frame& F, WorkQ& Q, int lane, int& u) {
    if (F.wave == 0 && lane == 0) F.MISC[Q.slot] = Q.nxt;
    __syncthreads();
    u = (int)F.MISC[Q.slot];
    __syncthreads();
    if (u >= Q.total) return false;
    if (F.wave == 0 && lane == 0) Q.nxt = __hip_atomic_fetch_add(Q.q, 1u, RLX_AGENT);
    return true;
}
template <int STREAM> __device__ __forceinline__ bool conv_batch(Frame& F, const Args& A, WorkQ& Q, int lane, int wave) {
    int b; if (!wq_take(F, Q, lane, b)) return false;
    const int i0 = 128 * b + 16 * wave;
    f32x4 va0[8], va1[8], vb0[8], vb1[8];
    { const ConvSrc c0 = conv_item<STREAM>(A, F.ws, i0), c1 = conv_item<STREAM>(A, F.ws, i0 + 1); conv_load(c0, lane, va0); conv_load(c1, lane, va1); }
#pragma unroll
    for (int p = 0; p < 8; ++p) {
        const ConvSrc c0 = conv_item<STREAM>(A, F.ws, i0 + 2 * p), c1 = conv_item<STREAM>(A, F.ws, i0 + 2 * p + 1);
        if (p + 1 < 8) { const ConvSrc n0 = conv_item<STREAM>(A, F.ws, i0 + 2 * p + 2), n1 = conv_item<STREAM>(A, F.ws, i0 + 2 * p + 3);
            if (p & 1) { conv_load(n0, lane, va0); conv_load(n1, lane, va1); } else { conv_load(n0, lane, vb0); conv_load(n1, lane, vb1); } }
        if (p & 1) { conv_store(c0, lane, vb0); conv_store(c1, lane, vb1); } else { conv_store(c0, lane, va0); conv_store(c1, lane, va1); }
    }
    return true;
}
__device__ __forceinline__ void mla_phase(Frame& F, const Args& A, WorkQ& QC, bool& conv_left) {
    PHASE_IDS(F);
    WorkQ QU; wq_init(F, QU, F.ctl + CW_QMLA, 256, 16, lane);
    if (F.vcu & 1) { for (int i = 0; i < 2 && conv_left; ++i) conv_left = conv_batch<1>(F, A, QC, lane, wave); }
    const bf16* Q = (const bf16*)(F.ws + WS_QMLA); const bf16* KV = (const bf16*)(F.ws + WS_KVMLA); const bf16* KR = (const bf16*)(F.ws + WS_KR); bf16* O = (bf16*)(F.ws + WS_ATTO);
    int u;
    while (wq_take(F, QU, lane, u)) {
        const int qb = 7 - (u >> 5), bh = u & 31, b = bh >> 3, h = bh & 7; const size_t r0 = (size_t)b * S_;
#pragma unroll 1
        for (int rep_ = 0; rep_ < ATT_REP; ++rep_)
        attn_unit<192, 0>(F.lds + RING_OFF, Q + r0 * 1536 + h * 192, 1536, KV + r0 * 2048 + h * 256, 2048, KR + r0 * 64, 64, KV + r0 * 2048 + h * 256 + 128, 2048,
                          O + r0 * 2048 + 1024 + h * 128, 2048, qb * 256, 0.f, tid, wave, lane, F.MISC + 32);
        if (conv_left) conv_left = conv_batch<1>(F, A, QC, lane, wave);
    }
}
__device__ __forceinline__ void sb_phase(Frame& F, const Args& A, WorkQ& QC, bool& conv_left) {
    PHASE_IDS(F);
    WorkQ QU; wq_init(F, QU, F.ctl + CW_QSB, 256, 17, lane);
    const bf16* P0 = (const bf16*)(F.ws + WS_PROJ0); bf16* O = (bf16*)(F.ws + WS_ATTO);
    int u;
    while (wq_take(F, QU, lane, u)) {
        const int qb = 7 - (u >> 5), bh = u & 31, b = bh >> 3, h = bh & 7; const size_t r0 = (size_t)b * S_;
#pragma unroll 1
        for (int rep_ = 0; rep_ < ATT_REP; ++rep_)
        attn_unit<128, 1>(F.lds + RING_OFF, P0 + r0 * 4096 + h * 128, 4096, P0 + r0 * 4096 + 1024 + h * 128, 4096, nullptr, 0, P0 + r0 * 4096 + 2048 + h * 128, 4096,
                          O + r0 * 2048 + h * 128, 2048, qb * 256, 0.f, tid, wave, lane, F.MISC + 32);
        if (conv_left) conv_left = conv_batch<1>(F, A, QC, lane, wave);
    }
    while (conv_left) conv_left = conv_batch<1>(F, A, QC, lane, wave);
}
__device__ __forceinline__ void ret_phase(Frame& F, const Args& A) {
    PHASE_IDS(F);
    WorkQ QC; wq_init(F, QC, F.ctl + CW_QC2, CONV_N2 / 128, 18, lane); bool conv_left = true;
    WorkQ QU; wq_init(F, QU, F.ctl + CW_QRET, 1024, 16, lane);
    if (F.vcu & 1) conv_left = conv_batch<2>(F, A, QC, lane, wave);
    const bf16* P1 = (const bf16*)(F.ws + WS_PROJ1); bf16* O = (bf16*)(F.ws + WS_RETO);
    int u;
    while (wq_take(F, QU, lane, u)) {
        const int qb = 7 - (u >> 7), rem = u & 127, eq = rem >> 5, bh = rem & 31, b = bh >> 3, h = bh & 7; const size_t r0 = (size_t)b * S_;
        const float dlog2 = log1pf(-exp2f(-5.0f - (float)h)) * LOG2E;
#pragma unroll 1
        for (int rep_ = 0; rep_ < RET_REP; ++rep_)
        attn_unit<256, 2>(F.lds + RING_OFF, P1 + r0 * 12288 + h * 256, 12288, P1 + r0 * 12288 + 2048 + h * 256, 12288, nullptr, 0, P1 + r0 * 12288 + 4096 + h * 512 + eq * 128, 12288,
                          O + r0 * 4096 + h * 512 + eq * 128, 4096, qb * 256, dlog2, tid, wave, lane, F.MISC + 32);
        if (conv_left && (u & 1)) conv_left = conv_batch<2>(F, A, QC, lane, wave);
    }
    while (conv_left) conv_left = conv_batch<2>(F, A, QC, lane, wave);
}
typedef f32x4 AccT[2][2][4][2];
__device__ __forceinline__ v4u pack8(const f32x4& a, const f32x4& b) { v4u w; w.x = pk2(a.x, a.y); w.y = pk2(a.z, a.w); w.z = pk2(b.x, b.y); w.w = pk2(b.z, b.w); return w; }
__device__ __forceinline__ float sq4(const f32x4& a) { return (a.x * a.x + a.y * a.y) + (a.z * a.z + a.w * a.w); }
__device__ __forceinline__ void rope4(const f32x4& x1, const f32x4& x2, const f32x2* cs, f32x4& o1, f32x4& o2) {
    const f32x4 c01 = *(const f32x4*)cs, c23 = *(const f32x4*)(cs + 2);
    o1.x = x1.x * c01.x - x2.x * c01.y; o2.x = x1.x * c01.y + x2.x * c01.x;
    o1.y = x1.y * c01.z - x2.y * c01.w; o2.y = x1.y * c01.w + x2.y * c01.z;
    o1.z = x1.z * c23.x - x2.z * c23.y; o2.z = x1.z * c23.y + x2.z * c23.x;
    o1.w = x1.w * c23.z - x2.w * c23.w; o2.w = x1.w * c23.w + x2.w * c23.z;
}
struct EpiG1 { static constexpr bool PERM = true, AFTER_DRAIN = false;
    bf16* P0; bf16* KR; float* ssqp; const f32x2* cs64;
    __device__ __forceinline__ void operator()(const AccT& acc, const pg8::Unit& u, int wr, int wc, int fr, int fq) const {
        const int row0 = u.pm * 256 + wr * 64 + fr, tc = wc * 32 + 8 * fq;
        if (u.pn < 15) {
            const float scl = u.pn < 4 ? C_SB : 1.0f;
#pragma unroll
            for (int ai = 0; ai < 2; ++ai)
#pragma unroll
                for (int m = 0; m < 4; ++m) { const int row = row0 + ai * 128 + m * 16; float ss = 0.f;
#pragma unroll
                    for (int bj = 0; bj < 2; ++bj) { const f32x4 v0 = acc[ai][bj][m][0], v1 = acc[ai][bj][m][1]; ss += sq4(v0) + sq4(v1);
                        *(v4u*)(P0 + (size_t)row * 4096 + u.pn * 256 + bj * 128 + tc) = pack8(v0 * scl, v1 * scl); }
                    if (u.pn >= 12) { ss += __shfl_xor(ss, 16); ss += __shfl_xor(ss, 32); if (fq == 0) { if (u.pn < 14) ssqp[(size_t)row * 8 + 4 * (u.pn - 12) + wc] = ss; else ssqp[(size_t)T_ * 8 + (size_t)row * 4 + wc] = ss; } } }
        } else if (wc == 0) {
#pragma unroll
            for (int ai = 0; ai < 2; ++ai)
#pragma unroll
                for (int m = 0; m < 4; ++m) { const int row = row0 + ai * 128 + m * 16; f32x4 a0, b0, a1, b1;
                    rope4(acc[ai][0][m][0], acc[ai][1][m][0], cs64 + (size_t)row * 32 + 8 * fq, a0, b0);
                    rope4(acc[ai][0][m][1], acc[ai][1][m][1], cs64 + (size_t)row * 32 + 8 * fq + 4, a1, b1);
                    *(v4u*)(KR + (size_t)row * 64 + 8 * fq) = pack8(a0, a1); *(v4u*)(KR + (size_t)row * 64 + 32 + 8 * fq) = pack8(b0, b1); asm volatile("" ::: "memory"); }
        }
    }
};
struct EpiG2q { static constexpr bool PERM = true, AFTER_DRAIN = false;
    bf16* Q; const float* ssq; const f32x2* cs64;
    __device__ __forceinline__ void operator()(const AccT& acc, const pg8::Unit& u, int wr, int wc, int fr, int fq) const {
        const int row0 = u.pm * 256 + wr * 64 + fr, tc = wc * 32 + 8 * fq;
        if (u.pn < 4) {
#pragma unroll
            for (int ai = 0; ai < 2; ++ai)
#pragma unroll
                for (int m = 0; m < 4; ++m) { const int row = row0 + ai * 128 + m * 16; const f32x4 pa = *(const f32x4*)(ssq + (size_t)row * 8), pb = *(const f32x4*)(ssq + (size_t)row * 8 + 4); const float rs = C_MLA * __builtin_amdgcn_rsqf(((((((pa.x + pa.y) + pa.z) + pa.w) + pb.x) + pb.y) + pb.z + pb.w) * (1.0f / 512.0f) + EPS_);
#pragma unroll
                    for (int bj = 0; bj < 2; ++bj) { const int nidx = u.pn * 256 + bj * 128 + tc, hh = nidx >> 7, d = nidx & 127;
                        *(v4u*)(Q + (size_t)row * 1536 + hh * 192 + d) = pack8(acc[ai][bj][m][0] * rs, acc[ai][bj][m][1] * rs); }
                    asm volatile("" ::: "memory"); }
        } else {
            const int head = 4 * (u.pn - 4) + wc;
#pragma unroll
            for (int ai = 0; ai < 2; ++ai)
#pragma unroll
                for (int m = 0; m < 4; ++m) { const int row = row0 + ai * 128 + m * 16; const f32x4 pa = *(const f32x4*)(ssq + (size_t)row * 8), pb = *(const f32x4*)(ssq + (size_t)row * 8 + 4); const float rs = C_MLA * __builtin_amdgcn_rsqf(((((((pa.x + pa.y) + pa.z) + pa.w) + pb.x) + pb.y) + pb.z + pb.w) * (1.0f / 512.0f) + EPS_); f32x4 a0, b0, a1, b1;
                    rope4(acc[ai][0][m][0] * rs, acc[ai][1][m][0] * rs, cs64 + (size_t)row * 32 + 8 * fq, a0, b0);
                    rope4(acc[ai][0][m][1] * rs, acc[ai][1][m][1] * rs, cs64 + (size_t)row * 32 + 8 * fq + 4, a1, b1);
                    *(v4u*)(Q + (size_t)row * 1536 + head * 192 + 128 + 8 * fq) = pack8(a0, a1); *(v4u*)(Q + (size_t)row * 1536 + head * 192 + 160 + 8 * fq) = pack8(b0, b1);
                    asm volatile("" ::: "memory"); }
        }
    }
};
struct EpiG2kv { static constexpr bool PERM = true, AFTER_DRAIN = false;
    bf16* KV; const float* ssq;
    __device__ __forceinline__ void operator()(const AccT& acc, const pg8::Unit& u, int wr, int wc, int fr, int fq) const {
        const int row0 = u.pm * 256 + wr * 64 + fr, tc = wc * 32 + 8 * fq;
#pragma unroll
        for (int ai = 0; ai < 2; ++ai)
#pragma unroll
            for (int m = 0; m < 4; ++m) { const int row = row0 + ai * 128 + m * 16; const f32x4 pa = *(const f32x4*)(ssq + (size_t)row * 4); const float rs = __builtin_amdgcn_rsqf((((pa.x + pa.y) + pa.z) + pa.w) * (1.0f / 256.0f) + EPS_);
#pragma unroll
                for (int bj = 0; bj < 2; ++bj) *(v4u*)(KV + (size_t)row * 2048 + u.pn * 256 + bj * 128 + tc) = pack8(acc[ai][bj][m][0] * rs, acc[ai][bj][m][1] * rs); asm volatile("" ::: "memory"); }
    }
};
struct EpiRes { static constexpr bool PERM = false, AFTER_DRAIN = false;
    const float* src; float* dst; const float* gate;
    __device__ __forceinline__ void operator()(const AccT& acc, const pg8::Unit& u, int wr, int wc, int fr, int fq) const {
        const int row0 = u.pm * 256 + wr * 64 + fr, col0 = u.pn * 256 + wc * 32 + 4 * fq;
#pragma unroll
        for (int ai = 0; ai < 2; ++ai)
#pragma unroll
            for (int m = 0; m < 4; ++m) { const int row = row0 + ai * 128 + m * 16; const float* g = gate + (size_t)(row >> 11) * 6144 + col0; const size_t off = (size_t)row * 2048 + col0;
#pragma unroll
                for (int bj = 0; bj < 2; ++bj)
#pragma unroll
                    for (int n = 0; n < 2; ++n) { const int o = bj * 128 + n * 16; *(f32x4*)(dst + off + o) = *(const f32x4*)(src + off + o) + *(const f32x4*)(g + o) * acc[ai][bj][m][n]; } asm volatile("" ::: "memory"); }
    }
};
struct EpiG4 { static constexpr bool PERM = true, AFTER_DRAIN = false;
    bf16* P1; const f32x2* cs256;
    __device__ __forceinline__ void operator()(const AccT& acc, const pg8::Unit& u, int wr, int wc, int fr, int fq) const {
        const int row0 = u.pm * 256 + wr * 64 + fr, tc = wc * 32 + 8 * fq;
#pragma unroll
        for (int ai = 0; ai < 2; ++ai)
#pragma unroll
            for (int m = 0; m < 4; ++m) { const int row = row0 + ai * 128 + m * 16; bf16* dst = P1 + (size_t)row * 12288 + u.pn * 256 + tc;
                if (u.pn < 16) {
                    const float dl2 = log1pf(-exp2f(-5.0f - (float)(u.pn & 7))) * LOG2E, rel = (float)((row & 2047) - 1024);
                    const float scl = u.pn >= 8 ? 0.0625f * ex2(-dl2 * rel) : ex2(dl2 * rel); f32x4 a0, b0, a1, b1;
                    rope4(acc[ai][0][m][0] * scl, acc[ai][1][m][0] * scl, cs256 + (size_t)row * 128 + tc, a0, b0);
                    rope4(acc[ai][0][m][1] * scl, acc[ai][1][m][1] * scl, cs256 + (size_t)row * 128 + tc + 4, a1, b1);
                    *(v4u*)dst = pack8(a0, a1); *(v4u*)(dst + 128) = pack8(b0, b1);
                } else if (u.pn < 32) {
#pragma unroll
                    for (int bj = 0; bj < 2; ++bj) *(v4u*)(dst + bj * 128) = pack8(acc[ai][bj][m][0], acc[ai][bj][m][1]);
                } else {
#pragma unroll
                    for (int bj = 0; bj < 2; ++bj) { f32x4 v0 = acc[ai][bj][m][0], v1 = acc[ai][bj][m][1];
                        v0.x = silu_f(v0.x); v0.y = silu_f(v0.y); v0.z = silu_f(v0.z); v0.w = silu_f(v0.w); v1.x = silu_f(v1.x); v1.y = silu_f(v1.y); v1.z = silu_f(v1.z); v1.w = silu_f(v1.w);
                        *(v4u*)(dst + bj * 128) = pack8(v0, v1); }
                } asm volatile("" ::: "memory"); }
    }
};
struct EpiM3 { static constexpr bool PERM = true, AFTER_DRAIN = false;
    bf16* ACT;
    __device__ __forceinline__ void operator()(const AccT& acc, const pg8::Unit& u, int wr, int wc, int fr, int fq) const {
        const int row0 = u.pm * 256 + wr * 64 + fr, tc = wc * 32 + 8 * fq;
#pragma unroll
        for (int ai = 0; ai < 2; ++ai)
#pragma unroll
            for (int m = 0; m < 4; ++m) { const int row = row0 + ai * 128 + m * 16; const f32x4 g0 = acc[ai][0][m][0], g1 = acc[ai][0][m][1], u0 = acc[ai][1][m][0], u1 = acc[ai][1][m][1]; f32x4 a0, a1;
                a0.x = silu_f(g0.x) * u0.x; a0.y = silu_f(g0.y) * u0.y; a0.z = silu_f(g0.z) * u0.z; a0.w = silu_f(g0.w) * u0.w;
                a1.x = silu_f(g1.x) * u1.x; a1.y = silu_f(g1.y) * u1.y; a1.z = silu_f(g1.z) * u1.z; a1.w = silu_f(g1.w) * u1.w;
                *(v4u*)(ACT + (size_t)row * 512 + u.pn * 128 + tc) = pack8(a0, a1); }
    }
};
struct EpiM4 { static constexpr bool PERM = true, AFTER_DRAIN = false;
    bf16* Y;
    __device__ __forceinline__ void operator()(const AccT& acc, const pg8::Unit& u, int wr, int wc, int fr, int fq) const {
        const int row0 = u.pm * 256 + wr * 64 + fr, tc = wc * 32 + 8 * fq;
#pragma unroll
        for (int ai = 0; ai < 2; ++ai)
#pragma unroll
            for (int m = 0; m < 4; ++m) { const int row = row0 + ai * 128 + m * 16;
#pragma unroll
                for (int bj = 0; bj < 2; ++bj) *(v4u*)(Y + (size_t)row * 2048 + u.pn * 256 + bj * 128 + tc) = pack8(acc[ai][bj][m][0], acc[ai][bj][m][1]); }
    }
};
__device__ __forceinline__ void moe_tables(Frame& F, int layer) {
    LAS int* tab = (LAS int*)(F.lds + MOE_TAB_OFF);
    __syncthreads();
    if (F.wave == 0) { const int lane = lane_id_opaque();
        const int cnt = lane < 32 ? (int)__hip_atomic_load(F.ctl + CW_ECNT + 64 * layer + lane, RLX_AGENT) : 0; const int nt = (cnt + 255) >> 8;
        int incl = nt;
#pragma unroll
        for (int off = 1; off < 32; off <<= 1) { const int v = __shfl_up(incl, off); if (lane >= off) incl += v; }
        const int start = incl - nt;
        if (lane < 32) { tab[128 + lane] = 256 * start; for (int i = 0; i < nt && start + i < 96; ++i) tab[start + i] = lane; }
        if (lane == 31) tab[160] = incl < 96 ? incl : 96; }
    __syncthreads();
}

#ifndef PH_MASK
#define PH_MASK 0x7FFFFFu
#endif
#ifndef PH_DUP
#define PH_DUP 0u
#endif
#define REP(k) _Pragma("unroll 1") for (int rep_ = 0; rep_ < ((((PH_DUP) >> (k)) & 1u) ? 2 : 1); ++rep_)
#define IN(k) (((PH_MASK >> (k)) & 1u) && lo <= (k) && (k) < hi)
#define SEAM(k) do { if (IN(k) && IN((k) + 1)) xcd_barrier(bar, F.wave); } while (0)
template <int LAYER, int PB> __device__ __forceinline__ void moe_phases(Frame& F, const Args& args, const XcdBarrier& bar, int lo, int hi) {
    unsigned char* ws = F.ws; LAS unsigned char* ring = F.lds + RING_OFF; const int c = (int)blockIdx.x;
    if (IN(PB)) { router_phase(F, args, (const float*)(ws + WS_XA), args.in[8] + LAYER * 2048, 2 * LAYER + 1, LAYER, true);
#if defined(ROUTER_TWICE)
        router_phase(F, args, (const float*)(ws + WS_XA), args.in[8] + LAYER * 2048, 2 * LAYER + 1, LAYER, false);
#endif
    } SEAM(PB);
    if (IN(PB + 1)) { moe_tables(F, LAYER); scatter_phase(F, (const float*)(ws + WS_XA), args.in[8] + LAYER * 2048, 2 * LAYER + 1, LAYER, true);
#if defined(SCATTER_TWICE)
        scatter_phase(F, (const float*)(ws + WS_XA), args.in[8] + LAYER * 2048, 2 * LAYER + 1, LAYER, false);
#endif
    } SEAM(PB + 1);
    if (IN(PB + 2)) {
        if (MK_MULTI) moe_tables(F, LAYER);     const LAS int* tab = (const LAS int*)(F.lds + MOE_TAB_OFF); const int TM = tab[160], TA = (TM + 1) >> 1;
        pg8::Gemm g{2048, 2048, 2048}; pg8::MoeOrder S; S.ntn = 4; S.t0 = 0; S.nunits = TA * 4; S.gdeal = F.G; S.busy = 0; S.G = F.G; S.c = c; S.A = (const char*)(ws + WS_HG); S.W = (const char*)(ws + WS_W_GU + (size_t)LAYER * 128 * MiB);
        S.tstepA = (size_t)256 * 2048 * 2; S.tstepB = (size_t)256 * 2048 * 2; S.estep = (size_t)1024 * 2048 * 2; S.tile_expert = tab;
        EpiM3 E{(bf16*)(ws + WS_ACT)};
        pg8::gemm_phase<EpiM3, pg8::MoeOrder, true, true>(ring, g, S, E, F.wave);
#if defined(M3_TWICE)
        pg8::gemm_phase<EpiM3, pg8::MoeOrder, true, true>(ring, g, S, E, F.wave);
#endif
    } SEAM(PB + 2);
    if (IN(PB + 3)) {
        if (MK_MULTI) moe_tables(F, LAYER);     const LAS int* tab = (const LAS int*)(F.lds + MOE_TAB_OFF); const int TM = tab[160], TA = (TM + 1) >> 1, nb3 = (TM - TA) * 4;
        { pg8::Gemm g{2048, 2048, 2048}; pg8::MoeOrder S; S.ntn = 4; S.t0 = TA; S.nunits = nb3; S.gdeal = nb3 < F.G ? nb3 : F.G; S.busy = 0; S.G = F.G; S.c = c; S.A = (const char*)(ws + WS_HG); S.W = (const char*)(ws + WS_W_GU + (size_t)LAYER * 128 * MiB);
          S.tstepA = (size_t)256 * 2048 * 2; S.tstepB = (size_t)256 * 2048 * 2; S.estep = (size_t)1024 * 2048 * 2; S.tile_expert = tab;
          EpiM3 E{(bf16*)(ws + WS_ACT)};
          pg8::gemm_phase<EpiM3, pg8::MoeOrder, true, true>(ring, g, S, E, F.wave); }
        { pg8::Gemm g{512, 512, 512}; pg8::MoeOrder S; S.ntn = 8; S.t0 = 0; S.nunits = TA * 8; S.gdeal = F.G; S.busy = (nb3 > 0 && nb3 < F.G) ? nb3 : 0; S.G = F.G; S.c = c; S.A = (const char*)(ws + WS_ACT); S.W = (const char*)(ws + WS_W_DN + (size_t)LAYER * 64 * MiB);
          S.tstepA = (size_t)256 * 512 * 2; S.tstepB = (size_t)256 * 512 * 2; S.estep = (size_t)2048 * 512 * 2; S.tile_expert = tab;
          EpiM4 E{(bf16*)(ws + WS_Y)};
          pg8::gemm_phase<EpiM4, pg8::MoeOrder, true, true>(ring, g, S, E, F.wave); }
    } SEAM(PB + 3);
    if (IN(PB + 4)) {
        if (MK_MULTI) moe_tables(F, LAYER);     const LAS int* tab = (const LAS int*)(F.lds + MOE_TAB_OFF); const int TM = tab[160], TA = (TM + 1) >> 1;
        pg8::Gemm g{512, 512, 512}; pg8::MoeOrder S; S.ntn = 8; S.t0 = TA; S.nunits = (TM - TA) * 8; S.gdeal = F.G; S.busy = 0; S.G = F.G; S.c = c; S.A = (const char*)(ws + WS_ACT); S.W = (const char*)(ws + WS_W_DN + (size_t)LAYER * 64 * MiB);
        S.tstepA = (size_t)256 * 512 * 2; S.tstepB = (size_t)256 * 512 * 2; S.estep = (size_t)2048 * 512 * 2; S.tile_expert = tab;
        EpiM4 E{(bf16*)(ws + WS_Y)};
        pg8::gemm_phase<EpiM4, pg8::MoeOrder, true, true>(ring, g, S, E, F.wave);
#if defined(M4_TWICE)
        pg8::gemm_phase<EpiM4, pg8::MoeOrder, true, true>(ring, g, S, E, F.wave);
#endif
    } SEAM(PB + 4);
}
__global__ void __launch_bounds__(NWAVES * 64, 2) mk_fwd(Args args) {
    extern __shared__ __attribute__((aligned(16))) unsigned char lds[];
    Frame F;
    F.lds = (LAS unsigned char*)lds;
    F.MISC = (volatile LAS unsigned*)(F.lds + MISC_OFF);
    F.wave = __builtin_amdgcn_readfirstlane((int)threadIdx.x >> 6);
    F.G = gridDim.x; { const int bx = blockIdx.x; F.vcu = (F.G % 8 == 0) ? (bx % 8) * (F.G / 8) + bx / 8 : bx; }
    F.ws = args.ws; F.ctl = (gu32*)(args.ws + WS_CTL); F.out = args.out;
    for (int u = threadIdx.x; u < (LDS_BYTES - LDSCTL_OFF) / 4; u += NWAVES * 64) ((LAS unsigned*)(F.lds + LDSCTL_OFF))[u] = 0u;
    __syncthreads();
    XcdBarrier bar; bar.bar = (unsigned*)(F.ctl + CW_BAR); bar.x = 0; bar.st = nullptr;
    if (!MK_MULTI) bar = xcd_barrier_post((unsigned*)(F.ctl + CW_BAR), F.MISC + 8, F.wave);
    const int lo = args.ph_lo, hi = args.ph_hi;
    unsigned char* ws = args.ws;
    const float* MOD = (const float*)(F.ctl + CW_MOD);
    LAS unsigned char* ring = F.lds + RING_OFF;
    const int c = (int)blockIdx.x;

    if (IN(0)) REP(0) { p0a_mod_partials(F, args); } SEAM(0);
    if (IN(1)) REP(1) { p0_prologue(F, args); local_mod(F, args.in[4], 0); norm_phase<0, true>(F, args.in[0], nullptr, args.in[5], 0, 0, 0); } SEAM(1);
    if (IN(3)) REP(3) {
        pg8::Gemm g{2048, 2048, 2048}; pg8::StaticOrder S; S.init(T_, 4096, F.G, c, ws + WS_H, 2048, ws + WS_W_IN0T, 2048);
        EpiG1 E{(bf16*)(ws + WS_PROJ0), (bf16*)(ws + WS_KR), (float*)(ws + WS_SSQP), (const f32x2*)(ws + WS_TAB64)};
        pg8::gemm_phase<EpiG1, pg8::StaticOrder, true, true>(ring, g, S, E, F.wave);
    } SEAM(3);
    if (IN(4)) REP(4) {
        { pg8::Gemm g{512, 4096, 512}; pg8::StaticOrder S; S.init(T_, 1536, F.G, c, ws + WS_PROJ0 + 3072 * 2, 4096, ws + WS_W_QUPT, 512);
          EpiG2q E{(bf16*)(ws + WS_QMLA), (const float*)(ws + WS_SSQP), (const f32x2*)(ws + WS_TAB64)};
          pg8::gemm_phase<EpiG2q, pg8::StaticOrder, true, true>(ring, g, S, E, F.wave); }
        { pg8::Gemm g{256, 4096, 256}; pg8::StaticOrder S; S.init(T_, 2048, F.G, c, ws + WS_PROJ0 + 3584 * 2, 4096, ws + WS_W_KVUPT, 256);
          EpiG2kv E{(bf16*)(ws + WS_KVMLA), (const float*)(ws + WS_SSQP) + (size_t)T_ * 8};
          pg8::gemm_phase<EpiG2kv, pg8::StaticOrder, true, true>(ring, g, S, E, F.wave); }
    } SEAM(4);
    if (IN(5)) REP(5) { bool conv_left = true; WorkQ QC; wq_init(F, QC, F.ctl + CW_QC1, CONV_N1 / 128, 18, lane_id_opaque()); mla_phase(F, args, QC, conv_left); sb_phase(F, args, QC, conv_left); } SEAM(5);
    if (IN(6)) REP(6) {
        pg8::Gemm g{2048, 2048, 2048}; pg8::StaticOrder S; S.init(T_, 2048, F.G, c, ws + WS_ATTO, 2048, ws + WS_W_OUT0T, 2048);
        EpiRes E{args.in[0], (float*)(ws + WS_XA), MOD + (size_t)(0 * 4) * 6144 + 4096};
        pg8::gemm_phase<EpiRes, pg8::StaticOrder, true, true>(ring, g, S, E, F.wave);
    } SEAM(6);
    moe_phases<0, 7>(F, args, bar, lo, hi);
    if (IN(12)) REP(12) { norm_phase<2>(F, (const float*)(ws + WS_XA), (float*)(ws + WS_XB), args.in[5] + 2048, 2, 1, 0); } SEAM(12);
    if (IN(13)) REP(13) {
        pg8::Gemm g{2048, 2048, 2048}; pg8::StaticOrder S; S.init(T_, 12288, F.G, c, ws + WS_H, 2048, ws + WS_W_IN1T, 2048);
        EpiG4 E{(bf16*)(ws + WS_PROJ1), (const f32x2*)(ws + WS_TAB256)};
        pg8::gemm_phase<EpiG4, pg8::StaticOrder, true, true>(ring, g, S, E, F.wave);
    } SEAM(13);
    if (IN(14)) REP(14) { ret_phase(F, args); } SEAM(14);
    if (IN(15)) REP(15) { retnorm_phase(F); } SEAM(15);
    if (IN(16)) REP(16) {
        pg8::Gemm g{4096, 4096, 4096}; pg8::StaticOrder S; S.init(T_, 2048, F.G, c, ws + WS_A5, 4096, ws + WS_W_OUT1T, 4096);
        EpiRes E{(const float*)(ws + WS_XB), (float*)(ws + WS_XA), MOD + (size_t)(2 * 4) * 6144 + 4096};
        pg8::gemm_phase<EpiRes, pg8::StaticOrder, true, true>(ring, g, S, E, F.wave);
    } SEAM(16);
    moe_phases<1, 17>(F, args, bar, lo, hi);
    if (IN(22)) REP(22) { norm_phase<3>(F, (const float*)(ws + WS_XA), nullptr, args.in[24], 0, 3, 1); }
}
#undef IN
#undef SEAM

extern "C" void kernel_launch(void* const* d_in, const int* in_sizes, int n_in, void* d_out, int out_size, void* d_ws, size_t ws_size, hipStream_t stream) {
    static int grid = 0;
    if (grid == 0) {
        if (n_in != 25 || in_sizes[0] != T_ * D_ || out_size != T_ * D_ || ws_size < WS_END) { fprintf(stderr, "kernel_launch: unexpected shapes (n_in %d, in0 %d, out %d, ws %zu < %zu); nothing launched\n", n_in, n_in > 0 ? in_sizes[0] : -1, out_size, ws_size, (size_t)WS_END); grid = -1; return; }
        int dev = 0, cus = 0, per_cu = 0;
        if (hipGetDevice(&dev) != hipSuccess || hipDeviceGetAttribute(&cus, hipDeviceAttributeMultiprocessorCount, dev) != hipSuccess) { fprintf(stderr, "kernel_launch: device query failed\n"); grid = -1; return; }
        if (hipFuncSetAttribute((const void*)mk_fwd, hipFuncAttributeMaxDynamicSharedMemorySize, LDS_BYTES) != hipSuccess) { fprintf(stderr, "kernel_launch: hipFuncSetAttribute failed\n"); grid = -1; return; }
        if (hipOccupancyMaxActiveBlocksPerMultiprocessor(&per_cu, (const void*)mk_fwd, NWAVES * 64, LDS_BYTES) != hipSuccess || per_cu < 1) fprintf(stderr, "kernel_launch: note: occupancy query reports %d workgroups per CU\n", per_cu);
        (void)hipGetLastError();
        grid = cus;
    }
    if (grid < 0) return;
    if (hipMemsetAsync((char*)d_ws + WS_CTL, 0, CTL_ZERO_BYTES, stream) != hipSuccess) { fprintf(stderr, "kernel_launch: memset failed\n"); return; }
    Args a{};
    for (int i = 0; i < 25; ++i) a.in[i] = (const float*)d_in[i];
    a.out = (float*)d_out; a.ws = (unsigned char*)d_ws;
#if MK_MULTI
    for (int p = 0; p < 23; ++p) { a.ph_lo = p; a.ph_hi = p + 1; hipLaunchKernelGGL(mk_fwd, dim3(grid), dim3(NWAVES * 64), LDS_BYTES, stream, a); }
#else
    a.ph_lo = 0; a.ph_hi = 23;
    hipLaunchKernelGGL(mk_fwd, dim3(grid), dim3(NWAVES * 64), LDS_BYTES, stream, a);
#endif
    const hipError_t le = hipPeekAtLastError();
    if (le != hipSuccess) fprintf(stderr, "kernel_launch: launch failed: %s\n", hipGetErrorName(le));
}
```

```cpp
#include <hip/hip_runtime.h>
#include <cstdio>
#include <cstdint>

#ifndef MK_MULTI
#define MK_MULTI 0
#endif

namespace pg8 {
#define PG8_LAS __attribute__((address_space(3)))
typedef unsigned short bf16_t;
typedef short bf16x8 __attribute__((ext_vector_type(8)));
typedef float f32x4 __attribute__((ext_vector_type(4)));
typedef unsigned u32x4 __attribute__((ext_vector_type(4)));
constexpr int BM = 256, BK = 64, HALF = 128, HTB = HALF * BK * 2  , STAGE_BYTES = 8 * HTB, NXCD = 8, WGM = 8;

__host__ __device__ __forceinline__ int lds_byte(int r, int c) { const int st = (r >> 4) * 2 + (c >> 5), rr = r & 15, cc = c & 31, ob = rr * 64 + cc * 2; return st * 1024 + (ob ^ (((ob >> 9) & 1) << 5)); }
__host__ __device__ __forceinline__ void stage_rc(int b, int& R, int& C) { const int st = b / 1024, sb = b % 1024, swz = sb ^ (((sb >> 9) & 1) << 5); R = (st >> 1) * 16 + swz / 64; C = (st & 1) * 32 + (swz % 64) / 2; }
__host__ __device__ __forceinline__ int perm32(int rho) { const int n = rho >> 4, i = rho & 15; return 8 * (i >> 2) + 4 * n + (i & 3); }

struct Unit { int pm, pn; const char* a; const char* b; };
struct Gemm { int K, lda, ldb; size_t kstepA = 128, kstepB = 128; };

struct StaticOrder {
    int nM, nN, nwg, G, c; const char* A; const char* Bt; size_t tstepA, tstepB;
    __device__ void init(int M, int N, int G_, int c_, const void* A_, int lda, const void* Bt_, int ldb) { nM = M / BM; nN = N / BM; nwg = nM * nN; G = G_; c = c_; A = (const char*)A_; Bt = (const char*)Bt_; tstepA = (size_t)BM * lda * 2; tstepB = (size_t)BM * ldb * 2; }
    __device__ bool next(int i, Unit& u) const {
        const long L = (long)i * G + c; if (L >= nwg) return false;
        int wgid = (int)L; { const int q = nwg / NXCD, r = nwg % NXCD, xcd = wgid % NXCD, off = wgid / NXCD; wgid = (xcd < r ? xcd * (q + 1) : r * (q + 1) + (xcd - r) * q) + off; }
        const int nig = WGM * nN, gid = wgid / nig, fm = gid * WGM, gsz = (nM - fm) < WGM ? (nM - fm) : WGM;
        u.pm = fm + ((wgid % nig) % gsz); u.pn = (wgid % nig) / gsz; u.a = A + (size_t)u.pm * tstepA; u.b = Bt + (size_t)u.pn * tstepB; return true;
    }
    __device__ __forceinline__ void a_ready(const Unit&) const {}
    __device__ __forceinline__ void done(const Unit&) const {}
};
struct MoeOrder {
    int ntn, t0, nunits, gdeal, busy, G, c; const char* A; const char* W; size_t tstepA, tstepB, estep; const PG8_LAS int* tile_expert;
    __device__ bool next(int i, Unit& u) const {
        int L;
        if (busy == 0) { if (c >= gdeal) return false; L = i * gdeal + c; }
        else { const int nfree = G - busy;
            if (c >= busy) { const int cap = 3 * nfree < nunits ? 3 * nfree : nunits; if (i >= 3) return false; L = i * nfree + (c - busy); if (L >= cap) return false; }
            else { L = 3 * nfree + i * busy + c; } }
        if (L >= nunits) return false;
        const int mt = t0 + L / ntn, pn = L % ntn, e = tile_expert[mt];
        u.pm = mt; u.pn = pn; u.a = A + (size_t)mt * tstepA; u.b = W + (size_t)e * estep + (size_t)pn * tstepB; return true;
    }
    __device__ __forceinline__ void a_ready(const Unit&) const {}
    __device__ __forceinline__ void done(const Unit&) const {}
};

template <class Epi, class Sched, bool ALIGN_EPI = false, bool SP2 = false>
__device__ __forceinline__ void gemm_phase(PG8_LAS unsigned char* lds, const Gemm g, const Sched& S, const Epi& E, const int wave_id) {
    int lane; asm volatile("v_mbcnt_lo_u32_b32 %0, -1, 0\n\tv_mbcnt_hi_u32_b32 %0, -1, %0" : "=v"(lane));
    const int wid = wave_id, tid = wid * 64 + lane, wr = wid >> 2, wc = wid & 3, fr = lane & 15, fq = lane >> 4;
    const int K = g.K, nt = K / BK;
    unsigned voffA[2], voffB[2];
#pragma unroll
    for (int i = 0; i < 2; ++i) { int R, C; stage_rc(tid * 16 + i * 8192, R, C); const int Rb = Epi::PERM ? ((R & ~31) + perm32(R & 31)) : R;
        voffA[i] = (unsigned)(R * g.lda + C) * 2u; voffB[i] = (unsigned)(Rb * g.ldb + C) * 2u; }
    const size_t kstepA = g.kstepA, kstepB = g.kstepB;
    const size_t hstepA = (size_t)HALF * g.lda * 2, hstepB = (size_t)HALF * g.ldb * 2;
    const unsigned ldsw = (unsigned)wid * 1024u;
    const int aoff = lds_byte(wr * 64 + fr, fq * 8), boff = lds_byte(wc * 32 + fr, fq * 8);
#define PG8_SA(b, h) (((b) * 2 + (h)) * HTB)
#define PG8_SB(b, h) ((4 + (b) * 2 + (h)) * HTB)
#define PG8_STAGE(bufoff, gbase, voff) do { _Pragma("unroll") for (int _i = 0; _i < 2; ++_i) \
        __builtin_amdgcn_global_load_lds((const unsigned*)((const char*)(gbase) + (voff)[_i]), (PG8_LAS unsigned*)(lds + (bufoff) + ldsw + _i * 8192), 16, 0, 0); } while (0)
#define PG8_LDA(dst, b, h) do { _Pragma("unroll") for (int m = 0; m < 4; ++m) _Pragma("unroll") for (int k = 0; k < 2; ++k) dst[m][k] = *(const PG8_LAS bf16x8*)(lds + PG8_SA(b, h) + aoff + m * 2048 + k * 1024); } while (0)
#define PG8_LDB(dst, b, h) do { _Pragma("unroll") for (int n = 0; n < 2; ++n) _Pragma("unroll") for (int k = 0; k < 2; ++k) dst[n][k] = *(const PG8_LAS bf16x8*)(lds + PG8_SB(b, h) + boff + n * 2048 + k * 1024); } while (0)
#define PG8_MMA(ai, bj, At, Bt) do { __builtin_amdgcn_s_setprio(1); _Pragma("unroll") for (int m = 0; m < 4; ++m) _Pragma("unroll") for (int n = 0; n < 2; ++n) _Pragma("unroll") for (int k = 0; k < 2; ++k) \
        acc[ai][bj][m][n] = __builtin_amdgcn_mfma_f32_16x16x32_bf16(Bt[n][k], At[m][k], acc[ai][bj][m][n], 0, 0, 0); __builtin_amdgcn_s_setprio(0); } while (0)
#define PG8_WAIT_V(n) asm volatile("s_waitcnt vmcnt(" #n ")" ::: "memory")
#define PG8_WAIT_L(n) asm volatile("s_waitcnt lgkmcnt(" #n ")" ::: "memory")
#define PG8_BAR __builtin_amdgcn_s_barrier()
#define PG8_SCHED __builtin_amdgcn_sched_barrier(0)
    Unit cur, nxt; int ui = 0;
    if (!S.next(0, cur)) return;
    f32x4 acc[2][2][4][2];
#pragma unroll
    for (int a = 0; a < 2; ++a)
#pragma unroll
        for (int b = 0; b < 2; ++b)
#pragma unroll
            for (int m = 0; m < 4; ++m)
#pragma unroll
                for (int n = 0; n < 2; ++n) acc[a][b][m][n] = (f32x4){0.f, 0.f, 0.f, 0.f};
    bf16x8 At[4][2], B0[2][2], B1[2][2];
    const char* cA = cur.a; const char* cB = cur.b;
    S.a_ready(cur);
    if constexpr (SP2) {
        PG8_STAGE(PG8_SB(0, 0), cB, voffB); PG8_STAGE(PG8_SB(0, 1), cB + hstepB, voffB); PG8_STAGE(PG8_SA(0, 0), cA, voffA); PG8_STAGE(PG8_SA(0, 1), cA + hstepA, voffA);
        if (wr == 1) PG8_BAR;
        PG8_WAIT_V(2); PG8_BAR;
        PG8_STAGE(PG8_SB(1, 0), cB + kstepB, voffB); PG8_STAGE(PG8_SA(1, 0), cA + kstepA, voffA); PG8_STAGE(PG8_SB(1, 1), cB + hstepB + kstepB, voffB);
        PG8_WAIT_V(6); PG8_BAR;
    } else {
        PG8_STAGE(PG8_SB(0, 0), cB, voffB); PG8_STAGE(PG8_SA(0, 0), cA, voffA); PG8_STAGE(PG8_SB(0, 1), cB + hstepB, voffB); PG8_STAGE(PG8_SA(0, 1), cA + hstepA, voffA);
        if (wr == 1) PG8_BAR;
        PG8_WAIT_V(4); PG8_BAR;
        PG8_STAGE(PG8_SB(1, 0), cB + kstepB, voffB); PG8_STAGE(PG8_SA(1, 0), cA + kstepA, voffA); PG8_STAGE(PG8_SB(1, 1), cB + hstepB + kstepB, voffB);
        PG8_WAIT_V(6); PG8_BAR;
    }
    for (;;) {
        const bool has_next = S.next(ui + 1, nxt);
        const char* nA = has_next ? nxt.a : cA; const char* nB = has_next ? nxt.b : cB;
        for (int t = 0; t < nt; t += 2) {
            const bool last = (t == nt - 2);
            const char* a1 = cA + (size_t)(t + 1) * kstepA;
            const char* a2 = last ? nA : cA + (size_t)(t + 2) * kstepA; const char* b2 = last ? nB : cB + (size_t)(t + 2) * kstepB;
            const char* a3 = a2 + kstepA; const char* b3 = b2 + kstepB;
            if (last && has_next) S.a_ready(nxt);
            if constexpr (SP2) {
            PG8_LDB(B0, 0, 0); PG8_LDB(B1, 0, 1); PG8_SCHED; PG8_LDA(At, 0, 0); PG8_STAGE(PG8_SA(1, 1), a1 + hstepA, voffA);
            PG8_WAIT_V(8); PG8_WAIT_L(0); PG8_BAR; PG8_MMA(0, 0, At, B0); PG8_MMA(0, 1, At, B1); PG8_BAR; PG8_SCHED;
            PG8_LDA(At, 0, 1); PG8_STAGE(PG8_SB(0, 0), b2, voffB); PG8_STAGE(PG8_SB(0, 1), b2 + hstepB, voffB); PG8_STAGE(PG8_SA(0, 0), a2, voffA);
            PG8_WAIT_V(8); PG8_WAIT_L(0); PG8_BAR; PG8_MMA(1, 0, At, B0); PG8_MMA(1, 1, At, B1); PG8_BAR; PG8_SCHED;
            PG8_LDB(B0, 1, 0); PG8_LDB(B1, 1, 1); PG8_SCHED; PG8_LDA(At, 1, 0); PG8_STAGE(PG8_SA(0, 1), a2 + hstepA, voffA);
            PG8_WAIT_V(8); PG8_WAIT_L(0); PG8_BAR; PG8_MMA(0, 0, At, B0); PG8_MMA(0, 1, At, B1); PG8_BAR; PG8_SCHED;
            PG8_LDA(At, 1, 1); PG8_STAGE(PG8_SB(1, 0), b3, voffB); PG8_STAGE(PG8_SB(1, 1), b3 + hstepB, voffB); PG8_STAGE(PG8_SA(1, 0), a3, voffA);
            PG8_WAIT_V(8); PG8_WAIT_L(0); PG8_BAR; PG8_MMA(1, 0, At, B0); PG8_MMA(1, 1, At, B1); PG8_BAR; PG8_SCHED;
            } else {
            PG8_LDB(B0, 0, 0); PG8_SCHED; PG8_LDA(At, 0, 0); PG8_STAGE(PG8_SA(1, 1), a1 + hstepA, voffA);
            PG8_WAIT_L(8); PG8_BAR; PG8_WAIT_L(0); PG8_MMA(0, 0, At, B0); PG8_BAR; PG8_SCHED;
            PG8_LDB(B1, 0, 1); PG8_STAGE(PG8_SB(0, 0), b2, voffB);
            PG8_BAR; PG8_WAIT_L(0); PG8_MMA(0, 1, At, B1); PG8_BAR;
            PG8_LDA(At, 0, 1); PG8_STAGE(PG8_SA(0, 0), a2, voffA);
            PG8_BAR; PG8_WAIT_L(0); PG8_MMA(1, 0, At, B0); PG8_BAR; PG8_SCHED;
            PG8_STAGE(PG8_SB(0, 1), b2 + hstepB, voffB);
            PG8_WAIT_V(6); PG8_BAR; PG8_MMA(1, 1, At, B1); PG8_BAR;
            PG8_LDB(B0, 1, 0); PG8_SCHED; PG8_LDA(At, 1, 0); PG8_STAGE(PG8_SA(0, 1), a2 + hstepA, voffA);
            PG8_WAIT_L(8); PG8_BAR; PG8_WAIT_L(0); PG8_MMA(0, 0, At, B0); PG8_BAR; PG8_SCHED;
            PG8_LDB(B1, 1, 1); PG8_STAGE(PG8_SB(1, 0), b3, voffB);
            PG8_BAR; PG8_WAIT_L(0); PG8_MMA(0, 1, At, B1); PG8_BAR;
            PG8_LDA(At, 1, 1); PG8_STAGE(PG8_SA(1, 0), a3, voffA);
            PG8_BAR; PG8_WAIT_L(0); PG8_MMA(1, 0, At, B0); PG8_BAR; PG8_SCHED;
            PG8_STAGE(PG8_SB(1, 1), b3 + hstepB, voffB);
            PG8_WAIT_V(6); PG8_BAR; PG8_MMA(1, 1, At, B1); PG8_BAR;
            }
        }
        if constexpr (ALIGN_EPI) { if (wr == 0) PG8_BAR; }
        if constexpr (!Epi::AFTER_DRAIN) { E(acc, cur, wr, wc, fr, fq); S.done(cur); }
        if (!has_next) break;
#pragma unroll
        for (int a = 0; a < 2; ++a)
#pragma unroll
            for (int b = 0; b < 2; ++b)
#pragma unroll
                for (int m = 0; m < 4; ++m)
#pragma unroll
                    for (int n = 0; n < 2; ++n) acc[a][b][m][n] = (f32x4){0.f, 0.f, 0.f, 0.f};
        cur = nxt; cA = nA; cB = nB; ++ui;
        if constexpr (ALIGN_EPI) { if (wr == 1) PG8_BAR; }
    }
    PG8_WAIT_V(0);
    if constexpr (!ALIGN_EPI) { if (wr == 0) PG8_BAR; }
    PG8_BAR;
    if constexpr (Epi::AFTER_DRAIN) { E.fused(acc, cur, wr, wc, fr, fq, lds, wid, lane); S.done(cur); }
#undef PG8_SA
#undef PG8_SB
#undef PG8_STAGE
#undef PG8_LDA
#undef PG8_LDB
#undef PG8_MMA
#undef PG8_WAIT_V
#undef PG8_WAIT_L
#undef PG8_BAR
#undef PG8_SCHED
}
}

constexpr int NWAVES = 8;
constexpr int T_ = 8192, D_ = 2048, NB_ = 4, S_ = 2048;
constexpr float EPS_ = 1e-6f;
constexpr float LOG2E = 1.4426950408889634f;
constexpr float C_SB = 0.08838834764831845f * LOG2E;
constexpr float C_MLA = 0.07216878364870323f * LOG2E;
constexpr int NPH = 22;

constexpr size_t MiB = 1u << 20;
constexpr size_t WS_CTL = 0, CTL_ZERO_BYTES = 1 * MiB;
constexpr size_t WS_TAB64 = 2 * MiB, WS_TAB256 = 4 * MiB, WS_WR = 12 * MiB, WS_ROUTE = 13 * MiB;
constexpr size_t WS_W_IN0T = 16 * MiB, WS_W_QUPT = 32 * MiB, WS_W_KVUPT = 34 * MiB, WS_W_OUT0T = 36 * MiB, WS_W_IN1T = 44 * MiB, WS_W_OUT1T = 92 * MiB;
constexpr size_t WS_W_GU = 108 * MiB, WS_W_DN = 364 * MiB;
constexpr size_t WS_XA = 492 * MiB, WS_XB = 556 * MiB, WS_H = 620 * MiB;
constexpr size_t WS_PROJ0 = 652 * MiB, WS_QMLA = 716 * MiB, WS_KVMLA = 740 * MiB, WS_KR = 772 * MiB, WS_ATTO = 774 * MiB;
constexpr size_t WS_PROJ1 = 652 * MiB;
constexpr size_t WS_HG = 844 * MiB, WS_ACT = 940 * MiB, WS_Y = 964 * MiB;
constexpr size_t WS_RETO = 844 * MiB, WS_A5 = 908 * MiB;
constexpr size_t WS_MODP = 1060 * MiB;
constexpr size_t WS_RS = 13 * MiB + 256 * 1024;
constexpr size_t WS_SSQP = 13 * MiB + 512 * 1024;
constexpr size_t WS_END = 1068 * MiB;
constexpr int CW_TMO = 0, CW_CODE = 1;
constexpr int CW_BAR = 4096;
constexpr int CW_QMLA = 8192, CW_QSB = 8256, CW_QRET = 8320, CW_QC1 = 8384, CW_QC2 = 8416;
constexpr int CW_ECNT = 8448, CW_ECUR = 8576;
constexpr int CW_MOD = 16384;
constexpr int CW_SSQQ = 114688, CW_SSQKV = 122880;
static_assert((CW_SSQKV + 8192) * 4 <= (int)CTL_ZERO_BYTES, "CTL words inside the memset region");
constexpr int RING_OFF = 0, RING_BYTES = 147456;
constexpr int LDSCTL_OFF = RING_BYTES, MISC_OFF = LDSCTL_OFF + 320;
constexpr int MOE_TAB_OFF = LDSCTL_OFF + 1024;
constexpr int LDS_BYTES = 155648;
static_assert(MOE_TAB_OFF + 1024 <= LDS_BYTES, "LDS map");

#define GAS __attribute__((address_space(1)))
#define LAS __attribute__((address_space(3)))
typedef unsigned short bf16;
typedef unsigned v4u __attribute__((ext_vector_type(4)));
typedef unsigned v2u __attribute__((ext_vector_type(2)));
typedef float f32x4 __attribute__((ext_vector_type(4)));
typedef float f32x2 __attribute__((ext_vector_type(2)));
typedef float f32x16 __attribute__((ext_vector_type(16)));
typedef short bf16x8 __attribute__((ext_vector_type(8)));
typedef short s16x4 __attribute__((ext_vector_type(4)));
typedef short v4i16_t __attribute__((ext_vector_type(4)));
typedef GAS unsigned gu32;
#define RLX_AGENT __ATOMIC_RELAXED, __HIP_MEMORY_SCOPE_AGENT
#define LDS_WAIT() asm volatile("s_waitcnt lgkmcnt(0)" ::: "memory")
#define VM_WAIT() asm volatile("s_waitcnt vmcnt(0)" ::: "memory")
typedef __bf16 bf16x2_t __attribute__((ext_vector_type(2)));
__device__ __forceinline__ unsigned pk2(float lo, float hi) { f32x2 v = {lo, hi}; bf16x2_t b = __builtin_convertvector(v, bf16x2_t); return __builtin_bit_cast(unsigned, b); }
__device__ __forceinline__ float bf_lo(unsigned w) { return __uint_as_float(w << 16); }
__device__ __forceinline__ float bf_hi(unsigned w) { return __uint_as_float(w & 0xffff0000u); }
__device__ __forceinline__ float ex2(float x) { return __builtin_amdgcn_exp2f(x); }
__device__ __forceinline__ float lg2(float x) { return __builtin_amdgcn_logf(x); }
__device__ __forceinline__ float silu_f(float v) { return v / (1.0f + __expf(-v)); }
__device__ __forceinline__ int lane_id_opaque() { int l; asm volatile("v_mbcnt_lo_u32_b32 %0, -1, 0\n\tv_mbcnt_hi_u32_b32 %0, -1, %0" : "=v"(l)); return l; }

#define XB_TMO      128
#define XB_XCNT(j)  (256  + 64 * (j))
#define XB_XSUB(j)  (1280 + 64 * (j))
#define XB_XGEN(j)  (2304 + 64 * (j))
#define XB_TOP      3328
#define XB_TOPGEN   3392
#define XCD_BAR_WORDS 3456
#define XB_SPIN_CAP (1u << 18)
__device__ __forceinline__ unsigned xb_ld(unsigned* p)              { return __hip_atomic_load(p, __ATOMIC_RELAXED, __HIP_MEMORY_SCOPE_AGENT); }
__device__ __forceinline__ unsigned xb_add(unsigned* p, unsigned v) { return __hip_atomic_fetch_add(p, v, __ATOMIC_RELAXED, __HIP_MEMORY_SCOPE_AGENT); }
__device__ __forceinline__ unsigned xb_xcc_id() { return (unsigned)__builtin_amdgcn_s_getreg((3 << 11) | 20) & 0xFu; }
#define XB_SPIN(cond, bar) do { unsigned _sp = 0; while (cond) { __builtin_amdgcn_s_sleep(1); \
    if ((++_sp & 255u) == 0u) { if (xb_ld(&(bar)[XB_TMO])) break; if (_sp > XB_SPIN_CAP) { atomicAdd(&(bar)[XB_TMO], 1u); break; } } } } while (0)
struct XcdBarrier { unsigned* bar; unsigned x; volatile LAS unsigned* st; };
__device__ __forceinline__ XcdBarrier xcd_barrier_post(unsigned* bar, volatile LAS unsigned* st, int wave) {
    XcdBarrier b; b.bar = bar; b.x = xb_xcc_id(); b.st = st;
    if (wave == 0 && lane_id_opaque() == 0) (void)xb_add(&bar[XB_XCNT(b.x)], 1u);
    return b;
}
__device__ __forceinline__ void xcd_barrier_complete(unsigned* bar, unsigned x, unsigned& nloc, unsigned& nx) {
    const unsigned G = gridDim.x * gridDim.y * gridDim.z;
    unsigned sum, cnt, mine, sp = 0u;
    for (;;) {
        sum = 0u; cnt = 0u; mine = 0u;
#pragma unroll
        for (unsigned j = 0; j < 16; ++j) { const unsigned c = xb_ld(&bar[XB_XCNT(j)]); sum += c; cnt += (c > 0u) ? 1u : 0u; mine = (j == x) ? c : mine; }
        if (sum == G) break;
        __builtin_amdgcn_s_sleep(1);
        if ((++sp & 255u) == 0u) { if (xb_ld(&bar[XB_TMO])) break; if (sp > XB_SPIN_CAP) { atomicAdd(&bar[XB_TMO], 1u); break; } }
    }
    nloc = mine > 0u ? mine : 1u; nx = cnt > 0u ? cnt : 1u;
}
__device__ __forceinline__ void xcd_barrier(const XcdBarrier& b, int wave) {
    asm volatile("s_waitcnt vmcnt(0)" ::: "memory");
    __syncthreads();
    if (wave == 0 && lane_id_opaque() == 0) {
        unsigned* bar = b.bar;
        __builtin_amdgcn_s_waitcnt(0);
        unsigned nloc = b.st[0], nx = b.st[1];
        if (nloc == 0u) { xcd_barrier_complete(bar, b.x, nloc, nx); b.st[0] = nloc; b.st[1] = nx; }
        const unsigned old = xb_add(&bar[XB_XSUB(b.x)], 1u);
        const unsigned gen = old / nloc;
        if (old + 1u == (gen + 1u) * nloc) {
            __builtin_amdgcn_fence(__ATOMIC_RELEASE, "agent");
            asm volatile("s_waitcnt vmcnt(0)" ::: "memory");
            const unsigned og = xb_add(&bar[XB_TOP], 1u);
            const unsigned tg = og / nx;
            if (og + 1u == (tg + 1u) * nx) xb_add(&bar[XB_TOPGEN], 1u);
            else XB_SPIN(xb_ld(&bar[XB_TOPGEN]) == tg, bar);
            __builtin_amdgcn_fence(__ATOMIC_ACQUIRE, "agent");
            xb_add(&bar[XB_XGEN(b.x)], 1u);
            asm volatile("s_waitcnt vmcnt(0)" ::: "memory");
        } else {
            XB_SPIN(xb_ld(&bar[XB_XGEN(b.x)]) == gen, bar);
            __builtin_amdgcn_fence(__ATOMIC_ACQUIRE, "agent");
            asm volatile("s_waitcnt vmcnt(0)" ::: "memory");
        }
    }
    __syncthreads();
}

struct Frame {
    LAS unsigned char* lds;
    volatile LAS unsigned* MISC;
    gu32* ctl;
    unsigned char* ws;
    int wave;
    int vcu, G;
    float* out;
};
struct Args { const float* in[25]; float* out; unsigned char* ws; int ph_lo, ph_hi; };
__device__ __forceinline__ float wave_sum(float v) {
#pragma unroll
    for (int o = 1; o < 64; o <<= 1) v += __shfl_xor(v, o);
    return v;
}
#define PHASE_IDS(F) const int lane = lane_id_opaque(), wave = (F).wave, tid = wave * 64 + lane; (void)lane; (void)wave; (void)tid
struct ConvSrc { const float* W; int ldn; bf16* WT; int ldk; const float* scale; };
__device__ __forceinline__ void conv_load(const ConvSrc& c, int lane, f32x4 (&v)[8]) {
    const float* src = c.W + (size_t)(8 * (lane >> 3)) * c.ldn + 4 * (lane & 7);
#pragma unroll
    for (int t = 0; t < 8; ++t) v[t] = __builtin_nontemporal_load((const f32x4*)(src + (size_t)t * c.ldn));
}
__device__ __forceinline__ void conv_store(const ConvSrc& c, int lane, f32x4 (&v)[8]) {
    if (c.scale) { const f32x4 s0 = *(const f32x4*)(c.scale + 8 * (lane >> 3)), s1 = *(const f32x4*)(c.scale + 8 * (lane >> 3) + 4);
        v[0] *= s0.x; v[1] *= s0.y; v[2] *= s0.z; v[3] *= s0.w; v[4] *= s1.x; v[5] *= s1.y; v[6] *= s1.z; v[7] *= s1.w; }
    bf16* dst = c.WT + (size_t)(4 * (lane & 7)) * c.ldk + 8 * (lane >> 3);
#pragma unroll
    for (int j = 0; j < 4; ++j) { v4u o; o.x = pk2(v[0][j], v[1][j]); o.y = pk2(v[2][j], v[3][j]); o.z = pk2(v[4][j], v[5][j]); o.w = pk2(v[6][j], v[7][j]); __builtin_nontemporal_store(o, (v4u*)(dst + (size_t)j * c.ldk)); }
}
static_assert((64 * 32 + 384 * 32 + 32 * 1024 + 32 * 512) % 128 == 0 && (64 * 64 + 32 * 1024 + 32 * 512) % 128 == 0, "conversion batches of 128 items");
constexpr int CONV_N0 = 122 * 32 + 48 * 8 + 64 * 4, CONV_N1 = 64 * 32 + 384 * 32 + 32 * 1024 + 32 * 512, CONV_N2 = 64 * 64 + 32 * 1024 + 32 * 512;
__device__ __forceinline__ ConvSrc conv_moe_gu(const Args& A, unsigned char* ws, int le, int r) {
    const int nb = r / 32, kb = r % 32, t = nb >> 3, hf = (nb >> 2) & 1, jb = nb & 3;
    return ConvSrc{(hf ? A.in[22] : A.in[21]) + (size_t)le * 2048 * 512 + (size_t)(64 * kb) * 512 + 128 * t + 32 * jb, 512,
                   (bf16*)(ws + WS_W_GU) + (size_t)le * 1024 * 2048 + ((size_t)(t * 32 + kb) * 256 + 32 * (nb & 7)) * 64, 64, nullptr};
}
__device__ __forceinline__ ConvSrc conv_moe_dn(const Args& A, unsigned char* ws, int le, int r) {
    const int nb = r / 8, kb = r % 8;
    return ConvSrc{A.in[23] + (size_t)le * 512 * 2048 + (size_t)(64 * kb) * 2048 + 32 * nb, 2048,
                   (bf16*)(ws + WS_W_DN) + (size_t)le * 2048 * 512 + ((size_t)((nb >> 3) * 8 + kb) * 256 + 32 * (nb & 7)) * 64, 64, nullptr};
}
template <int STREAM> __device__ __forceinline__ ConvSrc conv_item(const Args& A, unsigned char* ws, int it) {
    if (STREAM == 0) {
        if (it < 122 * 32) { const int t = it / 32, kb = it % 32; const int dnb = t < 120 ? t : (t == 120 ? 120 : 124), sc = t < 120 ? 32 * t : (t == 120 ? 3840 : 3872);
            return ConvSrc{A.in[9] + (size_t)(64 * kb) * 3904 + sc, 3904, (bf16*)(ws + WS_W_IN0T) + (size_t)(32 * dnb) * 2048 + 64 * kb, 2048, nullptr}; }
        it -= 122 * 32;
        if (it < 48 * 8) { const int nb = it / 8, kb = it % 8; int sc;
            if (nb < 32) sc = (nb >> 2) * 192 + 32 * (nb & 3);
            else { const int t = (nb - 32) >> 3, blk = (nb - 32) & 7, hf = blk >> 2, hh = blk & 3; sc = (4 * t + hh) * 192 + 128 + 32 * hf; }
            return ConvSrc{A.in[11] + (size_t)(64 * kb) * 1536 + sc, 1536, (bf16*)(ws + WS_W_QUPT) + (size_t)(32 * nb) * 512 + 64 * kb, 512, A.in[10] + 64 * kb}; }
        it -= 48 * 8;
        { const int nb = it / 4, kb = it % 4;
            return ConvSrc{A.in[13] + (size_t)(64 * kb) * 2048 + 32 * nb, 2048, (bf16*)(ws + WS_W_KVUPT) + (size_t)(32 * nb) * 256 + 64 * kb, 256, A.in[12] + 64 * kb}; }
    } else if (STREAM == 1) {
        if (it < 64 * 32) { const int nb = it / 32, kb = it % 32;
            return ConvSrc{A.in[14] + (size_t)(64 * kb) * 2048 + 32 * nb, 2048, (bf16*)(ws + WS_W_OUT0T) + (size_t)(32 * nb) * 2048 + 64 * kb, 2048, nullptr}; }
        it -= 64 * 32;
        if (it < 384 * 32) { const int nb = it / 32, kb = it % 32;
            return ConvSrc{A.in[15] + (size_t)(64 * kb) * 12288 + 32 * nb, 12288, (bf16*)(ws + WS_W_IN1T) + (size_t)(32 * nb) * 2048 + 64 * kb, 2048, nullptr}; }
        it -= 384 * 32;
        if (it < 32 * 1024) return conv_moe_gu(A, ws, it / 1024, it % 1024);
        it -= 32 * 1024;
        return conv_moe_dn(A, ws, it / 512, it % 512);
    } else {
        if (it < 64 * 64) { const int nb = it / 64, kb = it % 64;
            return ConvSrc{A.in[16] + (size_t)(64 * kb) * 2048 + 32 * nb, 2048, (bf16*)(ws + WS_W_OUT1T) + (size_t)(32 * nb) * 4096 + 64 * kb, 4096, nullptr}; }
        it -= 64 * 64;
        if (it < 32 * 1024) return conv_moe_gu(A, ws, 32 + it / 1024, it % 1024);
        it -= 32 * 1024;
        return conv_moe_dn(A, ws, 32 + it / 512, it % 512);
    }
}
template <int STREAM> __device__ __forceinline__ void conv_burst(Frame& F, const Args& A, int lane, int gw, int NGW, int& cur, int n) {
    constexpr int N = STREAM == 0 ? CONV_N0 : (STREAM == 1 ? CONV_N1 : CONV_N2);
#pragma unroll 1
    while (n > 0) {
        const int i0 = gw + NGW * cur; if (i0 >= N) break;
        const int i1 = i0 + NGW; const bool two = n > 1 && i1 < N;
        const ConvSrc c0 = conv_item<STREAM>(A, F.ws, i0); f32x4 v0[8], v1[8];
        conv_load(c0, lane, v0);
        if (two) { const ConvSrc c1 = conv_item<STREAM>(A, F.ws, i1); conv_load(c1, lane, v1); conv_store(c0, lane, v0); conv_store(c1, lane, v1); cur += 2; n -= 2; }
        else { conv_store(c0, lane, v0); cur += 1; n -= 1; }
    }
}

__device__ __forceinline__ void p0a_mod_partials(Frame& F, const Args& A) {
    PHASE_IDS(F);
    const int gw = F.vcu * NWAVES + wave, NGW = F.G * NWAVES;
    LAS float* cond = (LAS float*)(F.lds + RING_OFF);
    for (int i = tid; i < NB_ * D_; i += 512) cond[i] = silu_f(A.in[1][i]);
    __syncthreads();
    float* MODP = (float*)(F.ws + WS_MODP);
    for (int u = gw; u < 1536; u += NGW) {
        const int j = u / 384, r = u % 384, nc = r / 16, kc = r % 16, layer = j >> 1;
        const float* W = ((j & 1) ? A.in[6] : A.in[3]) + (size_t)layer * 2048 * 6144 + (size_t)(kc * 128) * 6144 + nc * 256 + 4 * lane;
        f32x4 acc[4];
#pragma unroll
        for (int b = 0; b < 4; ++b) acc[b] = (f32x4){0.f, 0.f, 0.f, 0.f};
#pragma unroll 32
        for (int k = 0; k < 128; ++k) { const f32x4 w = *(const f32x4*)(W + (size_t)k * 6144);
#pragma unroll
            for (int b = 0; b < 4; ++b) acc[b] += cond[b * 2048 + kc * 128 + k] * w; }
#pragma unroll
        for (int b = 0; b < 4; ++b) *(f32x4*)(MODP + ((size_t)(kc * 16 + j * 4 + b)) * 6144 + nc * 256 + 4 * lane) = acc[b];
    }
}
__device__ __forceinline__ void p0_prologue(Frame& F, const Args& A) {
    PHASE_IDS(F);
    const int gw = F.vcu * NWAVES + wave, NGW = F.G * NWAVES;
    const int gt = F.vcu * 512 + tid, NGT = F.G * 512;
    { float* MOD = (float*)(F.ctl + CW_MOD); const float* MODP = (const float*)(F.ws + WS_MODP);
      for (int idx = gt; idx < 16 * 6144; idx += NGT) { const int j = idx / (4 * 6144), n = idx % 6144; float a = ((j & 1) ? A.in[7] : A.in[4])[(j >> 1) * 6144 + n];
#pragma unroll
          for (int kc = 0; kc < 16; ++kc) a += MODP[(size_t)kc * 16 * 6144 + idx];
          MOD[idx] = a; } }
    { int cur = 0; conv_burst<0>(F, A, lane, gw, NGW, cur, 1 << 20); }
#if defined(CONV_IN_PROLOGUE)
    { int cur = 0; conv_burst<1>(F, A, lane, gw, NGW, cur, 1 << 20); }
    { int cur = 0; conv_burst<2>(F, A, lane, gw, NGW, cur, 1 << 20); }
#endif
    { const int* pos = (const int*)A.in[2]; f32x2* t64 = (f32x2*)(F.ws + WS_TAB64); f32x2* t256 = (f32x2*)(F.ws + WS_TAB256);
      for (int idx = gt; idx < T_ * 160; idx += NGT) { const int m = idx / 160, i = idx % 160; const double p = (double)pos[m];
          double fr; if (i < 32) fr = exp(-9.210340371976184 * (double)i / 32.0); else fr = exp(-9.210340371976184 * (double)(i - 32) / 128.0);
          double sn, cs; sincos(p * fr, &sn, &cs); const f32x2 v = {(float)cs, (float)sn};
          if (i < 32) t64[m * 32 + i] = v; else t256[m * 128 + (i - 32)] = v; } }
    { float* WR = (float*)(F.ws + WS_WR);
      for (int idx = gt; idx < 2 * 512 * 36 * 4; idx += NGT) { const int q = idx & 3, c = (idx >> 2) % 36, kq = ((idx >> 2) / 36) % 512, l = (idx >> 2) / (36 * 512); const int k = 4 * kq + q;
          WR[idx] = c < 4 ? A.in[17][(size_t)l * 2048 * 4 + k * 4 + c] : A.in[19][(size_t)l * 2048 * 32 + k * 32 + (c - 4)]; } }
}

__device__ __forceinline__ void local_mod(Frame& F, const float* bias, int j) {
    PHASE_IDS(F);
    const float* MODP = (const float*)(F.ws + WS_MODP); LAS f32x4* lm = (LAS f32x4*)(F.lds + RING_OFF);
    __syncthreads();
    for (int q = tid; q < 4096; q += 512) { const int b = q >> 10, n = 4 * (q & 1023); f32x4 a = *(const f32x4*)(bias + n);
#pragma unroll
        for (int kc = 0; kc < 16; ++kc) a += *(const f32x4*)(MODP + ((size_t)(kc * 16 + j * 4 + b)) * 6144 + n);
        lm[q] = a; }
    __syncthreads();
}
template <int MODE, bool LM = false> __device__ __forceinline__ void norm_phase(Frame& F, const float* src, float* xdst, const float* gvec, int jn, int jg, int layer_moe) {
    PHASE_IDS(F);
    const int gw = F.vcu * NWAVES + wave, NGW = F.G * NWAVES;
    const float* MOD = (const float*)(F.ctl + CW_MOD);
    bf16* H = (bf16*)(F.ws + WS_H);
    const bf16* Y = (const bf16*)(F.ws + WS_Y);
    const int* RT = (const int*)(F.ws + WS_ROUTE);
    v4u ra = {0u, 0u, 0u, 0u}, rb = {0u, 0u, 0u, 0u};
    if (MODE >= 2) { const int row_l = gw + NGW * lane; if (row_l < T_) { const v4u* rp = (const v4u*)(RT + (size_t)row_l * 8); ra = rp[0]; rb = rp[1]; } }
    for (int row = gw, ri = 0; row < T_; row += NGW, ++ri) {
        const int b = row >> 11;
        f32x4 v[8]; float ss = 0.f;
        const f32x4* xr = (const f32x4*)(src + (size_t)row * D_) + lane;
#pragma unroll
        for (int j = 0; j < 8; ++j) v[j] = xr[64 * j];
        if (MODE >= 2) {
            const int p0 = __shfl((int)rb.x, ri), p1 = __shfl((int)rb.y, ri); const float w0 = __int_as_float(__shfl((int)ra.z, ri)), w1 = __int_as_float(__shfl((int)ra.w, ri));
            const v2u* y0 = (const v2u*)(Y + (size_t)p0 * D_) + lane; const v2u* y1 = (const v2u*)(Y + (size_t)p1 * D_) + lane;
            const f32x4* gt = (const f32x4*)(MOD + (size_t)(jg * 4 + b) * 6144 + 4096) + lane;
#pragma unroll
            for (int j = 0; j < 8; ++j) { const v2u a = y0[64 * j], c = y1[64 * j]; const f32x4 g = gt[64 * j];
                f32x4 m; m.x = w0 * bf_lo(a.x) + w1 * bf_lo(c.x); m.y = w0 * bf_hi(a.x) + w1 * bf_hi(c.x); m.z = w0 * bf_lo(a.y) + w1 * bf_lo(c.y); m.w = w0 * bf_hi(a.y) + w1 * bf_hi(c.y);
                v[j] += g * m; }
            if (MODE == 2) { f32x4* xo = (f32x4*)(xdst + (size_t)row * D_) + lane;
#pragma unroll
                for (int j = 0; j < 8; ++j) xo[64 * j] = v[j]; }
        }
#pragma unroll
        for (int j = 0; j < 8; ++j) ss += (v[j].x * v[j].x + v[j].y * v[j].y) + (v[j].z * v[j].z + v[j].w * v[j].w);
        const float rstd = 1.0f / sqrtf(wave_sum(ss) * (1.0f / D_) + EPS_);
        const f32x4* gv = (const f32x4*)gvec + lane;
        if (MODE == 3) { f32x4* o = (f32x4*)(F.out + (size_t)row * D_) + lane;
#pragma unroll
            for (int j = 0; j < 8; ++j) o[64 * j] = v[j] * rstd * gv[64 * j];
        } else {
            v2u* o = (v2u*)(H + (size_t)row * D_) + lane;
            if (LM) { const LAS f32x4* sh = (const LAS f32x4*)(F.lds + RING_OFF) + b * 1024 + lane; const LAS f32x4* sc = sh + 512;
#pragma unroll
                for (int j = 0; j < 8; ++j) { const f32x4 h = v[j] * rstd * gv[64 * j] * (1.0f + sc[64 * j]) + sh[64 * j]; v2u w; w.x = pk2(h.x, h.y); w.y = pk2(h.z, h.w); o[64 * j] = w; }
            } else { const f32x4* sh = (const f32x4*)(MOD + (size_t)(jn * 4 + b) * 6144) + lane; const f32x4* sc = sh + 512;
#pragma unroll
                for (int j = 0; j < 8; ++j) { const f32x4 h = v[j] * rstd * gv[64 * j] * (1.0f + sc[64 * j]) + sh[64 * j]; v2u w; w.x = pk2(h.x, h.y); w.y = pk2(h.z, h.w); o[64 * j] = w; } }
        }
    }
}

__device__ __forceinline__ void router_phase(Frame& F, const Args& A, const float* X, const float* gvec, int jn, int layer, bool first) {
    const float* MOD = (const float*)(F.ctl + CW_MOD);
    const f32x4* WR4 = (const f32x4*)(F.ws + WS_WR) + (size_t)layer * 512 * 36;
    int* RT = (int*)(F.ws + WS_ROUTE); float* RS = (float*)(F.ws + WS_RS);
    LAS f32x4* hs = (LAS f32x4*)(F.lds + RING_OFF);
    LAS f32x4* wsm = (LAS f32x4*)(F.lds + RING_OFF + 40960);
    LAS f32x4* shs = (LAS f32x4*)(F.lds + RING_OFF + 81920);
    LAS float* rs = (LAS float*)(F.lds + RING_OFF + 83968);
    LAS float* lg = (LAS float*)(F.lds + RING_OFF + 84224);
    PHASE_IDS(F);
    const int r = tid >> 4, kp = tid & 15, kpart = lane & 15, cg = lane >> 4;
    int wpos[5];
#pragma unroll
    for (int i = 0; i < 5; ++i) { const int idx = tid + 512 * i; wpos[i] = idx + idx / 36; }
    for (int tile = F.vcu; tile < T_ / 32; tile += F.G) {
        const int row0 = tile * 32, b = row0 >> 11;
        const f32x4* sh = (const f32x4*)(MOD + (size_t)(jn * 4 + b) * 6144); const f32x4* sc = sh + 512; const f32x4* gv = (const f32x4*)gvec;
        const f32x4* xr = (const f32x4*)(X + (size_t)(row0 + r) * D_);
        float acc[4][9], accq[9], ss = 0.f;
#pragma unroll
        for (int c = 0; c < 9; ++c) { accq[c] = 0.f;
#pragma unroll
            for (int rr = 0; rr < 4; ++rr) acc[rr][c] = 0.f; }
        f32x4 xq[4], gq[4], sq[4], wq[5];
#define RT_LOAD(ch) do { _Pragma("unroll") for (int g = 0; g < 4; ++g) { const int q = (ch) * 64 + kp + 16 * g; xq[g] = xr[q]; gq[g] = gv[q] * (1.0f + sc[q]); if (r == 0) sq[g] = sh[q]; } \
            _Pragma("unroll") for (int i = 0; i < 5; ++i) { const int idx = tid + 512 * i; if (idx < 2304) wq[i] = WR4[(size_t)(ch) * 2304 + idx]; } } while (0)
        RT_LOAD(0);
#pragma unroll 1
        for (int ch = 0; ch < 8; ++ch) {
#pragma unroll
            for (int g = 0; g < 4; ++g) { const f32x4 x = xq[g]; ss += (x.x * x.x + x.y * x.y) + (x.z * x.z + x.w * x.w); hs[r * 65 + kp + 16 * g] = x * gq[g]; if (r == 0) shs[kp + 16 * g] = sq[g]; }
#pragma unroll
            for (int i = 0; i < 5; ++i) if (tid + 512 * i < 2304) wsm[wpos[i]] = wq[i];
            __syncthreads();
            if (ch + 1 < 8) RT_LOAD(ch + 1);
#pragma unroll 1
            for (int g = 0; g < 4; ++g) { const int kq = kpart + 16 * g; f32x4 h4[4];
#pragma unroll
                for (int rr = 0; rr < 4; ++rr) h4[rr] = hs[(wave * 4 + rr) * 65 + kq];
                const f32x4 q4 = shs[kq];
#pragma unroll
                for (int c = 0; c < 9; ++c) { const f32x4 w4 = wsm[kq * 37 + 9 * cg + c];
#pragma unroll
                    for (int rr = 0; rr < 4; ++rr) acc[rr][c] += (h4[rr].x * w4.x + h4[rr].y * w4.y) + (h4[rr].z * w4.z + h4[rr].w * w4.w);
                    if (wave == 0) accq[c] += (q4.x * w4.x + q4.y * w4.y) + (q4.z * w4.z + q4.w * w4.w); } }
            __syncthreads();
        }
#undef RT_LOAD
#pragma unroll
        for (int rr = 0; rr < 4; ++rr)
#pragma unroll
            for (int c = 0; c < 9; ++c) { float a = acc[rr][c]; a += __shfl_xor(a, 1); a += __shfl_xor(a, 2); a += __shfl_xor(a, 4); a += __shfl_xor(a, 8); if (kpart == 0) lg[(wave * 4 + rr) * 36 + 9 * cg + c] = a; }
        if (wave == 0) {
#pragma unroll
            for (int c = 0; c < 9; ++c) { float a = accq[c]; a += __shfl_xor(a, 1); a += __shfl_xor(a, 2); a += __shfl_xor(a, 4); a += __shfl_xor(a, 8); if (kpart == 0) lg[1152 + 9 * cg + c] = a; } }
        ss += __shfl_xor(ss, 1); ss += __shfl_xor(ss, 2); ss += __shfl_xor(ss, 4); ss += __shfl_xor(ss, 8);
        if (kp == 0) rs[r] = 1.0f / sqrtf(ss * (1.0f / D_) + EPS_);
        __syncthreads();
        if (tid < 32) { const int row = row0 + tid; const LAS float* l = lg + tid * 36; const LAS float* q = lg + 1152; const float* bg = A.in[18] + layer * 4; const float* be = A.in[20] + layer * 32; const float rstd = rs[tid];
            if (first) RS[row] = rstd;
            float g[4]; int gi = 0; float gm;
#pragma unroll
            for (int i = 0; i < 4; ++i) g[i] = rstd * l[i] + q[i] + bg[i];
            gm = g[0];
#pragma unroll
            for (int i = 1; i < 4; ++i) if (g[i] > gm) { gm = g[i]; gi = i; }
            float gs = 0.f;
#pragma unroll
            for (int i = 0; i < 4; ++i) gs += __expf(g[i] - gm);
            const float gw = 1.0f / gs;
            float e[8];
#pragma unroll
            for (int i = 0; i < 8; ++i) e[i] = rstd * l[4 + 8 * gi + i] + q[4 + 8 * gi + i] + be[8 * gi + i];
            int i0 = 0; float m0 = e[0];
#pragma unroll
            for (int i = 1; i < 8; ++i) if (e[i] > m0) { m0 = e[i]; i0 = i; }
            int i1 = -1; float m1 = -3.0e38f;
#pragma unroll
            for (int i = 0; i < 8; ++i) if (i != i0 && e[i] > m1) { m1 = e[i]; i1 = i; }
            const float p1 = __expf(m1 - m0), w0 = gw / (1.0f + p1), w1 = gw * p1 / (1.0f + p1);
            const int e0 = 8 * gi + i0, e1 = 8 * gi + i1;
            int* rt = RT + (size_t)row * 8; rt[0] = e0; rt[1] = e1; rt[2] = __float_as_int(w0); rt[3] = __float_as_int(w1);
            if (first) { atomicAdd((unsigned*)(F.ctl + CW_ECNT + 64 * layer + e0), 1u); atomicAdd((unsigned*)(F.ctl + CW_ECNT + 64 * layer + e1), 1u); }
        }
        __syncthreads();
    }
}

__device__ __forceinline__ void scatter_phase(Frame& F, const float* X, const float* gvec, int jn, int layer, bool first) {
    LAS int* tab = (LAS int*)(F.lds + MOE_TAB_OFF);
    PHASE_IDS(F);
    const int gw = F.vcu * NWAVES + wave, NGW = F.G * NWAVES;
    const float* MOD = (const float*)(F.ctl + CW_MOD);
    int* RT = (int*)(F.ws + WS_ROUTE); const float* RS = (const float*)(F.ws + WS_RS); bf16* HG = (bf16*)(F.ws + WS_HG);
    int myp0 = 0, myp1 = 0;
    { const int tok_l = gw + NGW * lane;
      if (tok_l < T_) { int* rt = RT + (size_t)tok_l * 8;
          if (first) { const int e0 = rt[0], e1 = rt[1];
              myp0 = tab[128 + e0] + (int)atomicAdd((unsigned*)(F.ctl + CW_ECUR + 64 * layer + e0), 1u);
              myp1 = tab[128 + e1] + (int)atomicAdd((unsigned*)(F.ctl + CW_ECUR + 64 * layer + e1), 1u);
              rt[4] = myp0; rt[5] = myp1; }
          else { myp0 = rt[4]; myp1 = rt[5]; } } }
    for (int i = 0; gw + NGW * i < T_; ++i) {
        const int tok = gw + NGW * i;
        const int p0 = __shfl(myp0, i), p1 = __shfl(myp1, i);
        const f32x4* xr = (const f32x4*)(X + (size_t)tok * D_) + lane; f32x4 v[8];
#pragma unroll
        for (int j = 0; j < 8; ++j) v[j] = xr[64 * j];
        const float rstd = RS[tok]; const int b = tok >> 11;
        const f32x4* sh = (const f32x4*)(MOD + (size_t)(jn * 4 + b) * 6144) + lane; const f32x4* sc = sh + 512; const f32x4* gv = (const f32x4*)gvec + lane;
        v2u* d0 = (v2u*)(HG + (size_t)p0 * D_) + lane; v2u* d1 = (v2u*)(HG + (size_t)p1 * D_) + lane;
#pragma unroll
        for (int j = 0; j < 8; ++j) { const f32x4 h = v[j] * rstd * gv[64 * j] * (1.0f + sc[64 * j]) + sh[64 * j]; v2u w; w.x = pk2(h.x, h.y); w.y = pk2(h.z, h.w); d0[64 * j] = w; d1[64 * j] = w; }
    }
#if defined(WARM_MOE)
    if (first) { const v4u* w = (const v4u*)(F.ws + WS_W_GU + (size_t)layer * 128 * MiB) + (size_t)gw * 4096 + lane; v4u acc = {0u, 0u, 0u, 0u};
#pragma unroll 16
        for (int i = 0; i < 64; ++i) { const v4u x = w[64 * i]; acc.x ^= x.x; acc.y ^= x.y; acc.z ^= x.z; acc.w ^= x.w; }
        asm volatile("" :: "v"(acc.x), "v"(acc.y), "v"(acc.z), "v"(acc.w)); }
#endif
}

__device__ __forceinline__ void retnorm_phase(Frame& F) {
    PHASE_IDS(F);
    const int gw = F.vcu * NWAVES + wave, NGW = F.G * NWAVES;
    const bf16* O = (const bf16*)(F.ws + WS_RETO); const bf16* P1 = (const bf16*)(F.ws + WS_PROJ1); bf16* A5 = (bf16*)(F.ws + WS_A5);
    for (int row = gw; row < T_; row += NGW) {
        const v4u* o = (const v4u*)(O + (size_t)row * 4096) + lane; const v4u* g = (const v4u*)(P1 + (size_t)row * 12288 + 8192) + lane; v4u* a = (v4u*)(A5 + (size_t)row * 4096) + lane;
#pragma unroll
        for (int h = 0; h < 8; ++h) { const v4u x = o[64 * h], s = g[64 * h];
            float f[8] = {bf_lo(x.x), bf_hi(x.x), bf_lo(x.y), bf_hi(x.y), bf_lo(x.z), bf_hi(x.z), bf_lo(x.w), bf_hi(x.w)};
            float ss = 0.f;
#pragma unroll
            for (int i = 0; i < 8; ++i) ss += f[i] * f[i];
            const float rstd = 1.0f / sqrtf(wave_sum(ss) * (1.0f / 512.0f) + EPS_);
            v4u w; w.x = pk2(f[0] * rstd * bf_lo(s.x), f[1] * rstd * bf_hi(s.x)); w.y = pk2(f[2] * rstd * bf_lo(s.y), f[3] * rstd * bf_hi(s.y));
            w.z = pk2(f[4] * rstd * bf_lo(s.z), f[5] * rstd * bf_hi(s.z)); w.w = pk2(f[6] * rstd * bf_lo(s.w), f[7] * rstd * bf_hi(s.w));
            a[64 * h] = w; }
    }
}
#ifndef ATT_REP
#define ATT_REP 1
#endif
#ifndef RET_REP
#define RET_REP 1
#endif
#ifndef ATT_KPF
#define ATT_KPF 4
#endif
constexpr int ATT_VST = 320;
__device__ __forceinline__ s16x4 vtr(const LAS unsigned char* p) { return __builtin_bit_cast(s16x4, __builtin_amdgcn_ds_read_tr16_b64_v4i16((LAS v4i16_t*)p)); }
__device__ __forceinline__ float xhalf(float v) { return __shfl_xor(v, 32); }

template <int DQK, int MODE>
__device__ __forceinline__ void attn_unit(LAS unsigned char* lds, const bf16* Qp, int qpitch, const bf16* Kp, int kpitch, const bf16* K2p, int k2pitch,
                                          const bf16* Vp, int vpitch, bf16* Op, int opitch, int q0, float dlog2, int tid_, int wave, int lane_, volatile LAS unsigned* flg) {
    const int lane = lane_id_opaque(), tid = wave * 64 + lane; (void)tid_; (void)lane_;
    constexpr int RB = DQK * 2, SW = (DQK == 192) ? 7 : 15, KB = 64 * RB, STG = KB + 16384;
    constexpr int NIK = KB / 8192, NI = NIK + 2;
    constexpr int NKS = DQK / 16;
    static_assert(3 * STG <= RING_BYTES, "three stages in the ring");
    const int r = lane & 31, h = lane >> 5, qrow = q0 + 32 * wave + r;
    bf16x8 qf[NKS];
    { const bf16* qp = Qp + (size_t)qrow * qpitch + 8 * h;
#pragma unroll
      for (int ks = 0; ks < NKS; ++ks) qf[ks] = *(const bf16x8*)(qp + 16 * ks); }
    f32x16 o[4];
#pragma unroll
    for (int db = 0; db < 4; ++db)
#pragma unroll
        for (int i = 0; i < 16; ++i) o[db][i] = 0.f;
    float m_run = -1.0e30f, l_run = 0.f, carry = 0.f;
    const int ntiles = (q0 + 256) >> 6;
    constexpr bool KLIN = (DQK != 192); constexpr int NKG = KLIN ? 1 : NIK;
    unsigned kgo[NKG], vgo0; bool krope[NKG];
#pragma unroll
    for (int j = 0; j < NKG; ++j) { const int pos = (j * 8 + wave) * 1024 + lane * 16, row = pos / RB, c = ((pos % RB) >> 4) ^ (row & SW);
        krope[j] = (DQK == 192) && c >= 16;
        kgo[j] = krope[j] ? (unsigned)(row * k2pitch * 2 + (c - 16) * 16) : (unsigned)(row * kpitch * 2 + c * 16); }
    { const int pos = wave * 1024 + lane * 16, row = pos >> 8, ch = ((pos & 255) >> 4) ^ (((row & 3) << 2) | ((row >> 2) & 3)); vgo0 = (unsigned)(row * vpitch * 2 + ch * 16); }
#define ATT_DMA(kt, stg) do { const size_t key0_ = (size_t)(kt) * 64; \
        const char* kb_ = (const char*)Kp + key0_ * kpitch * 2; const char* k2_ = (const char*)K2p + key0_ * k2pitch * 2; const char* vb_ = (const char*)Vp + key0_ * vpitch * 2; \
        LAS unsigned char* st_ = lds + (stg) * STG + wave * 1024; \
        _Pragma("unroll") for (int j_ = 0; j_ < NIK; ++j_) { const char* g_ = KLIN ? kb_ + kgo[0] + (size_t)j_ * (8192 / RB) * kpitch * 2 : ((krope[KLIN ? 0 : j_] ? k2_ : kb_) + kgo[KLIN ? 0 : j_]); \
            __builtin_amdgcn_global_load_lds((const unsigned*)g_, (LAS unsigned*)(st_ + j_ * 8192), 16, 0, 0); } \
        _Pragma("unroll") for (int j_ = 0; j_ < 2; ++j_) __builtin_amdgcn_global_load_lds((const unsigned*)(vb_ + vgo0 + (size_t)j_ * 32 * vpitch * 2), (LAS unsigned*)(st_ + KB + j_ * 8192), 16, 0, 0); } while (0)
    if (MODE == 1 && tid < 16) flg[tid] = 0u;
    ATT_DMA(ntiles - 1, 0);
    ATT_DMA(ntiles > 1 ? ntiles - 2 : 0, 1);
    const int q4 = (lane & 15) >> 2, p4 = lane & 3, blk = (lane >> 4) & 1, x4 = 2 * blk + (p4 >> 1);
    constexpr int NKO = (SW + 1) / 2;
    const int krow = r * RB, kxy = (r & SW) ^ h;
    const int vlo_off = 256 * (4 * h + q4) + 16 * (x4 ^ h) + 8 * (p4 & 1), vhi_off = 256 * (4 * h + q4 + 8) + 16 * (x4 ^ (h + 2)) + 8 * (p4 & 1);
    for (int it = 0; it < ntiles; ++it) {
        const int kt = ntiles - 1 - it;
        int y_ = kxy, q4_ = q4; asm volatile("" : "+v"(y_), "+v"(q4_));
        const bool wdone = (MODE == 1) && __all(carry < -140.0f);
        if (MODE == 1 && lane == 0) flg[8 * (it & 1) + wave] = wdone ? 1u : 0u;
        asm volatile("s_waitcnt vmcnt(%0)" :: "n"(NI) : "memory");
        asm volatile("s_waitcnt lgkmcnt(0)" ::: "memory");
        __builtin_amdgcn_s_barrier();
        asm volatile("" ::: "memory");
        if (MODE == 1) { v4u fa, fb; const unsigned fad = (unsigned)(size_t)(flg + 8 * (it & 1));
            asm volatile("ds_read_b128 %0, %2\n\tds_read_b128 %1, %2 offset:16\n\ts_waitcnt lgkmcnt(0)" : "=&v"(fa), "=&v"(fb) : "v"(fad) : "memory");
            if ((fa.x & fa.y & fa.z & fa.w & fb.x & fb.y & fb.z & fb.w) != 0u) break; }
        { const int ktn = kt >= 2 ? kt - 2 : 0; ATT_DMA(ktn, (it + 2) % 3); }
        if (!wdone && 64 * kt <= q0 + 32 * wave + 31) {
            const LAS unsigned char* Kb = lds + (it % 3) * STG; const LAS unsigned char* Vb = Kb + KB;
            f32x16 s[2];
            const int kbase = 64 * kt + 4 * h;
            const bool diag = 64 * kt + 63 > q0 + 32 * wave;
            unsigned va[8];
#pragma unroll
            for (int db = 0; db < 4; ++db) { va[db] = (unsigned)(size_t)(Vb + vlo_off + 64 * (db ^ q4_)); va[4 + db] = (unsigned)(size_t)(Vb + vhi_off + 64 * (db ^ q4_)); }
            s16x4 lo_[2][4], hi_[2][4];
#define ATT_VRD(buf, sidx) do { _Pragma("unroll") for (int db = 0; db < 4; ++db) { \
                    asm volatile("ds_read_b64_tr_b16 %0, %1 offset:%c2" : "=&v"(lo_[buf][db]) : "v"(va[db]), "i"(4096 * (sidx)) : "memory"); \
                    asm volatile("ds_read_b64_tr_b16 %0, %1 offset:%c2" : "=&v"(hi_[buf][db]) : "v"(va[4 + db]), "i"(4096 * (sidx)) : "memory"); } } while (0)
#define ATT_VMM(buf, sidx) do { const int kb_ = (sidx) >> 1, ss_ = (sidx) & 1; \
                v4u pw; pw.x = pk2(s[kb_][8 * ss_ + 0], s[kb_][8 * ss_ + 1]); pw.y = pk2(s[kb_][8 * ss_ + 2], s[kb_][8 * ss_ + 3]); pw.z = pk2(s[kb_][8 * ss_ + 4], s[kb_][8 * ss_ + 5]); pw.w = pk2(s[kb_][8 * ss_ + 6], s[kb_][8 * ss_ + 7]); \
                const bf16x8 pf = __builtin_bit_cast(bf16x8, pw); \
                _Pragma("unroll") for (int db = 0; db < 4; ++db) { \
                    const bf16x8 vf = __builtin_shufflevector(lo_[buf][db], hi_[buf][db], 0, 1, 2, 3, 4, 5, 6, 7); \
                    o[db] = __builtin_amdgcn_mfma_f32_32x32x16_bf16(vf, pf, o[db], 0, 0, 0); } } while (0)
#define ATT_PVN(first, count) do { ATT_VRD(0, first); \
                _Pragma("unroll") for (int i_ = 0; i_ < (count); ++i_) { \
                    if (i_ + 1 < (count)) { if (i_ & 1) ATT_VRD(0, (first) + i_ + 1); else ATT_VRD(1, (first) + i_ + 1); asm volatile("s_waitcnt lgkmcnt(8)" ::: "memory"); } \
                    else asm volatile("s_waitcnt lgkmcnt(0)" ::: "memory"); \
                    __builtin_amdgcn_sched_barrier(0); \
                    if (i_ & 1) ATT_VMM(1, (first) + i_); else ATT_VMM(0, (first) + i_); \
                    __builtin_amdgcn_sched_barrier(0); } } while (0)
#pragma unroll
            for (int kb = 0; kb < 2; ++kb) {
#pragma unroll
                for (int i = 0; i < 16; ++i) s[kb][i] = 0.f;
                const LAS unsigned char* kp = Kb + 32 * kb * RB;
#define ATT_KF(ks) (*(const LAS bf16x8*)(kp + krow + (((2 * ((ks) % NKO)) ^ y_) << 4) + (((2 * (ks)) & ~SW) << 4)))
                bf16x8 fa = ATT_KF(0), fb = ATT_KF(1);
#pragma unroll
                for (int g2 = 0; g2 < NKS / 2; ++g2) {
                    bf16x8 na = fa, nb = fb;
                    if (g2 + 1 < NKS / 2) { na = ATT_KF(2 * g2 + 2); nb = ATT_KF(2 * g2 + 3); }
                    __builtin_amdgcn_sched_barrier(0);
                    s[kb] = __builtin_amdgcn_mfma_f32_32x32x16_bf16(fa, qf[2 * g2], s[kb], 0, 0, 0); s[kb] = __builtin_amdgcn_mfma_f32_32x32x16_bf16(fb, qf[2 * g2 + 1], s[kb], 0, 0, 0);
                    __builtin_amdgcn_sched_barrier(0);
                    fa = na; fb = nb;
                }
#undef ATT_KF
                if (MODE == 2) {
                    if (diag) {
#pragma unroll
                        for (int i = 0; i < 16; ++i) { const int key = kbase + 32 * kb + (i & 3) + 8 * (i >> 2); s[kb][i] = key <= qrow ? s[kb][i] : 0.f; } }
                    ATT_PVN(2 * kb, 2);
                }
            }
            if (MODE == 0) {
                float tmax = -1.0e30f;
#pragma unroll
                for (int kb = 0; kb < 2; ++kb)
#pragma unroll
                    for (int i = 0; i < 16; ++i) { const int key = kbase + 32 * kb + (i & 3) + 8 * (i >> 2); const float v = (!diag || key <= qrow) ? s[kb][i] : -1.0e30f; s[kb][i] = v; tmax = fmaxf(tmax, v); }
                tmax = fmaxf(tmax, xhalf(tmax));
                const float m_new = fmaxf(m_run, tmax), alpha = ex2(m_run - m_new); m_run = m_new;
                float ps = 0.f;
#pragma unroll
                for (int kb = 0; kb < 2; ++kb)
#pragma unroll
                    for (int i = 0; i < 16; ++i) { const float p = ex2(s[kb][i] - m_new); s[kb][i] = p; ps += p; }
                l_run = l_run * alpha + ps;
#pragma unroll
                for (int db = 0; db < 4; ++db)
#pragma unroll
                    for (int i = 0; i < 16; ++i) o[db][i] *= alpha;
            } else if (MODE == 1) {
                float lkv[2][16], gs[2][4], go[2][4];
#pragma unroll
                for (int kb = 0; kb < 2; ++kb)
#pragma unroll
                    for (int g = 0; g < 4; ++g) { float t = 0.f;
#pragma unroll
                        for (int j = 0; j < 4; ++j) { const int i = 4 * g + j, key = kbase + 32 * kb + 8 * g + j; const float z = s[kb][i];
                            const bool vis = key < qrow;
                            const float lk = vis ? -(fmaxf(z, 0.f) + lg2(1.0f + ex2(-fabsf(z)))) : 0.f;
                            lkv[kb][i] = lk; s[kb][i] = vis ? z + lk : -1.0e30f; t += lk; }
                        gs[kb][g] = t; }
#pragma unroll
                for (int kb = 0; kb < 2; ++kb)
#pragma unroll
                    for (int g = 0; g < 4; ++g) go[kb][g] = xhalf(gs[kb][g]);
                float R = carry;
#pragma unroll
                for (int kb = 1; kb >= 0; --kb)
#pragma unroll
                    for (int g = 3; g >= 0; --g) {
                        float run = R + (h == 0 ? go[kb][g] : 0.f);
#pragma unroll
                        for (int j = 3; j >= 0; --j) { const int i = 4 * g + j; const float a = ex2(s[kb][i] + run); run += lkv[kb][i]; s[kb][i] = a; }
                        R += gs[kb][g] + go[kb][g];
                    }
                carry = R;
            }
            if (MODE != 2) { ATT_PVN(0, 4); }
#undef ATT_PVN
#undef ATT_VMM
#undef ATT_VRD
        }
    }
#undef ATT_DMA
    asm volatile("s_waitcnt vmcnt(0) lgkmcnt(0)" ::: "memory");
    __builtin_amdgcn_s_barrier();
    asm volatile("" ::: "memory");
    float inv = 1.0f;
    if (MODE == 0) { const float lt = l_run + xhalf(l_run); inv = 1.0f / lt; }
    bf16* op = Op + (size_t)qrow * opitch + 4 * h;
#pragma unroll
    for (int db = 0; db < 4; ++db)
#pragma unroll
        for (int g = 0; g < 4; ++g) { v2u w; w.x = pk2(o[db][4 * g] * inv, o[db][4 * g + 1] * inv); w.y = pk2(o[db][4 * g + 2] * inv, o[db][4 * g + 3] * inv); *(v2u*)(op + 32 * db + 8 * g) = w; }
}

struct WorkQ { gu32* q; int total; int slot; unsigned nxt; };
__device__ __forceinline__ void wq_init(Frame& F, WorkQ& Q, gu32* q, int total, int slot, int lane) {
    Q.q = q; Q.total = total; Q.slot = slot; Q.nxt = 0u;
    if (F.wave == 0 && lane == 0) Q.nxt = __hip_atomic_fetch_add(q, 1u, RLX_AGENT);
}
__device__ __forceinline__ bool wq_take(Frame& F, WorkQ& Q, int lane, int& u) {
    if (F.wave == 0 && lane == 0) F.MISC[Q.slot] = Q.nxt;
    __syncthreads();
    u = (int)F.MISC[Q.slot];
    __syncthreads();
    if (u >= Q.total) return false;
    if (F.wave == 0 && lane == 0) Q.nxt = __hip_atomic_fetch_add(Q.q, 1u, RLX_AGENT);
    return true;
}
template <int STREAM> __device__ __forceinline__ bool conv_batch(Frame& F, const Args& A, WorkQ& Q, int lane, int wave) {
#if defined(CONV_IN_PROLOGUE)
    return false;
#endif
    int b; if (!wq_take(F, Q, lane, b)) return false;
    const int i0 = 128 * b + 16 * wave;
    f32x4 va0[8], va1[8], vb0[8], vb1[8];
    { const ConvSrc c0 = conv_item<STREAM>(A, F.ws, i0), c1 = conv_item<STREAM>(A, F.ws, i0 + 1); conv_load(c0, lane, va0); conv_load(c1, lane, va1); }
#pragma unroll
    for (int p = 0; p < 8; ++p) {
        const ConvSrc c0 = conv_item<STREAM>(A, F.ws, i0 + 2 * p), c1 = conv_item<STREAM>(A, F.ws, i0 + 2 * p + 1);
        if (p + 1 < 8) { const ConvSrc n0 = conv_item<STREAM>(A, F.ws, i0 + 2 * p + 2), n1 = conv_item<STREAM>(A, F.ws, i0 + 2 * p + 3);
            if (p & 1) { conv_load(n0, lane, va0); conv_load(n1, lane, va1); } else { conv_load(n0, lane, vb0); conv_load(n1, lane, vb1); } }
        if (p & 1) { conv_store(c0, lane, vb0); conv_store(c1, lane, vb1); } else { conv_store(c0, lane, va0); conv_store(c1, lane, va1); }
    }
    return true;
}
__device__ __forceinline__ void mla_phase(Frame& F, const Args& A, WorkQ& QC, bool& conv_left) {
    PHASE_IDS(F);
    WorkQ QU; wq_init(F, QU, F.ctl + CW_QMLA, 256, 16, lane);
    if (F.vcu & 1) { for (int i = 0; i < 2 && conv_left; ++i) conv_left = conv_batch<1>(F, A, QC, lane, wave); }
    const bf16* Q = (const bf16*)(F.ws + WS_QMLA); const bf16* KV = (const bf16*)(F.ws + WS_KVMLA); const bf16* KR = (const bf16*)(F.ws + WS_KR); bf16* O = (bf16*)(F.ws + WS_ATTO);
    int u;
    while (wq_take(F, QU, lane, u)) {
        const int qb = 7 - (u >> 5), bh = u & 31, b = bh >> 3, h = bh & 7; const size_t r0 = (size_t)b * S_;
#pragma unroll 1
        for (int rep_ = 0; rep_ < ATT_REP; ++rep_)
        attn_unit<192, 0>(F.lds + RING_OFF, Q + r0 * 1536 + h * 192, 1536, KV + r0 * 2048 + h * 256, 2048, KR + r0 * 64, 64, KV + r0 * 2048 + h * 256 + 128, 2048,
                          O + r0 * 2048 + 1024 + h * 128, 2048, qb * 256, 0.f, tid, wave, lane, F.MISC + 32);
        if (conv_left) conv_left = conv_batch<1>(F, A, QC, lane, wave);
    }
}
__device__ __forceinline__ void sb_phase(Frame& F, const Args& A, WorkQ& QC, bool& conv_left) {
    PHASE_IDS(F);
    WorkQ QU; wq_init(F, QU, F.ctl + CW_QSB, 256, 17, lane);
    const bf16* P0 = (const bf16*)(F.ws + WS_PROJ0); bf16* O = (bf16*)(F.ws + WS_ATTO);
    int u;
    while (wq_take(F, QU, lane, u)) {
        const int qb = 7 - (u >> 5), bh = u & 31, b = bh >> 3, h = bh & 7; const size_t r0 = (size_t)b * S_;
#pragma unroll 1
        for (int rep_ = 0; rep_ < ATT_REP; ++rep_)
        attn_unit<128, 1>(F.lds + RING_OFF, P0 + r0 * 4096 + h * 128, 4096, P0 + r0 * 4096 + 1024 + h * 128, 4096, nullptr, 0, P0 + r0 * 4096 + 2048 + h * 128, 4096,
                          O + r0 * 2048 + h * 128, 2048, qb * 256, 0.f, tid, wave, lane, F.MISC + 32);
        if (conv_left) conv_left = conv_batch<1>(F, A, QC, lane, wave);
    }
    while (conv_left) conv_left = conv_batch<1>(F, A, QC, lane, wave);
}
__device__ __forceinline__ void ret_phase(Frame& F, const Args& A) {
    PHASE_IDS(F);
    WorkQ QC; wq_init(F, QC, F.ctl + CW_QC2, CONV_N2 / 128, 18, lane); bool conv_left = true;
    WorkQ QU; wq_init(F, QU, F.ctl + CW_QRET, 1024, 16, lane);
    if (F.vcu & 1) conv_left = conv_batch<2>(F, A, QC, lane, wave);
    const bf16* P1 = (const bf16*)(F.ws + WS_PROJ1); bf16* O = (bf16*)(F.ws + WS_RETO);
    int u;
    while (wq_take(F, QU, lane, u)) {
        const int qb = 7 - (u >> 7), rem = u & 127, eq = rem >> 5, bh = rem & 31, b = bh >> 3, h = bh & 7; const size_t r0 = (size_t)b * S_;
        const float dlog2 = log1pf(-exp2f(-5.0f - (float)h)) * LOG2E;
#pragma unroll 1
        for (int rep_ = 0; rep_ < RET_REP; ++rep_)
        attn_unit<256, 2>(F.lds + RING_OFF, P1 + r0 * 12288 + h * 256, 12288, P1 + r0 * 12288 + 2048 + h * 256, 12288, nullptr, 0, P1 + r0 * 12288 + 4096 + h * 512 + eq * 128, 12288,
                          O + r0 * 4096 + h * 512 + eq * 128, 4096, qb * 256, dlog2, tid, wave, lane, F.MISC + 32);
        if (conv_left && (u & 1)) conv_left = conv_batch<2>(F, A, QC, lane, wave);
    }
    while (conv_left) conv_left = conv_batch<2>(F, A, QC, lane, wave);
}
typedef f32x4 AccT[2][2][4][2];
__device__ __forceinline__ v4u pack8(const f32x4& a, const f32x4& b) { v4u w; w.x = pk2(a.x, a.y); w.y = pk2(a.z, a.w); w.z = pk2(b.x, b.y); w.w = pk2(b.z, b.w); return w; }
__device__ __forceinline__ float sq4(const f32x4& a) { return (a.x * a.x + a.y * a.y) + (a.z * a.z + a.w * a.w); }
__device__ __forceinline__ void rope4(const f32x4& x1, const f32x4& x2, const f32x2* cs, f32x4& o1, f32x4& o2) {
    const f32x4 c01 = *(const f32x4*)cs, c23 = *(const f32x4*)(cs + 2);
    o1.x = x1.x * c01.x - x2.x * c01.y; o2.x = x1.x * c01.y + x2.x * c01.x;
    o1.y = x1.y * c01.z - x2.y * c01.w; o2.y = x1.y * c01.w + x2.y * c01.z;
    o1.z = x1.z * c23.x - x2.z * c23.y; o2.z = x1.z * c23.y + x2.z * c23.x;
    o1.w = x1.w * c23.z - x2.w * c23.w; o2.w = x1.w * c23.w + x2.w * c23.z;
}
struct EpiG1 { static constexpr bool PERM = true, AFTER_DRAIN = false;
    bf16* P0; bf16* KR; float* ssqp; const f32x2* cs64;
    __device__ __forceinline__ void operator()(const AccT& acc, const pg8::Unit& u, int wr, int wc, int fr, int fq) const {
        const int row0 = u.pm * 256 + wr * 64 + fr, tc = wc * 32 + 8 * fq;
        if (u.pn < 15) {
            const float scl = u.pn < 4 ? C_SB : 1.0f;
#pragma unroll
            for (int ai = 0; ai < 2; ++ai)
#pragma unroll
                for (int m = 0; m < 4; ++m) { const int row = row0 + ai * 128 + m * 16; float ss = 0.f;
#pragma unroll
                    for (int bj = 0; bj < 2; ++bj) { const f32x4 v0 = acc[ai][bj][m][0], v1 = acc[ai][bj][m][1]; ss += sq4(v0) + sq4(v1);
                        *(v4u*)(P0 + (size_t)row * 4096 + u.pn * 256 + bj * 128 + tc) = pack8(v0 * scl, v1 * scl); }
                    if (u.pn >= 12) { ss += __shfl_xor(ss, 16); ss += __shfl_xor(ss, 32); if (fq == 0) { if (u.pn < 14) ssqp[(size_t)row * 8 + 4 * (u.pn - 12) + wc] = ss; else ssqp[(size_t)T_ * 8 + (size_t)row * 4 + wc] = ss; } } }
        } else if (wc == 0) {
#pragma unroll
            for (int ai = 0; ai < 2; ++ai)
#pragma unroll
                for (int m = 0; m < 4; ++m) { const int row = row0 + ai * 128 + m * 16; f32x4 a0, b0, a1, b1;
                    rope4(acc[ai][0][m][0], acc[ai][1][m][0], cs64 + (size_t)row * 32 + 8 * fq, a0, b0);
                    rope4(acc[ai][0][m][1], acc[ai][1][m][1], cs64 + (size_t)row * 32 + 8 * fq + 4, a1, b1);
                    *(v4u*)(KR + (size_t)row * 64 + 8 * fq) = pack8(a0, a1); *(v4u*)(KR + (size_t)row * 64 + 32 + 8 * fq) = pack8(b0, b1); asm volatile("" ::: "memory"); }
        }
    }
};
struct EpiG2q { static constexpr bool PERM = true, AFTER_DRAIN = false;
    bf16* Q; const float* ssq; const f32x2* cs64;
    __device__ __forceinline__ void operator()(const AccT& acc, const pg8::Unit& u, int wr, int wc, int fr, int fq) const {
        const int row0 = u.pm * 256 + wr * 64 + fr, tc = wc * 32 + 8 * fq;
        if (u.pn < 4) {
#pragma unroll
            for (int ai = 0; ai < 2; ++ai)
#pragma unroll
                for (int m = 0; m < 4; ++m) { const int row = row0 + ai * 128 + m * 16; const f32x4 pa = *(const f32x4*)(ssq + (size_t)row * 8), pb = *(const f32x4*)(ssq + (size_t)row * 8 + 4); const float rs = C_MLA * __builtin_amdgcn_rsqf(((((((pa.x + pa.y) + pa.z) + pa.w) + pb.x) + pb.y) + pb.z + pb.w) * (1.0f / 512.0f) + EPS_);
#pragma unroll
                    for (int bj = 0; bj < 2; ++bj) { const int nidx = u.pn * 256 + bj * 128 + tc, hh = nidx >> 7, d = nidx & 127;
                        *(v4u*)(Q + (size_t)row * 1536 + hh * 192 + d) = pack8(acc[ai][bj][m][0] * rs, acc[ai][bj][m][1] * rs); }
                    asm volatile("" ::: "memory"); }
        } else {
            const int head = 4 * (u.pn - 4) + wc;
#pragma unroll
            for (int ai = 0; ai < 2; ++ai)
#pragma unroll
                for (int m = 0; m < 4; ++m) { const int row = row0 + ai * 128 + m * 16; const f32x4 pa = *(const f32x4*)(ssq + (size_t)row * 8), pb = *(const f32x4*)(ssq + (size_t)row * 8 + 4); const float rs = C_MLA * __builtin_amdgcn_rsqf(((((((pa.x + pa.y) + pa.z) + pa.w) + pb.x) + pb.y) + pb.z + pb.w) * (1.0f / 512.0f) + EPS_); f32x4 a0, b0, a1, b1;
                    rope4(acc[ai][0][m][0] * rs, acc[ai][1][m][0] * rs, cs64 + (size_t)row * 32 + 8 * fq, a0, b0);
                    rope4(acc[ai][0][m][1] * rs, acc[ai][1][m][1] * rs, cs64 + (size_t)row * 32 + 8 * fq + 4, a1, b1);
                    *(v4u*)(Q + (size_t)row * 1536 + head * 192 + 128 + 8 * fq) = pack8(a0, a1); *(v4u*)(Q + (size_t)row * 1536 + head * 192 + 160 + 8 * fq) = pack8(b0, b1);
                    asm volatile("" ::: "memory"); }
        }
    }
};
struct EpiG2kv { static constexpr bool PERM = true, AFTER_DRAIN = false;
    bf16* KV; const float* ssq;
    __device__ __forceinline__ void operator()(const AccT& acc, const pg8::Unit& u, int wr, int wc, int fr, int fq) const {
        const int row0 = u.pm * 256 + wr * 64 + fr, tc = wc * 32 + 8 * fq;
#pragma unroll
        for (int ai = 0; ai < 2; ++ai)
#pragma unroll
            for (int m = 0; m < 4; ++m) { const int row = row0 + ai * 128 + m * 16; const f32x4 pa = *(const f32x4*)(ssq + (size_t)row * 4); const float rs = __builtin_amdgcn_rsqf((((pa.x + pa.y) + pa.z) + pa.w) * (1.0f / 256.0f) + EPS_);
#pragma unroll
                for (int bj = 0; bj < 2; ++bj) *(v4u*)(KV + (size_t)row * 2048 + u.pn * 256 + bj * 128 + tc) = pack8(acc[ai][bj][m][0] * rs, acc[ai][bj][m][1] * rs); asm volatile("" ::: "memory"); }
    }
};
struct EpiRes { static constexpr bool PERM = false, AFTER_DRAIN = false;
    const float* src; float* dst; const float* gate;
    __device__ __forceinline__ void operator()(const AccT& acc, const pg8::Unit& u, int wr, int wc, int fr, int fq) const {
        const int row0 = u.pm * 256 + wr * 64 + fr, col0 = u.pn * 256 + wc * 32 + 4 * fq;
#pragma unroll
        for (int ai = 0; ai < 2; ++ai)
#pragma unroll
            for (int m = 0; m < 4; ++m) { const int row = row0 + ai * 128 + m * 16; const float* g = gate + (size_t)(row >> 11) * 6144 + col0; const size_t off = (size_t)row * 2048 + col0;
#pragma unroll
                for (int bj = 0; bj < 2; ++bj)
#pragma unroll
                    for (int n = 0; n < 2; ++n) { const int o = bj * 128 + n * 16; *(f32x4*)(dst + off + o) = *(const f32x4*)(src + off + o) + *(const f32x4*)(g + o) * acc[ai][bj][m][n]; } asm volatile("" ::: "memory"); }
    }
};
struct EpiG4 { static constexpr bool PERM = true, AFTER_DRAIN = false;
    bf16* P1; const f32x2* cs256;
    __device__ __forceinline__ void operator()(const AccT& acc, const pg8::Unit& u, int wr, int wc, int fr, int fq) const {
        const int row0 = u.pm * 256 + wr * 64 + fr, tc = wc * 32 + 8 * fq;
#pragma unroll
        for (int ai = 0; ai < 2; ++ai)
#pragma unroll
            for (int m = 0; m < 4; ++m) { const int row = row0 + ai * 128 + m * 16; bf16* dst = P1 + (size_t)row * 12288 + u.pn * 256 + tc;
                if (u.pn < 16) {
                    const float dl2 = log1pf(-exp2f(-5.0f - (float)(u.pn & 7))) * LOG2E, rel = (float)((row & 2047) - 1024);
                    const float scl = u.pn >= 8 ? 0.0625f * ex2(-dl2 * rel) : ex2(dl2 * rel); f32x4 a0, b0, a1, b1;
                    rope4(acc[ai][0][m][0] * scl, acc[ai][1][m][0] * scl, cs256 + (size_t)row * 128 + tc, a0, b0);
                    rope4(acc[ai][0][m][1] * scl, acc[ai][1][m][1] * scl, cs256 + (size_t)row * 128 + tc + 4, a1, b1);
                    *(v4u*)dst = pack8(a0, a1); *(v4u*)(dst + 128) = pack8(b0, b1);
                } else if (u.pn < 32) {
#pragma unroll
                    for (int bj = 0; bj < 2; ++bj) *(v4u*)(dst + bj * 128) = pack8(acc[ai][bj][m][0], acc[ai][bj][m][1]);
                } else {
#pragma unroll
                    for (int bj = 0; bj < 2; ++bj) { f32x4 v0 = acc[ai][bj][m][0], v1 = acc[ai][bj][m][1];
                        v0.x = silu_f(v0.x); v0.y = silu_f(v0.y); v0.z = silu_f(v0.z); v0.w = silu_f(v0.w); v1.x = silu_f(v1.x); v1.y = silu_f(v1.y); v1.z = silu_f(v1.z); v1.w = silu_f(v1.w);
                        *(v4u*)(dst + bj * 128) = pack8(v0, v1); }
                } asm volatile("" ::: "memory"); }
    }
};
struct EpiM3 { static constexpr bool PERM = true, AFTER_DRAIN = false;
    bf16* ACT;
    __device__ __forceinline__ void operator()(const AccT& acc, const pg8::Unit& u, int wr, int wc, int fr, int fq) const {
        const int row0 = u.pm * 256 + wr * 64 + fr, tc = wc * 32 + 8 * fq;
#pragma unroll
        for (int ai = 0; ai < 2; ++ai)
#pragma unroll
            for (int m = 0; m < 4; ++m) { const int row = row0 + ai * 128 + m * 16; const f32x4 g0 = acc[ai][0][m][0], g1 = acc[ai][0][m][1], u0 = acc[ai][1][m][0], u1 = acc[ai][1][m][1]; f32x4 a0, a1;
                a0.x = silu_f(g0.x) * u0.x; a0.y = silu_f(g0.y) * u0.y; a0.z = silu_f(g0.z) * u0.z; a0.w = silu_f(g0.w) * u0.w;
                a1.x = silu_f(g1.x) * u1.x; a1.y = silu_f(g1.y) * u1.y; a1.z = silu_f(g1.z) * u1.z; a1.w = silu_f(g1.w) * u1.w;
                *(v4u*)(ACT + (size_t)row * 512 + u.pn * 128 + tc) = pack8(a0, a1); }
    }
};
struct EpiM4 { static constexpr bool PERM = true, AFTER_DRAIN = false;
    bf16* Y;
    __device__ __forceinline__ void operator()(const AccT& acc, const pg8::Unit& u, int wr, int wc, int fr, int fq) const {
        const int row0 = u.pm * 256 + wr * 64 + fr, tc = wc * 32 + 8 * fq;
#pragma unroll
        for (int ai = 0; ai < 2; ++ai)
#pragma unroll
            for (int m = 0; m < 4; ++m) { const int row = row0 + ai * 128 + m * 16;
#pragma unroll
                for (int bj = 0; bj < 2; ++bj) *(v4u*)(Y + (size_t)row * 2048 + u.pn * 256 + bj * 128 + tc) = pack8(acc[ai][bj][m][0], acc[ai][bj][m][1]); }
    }
};
__device__ __forceinline__ void moe_tables(Frame& F, int layer) {
    LAS int* tab = (LAS int*)(F.lds + MOE_TAB_OFF);
    __syncthreads();
    if (F.wave == 0) { const int lane = lane_id_opaque();
        const int cnt = lane < 32 ? (int)__hip_atomic_load(F.ctl + CW_ECNT + 64 * layer + lane, RLX_AGENT) : 0; const int nt = (cnt + 255) >> 8;
        int incl = nt;
#pragma unroll
        for (int off = 1; off < 32; off <<= 1) { const int v = __shfl_up(incl, off); if (lane >= off) incl += v; }
        const int start = incl - nt;
        if (lane < 32) { tab[128 + lane] = 256 * start; for (int i = 0; i < nt && start + i < 96; ++i) tab[start + i] = lane; }
        if (lane == 31) tab[160] = incl < 96 ? incl : 96; }
    __syncthreads();
}

#ifndef PH_MASK
#define PH_MASK 0x7FFFFFu
#endif
#ifndef PH_DUP
#define PH_DUP 0u
#endif
#define REP(k) _Pragma("unroll 1") for (int rep_ = 0; rep_ < ((((PH_DUP) >> (k)) & 1u) ? 2 : 1); ++rep_)
#define IN(k) (((PH_MASK >> (k)) & 1u) && lo <= (k) && (k) < hi)
#if defined(BAR_TWICE)
#define SEAM(k) do { if (IN(k) && IN((k) + 1)) { xcd_barrier(bar, F.wave); xcd_barrier(bar, F.wave); } } while (0)
#else
#define SEAM(k) do { if (IN(k) && IN((k) + 1)) xcd_barrier(bar, F.wave); } while (0)
#endif
template <int LAYER, int PB> __device__ __forceinline__ void moe_phases(Frame& F, const Args& args, const XcdBarrier& bar, int lo, int hi) {
    unsigned char* ws = F.ws; LAS unsigned char* ring = F.lds + RING_OFF; const int c = (int)blockIdx.x;
    if (IN(PB)) { router_phase(F, args, (const float*)(ws + WS_XA), args.in[8] + LAYER * 2048, 2 * LAYER + 1, LAYER, true);
#if defined(ROUTER_TWICE)
        router_phase(F, args, (const float*)(ws + WS_XA), args.in[8] + LAYER * 2048, 2 * LAYER + 1, LAYER, false);
#endif
    } SEAM(PB);
    if (IN(PB + 1)) { moe_tables(F, LAYER); scatter_phase(F, (const float*)(ws + WS_XA), args.in[8] + LAYER * 2048, 2 * LAYER + 1, LAYER, true);
#if defined(SCATTER_TWICE)
        scatter_phase(F, (const float*)(ws + WS_XA), args.in[8] + LAYER * 2048, 2 * LAYER + 1, LAYER, false);
#endif
    } SEAM(PB + 1);
    if (IN(PB + 2)) {
        if (MK_MULTI) moe_tables(F, LAYER);     const LAS int* tab = (const LAS int*)(F.lds + MOE_TAB_OFF); const int TM = tab[160], TA = (TM + 1) >> 1;
        pg8::Gemm g{2048, 2048, 64, 128, 32768}; pg8::MoeOrder S; S.ntn = 4; S.t0 = 0; S.nunits = TA * 4; S.gdeal = F.G; S.busy = 0; S.G = F.G; S.c = c; S.A = (const char*)(ws + WS_HG); S.W = (const char*)(ws + WS_W_GU + (size_t)LAYER * 128 * MiB);
        S.tstepA = (size_t)256 * 2048 * 2; S.tstepB = (size_t)256 * 2048 * 2; S.estep = (size_t)1024 * 2048 * 2; S.tile_expert = tab;
        EpiM3 E{(bf16*)(ws + WS_ACT)};
        pg8::gemm_phase<EpiM3, pg8::MoeOrder, true, true>(ring, g, S, E, F.wave);
#if defined(M3_TWICE)
        pg8::gemm_phase<EpiM3, pg8::MoeOrder, true, true>(ring, g, S, E, F.wave);
#endif
    } SEAM(PB + 2);
    if (IN(PB + 3)) {
        if (MK_MULTI) moe_tables(F, LAYER);     const LAS int* tab = (const LAS int*)(F.lds + MOE_TAB_OFF); const int TM = tab[160], TA = (TM + 1) >> 1, nb3 = (TM - TA) * 4;
        { pg8::Gemm g{2048, 2048, 64, 128, 32768}; pg8::MoeOrder S; S.ntn = 4; S.t0 = TA; S.nunits = nb3; S.gdeal = nb3 < F.G ? nb3 : F.G; S.busy = 0; S.G = F.G; S.c = c; S.A = (const char*)(ws + WS_HG); S.W = (const char*)(ws + WS_W_GU + (size_t)LAYER * 128 * MiB);
          S.tstepA = (size_t)256 * 2048 * 2; S.tstepB = (size_t)256 * 2048 * 2; S.estep = (size_t)1024 * 2048 * 2; S.tile_expert = tab;
          EpiM3 E{(bf16*)(ws + WS_ACT)};
          pg8::gemm_phase<EpiM3, pg8::MoeOrder, true, true>(ring, g, S, E, F.wave); }
        { pg8::Gemm g{512, 512, 64, 128, 32768}; pg8::MoeOrder S; S.ntn = 8; S.t0 = 0; S.nunits = TA * 8; S.gdeal = F.G; S.busy = (nb3 > 0 && nb3 < F.G) ? nb3 : 0; S.G = F.G; S.c = c; S.A = (const char*)(ws + WS_ACT); S.W = (const char*)(ws + WS_W_DN + (size_t)LAYER * 64 * MiB);
          S.tstepA = (size_t)256 * 512 * 2; S.tstepB = (size_t)256 * 512 * 2; S.estep = (size_t)2048 * 512 * 2; S.tile_expert = tab;
          EpiM4 E{(bf16*)(ws + WS_Y)};
          pg8::gemm_phase<EpiM4, pg8::MoeOrder, true, true>(ring, g, S, E, F.wave); }
    } SEAM(PB + 3);
    if (IN(PB + 4)) {
        if (MK_MULTI) moe_tables(F, LAYER);     const LAS int* tab = (const LAS int*)(F.lds + MOE_TAB_OFF); const int TM = tab[160], TA = (TM + 1) >> 1;
        pg8::Gemm g{512, 512, 64, 128, 32768}; pg8::MoeOrder S; S.ntn = 8; S.t0 = TA; S.nunits = (TM - TA) * 8; S.gdeal = F.G; S.busy = 0; S.G = F.G; S.c = c; S.A = (const char*)(ws + WS_ACT); S.W = (const char*)(ws + WS_W_DN + (size_t)LAYER * 64 * MiB);
        S.tstepA = (size_t)256 * 512 * 2; S.tstepB = (size_t)256 * 512 * 2; S.estep = (size_t)2048 * 512 * 2; S.tile_expert = tab;
        EpiM4 E{(bf16*)(ws + WS_Y)};
        pg8::gemm_phase<EpiM4, pg8::MoeOrder, true, true>(ring, g, S, E, F.wave);
#if defined(M4_TWICE)
        pg8::gemm_phase<EpiM4, pg8::MoeOrder, true, true>(ring, g, S, E, F.wave);
#endif
    } SEAM(PB + 4);
}
__global__ void __launch_bounds__(NWAVES * 64, 2) mk_fwd(Args args) {
    extern __shared__ __attribute__((aligned(16))) unsigned char lds[];
    Frame F;
    F.lds = (LAS unsigned char*)lds;
    F.MISC = (volatile LAS unsigned*)(F.lds + MISC_OFF);
    F.wave = __builtin_amdgcn_readfirstlane((int)threadIdx.x >> 6);
    F.G = gridDim.x; { const int bx = blockIdx.x; F.vcu = (F.G % 8 == 0) ? (bx % 8) * (F.G / 8) + bx / 8 : bx; }
    F.ws = args.ws; F.ctl = (gu32*)(args.ws + WS_CTL); F.out = args.out;
    for (int u = threadIdx.x; u < (LDS_BYTES - LDSCTL_OFF) / 4; u += NWAVES * 64) ((LAS unsigned*)(F.lds + LDSCTL_OFF))[u] = 0u;
    __syncthreads();
    XcdBarrier bar; bar.bar = (unsigned*)(F.ctl + CW_BAR); bar.x = 0; bar.st = nullptr;
    if (!MK_MULTI) bar = xcd_barrier_post((unsigned*)(F.ctl + CW_BAR), F.MISC + 8, F.wave);
    const int lo = args.ph_lo, hi = args.ph_hi;
    unsigned char* ws = args.ws;
    const float* MOD = (const float*)(F.ctl + CW_MOD);
    LAS unsigned char* ring = F.lds + RING_OFF;
    const int c = (int)blockIdx.x;

    if (IN(0)) REP(0) { p0a_mod_partials(F, args); } SEAM(0);
    if (IN(1)) REP(1) { p0_prologue(F, args); local_mod(F, args.in[4], 0); norm_phase<0, true>(F, args.in[0], nullptr, args.in[5], 0, 0, 0); } SEAM(1);
    if (IN(3)) REP(3) {
        pg8::Gemm g{2048, 2048, 2048}; pg8::StaticOrder S; S.init(T_, 4096, F.G, c, ws + WS_H, 2048, ws + WS_W_IN0T, 2048);
        EpiG1 E{(bf16*)(ws + WS_PROJ0), (bf16*)(ws + WS_KR), (float*)(ws + WS_SSQP), (const f32x2*)(ws + WS_TAB64)};
        pg8::gemm_phase<EpiG1, pg8::StaticOrder, true, true>(ring, g, S, E, F.wave);
    } SEAM(3);
    if (IN(4)) REP(4) {
        { pg8::Gemm g{512, 4096, 512}; pg8::StaticOrder S; S.init(T_, 1536, F.G, c, ws + WS_PROJ0 + 3072 * 2, 4096, ws + WS_W_QUPT, 512);
          EpiG2q E{(bf16*)(ws + WS_QMLA), (const float*)(ws + WS_SSQP), (const f32x2*)(ws + WS_TAB64)};
          pg8::gemm_phase<EpiG2q, pg8::StaticOrder, true, true>(ring, g, S, E, F.wave); }
        { pg8::Gemm g{256, 4096, 256}; pg8::StaticOrder S; S.init(T_, 2048, F.G, c, ws + WS_PROJ0 + 3584 * 2, 4096, ws + WS_W_KVUPT, 256);
          EpiG2kv E{(bf16*)(ws + WS_KVMLA), (const float*)(ws + WS_SSQP) + (size_t)T_ * 8};
          pg8::gemm_phase<EpiG2kv, pg8::StaticOrder, true, true>(ring, g, S, E, F.wave); }
    } SEAM(4);
    if (IN(5)) REP(5) { bool conv_left = true; WorkQ QC; wq_init(F, QC, F.ctl + CW_QC1, CONV_N1 / 128, 18, lane_id_opaque()); mla_phase(F, args, QC, conv_left); sb_phase(F, args, QC, conv_left); } SEAM(5);
    if (IN(6)) REP(6) {
        pg8::Gemm g{2048, 2048, 2048}; pg8::StaticOrder S; S.init(T_, 2048, F.G, c, ws + WS_ATTO, 2048, ws + WS_W_OUT0T, 2048);
        EpiRes E{args.in[0], (float*)(ws + WS_XA), MOD + (size_t)(0 * 4) * 6144 + 4096};
        pg8::gemm_phase<EpiRes, pg8::StaticOrder, true, true>(ring, g, S, E, F.wave);
    } SEAM(6);
    moe_phases<0, 7>(F, args, bar, lo, hi);
    if (IN(12)) REP(12) { norm_phase<2>(F, (const float*)(ws + WS_XA), (float*)(ws + WS_XB), args.in[5] + 2048, 2, 1, 0); } SEAM(12);
    if (IN(13)) REP(13) {
        pg8::Gemm g{2048, 2048, 2048}; pg8::StaticOrder S; S.init(T_, 12288, F.G, c, ws + WS_H, 2048, ws + WS_W_IN1T, 2048);
        EpiG4 E{(bf16*)(ws + WS_PROJ1), (const f32x2*)(ws + WS_TAB256)};
        pg8::gemm_phase<EpiG4, pg8::StaticOrder, true, true>(ring, g, S, E, F.wave);
    } SEAM(13);
    if (IN(14)) REP(14) { ret_phase(F, args); } SEAM(14);
    if (IN(15)) REP(15) { retnorm_phase(F); } SEAM(15);
    if (IN(16)) REP(16) {
        pg8::Gemm g{4096, 4096, 4096}; pg8::StaticOrder S; S.init(T_, 2048, F.G, c, ws + WS_A5, 4096, ws + WS_W_OUT1T, 4096);
        EpiRes E{(const float*)(ws + WS_XB), (float*)(ws + WS_XA), MOD + (size_t)(2 * 4) * 6144 + 4096};
        pg8::gemm_phase<EpiRes, pg8::StaticOrder, true, true>(ring, g, S, E, F.wave);
    } SEAM(16);
    moe_phases<1, 17>(F, args, bar, lo, hi);
    if (IN(22)) REP(22) { norm_phase<3>(F, (const float*)(ws + WS_XA), nullptr, args.in[24], 0, 3, 1); }
}
#undef IN
#undef SEAM

extern "C" void kernel_launch(void* const* d_in, const int* in_sizes, int n_in, void* d_out, int out_size, void* d_ws, size_t ws_size, hipStream_t stream) {
    static int grid = 0;
    if (grid == 0) {
        if (n_in != 25 || in_sizes[0] != T_ * D_ || out_size != T_ * D_ || ws_size < WS_END) { fprintf(stderr, "kernel_launch: unexpected shapes (n_in %d, in0 %d, out %d, ws %zu < %zu); nothing launched\n", n_in, n_in > 0 ? in_sizes[0] : -1, out_size, ws_size, (size_t)WS_END); grid = -1; return; }
        int dev = 0, cus = 0, per_cu = 0;
        if (hipGetDevice(&dev) != hipSuccess || hipDeviceGetAttribute(&cus, hipDeviceAttributeMultiprocessorCount, dev) != hipSuccess) { fprintf(stderr, "kernel_launch: device query failed\n"); grid = -1; return; }
        if (hipFuncSetAttribute((const void*)mk_fwd, hipFuncAttributeMaxDynamicSharedMemorySize, LDS_BYTES) != hipSuccess) { fprintf(stderr, "kernel_launch: hipFuncSetAttribute failed\n"); grid = -1; return; }
        if (hipOccupancyMaxActiveBlocksPerMultiprocessor(&per_cu, (const void*)mk_fwd, NWAVES * 64, LDS_BYTES) != hipSuccess || per_cu < 1) fprintf(stderr, "kernel_launch: note: occupancy query reports %d workgroups per CU\n", per_cu);
        (void)hipGetLastError();
        grid = cus;
    }
    if (grid < 0) return;
    if (hipMemsetAsync((char*)d_ws + WS_CTL, 0, CTL_ZERO_BYTES, stream) != hipSuccess) { fprintf(stderr, "kernel_launch: memset failed\n"); return; }
    Args a{};
    for (int i = 0; i < 25; ++i) a.in[i] = (const float*)d_in[i];
    a.out = (float*)d_out; a.ws = (unsigned char*)d_ws;
#if MK_MULTI
    for (int p = 0; p < 23; ++p) { a.ph_lo = p; a.ph_hi = p + 1; hipLaunchKernelGGL(mk_fwd, dim3(grid), dim3(NWAVES * 64), LDS_BYTES, stream, a); }
#else
    a.ph_lo = 0; a.ph_hi = 23;
    hipLaunchKernelGGL(mk_fwd, dim3(grid), dim3(NWAVES * 64), LDS_BYTES, stream, a);
#endif
    const hipError_t le = hipPeekAtLastError();
    if (le != hipSuccess) fprintf(stderr, "kernel_launch: launch failed: %s\n", hipGetErrorName(le));
}
```

```cpp
#include <hip/hip_runtime.h>
#include <cstdio>
#include <cstdint>

#ifndef MK_MULTI
#define MK_MULTI 0
#endif

namespace pg8 {
#define PG8_LAS __attribute__((address_space(3)))
typedef unsigned short bf16_t;
typedef short bf16x8 __attribute__((ext_vector_type(8)));
typedef float f32x4 __attribute__((ext_vector_type(4)));
typedef unsigned u32x4 __attribute__((ext_vector_type(4)));
constexpr int BM = 256, BK = 64, HALF = 128, HTB = HALF * BK * 2  , STAGE_BYTES = 8 * HTB, NXCD = 8, WGM = 8;

__host__ __device__ __forceinline__ int lds_byte(int r, int c) { const int st = (r >> 4) * 2 + (c >> 5), rr = r & 15, cc = c & 31, ob = rr * 64 + cc * 2; return st * 1024 + (ob ^ (((ob >> 9) & 1) << 5)); }
__host__ __device__ __forceinline__ void stage_rc(int b, int& R, int& C) { const int st = b / 1024, sb = b % 1024, swz = sb ^ (((sb >> 9) & 1) << 5); R = (st >> 1) * 16 + swz / 64; C = (st & 1) * 32 + (swz % 64) / 2; }
__host__ __device__ __forceinline__ int perm32(int rho) { const int n = rho >> 4, i = rho & 15; return 8 * (i >> 2) + 4 * n + (i & 3); }

struct Unit { int pm, pn; const char* a; const char* b; };
struct Gemm { int K, lda, ldb; size_t kstepA = 128, kstepB = 128; };

struct StaticOrder {
    int nM, nN, nwg, G, c; const char* A; const char* Bt; size_t tstepA, tstepB;
    __device__ void init(int M, int N, int G_, int c_, const void* A_, int lda, const void* Bt_, int ldb) { nM = M / BM; nN = N / BM; nwg = nM * nN; G = G_; c = c_; A = (const char*)A_; Bt = (const char*)Bt_; tstepA = (size_t)BM * lda * 2; tstepB = (size_t)BM * ldb * 2; }
    __device__ bool next(int i, Unit& u) const {
        const long L = (long)i * G + c; if (L >= nwg) return false;
        int wgid = (int)L; { const int q = nwg / NXCD, r = nwg % NXCD, xcd = wgid % NXCD, off = wgid / NXCD; wgid = (xcd < r ? xcd * (q + 1) : r * (q + 1) + (xcd - r) * q) + off; }
        const int nig = WGM * nN, gid = wgid / nig, fm = gid * WGM, gsz = (nM - fm) < WGM ? (nM - fm) : WGM;
        u.pm = fm + ((wgid % nig) % gsz); u.pn = (wgid % nig) / gsz; u.a = A + (size_t)u.pm * tstepA; u.b = Bt + (size_t)u.pn * tstepB; return true;
    }
    __device__ __forceinline__ void a_ready(const Unit&) const {}
    __device__ __forceinline__ void done(const Unit&) const {}
};
struct MoeOrder {
    int ntn, t0, nunits, gdeal, busy, G, c; const char* A; const char* W; size_t tstepA, tstepB, estep; const PG8_LAS int* tile_expert;
    __device__ bool next(int i, Unit& u) const {
        int L;
        if (busy == 0) { if (c >= gdeal) return false; L = i * gdeal + c; }
        else { const int nfree = G - busy;
            if (c >= busy) { const int cap = 3 * nfree < nunits ? 3 * nfree : nunits; if (i >= 3) return false; L = 3 * (c - busy) + i; if (L >= cap) return false; }
            else { L = 3 * nfree + i * busy + c; } }
        if (L >= nunits) return false;
        const int mt = t0 + L / ntn, pn = L % ntn, e = tile_expert[mt];
        u.pm = mt; u.pn = pn; u.a = A + (size_t)mt * tstepA; u.b = W + (size_t)e * estep + (size_t)pn * tstepB; return true;
    }
    __device__ __forceinline__ void a_ready(const Unit&) const {}
    __device__ __forceinline__ void done(const Unit&) const {}
};

template <class Epi, class Sched, bool ALIGN_EPI = false, bool SP2 = false>
__device__ __forceinline__ void gemm_phase(PG8_LAS unsigned char* lds, const Gemm g, const Sched& S, const Epi& E, const int wave_id) {
    int lane; asm volatile("v_mbcnt_lo_u32_b32 %0, -1, 0\n\tv_mbcnt_hi_u32_b32 %0, -1, %0" : "=v"(lane));
    const int wid = wave_id, tid = wid * 64 + lane, wr = wid >> 2, wc = wid & 3, fr = lane & 15, fq = lane >> 4;
    const int K = g.K, nt = K / BK;
    unsigned voffA[2], voffB[2];
#pragma unroll
    for (int i = 0; i < 2; ++i) { int R, C; stage_rc(tid * 16 + i * 8192, R, C); const int Rb = Epi::PERM ? ((R & ~31) + perm32(R & 31)) : R;
        voffA[i] = (unsigned)(R * g.lda + C) * 2u; voffB[i] = (unsigned)(Rb * g.ldb + C) * 2u; }
    const size_t kstepA = g.kstepA, kstepB = g.kstepB;
    const size_t hstepA = (size_t)HALF * g.lda * 2, hstepB = (size_t)HALF * g.ldb * 2;
    const unsigned ldsw = (unsigned)wid * 1024u;
    const int aoff = lds_byte(wr * 64 + fr, fq * 8), boff = lds_byte(wc * 32 + fr, fq * 8);
#define PG8_SA(b, h) (((b) * 2 + (h)) * HTB)
#define PG8_SB(b, h) ((4 + (b) * 2 + (h)) * HTB)
#define PG8_STAGE(bufoff, gbase, voff) do { _Pragma("unroll") for (int _i = 0; _i < 2; ++_i) \
        __builtin_amdgcn_global_load_lds((const unsigned*)((const char*)(gbase) + (voff)[_i]), (PG8_LAS unsigned*)(lds + (bufoff) + ldsw + _i * 8192), 16, 0, 0); } while (0)
#define PG8_LDA(dst, b, h) do { _Pragma("unroll") for (int m = 0; m < 4; ++m) _Pragma("unroll") for (int k = 0; k < 2; ++k) dst[m][k] = *(const PG8_LAS bf16x8*)(lds + PG8_SA(b, h) + aoff + m * 2048 + k * 1024); } while (0)
#define PG8_LDB(dst, b, h) do { _Pragma("unroll") for (int n = 0; n < 2; ++n) _Pragma("unroll") for (int k = 0; k < 2; ++k) dst[n][k] = *(const PG8_LAS bf16x8*)(lds + PG8_SB(b, h) + boff + n * 2048 + k * 1024); } while (0)
#define PG8_MMA(ai, bj, At, Bt) do { __builtin_amdgcn_s_setprio(1); _Pragma("unroll") for (int m = 0; m < 4; ++m) _Pragma("unroll") for (int n = 0; n < 2; ++n) _Pragma("unroll") for (int k = 0; k < 2; ++k) \
        acc[ai][bj][m][n] = __builtin_amdgcn_mfma_f32_16x16x32_bf16(Bt[n][k], At[m][k], acc[ai][bj][m][n], 0, 0, 0); __builtin_amdgcn_s_setprio(0); } while (0)
#define PG8_WAIT_V(n) asm volatile("s_waitcnt vmcnt(" #n ")" ::: "memory")
#define PG8_WAIT_L(n) asm volatile("s_waitcnt lgkmcnt(" #n ")" ::: "memory")
#define PG8_BAR __builtin_amdgcn_s_barrier()
#define PG8_SCHED __builtin_amdgcn_sched_barrier(0)
    Unit cur, nxt; int ui = 0;
    if (!S.next(0, cur)) return;
    f32x4 acc[2][2][4][2];
#pragma unroll
    for (int a = 0; a < 2; ++a)
#pragma unroll
        for (int b = 0; b < 2; ++b)
#pragma unroll
            for (int m = 0; m < 4; ++m)
#pragma unroll
                for (int n = 0; n < 2; ++n) acc[a][b][m][n] = (f32x4){0.f, 0.f, 0.f, 0.f};
    bf16x8 At[4][2], B0[2][2], B1[2][2];
    const char* cA = cur.a; const char* cB = cur.b;
    S.a_ready(cur);
    if constexpr (SP2) {
        PG8_STAGE(PG8_SB(0, 0), cB, voffB); PG8_STAGE(PG8_SB(0, 1), cB + hstepB, voffB); PG8_STAGE(PG8_SA(0, 0), cA, voffA); PG8_STAGE(PG8_SA(0, 1), cA + hstepA, voffA);
        if (wr == 1) PG8_BAR;
        PG8_WAIT_V(2); PG8_BAR;
        PG8_STAGE(PG8_SB(1, 0), cB + kstepB, voffB); PG8_STAGE(PG8_SA(1, 0), cA + kstepA, voffA); PG8_STAGE(PG8_SB(1, 1), cB + hstepB + kstepB, voffB);
        PG8_WAIT_V(6); PG8_BAR;
    } else {
        PG8_STAGE(PG8_SB(0, 0), cB, voffB); PG8_STAGE(PG8_SA(0, 0), cA, voffA); PG8_STAGE(PG8_SB(0, 1), cB + hstepB, voffB); PG8_STAGE(PG8_SA(0, 1), cA + hstepA, voffA);
        if (wr == 1) PG8_BAR;
        PG8_WAIT_V(4); PG8_BAR;
        PG8_STAGE(PG8_SB(1, 0), cB + kstepB, voffB); PG8_STAGE(PG8_SA(1, 0), cA + kstepA, voffA); PG8_STAGE(PG8_SB(1, 1), cB + hstepB + kstepB, voffB);
        PG8_WAIT_V(6); PG8_BAR;
    }
    for (;;) {
        const bool has_next = S.next(ui + 1, nxt);
        const char* nA = has_next ? nxt.a : cA; const char* nB = has_next ? nxt.b : cB;
        for (int t = 0; t < nt; t += 2) {
            const bool last = (t == nt - 2);
            const char* a1 = cA + (size_t)(t + 1) * kstepA;
            const char* a2 = last ? nA : cA + (size_t)(t + 2) * kstepA; const char* b2 = last ? nB : cB + (size_t)(t + 2) * kstepB;
            const char* a3 = a2 + kstepA; const char* b3 = b2 + kstepB;
            if (last && has_next) S.a_ready(nxt);
            if constexpr (SP2) {
            PG8_LDB(B0, 0, 0); PG8_LDB(B1, 0, 1); PG8_SCHED; PG8_LDA(At, 0, 0); PG8_STAGE(PG8_SA(1, 1), a1 + hstepA, voffA);
            PG8_WAIT_V(8); PG8_WAIT_L(0); PG8_BAR; PG8_MMA(0, 0, At, B0); PG8_MMA(0, 1, At, B1); PG8_BAR; PG8_SCHED;
            PG8_LDA(At, 0, 1); PG8_STAGE(PG8_SB(0, 0), b2, voffB); PG8_STAGE(PG8_SB(0, 1), b2 + hstepB, voffB); PG8_STAGE(PG8_SA(0, 0), a2, voffA);
            PG8_WAIT_V(8); PG8_WAIT_L(0); PG8_BAR; PG8_MMA(1, 0, At, B0); PG8_MMA(1, 1, At, B1); PG8_BAR; PG8_SCHED;
            PG8_LDB(B0, 1, 0); PG8_LDB(B1, 1, 1); PG8_SCHED; PG8_LDA(At, 1, 0); PG8_STAGE(PG8_SA(0, 1), a2 + hstepA, voffA);
            PG8_WAIT_V(8); PG8_WAIT_L(0); PG8_BAR; PG8_MMA(0, 0, At, B0); PG8_MMA(0, 1, At, B1); PG8_BAR; PG8_SCHED;
            PG8_LDA(At, 1, 1); PG8_STAGE(PG8_SB(1, 0), b3, voffB); PG8_STAGE(PG8_SB(1, 1), b3 + hstepB, voffB); PG8_STAGE(PG8_SA(1, 0), a3, voffA);
            PG8_WAIT_V(8); PG8_WAIT_L(0); PG8_BAR; PG8_MMA(1, 0, At, B0); PG8_MMA(1, 1, At, B1); PG8_BAR; PG8_SCHED;
            } else {
            PG8_LDB(B0, 0, 0); PG8_SCHED; PG8_LDA(At, 0, 0); PG8_STAGE(PG8_SA(1, 1), a1 + hstepA, voffA);
            PG8_WAIT_L(8); PG8_BAR; PG8_WAIT_L(0); PG8_MMA(0, 0, At, B0); PG8_BAR; PG8_SCHED;
            PG8_LDB(B1, 0, 1); PG8_STAGE(PG8_SB(0, 0), b2, voffB);
            PG8_BAR; PG8_WAIT_L(0); PG8_MMA(0, 1, At, B1); PG8_BAR;
            PG8_LDA(At, 0, 1); PG8_STAGE(PG8_SA(0, 0), a2, voffA);
            PG8_BAR; PG8_WAIT_L(0); PG8_MMA(1, 0, At, B0); PG8_BAR; PG8_SCHED;
            PG8_STAGE(PG8_SB(0, 1), b2 + hstepB, voffB);
            PG8_WAIT_V(6); PG8_BAR; PG8_MMA(1, 1, At, B1); PG8_BAR;
            PG8_LDB(B0, 1, 0); PG8_SCHED; PG8_LDA(At, 1, 0); PG8_STAGE(PG8_SA(0, 1), a2 + hstepA, voffA);
            PG8_WAIT_L(8); PG8_BAR; PG8_WAIT_L(0); PG8_MMA(0, 0, At, B0); PG8_BAR; PG8_SCHED;
            PG8_LDB(B1, 1, 1); PG8_STAGE(PG8_SB(1, 0), b3, voffB);
            PG8_BAR; PG8_WAIT_L(0); PG8_MMA(0, 1, At, B1); PG8_BAR;
            PG8_LDA(At, 1, 1); PG8_STAGE(PG8_SA(1, 0), a3, voffA);
            PG8_BAR; PG8_WAIT_L(0); PG8_MMA(1, 0, At, B0); PG8_BAR; PG8_SCHED;
            PG8_STAGE(PG8_SB(1, 1), b3 + hstepB, voffB);
            PG8_WAIT_V(6); PG8_BAR; PG8_MMA(1, 1, At, B1); PG8_BAR;
            }
        }
        if constexpr (ALIGN_EPI) { if (wr == 0) PG8_BAR; }
        if constexpr (!Epi::AFTER_DRAIN) { E(acc, cur, wr, wc, fr, fq); S.done(cur); }
        if (!has_next) break;
#pragma unroll
        for (int a = 0; a < 2; ++a)
#pragma unroll
            for (int b = 0; b < 2; ++b)
#pragma unroll
                for (int m = 0; m < 4; ++m)
#pragma unroll
                    for (int n = 0; n < 2; ++n) acc[a][b][m][n] = (f32x4){0.f, 0.f, 0.f, 0.f};
        cur = nxt; cA = nA; cB = nB; ++ui;
        if constexpr (ALIGN_EPI) { if (wr == 1) PG8_BAR; }
    }
    PG8_WAIT_V(0);
    if constexpr (!ALIGN_EPI) { if (wr == 0) PG8_BAR; }
    PG8_BAR;
    if constexpr (Epi::AFTER_DRAIN) { E.fused(acc, cur, wr, wc, fr, fq, lds, wid, lane); S.done(cur); }
#undef PG8_SA
#undef PG8_SB
#undef PG8_STAGE
#undef PG8_LDA
#undef PG8_LDB
#undef PG8_MMA
#undef PG8_WAIT_V
#undef PG8_WAIT_L
#undef PG8_BAR
#undef PG8_SCHED
}
}

constexpr int NWAVES = 8;
constexpr int T_ = 8192, D_ = 2048, NB_ = 4, S_ = 2048;
constexpr float EPS_ = 1e-6f;
constexpr float LOG2E = 1.4426950408889634f;
constexpr float C_SB = 0.08838834764831845f * LOG2E;
constexpr float C_MLA = 0.07216878364870323f * LOG2E;
constexpr int NPH = 22;

constexpr size_t MiB = 1u << 20;
constexpr size_t WS_CTL = 0, CTL_ZERO_BYTES = 1 * MiB;
constexpr size_t WS_TAB64 = 2 * MiB, WS_TAB256 = 4 * MiB, WS_WR = 12 * MiB, WS_ROUTE = 13 * MiB;
constexpr size_t WS_W_IN0T = 16 * MiB, WS_W_QUPT = 32 * MiB, WS_W_KVUPT = 34 * MiB, WS_W_OUT0T = 36 * MiB, WS_W_IN1T = 44 * MiB, WS_W_OUT1T = 92 * MiB;
constexpr size_t WS_W_GU = 108 * MiB, WS_W_DN = 364 * MiB;
constexpr size_t WS_XA = 492 * MiB, WS_XB = 556 * MiB, WS_H = 620 * MiB;
constexpr size_t WS_PROJ0 = 652 * MiB, WS_QMLA = 716 * MiB, WS_KVMLA = 740 * MiB, WS_KR = 772 * MiB, WS_ATTO = 774 * MiB;
constexpr size_t WS_PROJ1 = 652 * MiB;
constexpr size_t WS_HG = 844 * MiB, WS_ACT = 940 * MiB, WS_Y = 964 * MiB;
constexpr size_t WS_RETO = 844 * MiB, WS_A5 = 908 * MiB;
constexpr size_t WS_MODP = 1060 * MiB;
constexpr size_t WS_WRS = 14 * MiB;
constexpr size_t WS_RS = 13 * MiB + 256 * 1024;
constexpr size_t WS_SSQP = 13 * MiB + 512 * 1024;
constexpr size_t WS_END = 1068 * MiB;
constexpr int CW_TMO = 0, CW_CODE = 1;
constexpr int CW_BAR = 4096;
constexpr int CW_QMLA = 8192, CW_QSB = 8256, CW_QRET = 8320, CW_QC1 = 8384, CW_QC2 = 8416;
constexpr int CW_ECNT = 114688, CW_ECUR = 118784;
#define ECNT_IDX(layer, e) (CW_ECNT + ((layer) * 32 + (e)) * 64)
#define ECUR_IDX(layer, e) (CW_ECUR + ((layer) * 32 + (e)) * 64)
constexpr int CW_MOD = 16384;
constexpr int CW_SSQQ = 114688, CW_SSQKV = 122880;
static_assert((CW_SSQKV + 8192) * 4 <= (int)CTL_ZERO_BYTES, "CTL words inside the memset region");
constexpr int RING_OFF = 0, RING_BYTES = 147456;
constexpr int LDSCTL_OFF = RING_BYTES, MISC_OFF = LDSCTL_OFF + 320;
constexpr int MOE_TAB_OFF = LDSCTL_OFF + 1024;
constexpr int LDS_BYTES = 155648;
static_assert(MOE_TAB_OFF + 1024 <= LDS_BYTES, "LDS map");

#define GAS __attribute__((address_space(1)))
#define LAS __attribute__((address_space(3)))
typedef unsigned short bf16;
typedef unsigned v4u __attribute__((ext_vector_type(4)));
typedef unsigned v2u __attribute__((ext_vector_type(2)));
typedef float f32x4 __attribute__((ext_vector_type(4)));
typedef float f32x2 __attribute__((ext_vector_type(2)));
typedef float f32x16 __attribute__((ext_vector_type(16)));
typedef short bf16x8 __attribute__((ext_vector_type(8)));
typedef short s16x4 __attribute__((ext_vector_type(4)));
typedef short v4i16_t __attribute__((ext_vector_type(4)));
typedef GAS unsigned gu32;
#define RLX_AGENT __ATOMIC_RELAXED, __HIP_MEMORY_SCOPE_AGENT
#define LDS_WAIT() asm volatile("s_waitcnt lgkmcnt(0)" ::: "memory")
#define VM_WAIT() asm volatile("s_waitcnt vmcnt(0)" ::: "memory")
typedef __bf16 bf16x2_t __attribute__((ext_vector_type(2)));
__device__ __forceinline__ unsigned pk2(float lo, float hi) { f32x2 v = {lo, hi}; bf16x2_t b = __builtin_convertvector(v, bf16x2_t); return __builtin_bit_cast(unsigned, b); }
__device__ __forceinline__ float bf_lo(unsigned w) { return __uint_as_float(w << 16); }
__device__ __forceinline__ float bf_hi(unsigned w) { return __uint_as_float(w & 0xffff0000u); }
__device__ __forceinline__ float ex2(float x) { return __builtin_amdgcn_exp2f(x); }
__device__ __forceinline__ float lg2(float x) { return __builtin_amdgcn_logf(x); }
__device__ __forceinline__ float silu_f(float v) { return v / (1.0f + __expf(-v)); }
__device__ __forceinline__ int lane_id_opaque() { int l; asm volatile("v_mbcnt_lo_u32_b32 %0, -1, 0\n\tv_mbcnt_hi_u32_b32 %0, -1, %0" : "=v"(l)); return l; }

#define XB_TMO      128
#define XB_XCNT(j)  (256  + 64 * (j))
#define XB_XSUB(j)  (1280 + 64 * (j))
#define XB_XGEN(j)  (2304 + 64 * (j))
#define XB_TOP      3328
#define XB_TOPGEN   3392
#define XCD_BAR_WORDS 3456
#define XB_SPIN_CAP (1u << 18)
__device__ __forceinline__ unsigned xb_ld(unsigned* p)              { return __hip_atomic_load(p, __ATOMIC_RELAXED, __HIP_MEMORY_SCOPE_AGENT); }
__device__ __forceinline__ unsigned xb_add(unsigned* p, unsigned v) { return __hip_atomic_fetch_add(p, v, __ATOMIC_RELAXED, __HIP_MEMORY_SCOPE_AGENT); }
__device__ __forceinline__ unsigned xb_xcc_id() { return (unsigned)__builtin_amdgcn_s_getreg((3 << 11) | 20) & 0xFu; }
#define XB_SPIN(cond, bar) do { unsigned _sp = 0; while (cond) { __builtin_amdgcn_s_sleep(1); \
    if ((++_sp & 255u) == 0u) { if (xb_ld(&(bar)[XB_TMO])) break; if (_sp > XB_SPIN_CAP) { atomicAdd(&(bar)[XB_TMO], 1u); break; } } } } while (0)
struct XcdBarrier { unsigned* bar; unsigned x; volatile LAS unsigned* st; };
__device__ __forceinline__ XcdBarrier xcd_barrier_post(unsigned* bar, volatile LAS unsigned* st, int wave) {
    XcdBarrier b; b.bar = bar; b.x = xb_xcc_id(); b.st = st;
    if (wave == 0 && lane_id_opaque() == 0) (void)xb_add(&bar[XB_XCNT(b.x)], 1u);
    return b;
}
__device__ __forceinline__ void xcd_barrier_complete(unsigned* bar, unsigned x, unsigned& nloc, unsigned& nx) {
    const unsigned G = gridDim.x * gridDim.y * gridDim.z;
    unsigned sum, cnt, mine, sp = 0u;
    for (;;) {
        sum = 0u; cnt = 0u; mine = 0u;
#pragma unroll
        for (unsigned j = 0; j < 16; ++j) { const unsigned c = xb_ld(&bar[XB_XCNT(j)]); sum += c; cnt += (c > 0u) ? 1u : 0u; mine = (j == x) ? c : mine; }
        if (sum == G) break;
        __builtin_amdgcn_s_sleep(1);
        if ((++sp & 255u) == 0u) { if (xb_ld(&bar[XB_TMO])) break; if (sp > XB_SPIN_CAP) { atomicAdd(&bar[XB_TMO], 1u); break; } }
    }
    nloc = mine > 0u ? mine : 1u; nx = cnt > 0u ? cnt : 1u;
}
__device__ __forceinline__ void xcd_barrier(const XcdBarrier& b, int wave) {
    asm volatile("s_waitcnt vmcnt(0)" ::: "memory");
    __syncthreads();
    if (wave == 0 && lane_id_opaque() == 0) {
        unsigned* bar = b.bar;
        __builtin_amdgcn_s_waitcnt(0);
        unsigned nloc = b.st[0], nx = b.st[1];
        if (nloc == 0u) { xcd_barrier_complete(bar, b.x, nloc, nx); b.st[0] = nloc; b.st[1] = nx; }
        const unsigned old = xb_add(&bar[XB_XSUB(b.x)], 1u);
        const unsigned gen = old / nloc;
        if (old + 1u == (gen + 1u) * nloc) {
            __builtin_amdgcn_fence(__ATOMIC_RELEASE, "agent");
            asm volatile("s_waitcnt vmcnt(0)" ::: "memory");
            const unsigned og = xb_add(&bar[XB_TOP], 1u);
            const unsigned tg = og / nx;
            if (og + 1u == (tg + 1u) * nx) xb_add(&bar[XB_TOPGEN], 1u);
            else XB_SPIN(xb_ld(&bar[XB_TOPGEN]) == tg, bar);
            __builtin_amdgcn_fence(__ATOMIC_ACQUIRE, "agent");
            xb_add(&bar[XB_XGEN(b.x)], 1u);
            asm volatile("s_waitcnt vmcnt(0)" ::: "memory");
        } else {
            XB_SPIN(xb_ld(&bar[XB_XGEN(b.x)]) == gen, bar);
            __builtin_amdgcn_fence(__ATOMIC_ACQUIRE, "agent");
            asm volatile("s_waitcnt vmcnt(0)" ::: "memory");
        }
    }
    __syncthreads();
}

struct Frame {
    LAS unsigned char* lds;
    volatile LAS unsigned* MISC;
    gu32* ctl;
    unsigned char* ws;
    int wave;
    int vcu, G;
    float* out;
};
struct Args { const float* in[25]; float* out; unsigned char* ws; int ph_lo, ph_hi; };
__device__ __forceinline__ float wave_sum(float v) {
#pragma unroll
    for (int o = 1; o < 64; o <<= 1) v += __shfl_xor(v, o);
    return v;
}
#define PHASE_IDS(F) const int lane = lane_id_opaque(), wave = (F).wave, tid = wave * 64 + lane; (void)lane; (void)wave; (void)tid
struct ConvSrc { const float* W; int ldn; bf16* WT; int ldk; const float* scale; };
__device__ __forceinline__ void conv_load(const ConvSrc& c, int lane, f32x4 (&v)[8]) {
    const float* src = c.W + (size_t)(8 * (lane >> 3)) * c.ldn + 4 * (lane & 7);
#pragma unroll
    for (int t = 0; t < 8; ++t) v[t] = __builtin_nontemporal_load((const f32x4*)(src + (size_t)t * c.ldn));
}
__device__ __forceinline__ void conv_store(const ConvSrc& c, int lane, f32x4 (&v)[8]) {
    if (c.scale) { const f32x4 s0 = *(const f32x4*)(c.scale + 8 * (lane >> 3)), s1 = *(const f32x4*)(c.scale + 8 * (lane >> 3) + 4);
        v[0] *= s0.x; v[1] *= s0.y; v[2] *= s0.z; v[3] *= s0.w; v[4] *= s1.x; v[5] *= s1.y; v[6] *= s1.z; v[7] *= s1.w; }
    bf16* dst = c.WT + (size_t)(4 * (lane & 7)) * c.ldk + 8 * (lane >> 3);
#pragma unroll
    for (int j = 0; j < 4; ++j) { v4u o; o.x = pk2(v[0][j], v[1][j]); o.y = pk2(v[2][j], v[3][j]); o.z = pk2(v[4][j], v[5][j]); o.w = pk2(v[6][j], v[7][j]); __builtin_nontemporal_store(o, (v4u*)(dst + (size_t)j * c.ldk)); }
}
static_assert((64 * 32 + 384 * 32 + 32 * 1024 + 32 * 512) % 128 == 0 && (64 * 64 + 32 * 1024 + 32 * 512) % 128 == 0, "conversion batches of 128 items");
constexpr int CONV_N0 = 122 * 32 + 48 * 8 + 64 * 4, CONV_N1 = 64 * 32 + 384 * 32 + 32 * 1024 + 32 * 512, CONV_N2 = 64 * 64 + 32 * 1024 + 32 * 512;
__device__ __forceinline__ ConvSrc conv_moe_gu(const Args& A, unsigned char* ws, int le, int r) {
    const int nb = r / 32, kb = r % 32, t = nb >> 3, hf = (nb >> 2) & 1, jb = nb & 3;
    return ConvSrc{(hf ? A.in[22] : A.in[21]) + (size_t)le * 2048 * 512 + (size_t)(64 * kb) * 512 + 128 * t + 32 * jb, 512,
                   (bf16*)(ws + WS_W_GU) + (size_t)le * 1024 * 2048 + ((size_t)(t * 32 + kb) * 256 + 32 * (nb & 7)) * 64, 64, nullptr};
}
__device__ __forceinline__ ConvSrc conv_moe_dn(const Args& A, unsigned char* ws, int le, int r) {
    const int nb = r / 8, kb = r % 8;
    return ConvSrc{A.in[23] + (size_t)le * 512 * 2048 + (size_t)(64 * kb) * 2048 + 32 * nb, 2048,
                   (bf16*)(ws + WS_W_DN) + (size_t)le * 2048 * 512 + ((size_t)((nb >> 3) * 8 + kb) * 256 + 32 * (nb & 7)) * 64, 64, nullptr};
}
template <int STREAM> __device__ __forceinline__ ConvSrc conv_item(const Args& A, unsigned char* ws, int it) {
    if (STREAM == 0) {
        if (it < 122 * 32) { const int t = it / 32, kb = it % 32; const int dnb = t < 120 ? t : (t == 120 ? 120 : 124), sc = t < 120 ? 32 * t : (t == 120 ? 3840 : 3872);
            return ConvSrc{A.in[9] + (size_t)(64 * kb) * 3904 + sc, 3904, (bf16*)(ws + WS_W_IN0T) + (size_t)(32 * dnb) * 2048 + 64 * kb, 2048, nullptr}; }
        it -= 122 * 32;
        if (it < 48 * 8) { const int nb = it / 8, kb = it % 8; int sc;
            if (nb < 32) sc = (nb >> 2) * 192 + 32 * (nb & 3);
            else { const int t = (nb - 32) >> 3, blk = (nb - 32) & 7, hf = blk >> 2, hh = blk & 3; sc = (4 * t + hh) * 192 + 128 + 32 * hf; }
            return ConvSrc{A.in[11] + (size_t)(64 * kb) * 1536 + sc, 1536, (bf16*)(ws + WS_W_QUPT) + (size_t)(32 * nb) * 512 + 64 * kb, 512, A.in[10] + 64 * kb}; }
        it -= 48 * 8;
        { const int nb = it / 4, kb = it % 4;
            return ConvSrc{A.in[13] + (size_t)(64 * kb) * 2048 + 32 * nb, 2048, (bf16*)(ws + WS_W_KVUPT) + (size_t)(32 * nb) * 256 + 64 * kb, 256, A.in[12] + 64 * kb}; }
    } else if (STREAM == 1) {
        if (it < 64 * 32) { const int nb = it / 32, kb = it % 32;
            return ConvSrc{A.in[14] + (size_t)(64 * kb) * 2048 + 32 * nb, 2048, (bf16*)(ws + WS_W_OUT0T) + (size_t)(32 * nb) * 2048 + 64 * kb, 2048, nullptr}; }
        it -= 64 * 32;
        if (it < 384 * 32) { const int nb = it / 32, kb = it % 32;
            return ConvSrc{A.in[15] + (size_t)(64 * kb) * 12288 + 32 * nb, 12288, (bf16*)(ws + WS_W_IN1T) + (size_t)(32 * nb) * 2048 + 64 * kb, 2048, nullptr}; }
        it -= 384 * 32;
        if (it < 32 * 1024) return conv_moe_gu(A, ws, it / 1024, it % 1024);
        it -= 32 * 1024;
        return conv_moe_dn(A, ws, it / 512, it % 512);
    } else {
        if (it < 64 * 64) { const int nb = it / 64, kb = it % 64;
            return ConvSrc{A.in[16] + (size_t)(64 * kb) * 2048 + 32 * nb, 2048, (bf16*)(ws + WS_W_OUT1T) + (size_t)(32 * nb) * 4096 + 64 * kb, 4096, nullptr}; }
        it -= 64 * 64;
        if (it < 32 * 1024) return conv_moe_gu(A, ws, 32 + it / 1024, it % 1024);
        it -= 32 * 1024;
        return conv_moe_dn(A, ws, 32 + it / 512, it % 512);
    }
}
template <int STREAM> __device__ __forceinline__ void conv_burst(Frame& F, const Args& A, int lane, int gw, int NGW, int& cur, int n) {
    constexpr int N = STREAM == 0 ? CONV_N0 : (STREAM == 1 ? CONV_N1 : CONV_N2);
#pragma unroll 1
    while (n > 0) {
        const int i0 = gw + NGW * cur; if (i0 >= N) break;
        const int i1 = i0 + NGW; const bool two = n > 1 && i1 < N;
        const ConvSrc c0 = conv_item<STREAM>(A, F.ws, i0); f32x4 v0[8], v1[8];
        conv_load(c0, lane, v0);
        if (two) { const ConvSrc c1 = conv_item<STREAM>(A, F.ws, i1); conv_load(c1, lane, v1); conv_store(c0, lane, v0); conv_store(c1, lane, v1); cur += 2; n -= 2; }
        else { conv_store(c0, lane, v0); cur += 1; n -= 1; }
    }
}

__device__ __forceinline__ void p0a_mod_partials(Frame& F, const Args& A) {
    PHASE_IDS(F);
    const int gw = F.vcu * NWAVES + wave, NGW = F.G * NWAVES;
    LAS float* cond = (LAS float*)(F.lds + RING_OFF);
    for (int i = tid; i < NB_ * D_; i += 512) cond[i] = silu_f(A.in[1][i]);
    __syncthreads();
    float* MODP = (float*)(F.ws + WS_MODP);
    for (int u = gw; u < 1536; u += NGW) {
        const int j = u / 384, r = u % 384, nc = r / 16, kc = r % 16, layer = j >> 1;
        const float* W = ((j & 1) ? A.in[6] : A.in[3]) + (size_t)layer * 2048 * 6144 + (size_t)(kc * 128) * 6144 + nc * 256 + 4 * lane;
        f32x4 acc[4];
#pragma unroll
        for (int b = 0; b < 4; ++b) acc[b] = (f32x4){0.f, 0.f, 0.f, 0.f};
#pragma unroll 32
        for (int k = 0; k < 128; ++k) { const f32x4 w = *(const f32x4*)(W + (size_t)k * 6144);
#pragma unroll
            for (int b = 0; b < 4; ++b) acc[b] += cond[b * 2048 + kc * 128 + k] * w; }
#pragma unroll
        for (int b = 0; b < 4; ++b) *(f32x4*)(MODP + ((size_t)(kc * 16 + j * 4 + b)) * 6144 + nc * 256 + 4 * lane) = acc[b];
    }
    const int gt = F.vcu * 512 + tid, NGT = F.G * 512;
    { int cur = 0; conv_burst<0>(F, A, lane, gw, NGW, cur, 1 << 20); }
#if defined(CONV_IN_PROLOGUE)
    { int cur = 0; conv_burst<1>(F, A, lane, gw, NGW, cur, 1 << 20); }
    { int cur = 0; conv_burst<2>(F, A, lane, gw, NGW, cur, 1 << 20); }
#endif
    { const int* pos = (const int*)A.in[2]; f32x2* t64 = (f32x2*)(F.ws + WS_TAB64); f32x2* t256 = (f32x2*)(F.ws + WS_TAB256);
      for (int idx = gt; idx < T_ * 160; idx += NGT) { const int m = idx / 160, i = idx % 160; const double p = (double)pos[m];
          double fr; if (i < 32) fr = exp(-9.210340371976184 * (double)i / 32.0); else fr = exp(-9.210340371976184 * (double)(i - 32) / 128.0);
          double sn, cs; sincos(p * fr, &sn, &cs); const f32x2 v = {(float)cs, (float)sn};
          if (i < 32) t64[m * 32 + i] = v; else t256[m * 128 + (i - 32)] = v; } }
    { bf16* WS_ = (bf16*)(F.ws + WS_WRS);
      for (int idx = gt; idx < 2 * 2 * 128 * 64 * 8; idx += NGT) { const int j = idx & 7, ln = (idx >> 3) & 63, ks = (idx >> 9) & 127, cb = (idx >> 16) & 1, l = idx >> 17;
          const int k = 16 * ks + 8 * (ln >> 5) + j, c = 32 * cb + (ln & 31);
          const float w = c < 4 ? A.in[17][(size_t)l * 2048 * 4 + k * 4 + c] : (c < 36 ? A.in[19][(size_t)l * 2048 * 32 + k * 32 + (c - 4)] : 0.f);
          const unsigned hi = pk2(w, 0.f) & 0xffffu; const float wh = bf_lo(hi); const unsigned lo = pk2(w - wh, 0.f) & 0xffffu;
          const size_t o = (size_t)l * (2 * 2 * 128 * 512) + (size_t)(cb * 128 + ks) * 512 + ln * 8 + j;
          WS_[o] = (bf16)hi; WS_[o + 2 * 128 * 512] = (bf16)lo; } }
    { float* WR = (float*)(F.ws + WS_WR);
      for (int idx = gt; idx < 2 * 512 * 36 * 4; idx += NGT) { const int q = idx & 3, c = (idx >> 2) % 36, kq = ((idx >> 2) / 36) % 512, l = (idx >> 2) / (36 * 512); const int k = 4 * kq + q;
          WR[idx] = c < 4 ? A.in[17][(size_t)l * 2048 * 4 + k * 4 + c] : A.in[19][(size_t)l * 2048 * 32 + k * 32 + (c - 4)]; } }
}
__device__ __forceinline__ void p0_prologue(Frame& F, const Args& A) {
    PHASE_IDS(F);
    const int gw = F.vcu * NWAVES + wave, NGW = F.G * NWAVES;
    const int gt = F.vcu * 512 + tid, NGT = F.G * 512;
    { float* MOD = (float*)(F.ctl + CW_MOD); const float* MODP = (const float*)(F.ws + WS_MODP);
      for (int idx = gt; idx < 16 * 6144; idx += NGT) { const int j = idx / (4 * 6144), n = idx % 6144; float a = ((j & 1) ? A.in[7] : A.in[4])[(j >> 1) * 6144 + n];
#pragma unroll
          for (int kc = 0; kc < 16; ++kc) a += MODP[(size_t)kc * 16 * 6144 + idx];
          MOD[idx] = a; } }
}

__device__ __forceinline__ void local_mod(Frame& F, const float* bias, int j) {
    PHASE_IDS(F);
    const float* MODP = (const float*)(F.ws + WS_MODP); LAS f32x4* lm = (LAS f32x4*)(F.lds + RING_OFF);
    __syncthreads();
    for (int q = tid; q < 4096; q += 512) { const int b = q >> 10, n = 4 * (q & 1023); f32x4 a = *(const f32x4*)(bias + n);
#pragma unroll
        for (int kc = 0; kc < 16; ++kc) a += *(const f32x4*)(MODP + ((size_t)(kc * 16 + j * 4 + b)) * 6144 + n);
        lm[q] = a; }
    __syncthreads();
}
template <int MODE, bool LM = false> __device__ __forceinline__ void norm_phase(Frame& F, const float* src, float* xdst, const float* gvec, int jn, int jg, int layer_moe) {
    PHASE_IDS(F);
    const int gw = F.vcu * NWAVES + wave, NGW = F.G * NWAVES;
    const float* MOD = (const float*)(F.ctl + CW_MOD);
    bf16* H = (bf16*)(F.ws + WS_H);
    const bf16* Y = (const bf16*)(F.ws + WS_Y);
    const int* RT = (const int*)(F.ws + WS_ROUTE);
    v4u ra = {0u, 0u, 0u, 0u}, rb = {0u, 0u, 0u, 0u};
    if (MODE >= 2) { const int row_l = gw + NGW * lane; if (row_l < T_) { const v4u* rp = (const v4u*)(RT + (size_t)row_l * 8); ra = rp[0]; rb = rp[1]; } }
    for (int row = gw, ri = 0; row < T_; row += NGW, ++ri) {
        const int b = row >> 11;
        f32x4 v[8]; float ss = 0.f;
        const f32x4* xr = (const f32x4*)(src + (size_t)row * D_) + lane;
#pragma unroll
        for (int j = 0; j < 8; ++j) v[j] = xr[64 * j];
        if (MODE >= 2) {
            const int p0 = __shfl((int)rb.x, ri), p1 = __shfl((int)rb.y, ri); const float w0 = __int_as_float(__shfl((int)ra.z, ri)), w1 = __int_as_float(__shfl((int)ra.w, ri));
            const v2u* y0 = (const v2u*)(Y + (size_t)p0 * D_) + lane; const v2u* y1 = (const v2u*)(Y + (size_t)p1 * D_) + lane;
            const f32x4* gt = (const f32x4*)(MOD + (size_t)(jg * 4 + b) * 6144 + 4096) + lane;
#pragma unroll
            for (int j = 0; j < 8; ++j) { const v2u a = y0[64 * j], c = y1[64 * j]; const f32x4 g = gt[64 * j];
                f32x4 m; m.x = w0 * bf_lo(a.x) + w1 * bf_lo(c.x); m.y = w0 * bf_hi(a.x) + w1 * bf_hi(c.x); m.z = w0 * bf_lo(a.y) + w1 * bf_lo(c.y); m.w = w0 * bf_hi(a.y) + w1 * bf_hi(c.y);
                v[j] += g * m; }
            if (MODE == 2) { f32x4* xo = (f32x4*)(xdst + (size_t)row * D_) + lane;
#pragma unroll
                for (int j = 0; j < 8; ++j) xo[64 * j] = v[j]; }
        }
#pragma unroll
        for (int j = 0; j < 8; ++j) ss += (v[j].x * v[j].x + v[j].y * v[j].y) + (v[j].z * v[j].z + v[j].w * v[j].w);
        const float rstd = 1.0f / sqrtf(wave_sum(ss) * (1.0f / D_) + EPS_);
        const f32x4* gv = (const f32x4*)gvec + lane;
        if (MODE == 3) { f32x4* o = (f32x4*)(F.out + (size_t)row * D_) + lane;
#pragma unroll
            for (int j = 0; j < 8; ++j) o[64 * j] = v[j] * rstd * gv[64 * j];
        } else {
            v2u* o = (v2u*)(H + (size_t)row * D_) + lane;
            if (LM) { const LAS f32x4* sh = (const LAS f32x4*)(F.lds + RING_OFF) + b * 1024 + lane; const LAS f32x4* sc = sh + 512;
#pragma unroll
                for (int j = 0; j < 8; ++j) { const f32x4 h = v[j] * rstd * gv[64 * j] * (1.0f + sc[64 * j]) + sh[64 * j]; v2u w; w.x = pk2(h.x, h.y); w.y = pk2(h.z, h.w); o[64 * j] = w; }
            } else { const f32x4* sh = (const f32x4*)(MOD + (size_t)(jn * 4 + b) * 6144) + lane; const f32x4* sc = sh + 512;
#pragma unroll
                for (int j = 0; j < 8; ++j) { const f32x4 h = v[j] * rstd * gv[64 * j] * (1.0f + sc[64 * j]) + sh[64 * j]; v2u w; w.x = pk2(h.x, h.y); w.y = pk2(h.z, h.w); o[64 * j] = w; } }
        }
    }
}

__device__ __forceinline__ void router_phase(Frame& F, const Args& A, const float* X, const float* gvec, int jn, int layer, bool first) {
    const float* MOD = (const float*)(F.ctl + CW_MOD);
    const f32x4* WR4 = (const f32x4*)(F.ws + WS_WR) + (size_t)layer * 512 * 36;
    const bf16* WH = (const bf16*)(F.ws + WS_WRS) + (size_t)layer * (2 * 2 * 128 * 512); const bf16* WL = WH + 2 * 128 * 512;
    int* RT = (int*)(F.ws + WS_ROUTE); float* RS = (float*)(F.ws + WS_RS);
    LAS float* pp = (LAS float*)(F.lds + RING_OFF);
    LAS float* sq = (LAS float*)(F.lds + RING_OFF + 65536);
    LAS float* qq = (LAS float*)(F.lds + RING_OFF + 66560);
    LAS float* lg = (LAS float*)(F.lds + RING_OFF + 67712);
    LAS unsigned* hist = (LAS unsigned*)(F.lds + RING_OFF + 73728);
    PHASE_IDS(F);
    if (tid < 32) hist[tid] = 0u;
    __syncthreads();
#if defined(RT_PROBE)
    const unsigned long long rt_t0 = __builtin_amdgcn_s_memrealtime();
#endif
    const int r = lane & 31, hh = lane >> 5;
    for (int tile = F.vcu; tile < T_ / 32; tile += F.G) {
        const int row0 = tile * 32, b = row0 >> 11;
        const float* shp = MOD + (size_t)(jn * 4 + b) * 6144; const float* scp = shp + 2048;
        f32x16 acc[2];
#pragma unroll
        for (int cb = 0; cb < 2; ++cb)
#pragma unroll
            for (int i = 0; i < 16; ++i) acc[cb][i] = 0.f;
        float ss = 0.f;
        const float* xp = X + (size_t)(row0 + r) * D_ + 256 * wave + 8 * hh; const float* gp = gvec + 256 * wave + 8 * hh; const float* cp = scp + 256 * wave + 8 * hh;
        const bf16* whp = WH + (size_t)(16 * wave) * 512 + lane * 8; const bf16* wlp = WL + (size_t)(16 * wave) * 512 + lane * 8;
#pragma unroll 4
        for (int ks = 0; ks < 16; ++ks) {
            const f32x4 x0 = *(const f32x4*)(xp + 16 * ks), x1 = *(const f32x4*)(xp + 16 * ks + 4);
            const f32x4 g0 = *(const f32x4*)(gp + 16 * ks) * (1.0f + *(const f32x4*)(cp + 16 * ks)), g1 = *(const f32x4*)(gp + 16 * ks + 4) * (1.0f + *(const f32x4*)(cp + 16 * ks + 4));
            const v4u bh0 = *(const v4u*)(whp + 512 * ks), bh1 = *(const v4u*)(whp + 128 * 512 + 512 * ks), bl0 = *(const v4u*)(wlp + 512 * ks), bl1 = *(const v4u*)(wlp + 128 * 512 + 512 * ks);
            ss += (x0.x * x0.x + x0.y * x0.y) + (x0.z * x0.z + x0.w * x0.w) + (x1.x * x1.x + x1.y * x1.y) + (x1.z * x1.z + x1.w * x1.w);
            const f32x4 y0 = x0 * g0, y1 = x1 * g1;
            v4u ah, al; ah.x = pk2(y0.x, y0.y); ah.y = pk2(y0.z, y0.w); ah.z = pk2(y1.x, y1.y); ah.w = pk2(y1.z, y1.w);
            al.x = pk2(y0.x - bf_lo(ah.x), y0.y - bf_hi(ah.x)); al.y = pk2(y0.z - bf_lo(ah.y), y0.w - bf_hi(ah.y)); al.z = pk2(y1.x - bf_lo(ah.z), y1.y - bf_hi(ah.z)); al.w = pk2(y1.z - bf_lo(ah.w), y1.w - bf_hi(ah.w));
            const bf16x8 fah = __builtin_bit_cast(bf16x8, ah), fal = __builtin_bit_cast(bf16x8, al);
            acc[0] = __builtin_amdgcn_mfma_f32_32x32x16_bf16(fah, __builtin_bit_cast(bf16x8, bh0), acc[0], 0, 0, 0); acc[1] = __builtin_amdgcn_mfma_f32_32x32x16_bf16(fah, __builtin_bit_cast(bf16x8, bh1), acc[1], 0, 0, 0);
            acc[0] = __builtin_amdgcn_mfma_f32_32x32x16_bf16(fal, __builtin_bit_cast(bf16x8, bh0), acc[0], 0, 0, 0); acc[1] = __builtin_amdgcn_mfma_f32_32x32x16_bf16(fal, __builtin_bit_cast(bf16x8, bh1), acc[1], 0, 0, 0);
            acc[0] = __builtin_amdgcn_mfma_f32_32x32x16_bf16(fah, __builtin_bit_cast(bf16x8, bl0), acc[0], 0, 0, 0); acc[1] = __builtin_amdgcn_mfma_f32_32x32x16_bf16(fah, __builtin_bit_cast(bf16x8, bl1), acc[1], 0, 0, 0);
        }
#pragma unroll
        for (int cb = 0; cb < 2; ++cb)
#pragma unroll
            for (int i = 0; i < 16; ++i) pp[((wave * 2 + cb) * 16 + i) * 64 + lane] = acc[cb][i];
        ss += __shfl_xor(ss, 32);
        if (hh == 0) sq[wave * 32 + r] = ss;
#if defined(RT_PROBE) && RT_PROBE == 1
        { __syncthreads(); const unsigned long long t1_ = __builtin_amdgcn_s_memrealtime(); while (__builtin_amdgcn_s_memrealtime() - t1_ < t1_ - rt_t0) __builtin_amdgcn_s_sleep(8); }
#endif
        { float q[36]; const f32x4 s4 = *(const f32x4*)(shp + 4 * tid); const f32x4* w = WR4 + (size_t)tid * 36;
#pragma unroll
          for (int c = 0; c < 36; ++c) { const f32x4 w4 = w[c]; q[c] = (s4.x * w4.x + s4.y * w4.y) + (s4.z * w4.z + s4.w * w4.w); }
#pragma unroll
          for (int c = 0; c < 36; ++c) { float a = q[c];
#pragma unroll
              for (int o = 1; o < 64; o <<= 1) a += __shfl_xor(a, o);
              if (lane == 0) qq[wave * 36 + c] = a; } }
        __syncthreads();
#if defined(RT_PROBE) && RT_PROBE == 2
        { const unsigned long long t1_ = __builtin_amdgcn_s_memrealtime(); while (__builtin_amdgcn_s_memrealtime() - t1_ < t1_ - rt_t0) __builtin_amdgcn_s_sleep(8); }
#endif
        for (int e = tid; e < 32 * 36; e += 512) { const int row = e / 36, c = e % 36; const int cb = c >> 5, n = c & 31, h2 = (row >> 2) & 1, i = (row & 3) + 4 * (row >> 3); float a = 0.f;
#pragma unroll
            for (int w = 0; w < 8; ++w) a += pp[((w * 2 + cb) * 16 + i) * 64 + 32 * h2 + n];
            lg[e] = a; }
        if (tid < 36) { float a = 0.f;
#pragma unroll
            for (int w = 0; w < 8; ++w) a += qq[w * 36 + tid];
            lg[1152 + tid] = a; }
        if (tid >= 64 && tid < 96) { const int rr = tid - 64; float a = 0.f;
#pragma unroll
            for (int w = 0; w < 8; ++w) a += sq[w * 32 + rr];
            lg[1188 + rr] = 1.0f / sqrtf(a * (1.0f / D_) + EPS_); }
        __syncthreads();
        if (tid < 32) { const int row = row0 + tid; const LAS float* l = lg + tid * 36; const LAS float* q = lg + 1152; const float* bg = A.in[18] + layer * 4; const float* be = A.in[20] + layer * 32; const float rstd = lg[1188 + tid];
            if (first) RS[row] = rstd;
            float g[4]; int gi = 0; float gm;
#pragma unroll
            for (int i = 0; i < 4; ++i) g[i] = rstd * l[i] + q[i] + bg[i];
            gm = g[0];
#pragma unroll
            for (int i = 1; i < 4; ++i) if (g[i] > gm) { gm = g[i]; gi = i; }
            float gs = 0.f;
#pragma unroll
            for (int i = 0; i < 4; ++i) gs += __expf(g[i] - gm);
            const float gw = 1.0f / gs;
            float e[8];
#pragma unroll
            for (int i = 0; i < 8; ++i) e[i] = rstd * l[4 + 8 * gi + i] + q[4 + 8 * gi + i] + be[8 * gi + i];
            int i0 = 0; float m0 = e[0];
#pragma unroll
            for (int i = 1; i < 8; ++i) if (e[i] > m0) { m0 = e[i]; i0 = i; }
            int i1 = -1; float m1 = -3.0e38f;
#pragma unroll
            for (int i = 0; i < 8; ++i) if (i != i0 && e[i] > m1) { m1 = e[i]; i1 = i; }
            const float p1 = __expf(m1 - m0), w0 = gw / (1.0f + p1), w1 = gw * p1 / (1.0f + p1);
            const int e0 = 8 * gi + i0, e1 = 8 * gi + i1;
            int* rt = RT + (size_t)row * 8; rt[0] = e0; rt[1] = e1; rt[2] = __float_as_int(w0); rt[3] = __float_as_int(w1);
            if (first) { __hip_atomic_fetch_add(hist + e0, 1u, __ATOMIC_RELAXED, __HIP_MEMORY_SCOPE_WORKGROUP); __hip_atomic_fetch_add(hist + e1, 1u, __ATOMIC_RELAXED, __HIP_MEMORY_SCOPE_WORKGROUP); }
        }
        __syncthreads();
        if (first && tid < 32) { const unsigned n = hist[tid]; hist[tid] = 0u; if (n) atomicAdd((unsigned*)(F.ctl + ECNT_IDX(layer, tid)), n); }
        __syncthreads();
    }
}

__device__ __forceinline__ void scatter_phase(Frame& F, const float* X, const float* gvec, int jn, int layer, bool first) {
    LAS int* tab = (LAS int*)(F.lds + MOE_TAB_OFF);
    PHASE_IDS(F);
    const int gw = F.vcu * NWAVES + wave, NGW = F.G * NWAVES;
    const float* MOD = (const float*)(F.ctl + CW_MOD);
    int* RT = (int*)(F.ws + WS_ROUTE); const float* RS = (const float*)(F.ws + WS_RS); bf16* HG = (bf16*)(F.ws + WS_HG);
    int myp0 = 0, myp1 = 0;
    for (int i0 = 0; gw + NGW * i0 < T_; i0 += 4) {
        f32x4 xv[4][8];
#pragma unroll
        for (int i = 0; i < 4; ++i) { const int tok = gw + NGW * (i0 + i); if (tok < T_) { const f32x4* xr = (const f32x4*)(X + (size_t)tok * D_) + 2 * lane;
#pragma unroll
                for (int j = 0; j < 4; ++j) { xv[i][2 * j] = xr[128 * j]; xv[i][2 * j + 1] = xr[128 * j + 1]; } } }
        if (i0 == 0) {
        { const int tok_l = gw + NGW * lane;
          if (tok_l < T_) { int* rt = RT + (size_t)tok_l * 8;
              if (first) { const int e0 = rt[0], e1 = rt[1];
                  myp0 = tab[128 + e0] + (int)atomicAdd((unsigned*)(F.ctl + ECUR_IDX(layer, e0)), 1u);
                  myp1 = tab[128 + e1] + (int)atomicAdd((unsigned*)(F.ctl + ECUR_IDX(layer, e1)), 1u);
                  rt[4] = myp0; rt[5] = myp1; }
              else { myp0 = rt[4]; myp1 = rt[5]; } } }
        }
#pragma unroll
        for (int i = 0; i < 4; ++i) { const int tok = gw + NGW * (i0 + i); if (tok < T_) {
            const int p0 = __shfl(myp0, i0 + i), p1 = __shfl(myp1, i0 + i);
            const float rstd = RS[tok]; const int b = tok >> 11;
            const f32x4* sh = (const f32x4*)(MOD + (size_t)(jn * 4 + b) * 6144) + 2 * lane; const f32x4* sc = sh + 512; const f32x4* gv = (const f32x4*)gvec + 2 * lane;
            v4u* d0 = (v4u*)(HG + (size_t)p0 * D_) + lane; v4u* d1 = (v4u*)(HG + (size_t)p1 * D_) + lane;
#pragma unroll
            for (int j = 0; j < 4; ++j) {
                const f32x4 ha = xv[i][2 * j] * rstd * gv[128 * j] * (1.0f + sc[128 * j]) + sh[128 * j], hb = xv[i][2 * j + 1] * rstd * gv[128 * j + 1] * (1.0f + sc[128 * j + 1]) + sh[128 * j + 1];
                v4u w; w.x = pk2(ha.x, ha.y); w.y = pk2(ha.z, ha.w); w.z = pk2(hb.x, hb.y); w.w = pk2(hb.z, hb.w); d0[64 * j] = w; d1[64 * j] = w; } } }
    }
#if defined(WARM_MOE)
    if (first) { const v4u* w = (const v4u*)(F.ws + WS_W_GU + (size_t)layer * 128 * MiB) + (size_t)gw * 4096 + lane; v4u acc = {0u, 0u, 0u, 0u};
#pragma unroll 16
        for (int i = 0; i < 64; ++i) { const v4u x = w[64 * i]; acc.x ^= x.x; acc.y ^= x.y; acc.z ^= x.z; acc.w ^= x.w; }
        asm volatile("" :: "v"(acc.x), "v"(acc.y), "v"(acc.z), "v"(acc.w)); }
#endif
}

__device__ __forceinline__ void retnorm_phase(Frame& F) {
    PHASE_IDS(F);
    const int gw = F.vcu * NWAVES + wave, NGW = F.G * NWAVES;
    const bf16* O = (const bf16*)(F.ws + WS_RETO); const bf16* P1 = (const bf16*)(F.ws + WS_PROJ1); bf16* A5 = (bf16*)(F.ws + WS_A5);
    for (int row = gw; row < T_; row += NGW) {
        const v4u* o = (const v4u*)(O + (size_t)row * 4096) + lane; const v4u* g = (const v4u*)(P1 + (size_t)row * 12288 + 8192) + lane; v4u* a = (v4u*)(A5 + (size_t)row * 4096) + lane;
#pragma unroll
        for (int h = 0; h < 8; ++h) { const v4u x = o[64 * h], s = g[64 * h];
            float f[8] = {bf_lo(x.x), bf_hi(x.x), bf_lo(x.y), bf_hi(x.y), bf_lo(x.z), bf_hi(x.z), bf_lo(x.w), bf_hi(x.w)};
            float ss = 0.f;
#pragma unroll
            for (int i = 0; i < 8; ++i) ss += f[i] * f[i];
            const float rstd = 1.0f / sqrtf(wave_sum(ss) * (1.0f / 512.0f) + EPS_);
            v4u w; w.x = pk2(f[0] * rstd * bf_lo(s.x), f[1] * rstd * bf_hi(s.x)); w.y = pk2(f[2] * rstd * bf_lo(s.y), f[3] * rstd * bf_hi(s.y));
            w.z = pk2(f[4] * rstd * bf_lo(s.z), f[5] * rstd * bf_hi(s.z)); w.w = pk2(f[6] * rstd * bf_lo(s.w), f[7] * rstd * bf_hi(s.w));
            a[64 * h] = w; }
    }
}
#ifndef ATT_REP
#define ATT_REP 1
#endif
#ifndef RET_REP
#define RET_REP 1
#endif
#ifndef ATT_KPF
#define ATT_KPF 4
#endif
constexpr int ATT_VST = 320;
__device__ __forceinline__ s16x4 vtr(const LAS unsigned char* p) { return __builtin_bit_cast(s16x4, __builtin_amdgcn_ds_read_tr16_b64_v4i16((LAS v4i16_t*)p)); }
__device__ __forceinline__ float xhalf(float v) { return __shfl_xor(v, 32); }

template <int DQK, int MODE>
__device__ __forceinline__ void attn_unit(LAS unsigned char* lds, const bf16* Qp, int qpitch, const bf16* Kp, int kpitch, const bf16* K2p, int k2pitch,
                                          const bf16* Vp, int vpitch, bf16* Op, int opitch, int q0, float dlog2, int tid_, int wave, int lane_, volatile LAS unsigned* flg) {
    const int lane = lane_id_opaque(), tid = wave * 64 + lane; (void)tid_; (void)lane_;
    constexpr int RB = DQK * 2, SW = (DQK == 192) ? 7 : 15, KB = 64 * RB, STG = KB + 16384;
    constexpr int NIK = KB / 8192, NI = NIK + 2;
    constexpr int NKS = DQK / 16;
    static_assert(3 * STG <= RING_BYTES, "three stages in the ring");
    const int r = lane & 31, h = lane >> 5, qrow = q0 + 32 * wave + r;
    bf16x8 qf[NKS];
    { const bf16* qp = Qp + (size_t)qrow * qpitch + 8 * h;
#pragma unroll
      for (int ks = 0; ks < NKS; ++ks) qf[ks] = *(const bf16x8*)(qp + 16 * ks); }
    f32x16 o[4];
#pragma unroll
    for (int db = 0; db < 4; ++db)
#pragma unroll
        for (int i = 0; i < 16; ++i) o[db][i] = 0.f;
    float m_run = -1.0e30f, l_run = 0.f, carry = 0.f;
    const int ntiles = (q0 + 256) >> 6;
    constexpr bool KLIN = (DQK != 192); constexpr int NKG = KLIN ? 1 : NIK;
    unsigned kgo[NKG], vgo0; bool krope[NKG];
#pragma unroll
    for (int j = 0; j < NKG; ++j) { const int pos = (j * 8 + wave) * 1024 + lane * 16, row = pos / RB, c = ((pos % RB) >> 4) ^ (row & SW);
        krope[j] = (DQK == 192) && c >= 16;
        kgo[j] = krope[j] ? (unsigned)(row * k2pitch * 2 + (c - 16) * 16) : (unsigned)(row * kpitch * 2 + c * 16); }
    { const int pos = wave * 1024 + lane * 16, row = pos >> 8, ch = ((pos & 255) >> 4) ^ (((row & 3) << 2) | ((row >> 2) & 3)); vgo0 = (unsigned)(row * vpitch * 2 + ch * 16); }
#define ATT_DMA(kt, stg) do { const size_t key0_ = (size_t)(kt) * 64; \
        const char* kb_ = (const char*)Kp + key0_ * kpitch * 2; const char* k2_ = (const char*)K2p + key0_ * k2pitch * 2; const char* vb_ = (const char*)Vp + key0_ * vpitch * 2; \
        LAS unsigned char* st_ = lds + (stg) * STG + wave * 1024; \
        _Pragma("unroll") for (int j_ = 0; j_ < NIK; ++j_) { const char* g_ = KLIN ? kb_ + kgo[0] + (size_t)j_ * (8192 / RB) * kpitch * 2 : ((krope[KLIN ? 0 : j_] ? k2_ : kb_) + kgo[KLIN ? 0 : j_]); \
            __builtin_amdgcn_global_load_lds((const unsigned*)g_, (LAS unsigned*)(st_ + j_ * 8192), 16, 0, 0); } \
        _Pragma("unroll") for (int j_ = 0; j_ < 2; ++j_) __builtin_amdgcn_global_load_lds((const unsigned*)(vb_ + vgo0 + (size_t)j_ * 32 * vpitch * 2), (LAS unsigned*)(st_ + KB + j_ * 8192), 16, 0, 0); } while (0)
    if (MODE == 1 && tid < 16) flg[tid] = 0u;
    ATT_DMA(ntiles - 1, 0);
    ATT_DMA(ntiles > 1 ? ntiles - 2 : 0, 1);
    const int q4 = (lane & 15) >> 2, p4 = lane & 3, blk = (lane >> 4) & 1, x4 = 2 * blk + (p4 >> 1);
    constexpr int NKO = (SW + 1) / 2;
    const int krow = r * RB, kxy = (r & SW) ^ h;
    const int vlo_off = 256 * (4 * h + q4) + 16 * (x4 ^ h) + 8 * (p4 & 1), vhi_off = 256 * (4 * h + q4 + 8) + 16 * (x4 ^ (h + 2)) + 8 * (p4 & 1);
    for (int it = 0; it < ntiles; ++it) {
        const int kt = ntiles - 1 - it;
        int y_ = kxy, q4_ = q4; asm volatile("" : "+v"(y_), "+v"(q4_));
        const bool wdone = (MODE == 1) && __all(carry < -140.0f);
        if (MODE == 1 && lane == 0) flg[8 * (it & 1) + wave] = wdone ? 1u : 0u;
        asm volatile("s_waitcnt vmcnt(%0)" :: "n"(NI) : "memory");
        asm volatile("s_waitcnt lgkmcnt(0)" ::: "memory");
        __builtin_amdgcn_s_barrier();
        asm volatile("" ::: "memory");
        if (MODE == 1) { v4u fa, fb; const unsigned fad = (unsigned)(size_t)(flg + 8 * (it & 1));
            asm volatile("ds_read_b128 %0, %2\n\tds_read_b128 %1, %2 offset:16\n\ts_waitcnt lgkmcnt(0)" : "=&v"(fa), "=&v"(fb) : "v"(fad) : "memory");
            if ((fa.x & fa.y & fa.z & fa.w & fb.x & fb.y & fb.z & fb.w) != 0u) break; }
        { const int ktn = kt >= 2 ? kt - 2 : 0; ATT_DMA(ktn, (it + 2) % 3); }
        if (!wdone && 64 * kt <= q0 + 32 * wave + 31) {
            const LAS unsigned char* Kb = lds + (it % 3) * STG; const LAS unsigned char* Vb = Kb + KB;
            f32x16 s[2];
            const int kbase = 64 * kt + 4 * h;
            const bool diag = 64 * kt + 63 > q0 + 32 * wave;
            unsigned va[8];
#pragma unroll
            for (int db = 0; db < 4; ++db) { va[db] = (unsigned)(size_t)(Vb + vlo_off + 64 * (db ^ q4_)); va[4 + db] = (unsigned)(size_t)(Vb + vhi_off + 64 * (db ^ q4_)); }
            s16x4 lo_[2][4], hi_[2][4];
#define ATT_VRD(buf, sidx) do { _Pragma("unroll") for (int db = 0; db < 4; ++db) { \
                    asm volatile("ds_read_b64_tr_b16 %0, %1 offset:%c2" : "=&v"(lo_[buf][db]) : "v"(va[db]), "i"(4096 * (sidx)) : "memory"); \
                    asm volatile("ds_read_b64_tr_b16 %0, %1 offset:%c2" : "=&v"(hi_[buf][db]) : "v"(va[4 + db]), "i"(4096 * (sidx)) : "memory"); } } while (0)
#define ATT_VMM(buf, sidx) do { const int kb_ = (sidx) >> 1, ss_ = (sidx) & 1; \
                v4u pw; pw.x = pk2(s[kb_][8 * ss_ + 0], s[kb_][8 * ss_ + 1]); pw.y = pk2(s[kb_][8 * ss_ + 2], s[kb_][8 * ss_ + 3]); pw.z = pk2(s[kb_][8 * ss_ + 4], s[kb_][8 * ss_ + 5]); pw.w = pk2(s[kb_][8 * ss_ + 6], s[kb_][8 * ss_ + 7]); \
                const bf16x8 pf = __builtin_bit_cast(bf16x8, pw); \
                _Pragma("unroll") for (int db = 0; db < 4; ++db) { \
                    const bf16x8 vf = __builtin_shufflevector(lo_[buf][db], hi_[buf][db], 0, 1, 2, 3, 4, 5, 6, 7); \
                    o[db] = __builtin_amdgcn_mfma_f32_32x32x16_bf16(vf, pf, o[db], 0, 0, 0); } } while (0)
#define ATT_PVN(first, count) do { ATT_VRD(0, first); \
                _Pragma("unroll") for (int i_ = 0; i_ < (count); ++i_) { \
                    if (i_ + 1 < (count)) { if (i_ & 1) ATT_VRD(0, (first) + i_ + 1); else ATT_VRD(1, (first) + i_ + 1); asm volatile("s_waitcnt lgkmcnt(8)" ::: "memory"); } \
                    else asm volatile("s_waitcnt lgkmcnt(0)" ::: "memory"); \
                    __builtin_amdgcn_sched_barrier(0); \
                    if (i_ & 1) ATT_VMM(1, (first) + i_); else ATT_VMM(0, (first) + i_); \
                    __builtin_amdgcn_sched_barrier(0); } } while (0)
#pragma unroll
            for (int kb = 0; kb < 2; ++kb) {
#pragma unroll
                for (int i = 0; i < 16; ++i) s[kb][i] = 0.f;
                const LAS unsigned char* kp = Kb + 32 * kb * RB;
#define ATT_KF(ks) (*(const LAS bf16x8*)(kp + krow + (((2 * ((ks) % NKO)) ^ y_) << 4) + (((2 * (ks)) & ~SW) << 4)))
                bf16x8 fa = ATT_KF(0), fb = ATT_KF(1);
#pragma unroll
                for (int g2 = 0; g2 < NKS / 2; ++g2) {
                    bf16x8 na = fa, nb = fb;
                    if (g2 + 1 < NKS / 2) { na = ATT_KF(2 * g2 + 2); nb = ATT_KF(2 * g2 + 3); }
                    __builtin_amdgcn_sched_barrier(0);
                    s[kb] = __builtin_amdgcn_mfma_f32_32x32x16_bf16(fa, qf[2 * g2], s[kb], 0, 0, 0); s[kb] = __builtin_amdgcn_mfma_f32_32x32x16_bf16(fb, qf[2 * g2 + 1], s[kb], 0, 0, 0);
                    __builtin_amdgcn_sched_barrier(0);
                    fa = na; fb = nb;
                }
#undef ATT_KF
                if (MODE == 2) {
                    if (diag) {
#pragma unroll
                        for (int i = 0; i < 16; ++i) { const int key = kbase + 32 * kb + (i & 3) + 8 * (i >> 2); s[kb][i] = key <= qrow ? s[kb][i] : 0.f; } }
                    ATT_PVN(2 * kb, 2);
                }
            }
            if (MODE == 0) {
                float tmax = -1.0e30f;
#pragma unroll
                for (int kb = 0; kb < 2; ++kb)
#pragma unroll
                    for (int i = 0; i < 16; ++i) { const int key = kbase + 32 * kb + (i & 3) + 8 * (i >> 2); const float v = (!diag || key <= qrow) ? s[kb][i] : -1.0e30f; s[kb][i] = v; tmax = fmaxf(tmax, v); }
                tmax = fmaxf(tmax, xhalf(tmax));
                const float m_new = fmaxf(m_run, tmax), alpha = ex2(m_run - m_new); m_run = m_new;
                float ps = 0.f;
#pragma unroll
                for (int kb = 0; kb < 2; ++kb)
#pragma unroll
                    for (int i = 0; i < 16; ++i) { const float p = ex2(s[kb][i] - m_new); s[kb][i] = p; ps += p; }
                l_run = l_run * alpha + ps;
#pragma unroll
                for (int db = 0; db < 4; ++db)
#pragma unroll
                    for (int i = 0; i < 16; ++i) o[db][i] *= alpha;
            } else if (MODE == 1) {
                float lkv[2][16], gs[2][4], go[2][4];
#pragma unroll
                for (int kb = 0; kb < 2; ++kb)
#pragma unroll
                    for (int g = 0; g < 4; ++g) { float t = 0.f;
#pragma unroll
                        for (int j = 0; j < 4; ++j) { const int i = 4 * g + j, key = kbase + 32 * kb + 8 * g + j; const float z = s[kb][i];
                            const bool vis = key < qrow;
                            const float lk = vis ? -(fmaxf(z, 0.f) + lg2(1.0f + ex2(-fabsf(z)))) : 0.f;
                            lkv[kb][i] = lk; s[kb][i] = vis ? z + lk : -1.0e30f; t += lk; }
                        gs[kb][g] = t; }
#pragma unroll
                for (int kb = 0; kb < 2; ++kb)
#pragma unroll
                    for (int g = 0; g < 4; ++g) go[kb][g] = xhalf(gs[kb][g]);
                float R = carry;
#pragma unroll
                for (int kb = 1; kb >= 0; --kb)
#pragma unroll
                    for (int g = 3; g >= 0; --g) {
                        float run = R + (h == 0 ? go[kb][g] : 0.f);
#pragma unroll
                        for (int j = 3; j >= 0; --j) { const int i = 4 * g + j; const float a = ex2(s[kb][i] + run); run += lkv[kb][i]; s[kb][i] = a; }
                        R += gs[kb][g] + go[kb][g];
                    }
                carry = R;
            }
            if (MODE != 2) { ATT_PVN(0, 4); }
#undef ATT_PVN
#undef ATT_VMM
#undef ATT_VRD
        }
    }
#undef ATT_DMA
    asm volatile("s_waitcnt vmcnt(0) lgkmcnt(0)" ::: "memory");
    __builtin_amdgcn_s_barrier();
    asm volatile("" ::: "memory");
    float inv = 1.0f;
    if (MODE == 0) { const float lt = l_run + xhalf(l_run); inv = 1.0f / lt; }
    bf16* op = Op + (size_t)qrow * opitch + 4 * h;
#pragma unroll
    for (int db = 0; db < 4; ++db)
#pragma unroll
        for (int g = 0; g < 4; ++g) { v2u w; w.x = pk2(o[db][4 * g] * inv, o[db][4 * g + 1] * inv); w.y = pk2(o[db][4 * g + 2] * inv, o[db][4 * g + 3] * inv); *(v2u*)(op + 32 * db + 8 * g) = w; }
}

struct WorkQ { gu32* q; int total; int slot; unsigned nxt; };
__device__ __forceinline__ void wq_init(Frame& F, WorkQ& Q, gu32* q, int total, int slot, int lane) {
    Q.q = q; Q.total = total; Q.slot = slot; Q.nxt = 0u;
    if (F.wave == 0 && lane == 0) Q.nxt = __hip_atomic_fetch_add(q, 1u, RLX_AGENT);
}
__device__ __forceinline__ bool wq_take(Frame& F, WorkQ& Q, int lane, int& u) {
    if (F.wave == 0 && lane == 0) F.MISC[Q.slot] = Q.nxt;
    __syncthreads();
    u = (int)F.MISC[Q.slot];
    __syncthreads();
    if (u >= Q.total) return false;
    if (F.wave == 0 && lane == 0) Q.nxt = __hip_atomic_fetch_add(Q.q, 1u, RLX_AGENT);
    return true;
}
template <int STREAM> __device__ __forceinline__ bool conv_batch(Frame& F, const Args& A, WorkQ& Q, int lane, int wave) {
#if defined(CONV_IN_PROLOGUE)
    return false;
#endif
    int b; if (!wq_take(F, Q, lane, b)) return false;
    const int i0 = 128 * b + 16 * wave;
    f32x4 va0[8], va1[8], vb0[8], vb1[8];
    { const ConvSrc c0 = conv_item<STREAM>(A, F.ws, i0), c1 = conv_item<STREAM>(A, F.ws, i0 + 1); conv_load(c0, lane, va0); conv_load(c1, lane, va1); }
#pragma unroll
    for (int p = 0; p < 8; ++p) {
        const ConvSrc c0 = conv_item<STREAM>(A, F.ws, i0 + 2 * p), c1 = conv_item<STREAM>(A, F.ws, i0 + 2 * p + 1);
        if (p + 1 < 8) { const ConvSrc n0 = conv_item<STREAM>(A, F.ws, i0 + 2 * p + 2), n1 = conv_item<STREAM>(A, F.ws, i0 + 2 * p + 3);
            if (p & 1) { conv_load(n0, lane, va0); conv_load(n1, lane, va1); } else { conv_load(n0, lane, vb0); conv_load(n1, lane, vb1); } }
        if (p & 1) { conv_store(c0, lane, vb0); conv_store(c1, lane, vb1); } else { conv_store(c0, lane, va0); conv_store(c1, lane, va1); }
    }
    return true;
}
__device__ __forceinline__ void mla_phase(Frame& F, const Args& A, WorkQ& QC, bool& conv_left) {
    PHASE_IDS(F);
    WorkQ QU; wq_init(F, QU, F.ctl + CW_QMLA, 256, 16, lane);
    if (F.vcu & 1) { for (int i = 0; i < 2 && conv_left; ++i) conv_left = conv_batch<1>(F, A, QC, lane, wave); }
    const bf16* Q = (const bf16*)(F.ws + WS_QMLA); const bf16* KV = (const bf16*)(F.ws + WS_KVMLA); const bf16* KR = (const bf16*)(F.ws + WS_KR); bf16* O = (bf16*)(F.ws + WS_ATTO);
    int u;
    while (wq_take(F, QU, lane, u)) {
        const int qb = 7 - (u >> 5), bh = u & 31, b = bh >> 3, h = bh & 7; const size_t r0 = (size_t)b * S_;
#pragma unroll 1
        for (int rep_ = 0; rep_ < ATT_REP; ++rep_)
        attn_unit<192, 0>(F.lds + RING_OFF, Q + r0 * 1536 + h * 192, 1536, KV + r0 * 2048 + h * 256, 2048, KR + r0 * 64, 64, KV + r0 * 2048 + h * 256 + 128, 2048,
                          O + r0 * 2048 + 1024 + h * 128, 2048, qb * 256, 0.f, tid, wave, lane, F.MISC + 32);
        if (conv_left) conv_left = conv_batch<1>(F, A, QC, lane, wave);
    }
}
__device__ __forceinline__ void sb_phase(Frame& F, const Args& A, WorkQ& QC, bool& conv_left) {
    PHASE_IDS(F);
    WorkQ QU; wq_init(F, QU, F.ctl + CW_QSB, 256, 17, lane);
    const bf16* P0 = (const bf16*)(F.ws + WS_PROJ0); bf16* O = (bf16*)(F.ws + WS_ATTO);
    int u;
    while (wq_take(F, QU, lane, u)) {
        const int qb = 7 - (u >> 5), bh = u & 31, b = bh >> 3, h = bh & 7; const size_t r0 = (size_t)b * S_;
#pragma unroll 1
        for (int rep_ = 0; rep_ < ATT_REP; ++rep_)
        attn_unit<128, 1>(F.lds + RING_OFF, P0 + r0 * 4096 + h * 128, 4096, P0 + r0 * 4096 + 1024 + h * 128, 4096, nullptr, 0, P0 + r0 * 4096 + 2048 + h * 128, 4096,
                          O + r0 * 2048 + h * 128, 2048, qb * 256, 0.f, tid, wave, lane, F.MISC + 32);
        if (conv_left) conv_left = conv_batch<1>(F, A, QC, lane, wave);
    }
    while (conv_left) conv_left = conv_batch<1>(F, A, QC, lane, wave);
}
__device__ __forceinline__ void ret_phase(Frame& F, const Args& A) {
    PHASE_IDS(F);
    WorkQ QC; wq_init(F, QC, F.ctl + CW_QC2, CONV_N2 / 128, 18, lane); bool conv_left = true;
    WorkQ QU; wq_init(F, QU, F.ctl + CW_QRET, 1024, 16, lane);
    if (F.vcu & 1) conv_left = conv_batch<2>(F, A, QC, lane, wave);
    const bf16* P1 = (const bf16*)(F.ws + WS_PROJ1); bf16* O = (bf16*)(F.ws + WS_RETO);
    int u;
    while (wq_take(F, QU, lane, u)) {
        const int qb = 7 - (u >> 7), rem = u & 127, eq = rem >> 5, bh = rem & 31, b = bh >> 3, h = bh & 7; const size_t r0 = (size_t)b * S_;
        const float dlog2 = log1pf(-exp2f(-5.0f - (float)h)) * LOG2E;
#pragma unroll 1
        for (int rep_ = 0; rep_ < RET_REP; ++rep_)
        attn_unit<256, 2>(F.lds + RING_OFF, P1 + r0 * 12288 + h * 256, 12288, P1 + r0 * 12288 + 2048 + h * 256, 12288, nullptr, 0, P1 + r0 * 12288 + 4096 + h * 512 + eq * 128, 12288,
                          O + r0 * 4096 + h * 512 + eq * 128, 4096, qb * 256, dlog2, tid, wave, lane, F.MISC + 32);
        if (conv_left && (u & 1)) conv_left = conv_batch<2>(F, A, QC, lane, wave);
    }
    while (conv_left) conv_left = conv_batch<2>(F, A, QC, lane, wave);
}
typedef f32x4 AccT[2][2][4][2];
__device__ __forceinline__ v4u pack8(const f32x4& a, const f32x4& b) { v4u w; w.x = pk2(a.x, a.y); w.y = pk2(a.z, a.w); w.z = pk2(b.x, b.y); w.w = pk2(b.z, b.w); return w; }
__device__ __forceinline__ float sq4(const f32x4& a) { return (a.x * a.x + a.y * a.y) + (a.z * a.z + a.w * a.w); }
__device__ __forceinline__ void rope4(const f32x4& x1, const f32x4& x2, const f32x2* cs, f32x4& o1, f32x4& o2) {
    const f32x4 c01 = *(const f32x4*)cs, c23 = *(const f32x4*)(cs + 2);
    o1.x = x1.x * c01.x - x2.x * c01.y; o2.x = x1.x * c01.y + x2.x * c01.x;
    o1.y = x1.y * c01.z - x2.y * c01.w; o2.y = x1.y * c01.w + x2.y * c01.z;
    o1.z = x1.z * c23.x - x2.z * c23.y; o2.z = x1.z * c23.y + x2.z * c23.x;
    o1.w = x1.w * c23.z - x2.w * c23.w; o2.w = x1.w * c23.w + x2.w * c23.z;
}
struct EpiG1 { static constexpr bool PERM = true, AFTER_DRAIN = false;
    bf16* P0; bf16* KR; float* ssqp; const f32x2* cs64;
    __device__ __forceinline__ void operator()(const AccT& acc, const pg8::Unit& u, int wr, int wc, int fr, int fq) const {
        const int row0 = u.pm * 256 + wr * 64 + fr, tc = wc * 32 + 8 * fq;
        if (u.pn < 15) {
            const float scl = u.pn < 4 ? C_SB : 1.0f;
#pragma unroll
            for (int ai = 0; ai < 2; ++ai)
#pragma unroll
                for (int m = 0; m < 4; ++m) { const int row = row0 + ai * 128 + m * 16; float ss = 0.f;
#pragma unroll
                    for (int bj = 0; bj < 2; ++bj) { const f32x4 v0 = acc[ai][bj][m][0], v1 = acc[ai][bj][m][1]; ss += sq4(v0) + sq4(v1);
                        *(v4u*)(P0 + (size_t)row * 4096 + u.pn * 256 + bj * 128 + tc) = pack8(v0 * scl, v1 * scl); }
                    if (u.pn >= 12) { ss += __shfl_xor(ss, 16); ss += __shfl_xor(ss, 32); if (fq == 0) { if (u.pn < 14) ssqp[(size_t)row * 8 + 4 * (u.pn - 12) + wc] = ss; else ssqp[(size_t)T_ * 8 + (size_t)row * 4 + wc] = ss; } } }
        } else if (wc == 0) {
#pragma unroll
            for (int ai = 0; ai < 2; ++ai)
#pragma unroll
                for (int m = 0; m < 4; ++m) { const int row = row0 + ai * 128 + m * 16; f32x4 a0, b0, a1, b1;
                    rope4(acc[ai][0][m][0], acc[ai][1][m][0], cs64 + (size_t)row * 32 + 8 * fq, a0, b0);
                    rope4(acc[ai][0][m][1], acc[ai][1][m][1], cs64 + (size_t)row * 32 + 8 * fq + 4, a1, b1);
                    *(v4u*)(KR + (size_t)row * 64 + 8 * fq) = pack8(a0, a1); *(v4u*)(KR + (size_t)row * 64 + 32 + 8 * fq) = pack8(b0, b1); asm volatile("" ::: "memory"); }
        }
    }
};
struct EpiG2q { static constexpr bool PERM = true, AFTER_DRAIN = false;
    bf16* Q; const float* ssq; const f32x2* cs64;
    __device__ __forceinline__ void operator()(const AccT& acc, const pg8::Unit& u, int wr, int wc, int fr, int fq) const {
        const int row0 = u.pm * 256 + wr * 64 + fr, tc = wc * 32 + 8 * fq;
        if (u.pn < 4) {
#pragma unroll
            for (int ai = 0; ai < 2; ++ai)
#pragma unroll
                for (int m = 0; m < 4; ++m) { const int row = row0 + ai * 128 + m * 16; const f32x4 pa = *(const f32x4*)(ssq + (size_t)row * 8), pb = *(const f32x4*)(ssq + (size_t)row * 8 + 4); const float rs = C_MLA * __builtin_amdgcn_rsqf(((((((pa.x + pa.y) + pa.z) + pa.w) + pb.x) + pb.y) + pb.z + pb.w) * (1.0f / 512.0f) + EPS_);
#pragma unroll
                    for (int bj = 0; bj < 2; ++bj) { const int nidx = u.pn * 256 + bj * 128 + tc, hh = nidx >> 7, d = nidx & 127;
                        *(v4u*)(Q + (size_t)row * 1536 + hh * 192 + d) = pack8(acc[ai][bj][m][0] * rs, acc[ai][bj][m][1] * rs); }
                    asm volatile("" ::: "memory"); }
        } else {
            const int head = 4 * (u.pn - 4) + wc;
#pragma unroll
            for (int ai = 0; ai < 2; ++ai)
#pragma unroll
                for (int m = 0; m < 4; ++m) { const int row = row0 + ai * 128 + m * 16; const f32x4 pa = *(const f32x4*)(ssq + (size_t)row * 8), pb = *(const f32x4*)(ssq + (size_t)row * 8 + 4); const float rs = C_MLA * __builtin_amdgcn_rsqf(((((((pa.x + pa.y) + pa.z) + pa.w) + pb.x) + pb.y) + pb.z + pb.w) * (1.0f / 512.0f) + EPS_); f32x4 a0, b0, a1, b1;
                    rope4(acc[ai][0][m][0] * rs, acc[ai][1][m][0] * rs, cs64 + (size_t)row * 32 + 8 * fq, a0, b0);
                    rope4(acc[ai][0][m][1] * rs, acc[ai][1][m][1] * rs, cs64 + (size_t)row * 32 + 8 * fq + 4, a1, b1);
                    *(v4u*)(Q + (size_t)row * 1536 + head * 192 + 128 + 8 * fq) = pack8(a0, a1); *(v4u*)(Q + (size_t)row * 1536 + head * 192 + 160 + 8 * fq) = pack8(b0, b1);
                    asm volatile("" ::: "memory"); }
        }
    }
};
struct EpiG2kv { static constexpr bool PERM = true, AFTER_DRAIN = false;
    bf16* KV; const float* ssq;
    __device__ __forceinline__ void operator()(const AccT& acc, const pg8::Unit& u, int wr, int wc, int fr, int fq) const {
        const int row0 = u.pm * 256 + wr * 64 + fr, tc = wc * 32 + 8 * fq;
#pragma unroll
        for (int ai = 0; ai < 2; ++ai)
#pragma unroll
            for (int m = 0; m < 4; ++m) { const int row = row0 + ai * 128 + m * 16; const f32x4 pa = *(const f32x4*)(ssq + (size_t)row * 4); const float rs = __builtin_amdgcn_rsqf((((pa.x + pa.y) + pa.z) + pa.w) * (1.0f / 256.0f) + EPS_);
#pragma unroll
                for (int bj = 0; bj < 2; ++bj) *(v4u*)(KV + (size_t)row * 2048 + u.pn * 256 + bj * 128 + tc) = pack8(acc[ai][bj][m][0] * rs, acc[ai][bj][m][1] * rs); asm volatile("" ::: "memory"); }
    }
};
struct EpiRes { static constexpr bool PERM = false, AFTER_DRAIN = false;
    const float* src; float* dst; const float* gate;
    __device__ __forceinline__ void operator()(const AccT& acc, const pg8::Unit& u, int wr, int wc, int fr, int fq) const {
        const int row0 = u.pm * 256 + wr * 64 + fr, col0 = u.pn * 256 + wc * 32 + 4 * fq;
#pragma unroll
        for (int ai = 0; ai < 2; ++ai)
#pragma unroll
            for (int m = 0; m < 4; ++m) { const int row = row0 + ai * 128 + m * 16; const float* g = gate + (size_t)(row >> 11) * 6144 + col0; const size_t off = (size_t)row * 2048 + col0;
#pragma unroll
                for (int bj = 0; bj < 2; ++bj)
#pragma unroll
                    for (int n = 0; n < 2; ++n) { const int o = bj * 128 + n * 16; *(f32x4*)(dst + off + o) = *(const f32x4*)(src + off + o) + *(const f32x4*)(g + o) * acc[ai][bj][m][n]; } asm volatile("" ::: "memory"); }
    }
};
struct EpiG4 { static constexpr bool PERM = true, AFTER_DRAIN = false;
    bf16* P1; const f32x2* cs256;
    __device__ __forceinline__ void operator()(const AccT& acc, const pg8::Unit& u, int wr, int wc, int fr, int fq) const {
        const int row0 = u.pm * 256 + wr * 64 + fr, tc = wc * 32 + 8 * fq;
#pragma unroll
        for (int ai = 0; ai < 2; ++ai)
#pragma unroll
            for (int m = 0; m < 4; ++m) { const int row = row0 + ai * 128 + m * 16; bf16* dst = P1 + (size_t)row * 12288 + u.pn * 256 + tc;
                if (u.pn < 16) {
                    const float dl2 = log1pf(-exp2f(-5.0f - (float)(u.pn & 7))) * LOG2E, rel = (float)((row & 2047) - 1024);
                    const float scl = u.pn >= 8 ? 0.0625f * ex2(-dl2 * rel) : ex2(dl2 * rel); f32x4 a0, b0, a1, b1;
                    rope4(acc[ai][0][m][0] * scl, acc[ai][1][m][0] * scl, cs256 + (size_t)row * 128 + tc, a0, b0);
                    rope4(acc[ai][0][m][1] * scl, acc[ai][1][m][1] * scl, cs256 + (size_t)row * 128 + tc + 4, a1, b1);
                    *(v4u*)dst = pack8(a0, a1); *(v4u*)(dst + 128) = pack8(b0, b1);
                } else if (u.pn < 32) {
#pragma unroll
                    for (int bj = 0; bj < 2; ++bj) *(v4u*)(dst + bj * 128) = pack8(acc[ai][bj][m][0], acc[ai][bj][m][1]);
                } else {
#pragma unroll
                    for (int bj = 0; bj < 2; ++bj) { f32x4 v0 = acc[ai][bj][m][0], v1 = acc[ai][bj][m][1];
                        v0.x = silu_f(v0.x); v0.y = silu_f(v0.y); v0.z = silu_f(v0.z); v0.w = silu_f(v0.w); v1.x = silu_f(v1.x); v1.y = silu_f(v1.y); v1.z = silu_f(v1.z); v1.w = silu_f(v1.w);
                        *(v4u*)(dst + bj * 128) = pack8(v0, v1); }
                } asm volatile("" ::: "memory"); }
    }
};
struct EpiM3 { static constexpr bool PERM = true, AFTER_DRAIN = false;
    bf16* ACT;
    __device__ __forceinline__ void operator()(const AccT& acc, const pg8::Unit& u, int wr, int wc, int fr, int fq) const {
        const int row0 = u.pm * 256 + wr * 64 + fr, tc = wc * 32 + 8 * fq;
#pragma unroll
        for (int ai = 0; ai < 2; ++ai)
#pragma unroll
            for (int m = 0; m < 4; ++m) { const int row = row0 + ai * 128 + m * 16; const f32x4 g0 = acc[ai][0][m][0], g1 = acc[ai][0][m][1], u0 = acc[ai][1][m][0], u1 = acc[ai][1][m][1]; f32x4 a0, a1;
                a0.x = silu_f(g0.x) * u0.x; a0.y = silu_f(g0.y) * u0.y; a0.z = silu_f(g0.z) * u0.z; a0.w = silu_f(g0.w) * u0.w;
                a1.x = silu_f(g1.x) * u1.x; a1.y = silu_f(g1.y) * u1.y; a1.z = silu_f(g1.z) * u1.z; a1.w = silu_f(g1.w) * u1.w;
                *(v4u*)(ACT + (size_t)row * 512 + u.pn * 128 + tc) = pack8(a0, a1); }
    }
};
struct EpiM4 { static constexpr bool PERM = true, AFTER_DRAIN = false;
    bf16* Y;
    __device__ __forceinline__ void operator()(const AccT& acc, const pg8::Unit& u, int wr, int wc, int fr, int fq) const {
        const int row0 = u.pm * 256 + wr * 64 + fr, tc = wc * 32 + 8 * fq;
#pragma unroll
        for (int ai = 0; ai < 2; ++ai)
#pragma unroll
            for (int m = 0; m < 4; ++m) { const int row = row0 + ai * 128 + m * 16;
#pragma unroll
                for (int bj = 0; bj < 2; ++bj) *(v4u*)(Y + (size_t)row * 2048 + u.pn * 256 + bj * 128 + tc) = pack8(acc[ai][bj][m][0], acc[ai][bj][m][1]); }
    }
};
__device__ __forceinline__ void moe_tables(Frame& F, int layer) {
    LAS int* tab = (LAS int*)(F.lds + MOE_TAB_OFF);
    __syncthreads();
    if (F.wave == 0) { const int lane = lane_id_opaque();
        const int cnt = lane < 32 ? (int)__hip_atomic_load(F.ctl + ECNT_IDX(layer, lane), RLX_AGENT) : 0; const int nt = (cnt + 255) >> 8;
        int incl = nt;
#pragma unroll
        for (int off = 1; off < 32; off <<= 1) { const int v = __shfl_up(incl, off); if (lane >= off) incl += v; }
        const int start = incl - nt;
        if (lane < 32) { tab[128 + lane] = 256 * start; for (int i = 0; i < nt && start + i < 96; ++i) tab[start + i] = lane; }
        if (lane == 31) tab[160] = incl < 96 ? incl : 96; }
    __syncthreads();
}

#ifndef PH_MASK
#define PH_MASK 0x7FFFFFu
#endif
#ifndef PH_DUP
#define PH_DUP 0u
#endif
#define REP(k) _Pragma("unroll 1") for (int rep_ = 0; rep_ < ((((PH_DUP) >> (k)) & 1u) ? 2 : 1); ++rep_)
#define IN(k) (((PH_MASK >> (k)) & 1u) && lo <= (k) && (k) < hi)
#ifndef PH_DELAY
#define PH_DELAY 0u
#endif
#if PH_DELAY
#define PH_MARK() do { ph_t0 = __builtin_amdgcn_s_memrealtime(); } while (0)
#define PH_IDLE(k) do { if (((PH_DELAY) >> (k)) & 1u) { __syncthreads(); const unsigned long long t1_ = __builtin_amdgcn_s_memrealtime(); while (__builtin_amdgcn_s_memrealtime() - t1_ < t1_ - ph_t0) __builtin_amdgcn_s_sleep(8); } } while (0)
#else
#define PH_MARK() do { } while (0)
#define PH_IDLE(k) do { } while (0)
#endif
#define SEAM(k) do { PH_IDLE(k); if (IN(k) && IN((k) + 1)) xcd_barrier(bar, F.wave); PH_MARK(); } while (0)
__device__ __forceinline__ int moe_split(int TM) { int ta = TM - 32; const int half = (TM + 1) >> 1; if (ta < half) ta = half; if (ta > 64) ta = 64; return ta; }
template <int LAYER, int PB> __device__ __forceinline__ void moe_phases(Frame& F, const Args& args, const XcdBarrier& bar, int lo, int hi, unsigned long long& ph_t0) {
    unsigned char* ws = F.ws; LAS unsigned char* ring = F.lds + RING_OFF; const int c = (int)blockIdx.x;
    if (IN(PB)) { router_phase(F, args, (const float*)(ws + WS_XA), args.in[8] + LAYER * 2048, 2 * LAYER + 1, LAYER, true);
#if defined(ROUTER_TWICE)
        router_phase(F, args, (const float*)(ws + WS_XA), args.in[8] + LAYER * 2048, 2 * LAYER + 1, LAYER, false);
#endif
    } SEAM(PB);
    if (IN(PB + 1)) { moe_tables(F, LAYER); scatter_phase(F, (const float*)(ws + WS_XA), args.in[8] + LAYER * 2048, 2 * LAYER + 1, LAYER, true);
#if defined(SCATTER_TWICE)
        scatter_phase(F, (const float*)(ws + WS_XA), args.in[8] + LAYER * 2048, 2 * LAYER + 1, LAYER, false);
#endif
    } SEAM(PB + 1);
    if (IN(PB + 2)) {
        if (MK_MULTI) moe_tables(F, LAYER);     const LAS int* tab = (const LAS int*)(F.lds + MOE_TAB_OFF); const int TM = tab[160], TA = moe_split(TM);
        pg8::Gemm g{2048, 2048, 64, 128, 32768}; pg8::MoeOrder S; S.ntn = 4; S.t0 = 0; S.nunits = TA * 4; S.gdeal = F.G; S.busy = 0; S.G = F.G; S.c = c; S.A = (const char*)(ws + WS_HG); S.W = (const char*)(ws + WS_W_GU + (size_t)LAYER * 128 * MiB);
        S.tstepA = (size_t)256 * 2048 * 2; S.tstepB = (size_t)256 * 2048 * 2; S.estep = (size_t)1024 * 2048 * 2; S.tile_expert = tab;
        EpiM3 E{(bf16*)(ws + WS_ACT)};
        pg8::gemm_phase<EpiM3, pg8::MoeOrder, true, true>(ring, g, S, E, F.wave);
#if defined(M3_TWICE)
        pg8::gemm_phase<EpiM3, pg8::MoeOrder, true, true>(ring, g, S, E, F.wave);
#endif
    } SEAM(PB + 2);
    if (IN(PB + 3)) {
        if (MK_MULTI) moe_tables(F, LAYER);     const LAS int* tab = (const LAS int*)(F.lds + MOE_TAB_OFF); const int TM = tab[160], TA = moe_split(TM), nb3 = (TM - TA) * 4;
        { pg8::Gemm g{2048, 2048, 64, 128, 32768}; pg8::MoeOrder S; S.ntn = 4; S.t0 = TA; S.nunits = nb3; S.gdeal = nb3 < F.G ? nb3 : F.G; S.busy = 0; S.G = F.G; S.c = c; S.A = (const char*)(ws + WS_HG); S.W = (const char*)(ws + WS_W_GU + (size_t)LAYER * 128 * MiB);
          S.tstepA = (size_t)256 * 2048 * 2; S.tstepB = (size_t)256 * 2048 * 2; S.estep = (size_t)1024 * 2048 * 2; S.tile_expert = tab;
          EpiM3 E{(bf16*)(ws + WS_ACT)};
          pg8::gemm_phase<EpiM3, pg8::MoeOrder, true, true>(ring, g, S, E, F.wave); }
        { pg8::Gemm g{512, 512, 64, 128, 32768}; pg8::MoeOrder S; S.ntn = 8; S.t0 = 0; S.nunits = TA * 8; S.gdeal = F.G; S.busy = (nb3 > 0 && nb3 < F.G) ? nb3 : 0; S.G = F.G; S.c = c; S.A = (const char*)(ws + WS_ACT); S.W = (const char*)(ws + WS_W_DN + (size_t)LAYER * 64 * MiB);
          S.tstepA = (size_t)256 * 512 * 2; S.tstepB = (size_t)256 * 512 * 2; S.estep = (size_t)2048 * 512 * 2; S.tile_expert = tab;
          EpiM4 E{(bf16*)(ws + WS_Y)};
          pg8::gemm_phase<EpiM4, pg8::MoeOrder, true, true>(ring, g, S, E, F.wave); }
    } SEAM(PB + 3);
    if (IN(PB + 4)) {
        if (MK_MULTI) moe_tables(F, LAYER);     const LAS int* tab = (const LAS int*)(F.lds + MOE_TAB_OFF); const int TM = tab[160], TA = moe_split(TM);
        pg8::Gemm g{512, 512, 64, 128, 32768}; pg8::MoeOrder S; S.ntn = 8; S.t0 = TA; S.nunits = (TM - TA) * 8; S.gdeal = F.G; S.busy = 0; S.G = F.G; S.c = c; S.A = (const char*)(ws + WS_ACT); S.W = (const char*)(ws + WS_W_DN + (size_t)LAYER * 64 * MiB);
        S.tstepA = (size_t)256 * 512 * 2; S.tstepB = (size_t)256 * 512 * 2; S.estep = (size_t)2048 * 512 * 2; S.tile_expert = tab;
        EpiM4 E{(bf16*)(ws + WS_Y)};
        pg8::gemm_phase<EpiM4, pg8::MoeOrder, true, true>(ring, g, S, E, F.wave);
#if defined(M4_TWICE)
        pg8::gemm_phase<EpiM4, pg8::MoeOrder, true, true>(ring, g, S, E, F.wave);
#endif
    } SEAM(PB + 4);
}
__global__ void __launch_bounds__(NWAVES * 64, 2) mk_fwd(Args args) {
    extern __shared__ __attribute__((aligned(16))) unsigned char lds[];
    Frame F;
    F.lds = (LAS unsigned char*)lds;
    F.MISC = (volatile LAS unsigned*)(F.lds + MISC_OFF);
    F.wave = __builtin_amdgcn_readfirstlane((int)threadIdx.x >> 6);
    F.G = gridDim.x; { const int bx = blockIdx.x; F.vcu = (F.G % 8 == 0) ? (bx % 8) * (F.G / 8) + bx / 8 : bx; }
    F.ws = args.ws; F.ctl = (gu32*)(args.ws + WS_CTL); F.out = args.out;
    for (int u = threadIdx.x; u < (LDS_BYTES - LDSCTL_OFF) / 4; u += NWAVES * 64) ((LAS unsigned*)(F.lds + LDSCTL_OFF))[u] = 0u;
    __syncthreads();
    XcdBarrier bar; bar.bar = (unsigned*)(F.ctl + CW_BAR); bar.x = 0; bar.st = nullptr;
    if (!MK_MULTI) bar = xcd_barrier_post((unsigned*)(F.ctl + CW_BAR), F.MISC + 8, F.wave);
    const int lo = args.ph_lo, hi = args.ph_hi;
    unsigned long long ph_t0 = 0ull; PH_MARK(); (void)ph_t0;
    unsigned char* ws = args.ws;
    const float* MOD = (const float*)(F.ctl + CW_MOD);
    LAS unsigned char* ring = F.lds + RING_OFF;
    const int c = (int)blockIdx.x;

    if (IN(0)) REP(0) { p0a_mod_partials(F, args); } SEAM(0);
    if (IN(1)) REP(1) { p0_prologue(F, args); local_mod(F, args.in[4], 0); norm_phase<0, true>(F, args.in[0], nullptr, args.in[5], 0, 0, 0); } SEAM(1);
    if (IN(3)) REP(3) {
        pg8::Gemm g{2048, 2048, 2048}; pg8::StaticOrder S; S.init(T_, 4096, F.G, c, ws + WS_H, 2048, ws + WS_W_IN0T, 2048);
        EpiG1 E{(bf16*)(ws + WS_PROJ0), (bf16*)(ws + WS_KR), (float*)(ws + WS_SSQP), (const f32x2*)(ws + WS_TAB64)};
        pg8::gemm_phase<EpiG1, pg8::StaticOrder, true, true>(ring, g, S, E, F.wave);
    } SEAM(3);
    if (IN(4)) REP(4) {
        { pg8::Gemm g{512, 4096, 512}; pg8::StaticOrder S; S.init(T_, 1536, F.G, c, ws + WS_PROJ0 + 3072 * 2, 4096, ws + WS_W_QUPT, 512);
          EpiG2q E{(bf16*)(ws + WS_QMLA), (const float*)(ws + WS_SSQP), (const f32x2*)(ws + WS_TAB64)};
          pg8::gemm_phase<EpiG2q, pg8::StaticOrder, true, true>(ring, g, S, E, F.wave); }
        { pg8::Gemm g{256, 4096, 256}; pg8::StaticOrder S; S.init(T_, 2048, F.G, c, ws + WS_PROJ0 + 3584 * 2, 4096, ws + WS_W_KVUPT, 256);
          EpiG2kv E{(bf16*)(ws + WS_KVMLA), (const float*)(ws + WS_SSQP) + (size_t)T_ * 8};
          pg8::gemm_phase<EpiG2kv, pg8::StaticOrder, true, true>(ring, g, S, E, F.wave); }
    } SEAM(4);
    if (IN(5)) REP(5) { bool conv_left = true; WorkQ QC; wq_init(F, QC, F.ctl + CW_QC1, CONV_N1 / 128, 18, lane_id_opaque()); mla_phase(F, args, QC, conv_left); sb_phase(F, args, QC, conv_left); } SEAM(5);
    if (IN(6)) REP(6) {
        pg8::Gemm g{2048, 2048, 2048}; pg8::StaticOrder S; S.init(T_, 2048, F.G, c, ws + WS_ATTO, 2048, ws + WS_W_OUT0T, 2048);
        EpiRes E{args.in[0], (float*)(ws + WS_XA), MOD + (size_t)(0 * 4) * 6144 + 4096};
        pg8::gemm_phase<EpiRes, pg8::StaticOrder, true, true>(ring, g, S, E, F.wave);
    } SEAM(6);
    moe_phases<0, 7>(F, args, bar, lo, hi, ph_t0);
    if (IN(12)) REP(12) { norm_phase<2>(F, (const float*)(ws + WS_XA), (float*)(ws + WS_XB), args.in[5] + 2048, 2, 1, 0); } SEAM(12);
    if (IN(13)) REP(13) {
        pg8::Gemm g{2048, 2048, 2048}; pg8::StaticOrder S; S.init(T_, 12288, F.G, c, ws + WS_H, 2048, ws + WS_W_IN1T, 2048);
        EpiG4 E{(bf16*)(ws + WS_PROJ1), (const f32x2*)(ws + WS_TAB256)};
        pg8::gemm_phase<EpiG4, pg8::StaticOrder, true, true>(ring, g, S, E, F.wave);
    } SEAM(13);
    if (IN(14)) REP(14) { ret_phase(F, args); } SEAM(14);
    if (IN(15)) REP(15) { retnorm_phase(F); } SEAM(15);
    if (IN(16)) REP(16) {
        pg8::Gemm g{4096, 4096, 4096}; pg8::StaticOrder S; S.init(T_, 2048, F.G, c, ws + WS_A5, 4096, ws + WS_W_OUT1T, 4096);
        EpiRes E{(const float*)(ws + WS_XB), (float*)(ws + WS_XA), MOD + (size_t)(2 * 4) * 6144 + 4096};
        pg8::gemm_phase<EpiRes, pg8::StaticOrder, true, true>(ring, g, S, E, F.wave);
    } SEAM(16);
    moe_phases<1, 17>(F, args, bar, lo, hi, ph_t0);
    if (IN(22)) REP(22) { norm_phase<3>(F, (const float*)(ws + WS_XA), nullptr, args.in[24], 0, 3, 1); }
    PH_IDLE(22);
}
#undef IN
#undef SEAM

extern "C" void kernel_launch(void* const* d_in, const int* in_sizes, int n_in, void* d_out, int out_size, void* d_ws, size_t ws_size, hipStream_t stream) {
    static int grid = 0;
    if (grid == 0) {
        if (n_in != 25 || in_sizes[0] != T_ * D_ || out_size != T_ * D_ || ws_size < WS_END) { fprintf(stderr, "kernel_launch: unexpected shapes (n_in %d, in0 %d, out %d, ws %zu < %zu); nothing launched\n", n_in, n_in > 0 ? in_sizes[0] : -1, out_size, ws_size, (size_t)WS_END); grid = -1; return; }
        int dev = 0, cus = 0, per_cu = 0;
        if (hipGetDevice(&dev) != hipSuccess || hipDeviceGetAttribute(&cus, hipDeviceAttributeMultiprocessorCount, dev) != hipSuccess) { fprintf(stderr, "kernel_launch: device query failed\n"); grid = -1; return; }
        if (hipFuncSetAttribute((const void*)mk_fwd, hipFuncAttributeMaxDynamicSharedMemorySize, LDS_BYTES) != hipSuccess) { fprintf(stderr, "kernel_launch: hipFuncSetAttribute failed\n"); grid = -1; return; }
        if (hipOccupancyMaxActiveBlocksPerMultiprocessor(&per_cu, (const void*)mk_fwd, NWAVES * 64, LDS_BYTES) != hipSuccess || per_cu < 1) fprintf(stderr, "kernel_launch: note: occupancy query reports %d workgroups per CU\n", per_cu);
        (void)hipGetLastError();
        grid = cus;
    }
    if (grid < 0) return;
    if (hipMemsetAsync((char*)d_ws + WS_CTL, 0, CTL_ZERO_BYTES, stream) != hipSuccess) { fprintf(stderr, "kernel_launch: memset failed\n"); return; }
    Args a{};
    for (int i = 0; i < 25; ++i) a.in[i] = (const float*)d_in[i];
    a.out = (float*)d_out; a.ws = (unsigned char*)d_ws;
#if MK_MULTI
    for (int p = 0; p < 23; ++p) { a.ph_lo = p; a.ph_hi = p + 1; hipLaunchKernelGGL(mk_fwd, dim3(grid), dim3(NWAVES * 64), LDS_BYTES, stream, a); }
#else
    a.ph_lo = 0; a.ph_hi = 23;
    hipLaunchKernelGGL(mk_fwd, dim3(grid), dim3(NWAVES * 64), LDS_BYTES, stream, a);
#endif
    const hipError_t le = hipPeekAtLastError();
    if (le != hipSuccess) fprintf(stderr, "kernel_launch: launch failed: %s\n", hipGetErrorName(le));
}
```

```cpp
#include <hip/hip_runtime.h>
#include <cstdio>
#include <cstdint>

#ifndef MK_MULTI
#define MK_MULTI 0
#endif

namespace pg8 {
#define PG8_LAS __attribute__((address_space(3)))
typedef unsigned short bf16_t;
typedef short bf16x8 __attribute__((ext_vector_type(8)));
typedef float f32x4 __attribute__((ext_vector_type(4)));
typedef unsigned u32x4 __attribute__((ext_vector_type(4)));
constexpr int BM = 256, BK = 64, HALF = 128, HTB = HALF * BK * 2  , STAGE_BYTES = 8 * HTB, NXCD = 8, WGM = 8;

__host__ __device__ __forceinline__ int lds_byte(int r, int c) { const int st = (r >> 4) * 2 + (c >> 5), rr = r & 15, cc = c & 31, ob = rr * 64 + cc * 2; return st * 1024 + (ob ^ (((ob >> 9) & 1) << 5)); }
__host__ __device__ __forceinline__ void stage_rc(int b, int& R, int& C) { const int st = b / 1024, sb = b % 1024, swz = sb ^ (((sb >> 9) & 1) << 5); R = (st >> 1) * 16 + swz / 64; C = (st & 1) * 32 + (swz % 64) / 2; }
__host__ __device__ __forceinline__ int perm32(int rho) { const int n = rho >> 4, i = rho & 15; return 8 * (i >> 2) + 4 * n + (i & 3); }

struct Unit { int pm, pn; const char* a; const char* b; };
struct Gemm { int K, lda, ldb; size_t kstepA = 128, kstepB = 128; };

struct StaticOrder {
    int nM, nN, nwg, G, c; const char* A; const char* Bt; size_t tstepA, tstepB;
    __device__ void init(int M, int N, int G_, int c_, const void* A_, int lda, const void* Bt_, int ldb) { nM = M / BM; nN = N / BM; nwg = nM * nN; G = G_; c = c_; A = (const char*)A_; Bt = (const char*)Bt_; tstepA = (size_t)BM * lda * 2; tstepB = (size_t)BM * ldb * 2; }
    __device__ bool next(int i, Unit& u) const {
        const long L = (long)i * G + c; if (L >= nwg) return false;
        int wgid = (int)L; { const int q = nwg / NXCD, r = nwg % NXCD, xcd = wgid % NXCD, off = wgid / NXCD; wgid = (xcd < r ? xcd * (q + 1) : r * (q + 1) + (xcd - r) * q) + off; }
        const int nig = WGM * nN, gid = wgid / nig, fm = gid * WGM, gsz = (nM - fm) < WGM ? (nM - fm) : WGM;
        u.pm = fm + ((wgid % nig) % gsz); u.pn = (wgid % nig) / gsz; u.a = A + (size_t)u.pm * tstepA; u.b = Bt + (size_t)u.pn * tstepB; return true;
    }
    __device__ __forceinline__ void a_ready(const Unit&) const {}
    __device__ __forceinline__ void done(const Unit&) const {}
};
struct MoeOrder {
    int ntn, t0, nunits, gdeal, busy, G, c; const char* A; const char* W; size_t tstepA, tstepB, estep; const PG8_LAS int* tile_expert;
    __device__ bool next(int i, Unit& u) const {
        int L;
        if (busy == 0) { if (c >= gdeal) return false; L = i * gdeal + c; }
        else { const int nfree = G - busy;
            if (c >= busy) { const int cap = 3 * nfree < nunits ? 3 * nfree : nunits; if (i >= 3) return false; L = i * nfree + (c - busy); if (L >= cap) return false; }
            else { L = 3 * nfree + i * busy + c; } }
        if (L >= nunits) return false;
        const int mt = t0 + L / ntn, pn = L % ntn, e = tile_expert[mt];
        u.pm = mt; u.pn = pn; u.a = A + (size_t)mt * tstepA; u.b = W + (size_t)e * estep + (size_t)pn * tstepB; return true;
    }
    __device__ __forceinline__ void a_ready(const Unit&) const {}
    __device__ __forceinline__ void done(const Unit&) const {}
};

template <class Epi, class Sched, bool ALIGN_EPI = false, bool SP2 = false>
__device__ __forceinline__ void gemm_phase(PG8_LAS unsigned char* lds, const Gemm g, const Sched& S, const Epi& E, const int wave_id) {
    int lane; asm volatile("v_mbcnt_lo_u32_b32 %0, -1, 0\n\tv_mbcnt_hi_u32_b32 %0, -1, %0" : "=v"(lane));
    const int wid = wave_id, tid = wid * 64 + lane, wr = wid >> 2, wc = wid & 3, fr = lane & 15, fq = lane >> 4;
    const int K = g.K, nt = K / BK;
    unsigned voffA[2], voffB[2];
#pragma unroll
    for (int i = 0; i < 2; ++i) { int R, C; stage_rc(tid * 16 + i * 8192, R, C); const int Rb = Epi::PERM ? ((R & ~31) + perm32(R & 31)) : R;
        voffA[i] = (unsigned)(R * g.lda + C) * 2u; voffB[i] = (unsigned)(Rb * g.ldb + C) * 2u; }
    const size_t kstepA = g.kstepA, kstepB = g.kstepB;
    const size_t hstepA = (size_t)HALF * g.lda * 2, hstepB = (size_t)HALF * g.ldb * 2;
    const unsigned ldsw = (unsigned)wid * 1024u;
    const int aoff = lds_byte(wr * 64 + fr, fq * 8), boff = lds_byte(wc * 32 + fr, fq * 8);
#define PG8_SA(b, h) (((b) * 2 + (h)) * HTB)
#define PG8_SB(b, h) ((4 + (b) * 2 + (h)) * HTB)
#define PG8_STAGE(bufoff, gbase, voff) do { _Pragma("unroll") for (int _i = 0; _i < 2; ++_i) \
        __builtin_amdgcn_global_load_lds((const unsigned*)((const char*)(gbase) + (voff)[_i]), (PG8_LAS unsigned*)(lds + (bufoff) + ldsw + _i * 8192), 16, 0, 0); } while (0)
#define PG8_LDA(dst, b, h) do { _Pragma("unroll") for (int m = 0; m < 4; ++m) _Pragma("unroll") for (int k = 0; k < 2; ++k) dst[m][k] = *(const PG8_LAS bf16x8*)(lds + PG8_SA(b, h) + aoff + m * 2048 + k * 1024); } while (0)
#define PG8_LDB(dst, b, h) do { _Pragma("unroll") for (int n = 0; n < 2; ++n) _Pragma("unroll") for (int k = 0; k < 2; ++k) dst[n][k] = *(const PG8_LAS bf16x8*)(lds + PG8_SB(b, h) + boff + n * 2048 + k * 1024); } while (0)
#define PG8_MMA(ai, bj, At, Bt) do { __builtin_amdgcn_s_setprio(1); _Pragma("unroll") for (int m = 0; m < 4; ++m) _Pragma("unroll") for (int n = 0; n < 2; ++n) _Pragma("unroll") for (int k = 0; k < 2; ++k) \
        acc[ai][bj][m][n] = __builtin_amdgcn_mfma_f32_16x16x32_bf16(Bt[n][k], At[m][k], acc[ai][bj][m][n], 0, 0, 0); __builtin_amdgcn_s_setprio(0); } while (0)
#define PG8_WAIT_V(n) asm volatile("s_waitcnt vmcnt(" #n ")" ::: "memory")
#define PG8_WAIT_L(n) asm volatile("s_waitcnt lgkmcnt(" #n ")" ::: "memory")
#define PG8_BAR __builtin_amdgcn_s_barrier()
#define PG8_SCHED __builtin_amdgcn_sched_barrier(0)
    Unit cur, nxt; int ui = 0;
    if (!S.next(0, cur)) return;
    f32x4 acc[2][2][4][2];
#pragma unroll
    for (int a = 0; a < 2; ++a)
#pragma unroll
        for (int b = 0; b < 2; ++b)
#pragma unroll
            for (int m = 0; m < 4; ++m)
#pragma unroll
                for (int n = 0; n < 2; ++n) acc[a][b][m][n] = (f32x4){0.f, 0.f, 0.f, 0.f};
    bf16x8 At[4][2], B0[2][2], B1[2][2];
    const char* cA = cur.a; const char* cB = cur.b;
    S.a_ready(cur);
    if constexpr (SP2) {
        PG8_STAGE(PG8_SB(0, 0), cB, voffB); PG8_STAGE(PG8_SB(0, 1), cB + hstepB, voffB); PG8_STAGE(PG8_SA(0, 0), cA, voffA); PG8_STAGE(PG8_SA(0, 1), cA + hstepA, voffA);
        if (wr == 1) PG8_BAR;
        PG8_WAIT_V(2); PG8_BAR;
        PG8_STAGE(PG8_SB(1, 0), cB + kstepB, voffB); PG8_STAGE(PG8_SA(1, 0), cA + kstepA, voffA); PG8_STAGE(PG8_SB(1, 1), cB + hstepB + kstepB, voffB);
        PG8_WAIT_V(6); PG8_BAR;
    } else {
        PG8_STAGE(PG8_SB(0, 0), cB, voffB); PG8_STAGE(PG8_SA(0, 0), cA, voffA); PG8_STAGE(PG8_SB(0, 1), cB + hstepB, voffB); PG8_STAGE(PG8_SA(0, 1), cA + hstepA, voffA);
        if (wr == 1) PG8_BAR;
        PG8_WAIT_V(4); PG8_BAR;
        PG8_STAGE(PG8_SB(1, 0), cB + kstepB, voffB); PG8_STAGE(PG8_SA(1, 0), cA + kstepA, voffA); PG8_STAGE(PG8_SB(1, 1), cB + hstepB + kstepB, voffB);
        PG8_WAIT_V(6); PG8_BAR;
    }
    for (;;) {
        const bool has_next = S.next(ui + 1, nxt);
        const char* nA = has_next ? nxt.a : cA; const char* nB = has_next ? nxt.b : cB;
        for (int t = 0; t < nt; t += 2) {
            const bool last = (t == nt - 2);
            const char* a1 = cA + (size_t)(t + 1) * kstepA;
            const char* a2 = last ? nA : cA + (size_t)(t + 2) * kstepA; const char* b2 = last ? nB : cB + (size_t)(t + 2) * kstepB;
            const char* a3 = a2 + kstepA; const char* b3 = b2 + kstepB;
            if (last && has_next) S.a_ready(nxt);
            if constexpr (SP2) {
            PG8_LDB(B0, 0, 0); PG8_LDB(B1, 0, 1); PG8_SCHED; PG8_LDA(At, 0, 0); PG8_STAGE(PG8_SA(1, 1), a1 + hstepA, voffA);
            PG8_WAIT_V(8); PG8_WAIT_L(0); PG8_BAR; PG8_MMA(0, 0, At, B0); PG8_MMA(0, 1, At, B1); PG8_BAR; PG8_SCHED;
            PG8_LDA(At, 0, 1); PG8_STAGE(PG8_SB(0, 0), b2, voffB); PG8_STAGE(PG8_SB(0, 1), b2 + hstepB, voffB); PG8_STAGE(PG8_SA(0, 0), a2, voffA);
            PG8_WAIT_V(8); PG8_WAIT_L(0); PG8_BAR; PG8_MMA(1, 0, At, B0); PG8_MMA(1, 1, At, B1); PG8_BAR; PG8_SCHED;
            PG8_LDB(B0, 1, 0); PG8_LDB(B1, 1, 1); PG8_SCHED; PG8_LDA(At, 1, 0); PG8_STAGE(PG8_SA(0, 1), a2 + hstepA, voffA);
            PG8_WAIT_V(8); PG8_WAIT_L(0); PG8_BAR; PG8_MMA(0, 0, At, B0); PG8_MMA(0, 1, At, B1); PG8_BAR; PG8_SCHED;
            PG8_LDA(At, 1, 1); PG8_STAGE(PG8_SB(1, 0), b3, voffB); PG8_STAGE(PG8_SB(1, 1), b3 + hstepB, voffB); PG8_STAGE(PG8_SA(1, 0), a3, voffA);
            PG8_WAIT_V(8); PG8_WAIT_L(0); PG8_BAR; PG8_MMA(1, 0, At, B0); PG8_MMA(1, 1, At, B1); PG8_BAR; PG8_SCHED;
            } else {
            PG8_LDB(B0, 0, 0); PG8_SCHED; PG8_LDA(At, 0, 0); PG8_STAGE(PG8_SA(1, 1), a1 + hstepA, voffA);
            PG8_WAIT_L(8); PG8_BAR; PG8_WAIT_L(0); PG8_MMA(0, 0, At, B0); PG8_BAR; PG8_SCHED;
            PG8_LDB(B1, 0, 1); PG8_STAGE(PG8_SB(0, 0), b2, voffB);
            PG8_BAR; PG8_WAIT_L(0); PG8_MMA(0, 1, At, B1); PG8_BAR;
            PG8_LDA(At, 0, 1); PG8_STAGE(PG8_SA(0, 0), a2, voffA);
            PG8_BAR; PG8_WAIT_L(0); PG8_MMA(1, 0, At, B0); PG8_BAR; PG8_SCHED;
            PG8_STAGE(PG8_SB(0, 1), b2 + hstepB, voffB);
            PG8_WAIT_V(6); PG8_BAR; PG8_MMA(1, 1, At, B1); PG8_BAR;
            PG8_LDB(B0, 1, 0); PG8_SCHED; PG8_LDA(At, 1, 0); PG8_STAGE(PG8_SA(0, 1), a2 + hstepA, voffA);
            PG8_WAIT_L(8); PG8_BAR; PG8_WAIT_L(0); PG8_MMA(0, 0, At, B0); PG8_BAR; PG8_SCHED;
            PG8_LDB(B1, 1, 1); PG8_STAGE(PG8_SB(1, 0), b3, voffB);
            PG8_BAR; PG8_WAIT_L(0); PG8_MMA(0, 1, At, B1); PG8_BAR;
            PG8_LDA(At, 1, 1); PG8_STAGE(PG8_SA(1, 0), a3, voffA);
            PG8_BAR; PG8_WAIT_L(0); PG8_MMA(1, 0, At, B0); PG8_BAR; PG8_SCHED;
            PG8_STAGE(PG8_SB(1, 1), b3 + hstepB, voffB);
            PG8_WAIT_V(6); PG8_BAR; PG8_MMA(1, 1, At, B1); PG8_BAR;
            }
        }
        if constexpr (ALIGN_EPI) { if (wr == 0) PG8_BAR; }
        if constexpr (!Epi::AFTER_DRAIN) { E(acc, cur, wr, wc, fr, fq); S.done(cur); }
        if (!has_next) break;
#pragma unroll
        for (int a = 0; a < 2; ++a)
#pragma unroll
            for (int b = 0; b < 2; ++b)
#pragma unroll
                for (int m = 0; m < 4; ++m)
#pragma unroll
                    for (int n = 0; n < 2; ++n) acc[a][b][m][n] = (f32x4){0.f, 0.f, 0.f, 0.f};
        cur = nxt; cA = nA; cB = nB; ++ui;
        if constexpr (ALIGN_EPI) { if (wr == 1) PG8_BAR; }
    }
    PG8_WAIT_V(0);
    if constexpr (!ALIGN_EPI) { if (wr == 0) PG8_BAR; }
    PG8_BAR;
    if constexpr (Epi::AFTER_DRAIN) { E.fused(acc, cur, wr, wc, fr, fq, lds, wid, lane); S.done(cur); }
#undef PG8_SA
#undef PG8_SB
#undef PG8_STAGE
#undef PG8_LDA
#undef PG8_LDB
#undef PG8_MMA
#undef PG8_WAIT_V
#undef PG8_WAIT_L
#undef PG8_BAR
#undef PG8_SCHED
}
}

constexpr int NWAVES = 8;
constexpr int T_ = 8192, D_ = 2048, NB_ = 4, S_ = 2048;
constexpr float EPS_ = 1e-6f;
constexpr float LOG2E = 1.4426950408889634f;
constexpr float C_SB = 0.08838834764831845f * LOG2E;
constexpr float C_MLA = 0.07216878364870323f * LOG2E;
constexpr int NPH = 22;

constexpr size_t MiB = 1u << 20;
constexpr size_t WS_CTL = 0, CTL_ZERO_BYTES = 1 * MiB;
constexpr size_t WS_TAB64 = 2 * MiB, WS_TAB256 = 4 * MiB, WS_WR = 12 * MiB, WS_ROUTE = 13 * MiB;
constexpr size_t WS_W_IN0T = 16 * MiB, WS_W_QUPT = 32 * MiB, WS_W_KVUPT = 34 * MiB, WS_W_OUT0T = 36 * MiB, WS_W_IN1T = 44 * MiB, WS_W_OUT1T = 92 * MiB;
constexpr size_t WS_W_GU = 108 * MiB, WS_W_DN = 364 * MiB;
constexpr size_t WS_XA = 492 * MiB, WS_XB = 556 * MiB, WS_H = 620 * MiB;
constexpr size_t WS_PROJ0 = 652 * MiB, WS_QMLA = 716 * MiB, WS_KVMLA = 740 * MiB, WS_KR = 772 * MiB, WS_ATTO = 774 * MiB;
constexpr size_t WS_PROJ1 = 652 * MiB;
constexpr size_t WS_HG = 844 * MiB, WS_ACT = 940 * MiB, WS_Y = 964 * MiB;
constexpr size_t WS_RETO = 844 * MiB, WS_A5 = 908 * MiB;
constexpr size_t WS_MODP = 1060 * MiB;
constexpr size_t WS_WRS = 14 * MiB;
constexpr size_t WS_RS = 13 * MiB + 256 * 1024;
constexpr size_t WS_SSQP = 13 * MiB + 512 * 1024;
constexpr size_t WS_END = 1068 * MiB;
constexpr int CW_TMO = 0, CW_CODE = 1;
constexpr int CW_BAR = 4096;
constexpr int CW_QMLA = 8192, CW_QSB = 8256, CW_QRET = 8320, CW_QC1 = 8384, CW_QC2 = 8416;
constexpr int CW_ECNT = 114688, CW_ECUR = 118784;
#define ECNT_IDX(layer, e) (CW_ECNT + ((layer) * 32 + (e)) * 64)
#define ECUR_IDX(layer, e) (CW_ECUR + ((layer) * 32 + (e)) * 64)
constexpr int CW_MOD = 16384;
constexpr int CW_SSQQ = 114688, CW_SSQKV = 122880;
static_assert((CW_SSQKV + 8192) * 4 <= (int)CTL_ZERO_BYTES, "CTL words inside the memset region");
constexpr int RING_OFF = 0, RING_BYTES = 147456;
constexpr int LDSCTL_OFF = RING_BYTES, MISC_OFF = LDSCTL_OFF + 320;
constexpr int MOE_TAB_OFF = LDSCTL_OFF + 1024;
constexpr int LDS_BYTES = 155648;
static_assert(MOE_TAB_OFF + 1024 <= LDS_BYTES, "LDS map");

#define GAS __attribute__((address_space(1)))
#define LAS __attribute__((address_space(3)))
typedef unsigned short bf16;
typedef unsigned v4u __attribute__((ext_vector_type(4)));
typedef unsigned v2u __attribute__((ext_vector_type(2)));
typedef float f32x4 __attribute__((ext_vector_type(4)));
typedef float f32x2 __attribute__((ext_vector_type(2)));
typedef float f32x16 __attribute__((ext_vector_type(16)));
typedef short bf16x8 __attribute__((ext_vector_type(8)));
typedef short s16x4 __attribute__((ext_vector_type(4)));
typedef short v4i16_t __attribute__((ext_vector_type(4)));
typedef GAS unsigned gu32;
#define RLX_AGENT __ATOMIC_RELAXED, __HIP_MEMORY_SCOPE_AGENT
#define LDS_WAIT() asm volatile("s_waitcnt lgkmcnt(0)" ::: "memory")
#define VM_WAIT() asm volatile("s_waitcnt vmcnt(0)" ::: "memory")
typedef __bf16 bf16x2_t __attribute__((ext_vector_type(2)));
__device__ __forceinline__ unsigned pk2(float lo, float hi) { f32x2 v = {lo, hi}; bf16x2_t b = __builtin_convertvector(v, bf16x2_t); return __builtin_bit_cast(unsigned, b); }
__device__ __forceinline__ float bf_lo(unsigned w) { return __uint_as_float(w << 16); }
__device__ __forceinline__ float bf_hi(unsigned w) { return __uint_as_float(w & 0xffff0000u); }
__device__ __forceinline__ float ex2(float x) { return __builtin_amdgcn_exp2f(x); }
__device__ __forceinline__ float lg2(float x) { return __builtin_amdgcn_logf(x); }
__device__ __forceinline__ float silu_f(float v) { return v / (1.0f + __expf(-v)); }
__device__ __forceinline__ int lane_id_opaque() { int l; asm volatile("v_mbcnt_lo_u32_b32 %0, -1, 0\n\tv_mbcnt_hi_u32_b32 %0, -1, %0" : "=v"(l)); return l; }

#define XB_TMO      128
#define XB_XCNT(j)  (256  + 64 * (j))
#define XB_XSUB(j)  (1280 + 64 * (j))
#define XB_XGEN(j)  (2304 + 64 * (j))
#define XB_TOP      3328
#define XB_TOPGEN   3392
#define XCD_BAR_WORDS 3456
#define XB_SPIN_CAP (1u << 18)
__device__ __forceinline__ unsigned xb_ld(unsigned* p)              { return __hip_atomic_load(p, __ATOMIC_RELAXED, __HIP_MEMORY_SCOPE_AGENT); }
__device__ __forceinline__ unsigned xb_add(unsigned* p, unsigned v) { return __hip_atomic_fetch_add(p, v, __ATOMIC_RELAXED, __HIP_MEMORY_SCOPE_AGENT); }
__device__ __forceinline__ unsigned xb_xcc_id() { return (unsigned)__builtin_amdgcn_s_getreg((3 << 11) | 20) & 0xFu; }
#define XB_SPIN(cond, bar) do { unsigned _sp = 0; while (cond) { __builtin_amdgcn_s_sleep(1); \
    if ((++_sp & 255u) == 0u) { if (xb_ld(&(bar)[XB_TMO])) break; if (_sp > XB_SPIN_CAP) { atomicAdd(&(bar)[XB_TMO], 1u); break; } } } } while (0)
struct XcdBarrier { unsigned* bar; unsigned x; volatile LAS unsigned* st; };
__device__ __forceinline__ XcdBarrier xcd_barrier_post(unsigned* bar, volatile LAS unsigned* st, int wave) {
    XcdBarrier b; b.bar = bar; b.x = xb_xcc_id(); b.st = st;
    if (wave == 0 && lane_id_opaque() == 0) (void)xb_add(&bar[XB_XCNT(b.x)], 1u);
    return b;
}
__device__ __forceinline__ void xcd_barrier_complete(unsigned* bar, unsigned x, unsigned& nloc, unsigned& nx) {
    const unsigned G = gridDim.x * gridDim.y * gridDim.z;
    unsigned sum, cnt, mine, sp = 0u;
    for (;;) {
        sum = 0u; cnt = 0u; mine = 0u;
#pragma unroll
        for (unsigned j = 0; j < 16; ++j) { const unsigned c = xb_ld(&bar[XB_XCNT(j)]); sum += c; cnt += (c > 0u) ? 1u : 0u; mine = (j == x) ? c : mine; }
        if (sum == G) break;
        __builtin_amdgcn_s_sleep(1);
        if ((++sp & 255u) == 0u) { if (xb_ld(&bar[XB_TMO])) break; if (sp > XB_SPIN_CAP) { atomicAdd(&bar[XB_TMO], 1u); break; } }
    }
    nloc = mine > 0u ? mine : 1u; nx = cnt > 0u ? cnt : 1u;
}
__device__ __forceinline__ void xcd_barrier(const XcdBarrier& b, int wave) {
    asm volatile("s_waitcnt vmcnt(0)" ::: "memory");
    __syncthreads();
    if (wave == 0 && lane_id_opaque() == 0) {
        unsigned* bar = b.bar;
        __builtin_amdgcn_s_waitcnt(0);
        unsigned nloc = b.st[0], nx = b.st[1];
        if (nloc == 0u) { xcd_barrier_complete(bar, b.x, nloc, nx); b.st[0] = nloc; b.st[1] = nx; }
        const unsigned old = xb_add(&bar[XB_XSUB(b.x)], 1u);
        const unsigned gen = old / nloc;
        if (old + 1u == (gen + 1u) * nloc) {
            __builtin_amdgcn_fence(__ATOMIC_RELEASE, "agent");
            asm volatile("s_waitcnt vmcnt(0)" ::: "memory");
            const unsigned og = xb_add(&bar[XB_TOP], 1u);
            const unsigned tg = og / nx;
            if (og + 1u == (tg + 1u) * nx) xb_add(&bar[XB_TOPGEN], 1u);
            else XB_SPIN(xb_ld(&bar[XB_TOPGEN]) == tg, bar);
            __builtin_amdgcn_fence(__ATOMIC_ACQUIRE, "agent");
            xb_add(&bar[XB_XGEN(b.x)], 1u);
            asm volatile("s_waitcnt vmcnt(0)" ::: "memory");
        } else {
            XB_SPIN(xb_ld(&bar[XB_XGEN(b.x)]) == gen, bar);
            __builtin_amdgcn_fence(__ATOMIC_ACQUIRE, "agent");
            asm volatile("s_waitcnt vmcnt(0)" ::: "memory");
        }
    }
    __syncthreads();
}

struct Frame {
    LAS unsigned char* lds;
    volatile LAS unsigned* MISC;
    gu32* ctl;
    unsigned char* ws;
    int wave;
    int vcu, G;
    float* out;
};
struct Args { const float* in[25]; float* out; unsigned char* ws; int ph_lo, ph_hi; };
__device__ __forceinline__ float wave_sum(float v) {
#pragma unroll
    for (int o = 1; o < 64; o <<= 1) v += __shfl_xor(v, o);
    return v;
}
#define PHASE_IDS(F) const int lane = lane_id_opaque(), wave = (F).wave, tid = wave * 64 + lane; (void)lane; (void)wave; (void)tid
struct ConvSrc { const float* W; int ldn; bf16* WT; int ldk; const float* scale; };
__device__ __forceinline__ void conv_load(const ConvSrc& c, int lane, f32x4 (&v)[8]) {
    const float* src = c.W + (size_t)(8 * (lane >> 3)) * c.ldn + 4 * (lane & 7);
#pragma unroll
    for (int t = 0; t < 8; ++t) v[t] = __builtin_nontemporal_load((const f32x4*)(src + (size_t)t * c.ldn));
}
__device__ __forceinline__ void conv_store(const ConvSrc& c, int lane, f32x4 (&v)[8]) {
    if (c.scale) { const f32x4 s0 = *(const f32x4*)(c.scale + 8 * (lane >> 3)), s1 = *(const f32x4*)(c.scale + 8 * (lane >> 3) + 4);
        v[0] *= s0.x; v[1] *= s0.y; v[2] *= s0.z; v[3] *= s0.w; v[4] *= s1.x; v[5] *= s1.y; v[6] *= s1.z; v[7] *= s1.w; }
    bf16* dst = c.WT + (size_t)(4 * (lane & 7)) * c.ldk + 8 * (lane >> 3);
#pragma unroll
    for (int j = 0; j < 4; ++j) { v4u o; o.x = pk2(v[0][j], v[1][j]); o.y = pk2(v[2][j], v[3][j]); o.z = pk2(v[4][j], v[5][j]); o.w = pk2(v[6][j], v[7][j]); __builtin_nontemporal_store(o, (v4u*)(dst + (size_t)j * c.ldk)); }
}
static_assert((64 * 32 + 384 * 32 + 32 * 1024 + 32 * 512) % 128 == 0 && (64 * 64 + 32 * 1024 + 32 * 512) % 128 == 0, "conversion batches of 128 items");
constexpr int CONV_N0 = 122 * 32 + 48 * 8 + 64 * 4, CONV_N1 = 64 * 32 + 384 * 32 + 32 * 1024 + 32 * 512, CONV_N2 = 64 * 64 + 32 * 1024 + 32 * 512;
__device__ __forceinline__ ConvSrc conv_moe_gu(const Args& A, unsigned char* ws, int le, int r) {
    const int nb = r / 32, kb = r % 32, t = nb >> 3, hf = (nb >> 2) & 1, jb = nb & 3;
    return ConvSrc{(hf ? A.in[22] : A.in[21]) + (size_t)le * 2048 * 512 + (size_t)(64 * kb) * 512 + 128 * t + 32 * jb, 512,
                   (bf16*)(ws + WS_W_GU) + (size_t)le * 1024 * 2048 + ((size_t)(t * 32 + kb) * 256 + 32 * (nb & 7)) * 64, 64, nullptr};
}
__device__ __forceinline__ ConvSrc conv_moe_dn(const Args& A, unsigned char* ws, int le, int r) {
    const int nb = r / 8, kb = r % 8;
    return ConvSrc{A.in[23] + (size_t)le * 512 * 2048 + (size_t)(64 * kb) * 2048 + 32 * nb, 2048,
                   (bf16*)(ws + WS_W_DN) + (size_t)le * 2048 * 512 + ((size_t)((nb >> 3) * 8 + kb) * 256 + 32 * (nb & 7)) * 64, 64, nullptr};
}
template <int STREAM> __device__ __forceinline__ ConvSrc conv_item(const Args& A, unsigned char* ws, int it) {
    if (STREAM == 0) {
        if (it < 122 * 32) { const int t = it / 32, kb = it % 32; const int dnb = t < 120 ? t : (t == 120 ? 120 : 124), sc = t < 120 ? 32 * t : (t == 120 ? 3840 : 3872);
            return ConvSrc{A.in[9] + (size_t)(64 * kb) * 3904 + sc, 3904, (bf16*)(ws + WS_W_IN0T) + (size_t)(32 * dnb) * 2048 + 64 * kb, 2048, nullptr}; }
        it -= 122 * 32;
        if (it < 48 * 8) { const int nb = it / 8, kb = it % 8; int sc;
            if (nb < 32) sc = (nb >> 2) * 192 + 32 * (nb & 3);
            else { const int t = (nb - 32) >> 3, blk = (nb - 32) & 7, hf = blk >> 2, hh = blk & 3; sc = (4 * t + hh) * 192 + 128 + 32 * hf; }
            return ConvSrc{A.in[11] + (size_t)(64 * kb) * 1536 + sc, 1536, (bf16*)(ws + WS_W_QUPT) + (size_t)(32 * nb) * 512 + 64 * kb, 512, A.in[10] + 64 * kb}; }
        it -= 48 * 8;
        { const int nb = it / 4, kb = it % 4;
            return ConvSrc{A.in[13] + (size_t)(64 * kb) * 2048 + 32 * nb, 2048, (bf16*)(ws + WS_W_KVUPT) + (size_t)(32 * nb) * 256 + 64 * kb, 256, A.in[12] + 64 * kb}; }
    } else if (STREAM == 1) {
        if (it < 64 * 32) { const int nb = it / 32, kb = it % 32;
            return ConvSrc{A.in[14] + (size_t)(64 * kb) * 2048 + 32 * nb, 2048, (bf16*)(ws + WS_W_OUT0T) + (size_t)(32 * nb) * 2048 + 64 * kb, 2048, nullptr}; }
        it -= 64 * 32;
        if (it < 384 * 32) { const int nb = it / 32, kb = it % 32;
            return ConvSrc{A.in[15] + (size_t)(64 * kb) * 12288 + 32 * nb, 12288, (bf16*)(ws + WS_W_IN1T) + (size_t)(32 * nb) * 2048 + 64 * kb, 2048, nullptr}; }
        it -= 384 * 32;
        if (it < 32 * 1024) return conv_moe_gu(A, ws, it / 1024, it % 1024);
        it -= 32 * 1024;
        return conv_moe_dn(A, ws, it / 512, it % 512);
    } else {
        if (it < 64 * 64) { const int nb = it / 64, kb = it % 64;
            return ConvSrc{A.in[16] + (size_t)(64 * kb) * 2048 + 32 * nb, 2048, (bf16*)(ws + WS_W_OUT1T) + (size_t)(32 * nb) * 4096 + 64 * kb, 4096, nullptr}; }
        it -= 64 * 64;
        if (it < 32 * 1024) return conv_moe_gu(A, ws, 32 + it / 1024, it % 1024);
        it -= 32 * 1024;
        return conv_moe_dn(A, ws, 32 + it / 512, it % 512);
    }
}
template <int STREAM> __device__ __forceinline__ void conv_burst(Frame& F, const Args& A, int lane, int gw, int NGW, int& cur, int n) {
    constexpr int N = STREAM == 0 ? CONV_N0 : (STREAM == 1 ? CONV_N1 : CONV_N2);
#pragma unroll 1
    while (n > 0) {
        const int i0 = gw + NGW * cur; if (i0 >= N) break;
        const int i1 = i0 + NGW; const bool two = n > 1 && i1 < N;
        const ConvSrc c0 = conv_item<STREAM>(A, F.ws, i0); f32x4 v0[8], v1[8];
        conv_load(c0, lane, v0);
        if (two) { const ConvSrc c1 = conv_item<STREAM>(A, F.ws, i1); conv_load(c1, lane, v1); conv_store(c0, lane, v0); conv_store(c1, lane, v1); cur += 2; n -= 2; }
        else { conv_store(c0, lane, v0); cur += 1; n -= 1; }
    }
}

__device__ __forceinline__ void p0a_mod_partials(Frame& F, const Args& A) {
    PHASE_IDS(F);
    const int gw = F.vcu * NWAVES + wave, NGW = F.G * NWAVES;
    LAS float* cond = (LAS float*)(F.lds + RING_OFF);
    for (int i = tid; i < NB_ * D_; i += 512) cond[i] = silu_f(A.in[1][i]);
    __syncthreads();
    float* MODP = (float*)(F.ws + WS_MODP);
    for (int u = gw; u < 1536; u += NGW) {
        const int j = u / 384, r = u % 384, nc = r / 16, kc = r % 16, layer = j >> 1;
        const float* W = ((j & 1) ? A.in[6] : A.in[3]) + (size_t)layer * 2048 * 6144 + (size_t)(kc * 128) * 6144 + nc * 256 + 4 * lane;
        f32x4 acc[4];
#pragma unroll
        for (int b = 0; b < 4; ++b) acc[b] = (f32x4){0.f, 0.f, 0.f, 0.f};
#pragma unroll 32
        for (int k = 0; k < 128; ++k) { const f32x4 w = *(const f32x4*)(W + (size_t)k * 6144);
#pragma unroll
            for (int b = 0; b < 4; ++b) acc[b] += cond[b * 2048 + kc * 128 + k] * w; }
#pragma unroll
        for (int b = 0; b < 4; ++b) *(f32x4*)(MODP + ((size_t)(kc * 16 + j * 4 + b)) * 6144 + nc * 256 + 4 * lane) = acc[b];
    }
    const int gt = F.vcu * 512 + tid, NGT = F.G * 512;
    { int cur = 0; conv_burst<0>(F, A, lane, gw, NGW, cur, 1 << 20); }
#if defined(CONV_IN_PROLOGUE)
    { int cur = 0; conv_burst<1>(F, A, lane, gw, NGW, cur, 1 << 20); }
    { int cur = 0; conv_burst<2>(F, A, lane, gw, NGW, cur, 1 << 20); }
#endif
    { const int* pos = (const int*)A.in[2]; f32x2* t64 = (f32x2*)(F.ws + WS_TAB64); f32x2* t256 = (f32x2*)(F.ws + WS_TAB256);
      for (int idx = gt; idx < T_ * 160; idx += NGT) { const int m = idx / 160, i = idx % 160; const double p = (double)pos[m];
          double fr; if (i < 32) fr = exp(-9.210340371976184 * (double)i / 32.0); else fr = exp(-9.210340371976184 * (double)(i - 32) / 128.0);
          double sn, cs; sincos(p * fr, &sn, &cs); const f32x2 v = {(float)cs, (float)sn};
          if (i < 32) t64[m * 32 + i] = v; else t256[m * 128 + (i - 32)] = v; } }
    { bf16* WS_ = (bf16*)(F.ws + WS_WRS);
      for (int idx = gt; idx < 2 * 2 * 128 * 64 * 8; idx += NGT) { const int j = idx & 7, ln = (idx >> 3) & 63, ks = (idx >> 9) & 127, cb = (idx >> 16) & 1, l = idx >> 17;
          const int k = 16 * ks + 8 * (ln >> 5) + j, c = 32 * cb + (ln & 31);
          const float w = c < 4 ? A.in[17][(size_t)l * 2048 * 4 + k * 4 + c] : (c < 36 ? A.in[19][(size_t)l * 2048 * 32 + k * 32 + (c - 4)] : 0.f);
          const unsigned hi = pk2(w, 0.f) & 0xffffu; const float wh = bf_lo(hi); const unsigned lo = pk2(w - wh, 0.f) & 0xffffu;
          const size_t o = (size_t)l * (2 * 2 * 128 * 512) + (size_t)(cb * 128 + ks) * 512 + ln * 8 + j;
          WS_[o] = (bf16)hi; WS_[o + 2 * 128 * 512] = (bf16)lo; } }
    { float* WR = (float*)(F.ws + WS_WR);
      for (int idx = gt; idx < 2 * 512 * 36 * 4; idx += NGT) { const int q = idx & 3, c = (idx >> 2) % 36, kq = ((idx >> 2) / 36) % 512, l = (idx >> 2) / (36 * 512); const int k = 4 * kq + q;
          WR[idx] = c < 4 ? A.in[17][(size_t)l * 2048 * 4 + k * 4 + c] : A.in[19][(size_t)l * 2048 * 32 + k * 32 + (c - 4)]; } }
}
__device__ __forceinline__ void p0_prologue(Frame& F, const Args& A) {
    PHASE_IDS(F);
    const int gw = F.vcu * NWAVES + wave, NGW = F.G * NWAVES;
    const int gt = F.vcu * 512 + tid, NGT = F.G * 512;
    { float* MOD = (float*)(F.ctl + CW_MOD); const float* MODP = (const float*)(F.ws + WS_MODP);
      for (int idx = gt; idx < 16 * 6144; idx += NGT) { const int j = idx / (4 * 6144), n = idx % 6144; float a = ((j & 1) ? A.in[7] : A.in[4])[(j >> 1) * 6144 + n];
#pragma unroll
          for (int kc = 0; kc < 16; ++kc) a += MODP[(size_t)kc * 16 * 6144 + idx];
          MOD[idx] = a; } }
}

__device__ __forceinline__ void local_mod(Frame& F, const float* bias, int j) {
    PHASE_IDS(F);
    const float* MODP = (const float*)(F.ws + WS_MODP); LAS f32x4* lm = (LAS f32x4*)(F.lds + RING_OFF);
    __syncthreads();
    for (int q = tid; q < 4096; q += 512) { const int b = q >> 10, n = 4 * (q & 1023); f32x4 a = *(const f32x4*)(bias + n);
#pragma unroll
        for (int kc = 0; kc < 16; ++kc) a += *(const f32x4*)(MODP + ((size_t)(kc * 16 + j * 4 + b)) * 6144 + n);
        lm[q] = a; }
    __syncthreads();
}
template <int MODE, bool LM = false> __device__ __forceinline__ void norm_phase(Frame& F, const float* src, float* xdst, const float* gvec, int jn, int jg, int layer_moe) {
    PHASE_IDS(F);
    const int gw = F.vcu * NWAVES + wave, NGW = F.G * NWAVES;
    const float* MOD = (const float*)(F.ctl + CW_MOD);
    bf16* H = (bf16*)(F.ws + WS_H);
    const bf16* Y = (const bf16*)(F.ws + WS_Y);
    const int* RT = (const int*)(F.ws + WS_ROUTE);
    v4u ra = {0u, 0u, 0u, 0u}, rb = {0u, 0u, 0u, 0u};
    if (MODE >= 2) { const int row_l = gw + NGW * lane; if (row_l < T_) { const v4u* rp = (const v4u*)(RT + (size_t)row_l * 8); ra = rp[0]; rb = rp[1]; } }
    for (int row = gw, ri = 0; row < T_; row += NGW, ++ri) {
        const int b = row >> 11;
        f32x4 v[8]; float ss = 0.f;
        const f32x4* xr = (const f32x4*)(src + (size_t)row * D_) + lane;
#pragma unroll
        for (int j = 0; j < 8; ++j) v[j] = xr[64 * j];
        if (MODE >= 2) {
            const int p0 = __shfl((int)rb.x, ri), p1 = __shfl((int)rb.y, ri); const float w0 = __int_as_float(__shfl((int)ra.z, ri)), w1 = __int_as_float(__shfl((int)ra.w, ri));
            const v2u* y0 = (const v2u*)(Y + (size_t)p0 * D_) + lane; const v2u* y1 = (const v2u*)(Y + (size_t)p1 * D_) + lane;
            const f32x4* gt = (const f32x4*)(MOD + (size_t)(jg * 4 + b) * 6144 + 4096) + lane;
#pragma unroll
            for (int j = 0; j < 8; ++j) { const v2u a = y0[64 * j], c = y1[64 * j]; const f32x4 g = gt[64 * j];
                f32x4 m; m.x = w0 * bf_lo(a.x) + w1 * bf_lo(c.x); m.y = w0 * bf_hi(a.x) + w1 * bf_hi(c.x); m.z = w0 * bf_lo(a.y) + w1 * bf_lo(c.y); m.w = w0 * bf_hi(a.y) + w1 * bf_hi(c.y);
                v[j] += g * m; }
            if (MODE == 2) { f32x4* xo = (f32x4*)(xdst + (size_t)row * D_) + lane;
#pragma unroll
                for (int j = 0; j < 8; ++j) xo[64 * j] = v[j]; }
        }
#pragma unroll
        for (int j = 0; j < 8; ++j) ss += (v[j].x * v[j].x + v[j].y * v[j].y) + (v[j].z * v[j].z + v[j].w * v[j].w);
        const float rstd = 1.0f / sqrtf(wave_sum(ss) * (1.0f / D_) + EPS_);
        const f32x4* gv = (const f32x4*)gvec + lane;
        if (MODE == 3) { f32x4* o = (f32x4*)(F.out + (size_t)row * D_) + lane;
#pragma unroll
            for (int j = 0; j < 8; ++j) o[64 * j] = v[j] * rstd * gv[64 * j];
        } else {
            v2u* o = (v2u*)(H + (size_t)row * D_) + lane;
            if (LM) { const LAS f32x4* sh = (const LAS f32x4*)(F.lds + RING_OFF) + b * 1024 + lane; const LAS f32x4* sc = sh + 512;
#pragma unroll
                for (int j = 0; j < 8; ++j) { const f32x4 h = v[j] * rstd * gv[64 * j] * (1.0f + sc[64 * j]) + sh[64 * j]; v2u w; w.x = pk2(h.x, h.y); w.y = pk2(h.z, h.w); o[64 * j] = w; }
            } else { const f32x4* sh = (const f32x4*)(MOD + (size_t)(jn * 4 + b) * 6144) + lane; const f32x4* sc = sh + 512;
#pragma unroll
                for (int j = 0; j < 8; ++j) { const f32x4 h = v[j] * rstd * gv[64 * j] * (1.0f + sc[64 * j]) + sh[64 * j]; v2u w; w.x = pk2(h.x, h.y); w.y = pk2(h.z, h.w); o[64 * j] = w; } }
        }
    }
}

__device__ __forceinline__ void router_phase(Frame& F, const Args& A, const float* X, const float* gvec, int jn, int layer, bool first) {
    const float* MOD = (const float*)(F.ctl + CW_MOD);
    const f32x4* WR4 = (const f32x4*)(F.ws + WS_WR) + (size_t)layer * 512 * 36;
    const bf16* WH = (const bf16*)(F.ws + WS_WRS) + (size_t)layer * (2 * 2 * 128 * 512); const bf16* WL = WH + 2 * 128 * 512;
    int* RT = (int*)(F.ws + WS_ROUTE); float* RS = (float*)(F.ws + WS_RS);
    LAS float* pp = (LAS float*)(F.lds + RING_OFF);
    LAS float* sq = (LAS float*)(F.lds + RING_OFF + 65536);
    LAS float* qq = (LAS float*)(F.lds + RING_OFF + 66560);
    LAS float* lg = (LAS float*)(F.lds + RING_OFF + 67712);
    LAS unsigned* hist = (LAS unsigned*)(F.lds + RING_OFF + 73728);
    PHASE_IDS(F);
    if (tid < 32) hist[tid] = 0u;
    __syncthreads();
#if defined(RT_PROBE)
    const unsigned long long rt_t0 = __builtin_amdgcn_s_memrealtime();
#endif
    const int r = lane & 31, hh = lane >> 5;
    for (int tile = F.vcu; tile < T_ / 32; tile += F.G) {
        const int row0 = tile * 32, b = row0 >> 11;
        const float* shp = MOD + (size_t)(jn * 4 + b) * 6144; const float* scp = shp + 2048;
        f32x16 acc[2];
#pragma unroll
        for (int cb = 0; cb < 2; ++cb)
#pragma unroll
            for (int i = 0; i < 16; ++i) acc[cb][i] = 0.f;
        float ss = 0.f;
        const float* xp = X + (size_t)(row0 + r) * D_ + 256 * wave + 8 * hh; const float* gp = gvec + 256 * wave + 8 * hh; const float* cp = scp + 256 * wave + 8 * hh;
        const bf16* whp = WH + (size_t)(16 * wave) * 512 + lane * 8; const bf16* wlp = WL + (size_t)(16 * wave) * 512 + lane * 8;
#pragma unroll 4
        for (int ks = 0; ks < 16; ++ks) {
            const f32x4 x0 = *(const f32x4*)(xp + 16 * ks), x1 = *(const f32x4*)(xp + 16 * ks + 4);
            const f32x4 g0 = *(const f32x4*)(gp + 16 * ks) * (1.0f + *(const f32x4*)(cp + 16 * ks)), g1 = *(const f32x4*)(gp + 16 * ks + 4) * (1.0f + *(const f32x4*)(cp + 16 * ks + 4));
            const v4u bh0 = *(const v4u*)(whp + 512 * ks), bh1 = *(const v4u*)(whp + 128 * 512 + 512 * ks), bl0 = *(const v4u*)(wlp + 512 * ks), bl1 = *(const v4u*)(wlp + 128 * 512 + 512 * ks);
            ss += (x0.x * x0.x + x0.y * x0.y) + (x0.z * x0.z + x0.w * x0.w) + (x1.x * x1.x + x1.y * x1.y) + (x1.z * x1.z + x1.w * x1.w);
            const f32x4 y0 = x0 * g0, y1 = x1 * g1;
            v4u ah, al; ah.x = pk2(y0.x, y0.y); ah.y = pk2(y0.z, y0.w); ah.z = pk2(y1.x, y1.y); ah.w = pk2(y1.z, y1.w);
            al.x = pk2(y0.x - bf_lo(ah.x), y0.y - bf_hi(ah.x)); al.y = pk2(y0.z - bf_lo(ah.y), y0.w - bf_hi(ah.y)); al.z = pk2(y1.x - bf_lo(ah.z), y1.y - bf_hi(ah.z)); al.w = pk2(y1.z - bf_lo(ah.w), y1.w - bf_hi(ah.w));
            const bf16x8 fah = __builtin_bit_cast(bf16x8, ah), fal = __builtin_bit_cast(bf16x8, al);
            acc[0] = __builtin_amdgcn_mfma_f32_32x32x16_bf16(fah, __builtin_bit_cast(bf16x8, bh0), acc[0], 0, 0, 0); acc[1] = __builtin_amdgcn_mfma_f32_32x32x16_bf16(fah, __builtin_bit_cast(bf16x8, bh1), acc[1], 0, 0, 0);
            acc[0] = __builtin_amdgcn_mfma_f32_32x32x16_bf16(fal, __builtin_bit_cast(bf16x8, bh0), acc[0], 0, 0, 0); acc[1] = __builtin_amdgcn_mfma_f32_32x32x16_bf16(fal, __builtin_bit_cast(bf16x8, bh1), acc[1], 0, 0, 0);
            acc[0] = __builtin_amdgcn_mfma_f32_32x32x16_bf16(fah, __builtin_bit_cast(bf16x8, bl0), acc[0], 0, 0, 0); acc[1] = __builtin_amdgcn_mfma_f32_32x32x16_bf16(fah, __builtin_bit_cast(bf16x8, bl1), acc[1], 0, 0, 0);
        }
#pragma unroll
        for (int cb = 0; cb < 2; ++cb)
#pragma unroll
            for (int i = 0; i < 16; ++i) pp[((wave * 2 + cb) * 16 + i) * 64 + lane] = acc[cb][i];
        ss += __shfl_xor(ss, 32);
        if (hh == 0) sq[wave * 32 + r] = ss;
#if defined(RT_PROBE) && RT_PROBE == 1
        { __syncthreads(); const unsigned long long t1_ = __builtin_amdgcn_s_memrealtime(); while (__builtin_amdgcn_s_memrealtime() - t1_ < t1_ - rt_t0) __builtin_amdgcn_s_sleep(8); }
#endif
        { float q[36]; const f32x4 s4 = *(const f32x4*)(shp + 4 * tid); const f32x4* w = WR4 + (size_t)tid * 36;
#pragma unroll
          for (int c = 0; c < 36; ++c) { const f32x4 w4 = w[c]; q[c] = (s4.x * w4.x + s4.y * w4.y) + (s4.z * w4.z + s4.w * w4.w); }
#pragma unroll
          for (int c = 0; c < 36; ++c) { float a = q[c];
#pragma unroll
              for (int o = 1; o < 64; o <<= 1) a += __shfl_xor(a, o);
              if (lane == 0) qq[wave * 36 + c] = a; } }
        __syncthreads();
#if defined(RT_PROBE) && RT_PROBE == 2
        { const unsigned long long t1_ = __builtin_amdgcn_s_memrealtime(); while (__builtin_amdgcn_s_memrealtime() - t1_ < t1_ - rt_t0) __builtin_amdgcn_s_sleep(8); }
#endif
        for (int e = tid; e < 32 * 36; e += 512) { const int row = e / 36, c = e % 36; const int cb = c >> 5, n = c & 31, h2 = (row >> 2) & 1, i = (row & 3) + 4 * (row >> 3); float a = 0.f;
#pragma unroll
            for (int w = 0; w < 8; ++w) a += pp[((w * 2 + cb) * 16 + i) * 64 + 32 * h2 + n];
            lg[e] = a; }
        if (tid < 36) { float a = 0.f;
#pragma unroll
            for (int w = 0; w < 8; ++w) a += qq[w * 36 + tid];
            lg[1152 + tid] = a; }
        if (tid >= 64 && tid < 96) { const int rr = tid - 64; float a = 0.f;
#pragma unroll
            for (int w = 0; w < 8; ++w) a += sq[w * 32 + rr];
            lg[1188 + rr] = 1.0f / sqrtf(a * (1.0f / D_) + EPS_); }
        __syncthreads();
        if (tid < 32) { const int row = row0 + tid; const LAS float* l = lg + tid * 36; const LAS float* q = lg + 1152; const float* bg = A.in[18] + layer * 4; const float* be = A.in[20] + layer * 32; const float rstd = lg[1188 + tid];
            if (first) RS[row] = rstd;
            float g[4]; int gi = 0; float gm;
#pragma unroll
            for (int i = 0; i < 4; ++i) g[i] = rstd * l[i] + q[i] + bg[i];
            gm = g[0];
#pragma unroll
            for (int i = 1; i < 4; ++i) if (g[i] > gm) { gm = g[i]; gi = i; }
            float gs = 0.f;
#pragma unroll
            for (int i = 0; i < 4; ++i) gs += __expf(g[i] - gm);
            const float gw = 1.0f / gs;
            float e[8];
#pragma unroll
            for (int i = 0; i < 8; ++i) e[i] = rstd * l[4 + 8 * gi + i] + q[4 + 8 * gi + i] + be[8 * gi + i];
            int i0 = 0; float m0 = e[0];
#pragma unroll
            for (int i = 1; i < 8; ++i) if (e[i] > m0) { m0 = e[i]; i0 = i; }
            int i1 = -1; float m1 = -3.0e38f;
#pragma unroll
            for (int i = 0; i < 8; ++i) if (i != i0 && e[i] > m1) { m1 = e[i]; i1 = i; }
            const float p1 = __expf(m1 - m0), w0 = gw / (1.0f + p1), w1 = gw * p1 / (1.0f + p1);
            const int e0 = 8 * gi + i0, e1 = 8 * gi + i1;
            int* rt = RT + (size_t)row * 8; rt[0] = e0; rt[1] = e1; rt[2] = __float_as_int(w0); rt[3] = __float_as_int(w1);
            if (first) { __hip_atomic_fetch_add(hist + e0, 1u, __ATOMIC_RELAXED, __HIP_MEMORY_SCOPE_WORKGROUP); __hip_atomic_fetch_add(hist + e1, 1u, __ATOMIC_RELAXED, __HIP_MEMORY_SCOPE_WORKGROUP); }
        }
        __syncthreads();
        if (first && tid < 32) { const unsigned n = hist[tid]; hist[tid] = 0u; if (n) atomicAdd((unsigned*)(F.ctl + ECNT_IDX(layer, tid)), n); }
        __syncthreads();
    }
}

__device__ __forceinline__ void scatter_phase(Frame& F, const float* X, const float* gvec, int jn, int layer, bool first) {
    LAS int* tab = (LAS int*)(F.lds + MOE_TAB_OFF);
    PHASE_IDS(F);
    const int gw = F.vcu * NWAVES + wave, NGW = F.G * NWAVES;
    const float* MOD = (const float*)(F.ctl + CW_MOD);
    int* RT = (int*)(F.ws + WS_ROUTE); const float* RS = (const float*)(F.ws + WS_RS); bf16* HG = (bf16*)(F.ws + WS_HG);
    int myp0 = 0, myp1 = 0;
    for (int i0 = 0; gw + NGW * i0 < T_; i0 += 4) {
        f32x4 xv[4][8];
#pragma unroll
        for (int i = 0; i < 4; ++i) { const int tok = gw + NGW * (i0 + i); if (tok < T_) { const f32x4* xr = (const f32x4*)(X + (size_t)tok * D_) + 2 * lane;
#pragma unroll
                for (int j = 0; j < 4; ++j) { xv[i][2 * j] = xr[128 * j]; xv[i][2 * j + 1] = xr[128 * j + 1]; } } }
        if (i0 == 0) {
        { const int tok_l = gw + NGW * lane;
          if (tok_l < T_) { int* rt = RT + (size_t)tok_l * 8;
              if (first) { const int e0 = rt[0], e1 = rt[1];
                  myp0 = tab[128 + e0] + (int)atomicAdd((unsigned*)(F.ctl + ECUR_IDX(layer, e0)), 1u);
                  myp1 = tab[128 + e1] + (int)atomicAdd((unsigned*)(F.ctl + ECUR_IDX(layer, e1)), 1u);
                  rt[4] = myp0; rt[5] = myp1; }
              else { myp0 = rt[4]; myp1 = rt[5]; } } }
        }
#pragma unroll
        for (int i = 0; i < 4; ++i) { const int tok = gw + NGW * (i0 + i); if (tok < T_) {
            const int p0 = __shfl(myp0, i0 + i), p1 = __shfl(myp1, i0 + i);
            const float rstd = RS[tok]; const int b = tok >> 11;
            const f32x4* sh = (const f32x4*)(MOD + (size_t)(jn * 4 + b) * 6144) + 2 * lane; const f32x4* sc = sh + 512; const f32x4* gv = (const f32x4*)gvec + 2 * lane;
            v4u* d0 = (v4u*)(HG + (size_t)p0 * D_) + lane; v4u* d1 = (v4u*)(HG + (size_t)p1 * D_) + lane;
#pragma unroll
            for (int j = 0; j < 4; ++j) {
                const f32x4 ha = xv[i][2 * j] * rstd * gv[128 * j] * (1.0f + sc[128 * j]) + sh[128 * j], hb = xv[i][2 * j + 1] * rstd * gv[128 * j + 1] * (1.0f + sc[128 * j + 1]) + sh[128 * j + 1];
                v4u w; w.x = pk2(ha.x, ha.y); w.y = pk2(ha.z, ha.w); w.z = pk2(hb.x, hb.y); w.w = pk2(hb.z, hb.w); d0[64 * j] = w; d1[64 * j] = w; } } }
    }
#if defined(WARM_MOE)
    if (first) { const v4u* w = (const v4u*)(F.ws + WS_W_GU + (size_t)layer * 128 * MiB) + (size_t)gw * 4096 + lane; v4u acc = {0u, 0u, 0u, 0u};
#pragma unroll 16
        for (int i = 0; i < 64; ++i) { const v4u x = w[64 * i]; acc.x ^= x.x; acc.y ^= x.y; acc.z ^= x.z; acc.w ^= x.w; }
        asm volatile("" :: "v"(acc.x), "v"(acc.y), "v"(acc.z), "v"(acc.w)); }
#endif
}

__device__ __forceinline__ void retnorm_phase(Frame& F) {
    PHASE_IDS(F);
    const int gw = F.vcu * NWAVES + wave, NGW = F.G * NWAVES;
    const bf16* O = (const bf16*)(F.ws + WS_RETO); const bf16* P1 = (const bf16*)(F.ws + WS_PROJ1); bf16* A5 = (bf16*)(F.ws + WS_A5);
    for (int row = gw; row < T_; row += NGW) {
        const v4u* o = (const v4u*)(O + (size_t)row * 4096) + lane; const v4u* g = (const v4u*)(P1 + (size_t)row * 12288 + 8192) + lane; v4u* a = (v4u*)(A5 + (size_t)row * 4096) + lane;
#pragma unroll
        for (int h = 0; h < 8; ++h) { const v4u x = o[64 * h], s = g[64 * h];
            float f[8] = {bf_lo(x.x), bf_hi(x.x), bf_lo(x.y), bf_hi(x.y), bf_lo(x.z), bf_hi(x.z), bf_lo(x.w), bf_hi(x.w)};
            float ss = 0.f;
#pragma unroll
            for (int i = 0; i < 8; ++i) ss += f[i] * f[i];
            const float rstd = 1.0f / sqrtf(wave_sum(ss) * (1.0f / 512.0f) + EPS_);
            v4u w; w.x = pk2(f[0] * rstd * bf_lo(s.x), f[1] * rstd * bf_hi(s.x)); w.y = pk2(f[2] * rstd * bf_lo(s.y), f[3] * rstd * bf_hi(s.y));
            w.z = pk2(f[4] * rstd * bf_lo(s.z), f[5] * rstd * bf_hi(s.z)); w.w = pk2(f[6] * rstd * bf_lo(s.w), f[7] * rstd * bf_hi(s.w));
            a[64 * h] = w; }
    }
}
#ifndef ATT_REP
#define ATT_REP 1
#endif
#ifndef RET_REP
#define RET_REP 1
#endif
#ifndef ATT_KPF
#define ATT_KPF 4
#endif
constexpr int ATT_VST = 320;
__device__ __forceinline__ s16x4 vtr(const LAS unsigned char* p) { return __builtin_bit_cast(s16x4, __builtin_amdgcn_ds_read_tr16_b64_v4i16((LAS v4i16_t*)p)); }
__device__ __forceinline__ float xhalf(float v) { return __shfl_xor(v, 32); }

template <int DQK, int MODE>
__device__ __forceinline__ void attn_unit(LAS unsigned char* lds, const bf16* Qp, int qpitch, const bf16* Kp, int kpitch, const bf16* K2p, int k2pitch,
                                          const bf16* Vp, int vpitch, bf16* Op, int opitch, int q0, float dlog2, int tid_, int wave, int lane_, volatile LAS unsigned* flg) {
    const int lane = lane_id_opaque(), tid = wave * 64 + lane; (void)tid_; (void)lane_;
    constexpr int RB = DQK * 2, SW = (DQK == 192) ? 7 : 15, KB = 64 * RB, STG = KB + 16384;
    constexpr int NIK = KB / 8192, NI = NIK + 2;
    constexpr int NKS = DQK / 16;
    static_assert(3 * STG <= RING_BYTES, "three stages in the ring");
    const int r = lane & 31, h = lane >> 5, qrow = q0 + 32 * wave + r;
    bf16x8 qf[NKS];
    { const bf16* qp = Qp + (size_t)qrow * qpitch + 8 * h;
#pragma unroll
      for (int ks = 0; ks < NKS; ++ks) qf[ks] = *(const bf16x8*)(qp + 16 * ks); }
    f32x16 o[4];
#pragma unroll
    for (int db = 0; db < 4; ++db)
#pragma unroll
        for (int i = 0; i < 16; ++i) o[db][i] = 0.f;
    float m_run = -1.0e30f, l_run = 0.f, carry = 0.f;
    const int ntiles = (q0 + 256) >> 6;
    constexpr bool KLIN = (DQK != 192); constexpr int NKG = KLIN ? 1 : NIK;
    unsigned kgo[NKG], vgo0; bool krope[NKG];
#pragma unroll
    for (int j = 0; j < NKG; ++j) { const int pos = (j * 8 + wave) * 1024 + lane * 16, row = pos / RB, c = ((pos % RB) >> 4) ^ (row & SW);
        krope[j] = (DQK == 192) && c >= 16;
        kgo[j] = krope[j] ? (unsigned)(row * k2pitch * 2 + (c - 16) * 16) : (unsigned)(row * kpitch * 2 + c * 16); }
    { const int pos = wave * 1024 + lane * 16, row = pos >> 8, ch = ((pos & 255) >> 4) ^ (((row & 3) << 2) | ((row >> 2) & 3)); vgo0 = (unsigned)(row * vpitch * 2 + ch * 16); }
#define ATT_DMA(kt, stg) do { const size_t key0_ = (size_t)(kt) * 64; \
        const char* kb_ = (const char*)Kp + key0_ * kpitch * 2; const char* k2_ = (const char*)K2p + key0_ * k2pitch * 2; const char* vb_ = (const char*)Vp + key0_ * vpitch * 2; \
        LAS unsigned char* st_ = lds + (stg) * STG + wave * 1024; \
        _Pragma("unroll") for (int j_ = 0; j_ < NIK; ++j_) { const char* g_ = KLIN ? kb_ + kgo[0] + (size_t)j_ * (8192 / RB) * kpitch * 2 : ((krope[KLIN ? 0 : j_] ? k2_ : kb_) + kgo[KLIN ? 0 : j_]); \
            __builtin_amdgcn_global_load_lds((const unsigned*)g_, (LAS unsigned*)(st_ + j_ * 8192), 16, 0, 0); } \
        _Pragma("unroll") for (int j_ = 0; j_ < 2; ++j_) __builtin_amdgcn_global_load_lds((const unsigned*)(vb_ + vgo0 + (size_t)j_ * 32 * vpitch * 2), (LAS unsigned*)(st_ + KB + j_ * 8192), 16, 0, 0); } while (0)
    if (MODE == 1 && tid < 16) flg[tid] = 0u;
    ATT_DMA(ntiles - 1, 0);
    ATT_DMA(ntiles > 1 ? ntiles - 2 : 0, 1);
    const int q4 = (lane & 15) >> 2, p4 = lane & 3, blk = (lane >> 4) & 1, x4 = 2 * blk + (p4 >> 1);
    constexpr int NKO = (SW + 1) / 2;
    const int krow = r * RB, kxy = (r & SW) ^ h;
    const int vlo_off = 256 * (4 * h + q4) + 16 * (x4 ^ h) + 8 * (p4 & 1), vhi_off = 256 * (4 * h + q4 + 8) + 16 * (x4 ^ (h + 2)) + 8 * (p4 & 1);
    for (int it = 0; it < ntiles; ++it) {
        const int kt = ntiles - 1 - it;
        int y_ = kxy, q4_ = q4; asm volatile("" : "+v"(y_), "+v"(q4_));
        const bool wdone = (MODE == 1) && __all(carry < -140.0f);
        if (MODE == 1 && lane == 0) flg[8 * (it & 1) + wave] = wdone ? 1u : 0u;
        asm volatile("s_waitcnt vmcnt(%0)" :: "n"(NI) : "memory");
        asm volatile("s_waitcnt lgkmcnt(0)" ::: "memory");
        __builtin_amdgcn_s_barrier();
        asm volatile("" ::: "memory");
        if (MODE == 1) { v4u fa, fb; const unsigned fad = (unsigned)(size_t)(flg + 8 * (it & 1));
            asm volatile("ds_read_b128 %0, %2\n\tds_read_b128 %1, %2 offset:16\n\ts_waitcnt lgkmcnt(0)" : "=&v"(fa), "=&v"(fb) : "v"(fad) : "memory");
            if ((fa.x & fa.y & fa.z & fa.w & fb.x & fb.y & fb.z & fb.w) != 0u) break; }
        { const int ktn = kt >= 2 ? kt - 2 : 0; ATT_DMA(ktn, (it + 2) % 3); }
        if (!wdone && 64 * kt <= q0 + 32 * wave + 31) {
            const LAS unsigned char* Kb = lds + (it % 3) * STG; const LAS unsigned char* Vb = Kb + KB;
            f32x16 s[2];
            const int kbase = 64 * kt + 4 * h;
            const bool diag = 64 * kt + 63 > q0 + 32 * wave;
            unsigned va[8];
#pragma unroll
            for (int db = 0; db < 4; ++db) { va[db] = (unsigned)(size_t)(Vb + vlo_off + 64 * (db ^ q4_)); va[4 + db] = (unsigned)(size_t)(Vb + vhi_off + 64 * (db ^ q4_)); }
            s16x4 lo_[2][4], hi_[2][4];
#define ATT_VRD(buf, sidx) do { _Pragma("unroll") for (int db = 0; db < 4; ++db) { \
                    asm volatile("ds_read_b64_tr_b16 %0, %1 offset:%c2" : "=&v"(lo_[buf][db]) : "v"(va[db]), "i"(4096 * (sidx)) : "memory"); \
                    asm volatile("ds_read_b64_tr_b16 %0, %1 offset:%c2" : "=&v"(hi_[buf][db]) : "v"(va[4 + db]), "i"(4096 * (sidx)) : "memory"); } } while (0)
#define ATT_VMM(buf, sidx) do { const int kb_ = (sidx) >> 1, ss_ = (sidx) & 1; \
                v4u pw; pw.x = pk2(s[kb_][8 * ss_ + 0], s[kb_][8 * ss_ + 1]); pw.y = pk2(s[kb_][8 * ss_ + 2], s[kb_][8 * ss_ + 3]); pw.z = pk2(s[kb_][8 * ss_ + 4], s[kb_][8 * ss_ + 5]); pw.w = pk2(s[kb_][8 * ss_ + 6], s[kb_][8 * ss_ + 7]); \
                const bf16x8 pf = __builtin_bit_cast(bf16x8, pw); \
                _Pragma("unroll") for (int db = 0; db < 4; ++db) { \
                    const bf16x8 vf = __builtin_shufflevector(lo_[buf][db], hi_[buf][db], 0, 1, 2, 3, 4, 5, 6, 7); \
                    o[db] = __builtin_amdgcn_mfma_f32_32x32x16_bf16(vf, pf, o[db], 0, 0, 0); } } while (0)
#define ATT_PVN(first, count) do { ATT_VRD(0, first); \
                _Pragma("unroll") for (int i_ = 0; i_ < (count); ++i_) { \
                    if (i_ + 1 < (count)) { if (i_ & 1) ATT_VRD(0, (first) + i_ + 1); else ATT_VRD(1, (first) + i_ + 1); asm volatile("s_waitcnt lgkmcnt(8)" ::: "memory"); } \
                    else asm volatile("s_waitcnt lgkmcnt(0)" ::: "memory"); \
                    __builtin_amdgcn_sched_barrier(0); \
                    if (i_ & 1) ATT_VMM(1, (first) + i_); else ATT_VMM(0, (first) + i_); \
                    __builtin_amdgcn_sched_barrier(0); } } while (0)
#pragma unroll
            for (int kb = 0; kb < 2; ++kb) {
#pragma unroll
                for (int i = 0; i < 16; ++i) s[kb][i] = 0.f;
                const LAS unsigned char* kp = Kb + 32 * kb * RB;
#define ATT_KF(ks) (*(const LAS bf16x8*)(kp + krow + (((2 * ((ks) % NKO)) ^ y_) << 4) + (((2 * (ks)) & ~SW) << 4)))
                bf16x8 fa = ATT_KF(0), fb = ATT_KF(1);
#pragma unroll
                for (int g2 = 0; g2 < NKS / 2; ++g2) {
                    bf16x8 na = fa, nb = fb;
                    if (g2 + 1 < NKS / 2) { na = ATT_KF(2 * g2 + 2); nb = ATT_KF(2 * g2 + 3); }
                    __builtin_amdgcn_sched_barrier(0);
                    s[kb] = __builtin_amdgcn_mfma_f32_32x32x16_bf16(fa, qf[2 * g2], s[kb], 0, 0, 0); s[kb] = __builtin_amdgcn_mfma_f32_32x32x16_bf16(fb, qf[2 * g2 + 1], s[kb], 0, 0, 0);
                    __builtin_amdgcn_sched_barrier(0);
                    fa = na; fb = nb;
                }
#undef ATT_KF
                if (MODE == 2) {
                    if (diag) {
#pragma unroll
                        for (int i = 0; i < 16; ++i) { const int key = kbase + 32 * kb + (i & 3) + 8 * (i >> 2); s[kb][i] = key <= qrow ? s[kb][i] : 0.f; } }
                    ATT_PVN(2 * kb, 2);
                }
            }
            if (MODE == 0) {
                float tmax = -1.0e30f;
#pragma unroll
                for (int kb = 0; kb < 2; ++kb)
#pragma unroll
                    for (int i = 0; i < 16; ++i) { const int key = kbase + 32 * kb + (i & 3) + 8 * (i >> 2); const float v = (!diag || key <= qrow) ? s[kb][i] : -1.0e30f; s[kb][i] = v; tmax = fmaxf(tmax, v); }
                tmax = fmaxf(tmax, xhalf(tmax));
                const float m_new = fmaxf(m_run, tmax), alpha = ex2(m_run - m_new); m_run = m_new;
                float ps = 0.f;
#pragma unroll
                for (int kb = 0; kb < 2; ++kb)
#pragma unroll
                    for (int i = 0; i < 16; ++i) { const float p = ex2(s[kb][i] - m_new); s[kb][i] = p; ps += p; }
                l_run = l_run * alpha + ps;
#pragma unroll
                for (int db = 0; db < 4; ++db)
#pragma unroll
                    for (int i = 0; i < 16; ++i) o[db][i] *= alpha;
            } else if (MODE == 1) {
                float lkv[2][16], gs[2][4], go[2][4];
#pragma unroll
                for (int kb = 0; kb < 2; ++kb)
#pragma unroll
                    for (int g = 0; g < 4; ++g) { float t = 0.f;
#pragma unroll
                        for (int j = 0; j < 4; ++j) { const int i = 4 * g + j, key = kbase + 32 * kb + 8 * g + j; const float z = s[kb][i];
                            const bool vis = key < qrow;
                            const float lk = vis ? -(fmaxf(z, 0.f) + lg2(1.0f + ex2(-fabsf(z)))) : 0.f;
                            lkv[kb][i] = lk; s[kb][i] = vis ? z + lk : -1.0e30f; t += lk; }
                        gs[kb][g] = t; }
#pragma unroll
                for (int kb = 0; kb < 2; ++kb)
#pragma unroll
                    for (int g = 0; g < 4; ++g) go[kb][g] = xhalf(gs[kb][g]);
                float R = carry;
#pragma unroll
                for (int kb = 1; kb >= 0; --kb)
#pragma unroll
                    for (int g = 3; g >= 0; --g) {
                        float run = R + (h == 0 ? go[kb][g] : 0.f);
#pragma unroll
                        for (int j = 3; j >= 0; --j) { const int i = 4 * g + j; const float a = ex2(s[kb][i] + run); run += lkv[kb][i]; s[kb][i] = a; }
                        R += gs[kb][g] + go[kb][g];
                    }
                carry = R;
            }
            if (MODE != 2) { ATT_PVN(0, 4); }
#undef ATT_PVN
#undef ATT_VMM
#undef ATT_VRD
        }
    }
#undef ATT_DMA
    asm volatile("s_waitcnt vmcnt(0) lgkmcnt(0)" ::: "memory");
    __builtin_amdgcn_s_barrier();
    asm volatile("" ::: "memory");
    float inv = 1.0f;
    if (MODE == 0) { const float lt = l_run + xhalf(l_run); inv = 1.0f / lt; }
    bf16* op = Op + (size_t)qrow * opitch + 4 * h;
#pragma unroll
    for (int db = 0; db < 4; ++db)
#pragma unroll
        for (int g = 0; g < 4; ++g) { v2u w; w.x = pk2(o[db][4 * g] * inv, o[db][4 * g + 1] * inv); w.y = pk2(o[db][4 * g + 2] * inv, o[db][4 * g + 3] * inv); *(v2u*)(op + 32 * db + 8 * g) = w; }
}

struct WorkQ { gu32* q; int total; int slot; unsigned nxt; };
__device__ __forceinline__ void wq_init(Frame& F, WorkQ& Q, gu32* q, int total, int slot, int lane) {
    Q.q = q; Q.total = total; Q.slot = slot; Q.nxt = 0u;
    if (F.wave == 0 && lane == 0) Q.nxt = __hip_atomic_fetch_add(q, 1u, RLX_AGENT);
}
__device__ __forceinline__ bool wq_take(Frame& F, WorkQ& Q, int lane, int& u) {
    if (F.wave == 0 && lane == 0) F.MISC[Q.slot] = Q.nxt;
    __syncthreads();
    u = (int)F.MISC[Q.slot];
    __syncthreads();
    if (u >= Q.total) return false;
    if (F.wave == 0 && lane == 0) Q.nxt = __hip_atomic_fetch_add(Q.q, 1u, RLX_AGENT);
    return true;
}
template <int STREAM> __device__ __forceinline__ bool conv_batch(Frame& F, const Args& A, WorkQ& Q, int lane, int wave) {
#if defined(CONV_IN_PROLOGUE)
    return false;
#endif
    int b; if (!wq_take(F, Q, lane, b)) return false;
    const int i0 = 128 * b + 16 * wave;
    f32x4 va0[8], va1[8], vb0[8], vb1[8];
    { const ConvSrc c0 = conv_item<STREAM>(A, F.ws, i0), c1 = conv_item<STREAM>(A, F.ws, i0 + 1); conv_load(c0, lane, va0); conv_load(c1, lane, va1); }
#pragma unroll
    for (int p = 0; p < 8; ++p) {
        const ConvSrc c0 = conv_item<STREAM>(A, F.ws, i0 + 2 * p), c1 = conv_item<STREAM>(A, F.ws, i0 + 2 * p + 1);
        if (p + 1 < 8) { const ConvSrc n0 = conv_item<STREAM>(A, F.ws, i0 + 2 * p + 2), n1 = conv_item<STREAM>(A, F.ws, i0 + 2 * p + 3);
            if (p & 1) { conv_load(n0, lane, va0); conv_load(n1, lane, va1); } else { conv_load(n0, lane, vb0); conv_load(n1, lane, vb1); } }
        if (p & 1) { conv_store(c0, lane, vb0); conv_store(c1, lane, vb1); } else { conv_store(c0, lane, va0); conv_store(c1, lane, va1); }
    }
    return true;
}
__device__ __forceinline__ void mla_phase(Frame& F, const Args& A, WorkQ& QC, bool& conv_left) {
    PHASE_IDS(F);
    WorkQ QU; wq_init(F, QU, F.ctl + CW_QMLA, 256, 16, lane);
    if (F.vcu & 1) { for (int i = 0; i < 2 && conv_left; ++i) conv_left = conv_batch<1>(F, A, QC, lane, wave); }
    const bf16* Q = (const bf16*)(F.ws + WS_QMLA); const bf16* KV = (const bf16*)(F.ws + WS_KVMLA); const bf16* KR = (const bf16*)(F.ws + WS_KR); bf16* O = (bf16*)(F.ws + WS_ATTO);
    int u;
    while (wq_take(F, QU, lane, u)) {
        const int qb = 7 - (u >> 5), bh = u & 31, b = bh >> 3, h = bh & 7; const size_t r0 = (size_t)b * S_;
#pragma unroll 1
        for (int rep_ = 0; rep_ < ATT_REP; ++rep_)
        attn_unit<192, 0>(F.lds + RING_OFF, Q + r0 * 1536 + h * 192, 1536, KV + r0 * 2048 + h * 256, 2048, KR + r0 * 64, 64, KV + r0 * 2048 + h * 256 + 128, 2048,
                          O + r0 * 2048 + 1024 + h * 128, 2048, qb * 256, 0.f, tid, wave, lane, F.MISC + 32);
        if (conv_left) conv_left = conv_batch<1>(F, A, QC, lane, wave);
    }
}
__device__ __forceinline__ void sb_phase(Frame& F, const Args& A, WorkQ& QC, bool& conv_left) {
    PHASE_IDS(F);
    WorkQ QU; wq_init(F, QU, F.ctl + CW_QSB, 256, 17, lane);
    const bf16* P0 = (const bf16*)(F.ws + WS_PROJ0); bf16* O = (bf16*)(F.ws + WS_ATTO);
    int u;
    while (wq_take(F, QU, lane, u)) {
        const int qb = 7 - (u >> 5), bh = u & 31, b = bh >> 3, h = bh & 7; const size_t r0 = (size_t)b * S_;
#pragma unroll 1
        for (int rep_ = 0; rep_ < ATT_REP; ++rep_)
        attn_unit<128, 1>(F.lds + RING_OFF, P0 + r0 * 4096 + h * 128, 4096, P0 + r0 * 4096 + 1024 + h * 128, 4096, nullptr, 0, P0 + r0 * 4096 + 2048 + h * 128, 4096,
                          O + r0 * 2048 + h * 128, 2048, qb * 256, 0.f, tid, wave, lane, F.MISC + 32);
        if (conv_left) conv_left = conv_batch<1>(F, A, QC, lane, wave);
    }
    while (conv_left) conv_left = conv_batch<1>(F, A, QC, lane, wave);
}
__device__ __forceinline__ void ret_phase(Frame& F, const Args& A) {
    PHASE_IDS(F);
    WorkQ QC; wq_init(F, QC, F.ctl + CW_QC2, CONV_N2 / 128, 18, lane); bool conv_left = true;
    WorkQ QU; wq_init(F, QU, F.ctl + CW_QRET, 1024, 16, lane);
    if (F.vcu & 1) conv_left = conv_batch<2>(F, A, QC, lane, wave);
    const bf16* P1 = (const bf16*)(F.ws + WS_PROJ1); bf16* O = (bf16*)(F.ws + WS_RETO);
    int u;
    while (wq_take(F, QU, lane, u)) {
        const int qb = 7 - (u >> 7), rem = u & 127, eq = rem >> 5, bh = rem & 31, b = bh >> 3, h = bh & 7; const size_t r0 = (size_t)b * S_;
        const float dlog2 = log1pf(-exp2f(-5.0f - (float)h)) * LOG2E;
#pragma unroll 1
        for (int rep_ = 0; rep_ < RET_REP; ++rep_)
        attn_unit<256, 2>(F.lds + RING_OFF, P1 + r0 * 12288 + h * 256, 12288, P1 + r0 * 12288 + 2048 + h * 256, 12288, nullptr, 0, P1 + r0 * 12288 + 4096 + h * 512 + eq * 128, 12288,
                          O + r0 * 4096 + h * 512 + eq * 128, 4096, qb * 256, dlog2, tid, wave, lane, F.MISC + 32);
        if (conv_left && (u & 1)) conv_left = conv_batch<2>(F, A, QC, lane, wave);
    }
    while (conv_left) conv_left = conv_batch<2>(F, A, QC, lane, wave);
}
typedef f32x4 AccT[2][2][4][2];
__device__ __forceinline__ v4u pack8(const f32x4& a, const f32x4& b) { v4u w; w.x = pk2(a.x, a.y); w.y = pk2(a.z, a.w); w.z = pk2(b.x, b.y); w.w = pk2(b.z, b.w); return w; }
__device__ __forceinline__ float sq4(const f32x4& a) { return (a.x * a.x + a.y * a.y) + (a.z * a.z + a.w * a.w); }
__device__ __forceinline__ void rope4(const f32x4& x1, const f32x4& x2, const f32x2* cs, f32x4& o1, f32x4& o2) {
    const f32x4 c01 = *(const f32x4*)cs, c23 = *(const f32x4*)(cs + 2);
    o1.x = x1.x * c01.x - x2.x * c01.y; o2.x = x1.x * c01.y + x2.x * c01.x;
    o1.y = x1.y * c01.z - x2.y * c01.w; o2.y = x1.y * c01.w + x2.y * c01.z;
    o1.z = x1.z * c23.x - x2.z * c23.y; o2.z = x1.z * c23.y + x2.z * c23.x;
    o1.w = x1.w * c23.z - x2.w * c23.w; o2.w = x1.w * c23.w + x2.w * c23.z;
}
struct EpiG1 { static constexpr bool PERM = true, AFTER_DRAIN = false;
    bf16* P0; bf16* KR; float* ssqp; const f32x2* cs64;
    __device__ __forceinline__ void operator()(const AccT& acc, const pg8::Unit& u, int wr, int wc, int fr, int fq) const {
        const int row0 = u.pm * 256 + wr * 64 + fr, tc = wc * 32 + 8 * fq;
        if (u.pn < 15) {
            const float scl = u.pn < 4 ? C_SB : 1.0f;
#pragma unroll
            for (int ai = 0; ai < 2; ++ai)
#pragma unroll
                for (int m = 0; m < 4; ++m) { const int row = row0 + ai * 128 + m * 16; float ss = 0.f;
#pragma unroll
                    for (int bj = 0; bj < 2; ++bj) { const f32x4 v0 = acc[ai][bj][m][0], v1 = acc[ai][bj][m][1]; ss += sq4(v0) + sq4(v1);
                        *(v4u*)(P0 + (size_t)row * 4096 + u.pn * 256 + bj * 128 + tc) = pack8(v0 * scl, v1 * scl); }
                    if (u.pn >= 12) { ss += __shfl_xor(ss, 16); ss += __shfl_xor(ss, 32); if (fq == 0) { if (u.pn < 14) ssqp[(size_t)row * 8 + 4 * (u.pn - 12) + wc] = ss; else ssqp[(size_t)T_ * 8 + (size_t)row * 4 + wc] = ss; } } }
        } else if (wc == 0) {
#pragma unroll
            for (int ai = 0; ai < 2; ++ai)
#pragma unroll
                for (int m = 0; m < 4; ++m) { const int row = row0 + ai * 128 + m * 16; f32x4 a0, b0, a1, b1;
                    rope4(acc[ai][0][m][0], acc[ai][1][m][0], cs64 + (size_t)row * 32 + 8 * fq, a0, b0);
                    rope4(acc[ai][0][m][1], acc[ai][1][m][1], cs64 + (size_t)row * 32 + 8 * fq + 4, a1, b1);
                    *(v4u*)(KR + (size_t)row * 64 + 8 * fq) = pack8(a0, a1); *(v4u*)(KR + (size_t)row * 64 + 32 + 8 * fq) = pack8(b0, b1); asm volatile("" ::: "memory"); }
        }
    }
};
struct EpiG2q { static constexpr bool PERM = true, AFTER_DRAIN = false;
    bf16* Q; const float* ssq; const f32x2* cs64;
    __device__ __forceinline__ void operator()(const AccT& acc, const pg8::Unit& u, int wr, int wc, int fr, int fq) const {
        const int row0 = u.pm * 256 + wr * 64 + fr, tc = wc * 32 + 8 * fq;
        if (u.pn < 4) {
#pragma unroll
            for (int ai = 0; ai < 2; ++ai)
#pragma unroll
                for (int m = 0; m < 4; ++m) { const int row = row0 + ai * 128 + m * 16; const f32x4 pa = *(const f32x4*)(ssq + (size_t)row * 8), pb = *(const f32x4*)(ssq + (size_t)row * 8 + 4); const float rs = C_MLA * __builtin_amdgcn_rsqf(((((((pa.x + pa.y) + pa.z) + pa.w) + pb.x) + pb.y) + pb.z + pb.w) * (1.0f / 512.0f) + EPS_);
#pragma unroll
                    for (int bj = 0; bj < 2; ++bj) { const int nidx = u.pn * 256 + bj * 128 + tc, hh = nidx >> 7, d = nidx & 127;
                        *(v4u*)(Q + (size_t)row * 1536 + hh * 192 + d) = pack8(acc[ai][bj][m][0] * rs, acc[ai][bj][m][1] * rs); }
                    asm volatile("" ::: "memory"); }
        } else {
            const int head = 4 * (u.pn - 4) + wc;
#pragma unroll
            for (int ai = 0; ai < 2; ++ai)
#pragma unroll
                for (int m = 0; m < 4; ++m) { const int row = row0 + ai * 128 + m * 16; const f32x4 pa = *(const f32x4*)(ssq + (size_t)row * 8), pb = *(const f32x4*)(ssq + (size_t)row * 8 + 4); const float rs = C_MLA * __builtin_amdgcn_rsqf(((((((pa.x + pa.y) + pa.z) + pa.w) + pb.x) + pb.y) + pb.z + pb.w) * (1.0f / 512.0f) + EPS_); f32x4 a0, b0, a1, b1;
                    rope4(acc[ai][0][m][0] * rs, acc[ai][1][m][0] * rs, cs64 + (size_t)row * 32 + 8 * fq, a0, b0);
                    rope4(acc[ai][0][m][1] * rs, acc[ai][1][m][1] * rs, cs64 + (size_t)row * 32 + 8 * fq + 4, a1, b1);
                    *(v4u*)(Q + (size_t)row * 1536 + head * 192 + 128 + 8 * fq) = pack8(a0, a1); *(v4u*)(Q + (size_t)row * 1536 + head * 192 + 160 + 8 * fq) = pack8(b0, b1);
                    asm volatile("" ::: "memory"); }
        }
    }
};
struct EpiG2kv { static constexpr bool PERM = true, AFTER_DRAIN = false;
    bf16* KV; const float* ssq;
    __device__ __forceinline__ void operator()(const AccT& acc, const pg8::Unit& u, int wr, int wc, int fr, int fq) const {
        const int row0 = u.pm * 256 + wr * 64 + fr, tc = wc * 32 + 8 * fq;
#pragma unroll
        for (int ai = 0; ai < 2; ++ai)
#pragma unroll
            for (int m = 0; m < 4; ++m) { const int row = row0 + ai * 128 + m * 16; const f32x4 pa = *(const f32x4*)(ssq + (size_t)row * 4); const float rs = __builtin_amdgcn_rsqf((((pa.x + pa.y) + pa.z) + pa.w) * (1.0f / 256.0f) + EPS_);
#pragma unroll
                for (int bj = 0; bj < 2; ++bj) *(v4u*)(KV + (size_t)row * 2048 + u.pn * 256 + bj * 128 + tc) = pack8(acc[ai][bj][m][0] * rs, acc[ai][bj][m][1] * rs); asm volatile("" ::: "memory"); }
    }
};
struct EpiRes { static constexpr bool PERM = false, AFTER_DRAIN = false;
    const float* src; float* dst; const float* gate;
    __device__ __forceinline__ void operator()(const AccT& acc, const pg8::Unit& u, int wr, int wc, int fr, int fq) const {
        const int row0 = u.pm * 256 + wr * 64 + fr, col0 = u.pn * 256 + wc * 32 + 4 * fq;
        const float* g = gate + (size_t)((u.pm * 256) >> 11) * 6144 + col0;
        f32x4 gv[2][2];
#pragma unroll
        for (int bj = 0; bj < 2; ++bj)
#pragma unroll
            for (int n = 0; n < 2; ++n) gv[bj][n] = *(const f32x4*)(g + bj * 128 + n * 16);
#pragma unroll
        for (int ai = 0; ai < 2; ++ai)
#pragma unroll
            for (int mp = 0; mp < 2; ++mp) {
                f32x4 sv[2][2][2];
#pragma unroll
                for (int mm = 0; mm < 2; ++mm) { const size_t off = (size_t)(row0 + ai * 128 + (2 * mp + mm) * 16) * 2048 + col0;
#pragma unroll
                    for (int bj = 0; bj < 2; ++bj)
#pragma unroll
                        for (int n = 0; n < 2; ++n) sv[mm][bj][n] = *(const f32x4*)(src + off + bj * 128 + n * 16); }
#pragma unroll
                for (int mm = 0; mm < 2; ++mm) { const int m = 2 * mp + mm; const size_t off = (size_t)(row0 + ai * 128 + m * 16) * 2048 + col0;
#pragma unroll
                    for (int bj = 0; bj < 2; ++bj)
#pragma unroll
                        for (int n = 0; n < 2; ++n) *(f32x4*)(dst + off + bj * 128 + n * 16) = sv[mm][bj][n] + gv[bj][n] * acc[ai][bj][m][n]; }
                asm volatile("" ::: "memory"); }
    }
};
struct EpiG4 { static constexpr bool PERM = true, AFTER_DRAIN = false;
    bf16* P1; const f32x2* cs256;
    __device__ __forceinline__ void operator()(const AccT& acc, const pg8::Unit& u, int wr, int wc, int fr, int fq) const {
        const int row0 = u.pm * 256 + wr * 64 + fr, tc = wc * 32 + 8 * fq;
#pragma unroll
        for (int ai = 0; ai < 2; ++ai)
#pragma unroll
            for (int m = 0; m < 4; ++m) { const int row = row0 + ai * 128 + m * 16; bf16* dst = P1 + (size_t)row * 12288 + u.pn * 256 + tc;
                if (u.pn < 16) {
                    const float dl2 = log1pf(-exp2f(-5.0f - (float)(u.pn & 7))) * LOG2E, rel = (float)((row & 2047) - 1024);
                    const float scl = u.pn >= 8 ? 0.0625f * ex2(-dl2 * rel) : ex2(dl2 * rel); f32x4 a0, b0, a1, b1;
                    rope4(acc[ai][0][m][0] * scl, acc[ai][1][m][0] * scl, cs256 + (size_t)row * 128 + tc, a0, b0);
                    rope4(acc[ai][0][m][1] * scl, acc[ai][1][m][1] * scl, cs256 + (size_t)row * 128 + tc + 4, a1, b1);
                    *(v4u*)dst = pack8(a0, a1); *(v4u*)(dst + 128) = pack8(b0, b1);
                } else if (u.pn < 32) {
#pragma unroll
                    for (int bj = 0; bj < 2; ++bj) *(v4u*)(dst + bj * 128) = pack8(acc[ai][bj][m][0], acc[ai][bj][m][1]);
                } else {
#pragma unroll
                    for (int bj = 0; bj < 2; ++bj) { f32x4 v0 = acc[ai][bj][m][0], v1 = acc[ai][bj][m][1];
                        v0.x = silu_f(v0.x); v0.y = silu_f(v0.y); v0.z = silu_f(v0.z); v0.w = silu_f(v0.w); v1.x = silu_f(v1.x); v1.y = silu_f(v1.y); v1.z = silu_f(v1.z); v1.w = silu_f(v1.w);
                        *(v4u*)(dst + bj * 128) = pack8(v0, v1); }
                } asm volatile("" ::: "memory"); }
    }
};
struct EpiM3 { static constexpr bool PERM = true, AFTER_DRAIN = false;
    bf16* ACT;
    __device__ __forceinline__ void operator()(const AccT& acc, const pg8::Unit& u, int wr, int wc, int fr, int fq) const {
        const int row0 = u.pm * 256 + wr * 64 + fr, tc = wc * 32 + 8 * fq;
#pragma unroll
        for (int ai = 0; ai < 2; ++ai)
#pragma unroll
            for (int m = 0; m < 4; ++m) { const int row = row0 + ai * 128 + m * 16; const f32x4 g0 = acc[ai][0][m][0], g1 = acc[ai][0][m][1], u0 = acc[ai][1][m][0], u1 = acc[ai][1][m][1]; f32x4 a0, a1;
                a0.x = silu_f(g0.x) * u0.x; a0.y = silu_f(g0.y) * u0.y; a0.z = silu_f(g0.z) * u0.z; a0.w = silu_f(g0.w) * u0.w;
                a1.x = silu_f(g1.x) * u1.x; a1.y = silu_f(g1.y) * u1.y; a1.z = silu_f(g1.z) * u1.z; a1.w = silu_f(g1.w) * u1.w;
                *(v4u*)(ACT + (size_t)row * 512 + u.pn * 128 + tc) = pack8(a0, a1); }
    }
};
struct EpiM4 { static constexpr bool PERM = true, AFTER_DRAIN = false;
    bf16* Y;
    __device__ __forceinline__ void operator()(const AccT& acc, const pg8::Unit& u, int wr, int wc, int fr, int fq) const {
        const int row0 = u.pm * 256 + wr * 64 + fr, tc = wc * 32 + 8 * fq;
#pragma unroll
        for (int ai = 0; ai < 2; ++ai)
#pragma unroll
            for (int m = 0; m < 4; ++m) { const int row = row0 + ai * 128 + m * 16;
#pragma unroll
                for (int bj = 0; bj < 2; ++bj) *(v4u*)(Y + (size_t)row * 2048 + u.pn * 256 + bj * 128 + tc) = pack8(acc[ai][bj][m][0], acc[ai][bj][m][1]); }
    }
};
__device__ __forceinline__ void moe_tables(Frame& F, int layer) {
    LAS int* tab = (LAS int*)(F.lds + MOE_TAB_OFF);
    __syncthreads();
    if (F.wave == 0) { const int lane = lane_id_opaque();
        const int cnt = lane < 32 ? (int)__hip_atomic_load(F.ctl + ECNT_IDX(layer, lane), RLX_AGENT) : 0; const int nt = (cnt + 255) >> 8;
        int incl = nt;
#pragma unroll
        for (int off = 1; off < 32; off <<= 1) { const int v = __shfl_up(incl, off); if (lane >= off) incl += v; }
        const int start = incl - nt;
        if (lane < 32) { tab[128 + lane] = 256 * start; for (int i = 0; i < nt && start + i < 96; ++i) tab[start + i] = lane; }
        if (lane == 31) tab[160] = incl < 96 ? incl : 96; }
    __syncthreads();
}

#ifndef PH_MASK
#define PH_MASK 0x7FFFFFu
#endif
#ifndef PH_DUP
#define PH_DUP 0u
#endif
#define REP(k) _Pragma("unroll 1") for (int rep_ = 0; rep_ < ((((PH_DUP) >> (k)) & 1u) ? 2 : 1); ++rep_)
#define IN(k) (((PH_MASK >> (k)) & 1u) && lo <= (k) && (k) < hi)
#ifndef PH_DELAY
#define PH_DELAY 0u
#endif
#if PH_DELAY
#define PH_MARK() do { ph_t0 = __builtin_amdgcn_s_memrealtime(); } while (0)
#define PH_IDLE(k) do { if (((PH_DELAY) >> (k)) & 1u) { __syncthreads(); const unsigned long long t1_ = __builtin_amdgcn_s_memrealtime(); while (__builtin_amdgcn_s_memrealtime() - t1_ < t1_ - ph_t0) __builtin_amdgcn_s_sleep(8); } } while (0)
#else
#define PH_MARK() do { } while (0)
#define PH_IDLE(k) do { } while (0)
#endif
#define SEAM(k) do { PH_IDLE(k); if (IN(k) && IN((k) + 1)) xcd_barrier(bar, F.wave); PH_MARK(); } while (0)
__device__ __forceinline__ int moe_split(int TM) { int ta = TM - 32; const int half = (TM + 1) >> 1; if (ta < half) ta = half; if (ta > 64) ta = 64; return ta; }
template <int LAYER, int PB> __device__ __forceinline__ void moe_phases(Frame& F, const Args& args, const XcdBarrier& bar, int lo, int hi, unsigned long long& ph_t0) {
    unsigned char* ws = F.ws; LAS unsigned char* ring = F.lds + RING_OFF; const int c = (int)blockIdx.x;
    if (IN(PB)) { router_phase(F, args, (const float*)(ws + WS_XA), args.in[8] + LAYER * 2048, 2 * LAYER + 1, LAYER, true);
#if defined(ROUTER_TWICE)
        router_phase(F, args, (const float*)(ws + WS_XA), args.in[8] + LAYER * 2048, 2 * LAYER + 1, LAYER, false);
#endif
    } SEAM(PB);
    if (IN(PB + 1)) { moe_tables(F, LAYER); scatter_phase(F, (const float*)(ws + WS_XA), args.in[8] + LAYER * 2048, 2 * LAYER + 1, LAYER, true);
#if defined(SCATTER_TWICE)
        scatter_phase(F, (const float*)(ws + WS_XA), args.in[8] + LAYER * 2048, 2 * LAYER + 1, LAYER, false);
#endif
    } SEAM(PB + 1);
    if (IN(PB + 2)) {
        if (MK_MULTI) moe_tables(F, LAYER);     const LAS int* tab = (const LAS int*)(F.lds + MOE_TAB_OFF); const int TM = tab[160], TA = moe_split(TM);
        pg8::Gemm g{2048, 2048, 64, 128, 32768}; pg8::MoeOrder S; S.ntn = 4; S.t0 = 0; S.nunits = TA * 4; S.gdeal = F.G; S.busy = 0; S.G = F.G; S.c = c; S.A = (const char*)(ws + WS_HG); S.W = (const char*)(ws + WS_W_GU + (size_t)LAYER * 128 * MiB);
        S.tstepA = (size_t)256 * 2048 * 2; S.tstepB = (size_t)256 * 2048 * 2; S.estep = (size_t)1024 * 2048 * 2; S.tile_expert = tab;
        EpiM3 E{(bf16*)(ws + WS_ACT)};
        pg8::gemm_phase<EpiM3, pg8::MoeOrder, true, true>(ring, g, S, E, F.wave);
#if defined(M3_TWICE)
        pg8::gemm_phase<EpiM3, pg8::MoeOrder, true, true>(ring, g, S, E, F.wave);
#endif
    } SEAM(PB + 2);
    if (IN(PB + 3)) {
        if (MK_MULTI) moe_tables(F, LAYER);     const LAS int* tab = (const LAS int*)(F.lds + MOE_TAB_OFF); const int TM = tab[160], TA = moe_split(TM), nb3 = (TM - TA) * 4;
        { pg8::Gemm g{2048, 2048, 64, 128, 32768}; pg8::MoeOrder S; S.ntn = 4; S.t0 = TA; S.nunits = nb3; S.gdeal = nb3 < F.G ? nb3 : F.G; S.busy = 0; S.G = F.G; S.c = c; S.A = (const char*)(ws + WS_HG); S.W = (const char*)(ws + WS_W_GU + (size_t)LAYER * 128 * MiB);
          S.tstepA = (size_t)256 * 2048 * 2; S.tstepB = (size_t)256 * 2048 * 2; S.estep = (size_t)1024 * 2048 * 2; S.tile_expert = tab;
          EpiM3 E{(bf16*)(ws + WS_ACT)};
          pg8::gemm_phase<EpiM3, pg8::MoeOrder, true, true>(ring, g, S, E, F.wave); }
        { pg8::Gemm g{512, 512, 64, 128, 32768}; pg8::MoeOrder S; S.ntn = 8; S.t0 = 0; S.nunits = TA * 8; S.gdeal = F.G; S.busy = (nb3 > 0 && nb3 < F.G) ? nb3 : 0; S.G = F.G; S.c = c; S.A = (const char*)(ws + WS_ACT); S.W = (const char*)(ws + WS_W_DN + (size_t)LAYER * 64 * MiB);
          S.tstepA = (size_t)256 * 512 * 2; S.tstepB = (size_t)256 * 512 * 2; S.estep = (size_t)2048 * 512 * 2; S.tile_expert = tab;
          EpiM4 E{(bf16*)(ws + WS_Y)};
          pg8::gemm_phase<EpiM4, pg8::MoeOrder, true, true>(ring, g, S, E, F.wave); }
    } SEAM(PB + 3);
    if (IN(PB + 4)) {
        if (MK_MULTI) moe_tables(F, LAYER);     const LAS int* tab = (const LAS int*)(F.lds + MOE_TAB_OFF); const int TM = tab[160], TA = moe_split(TM);
        pg8::Gemm g{512, 512, 64, 128, 32768}; pg8::MoeOrder S; S.ntn = 8; S.t0 = TA; S.nunits = (TM - TA) * 8; S.gdeal = F.G; S.busy = 0; S.G = F.G; S.c = c; S.A = (const char*)(ws + WS_ACT); S.W = (const char*)(ws + WS_W_DN + (size_t)LAYER * 64 * MiB);
        S.tstepA = (size_t)256 * 512 * 2; S.tstepB = (size_t)256 * 512 * 2; S.estep = (size_t)2048 * 512 * 2; S.tile_expert = tab;
        EpiM4 E{(bf16*)(ws + WS_Y)};
        pg8::gemm_phase<EpiM4, pg8::MoeOrder, true, true>(ring, g, S, E, F.wave);
#if defined(M4_TWICE)
        pg8::gemm_phase<EpiM4, pg8::MoeOrder, true, true>(ring, g, S, E, F.wave);
#endif
    } SEAM(PB + 4);
}
__global__ void __launch_bounds__(NWAVES * 64, 2) mk_fwd(Args args) {
    extern __shared__ __attribute__((aligned(16))) unsigned char lds[];
    Frame F;
    F.lds = (LAS unsigned char*)lds;
    F.MISC = (volatile LAS unsigned*)(F.lds + MISC_OFF);
    F.wave = __builtin_amdgcn_readfirstlane((int)threadIdx.x >> 6);
    F.G = gridDim.x; { const int bx = blockIdx.x; F.vcu = (F.G % 8 == 0) ? (bx % 8) * (F.G / 8) + bx / 8 : bx; }
    F.ws = args.ws; F.ctl = (gu32*)(args.ws + WS_CTL); F.out = args.out;
    for (int u = threadIdx.x; u < (LDS_BYTES - LDSCTL_OFF) / 4; u += NWAVES * 64) ((LAS unsigned*)(F.lds + LDSCTL_OFF))[u] = 0u;
    __syncthreads();
    XcdBarrier bar; bar.bar = (unsigned*)(F.ctl + CW_BAR); bar.x = 0; bar.st = nullptr;
    if (!MK_MULTI) bar = xcd_barrier_post((unsigned*)(F.ctl + CW_BAR), F.MISC + 8, F.wave);
    const int lo = args.ph_lo, hi = args.ph_hi;
    unsigned long long ph_t0 = 0ull; PH_MARK(); (void)ph_t0;
    unsigned char* ws = args.ws;
    const float* MOD = (const float*)(F.ctl + CW_MOD);
    LAS unsigned char* ring = F.lds + RING_OFF;
    const int c = (int)blockIdx.x;

    if (IN(0)) REP(0) { p0a_mod_partials(F, args); } SEAM(0);
    if (IN(1)) REP(1) { p0_prologue(F, args); local_mod(F, args.in[4], 0); norm_phase<0, true>(F, args.in[0], nullptr, args.in[5], 0, 0, 0); } SEAM(1);
    if (IN(3)) REP(3) {
        pg8::Gemm g{2048, 2048, 2048}; pg8::StaticOrder S; S.init(T_, 4096, F.G, c, ws + WS_H, 2048, ws + WS_W_IN0T, 2048);
        EpiG1 E{(bf16*)(ws + WS_PROJ0), (bf16*)(ws + WS_KR), (float*)(ws + WS_SSQP), (const f32x2*)(ws + WS_TAB64)};
        pg8::gemm_phase<EpiG1, pg8::StaticOrder, true, true>(ring, g, S, E, F.wave);
    } SEAM(3);
    if (IN(4)) REP(4) {
        { pg8::Gemm g{512, 4096, 512}; pg8::StaticOrder S; S.init(T_, 1536, F.G, c, ws + WS_PROJ0 + 3072 * 2, 4096, ws + WS_W_QUPT, 512);
          EpiG2q E{(bf16*)(ws + WS_QMLA), (const float*)(ws + WS_SSQP), (const f32x2*)(ws + WS_TAB64)};
          pg8::gemm_phase<EpiG2q, pg8::StaticOrder, true, true>(ring, g, S, E, F.wave); }
        { pg8::Gemm g{256, 4096, 256}; pg8::StaticOrder S; S.init(T_, 2048, F.G, c, ws + WS_PROJ0 + 3584 * 2, 4096, ws + WS_W_KVUPT, 256);
          EpiG2kv E{(bf16*)(ws + WS_KVMLA), (const float*)(ws + WS_SSQP) + (size_t)T_ * 8};
          pg8::gemm_phase<EpiG2kv, pg8::StaticOrder, true, true>(ring, g, S, E, F.wave); }
    } SEAM(4);
    if (IN(5)) REP(5) { bool conv_left = true; WorkQ QC; wq_init(F, QC, F.ctl + CW_QC1, CONV_N1 / 128, 18, lane_id_opaque()); mla_phase(F, args, QC, conv_left); sb_phase(F, args, QC, conv_left); } SEAM(5);
    if (IN(6)) REP(6) {
        pg8::Gemm g{2048, 2048, 2048}; pg8::StaticOrder S; S.init(T_, 2048, F.G, c, ws + WS_ATTO, 2048, ws + WS_W_OUT0T, 2048);
        EpiRes E{args.in[0], (float*)(ws + WS_XA), MOD + (size_t)(0 * 4) * 6144 + 4096};
        pg8::gemm_phase<EpiRes, pg8::StaticOrder, true, true>(ring, g, S, E, F.wave);
    } SEAM(6);
    moe_phases<0, 7>(F, args, bar, lo, hi, ph_t0);
    if (IN(12)) REP(12) { norm_phase<2>(F, (const float*)(ws + WS_XA), (float*)(ws + WS_XB), args.in[5] + 2048, 2, 1, 0); } SEAM(12);
    if (IN(13)) REP(13) {
        pg8::Gemm g{2048, 2048, 2048}; pg8::StaticOrder S; S.init(T_, 12288, F.G, c, ws + WS_H, 2048, ws + WS_W_IN1T, 2048);
        EpiG4 E{(bf16*)(ws + WS_PROJ1), (const f32x2*)(ws + WS_TAB256)};
        pg8::gemm_phase<EpiG4, pg8::StaticOrder, true, true>(ring, g, S, E, F.wave);
    } SEAM(13);
    if (IN(14)) REP(14) { ret_phase(F, args); } SEAM(14);
    if (IN(15)) REP(15) { retnorm_phase(F); } SEAM(15);
    if (IN(16)) REP(16) {
        pg8::Gemm g{4096, 4096, 4096}; pg8::StaticOrder S; S.init(T_, 2048, F.G, c, ws + WS_A5, 4096, ws + WS_W_OUT1T, 4096);
        EpiRes E{(const float*)(ws + WS_XB), (float*)(ws + WS_XA), MOD + (size_t)(2 * 4) * 6144 + 4096};
        pg8::gemm_phase<EpiRes, pg8::StaticOrder, true, true>(ring, g, S, E, F.wave);
    } SEAM(16);
    moe_phases<1, 17>(F, args, bar, lo, hi, ph_t0);
    if (IN(22)) REP(22) { norm_phase<3>(F, (const float*)(ws + WS_XA), nullptr, args.in[24], 0, 3, 1); }
    PH_IDLE(22);
}
#undef IN
#undef SEAM

extern "C" void kernel_launch(void* const* d_in, const int* in_sizes, int n_in, void* d_out, int out_size, void* d_ws, size_t ws_size, hipStream_t stream) {
    static int grid = 0;
    if (grid == 0) {
        if (n_in != 25 || in_sizes[0] != T_ * D_ || out_size != T_ * D_ || ws_size < WS_END) { fprintf(stderr, "kernel_launch: unexpected shapes (n_in %d, in0 %d, out %d, ws %zu < %zu); nothing launched\n", n_in, n_in > 0 ? in_sizes[0] : -1, out_size, ws_size, (size_t)WS_END); grid = -1; return; }
        int dev = 0, cus = 0, per_cu = 0;
        if (hipGetDevice(&dev) != hipSuccess || hipDeviceGetAttribute(&cus, hipDeviceAttributeMultiprocessorCount, dev) != hipSuccess) { fprintf(stderr, "kernel_launch: device query failed\n"); grid = -1; return; }
        if (hipFuncSetAttribute((const void*)mk_fwd, hipFuncAttributeMaxDynamicSharedMemorySize, LDS_BYTES) != hipSuccess) { fprintf(stderr, "kernel_launch: hipFuncSetAttribute failed\n"); grid = -1; return; }
        if (hipOccupancyMaxActiveBlocksPerMultiprocessor(&per_cu, (const void*)mk_fwd, NWAVES * 64, LDS_BYTES) != hipSuccess || per_cu < 1) fprintf(stderr, "kernel_launch: note: occupancy query reports %d workgroups per CU\n", per_cu);
        (void)hipGetLastError();
        grid = cus;
    }
    if (grid < 0) return;
    if (hipMemsetAsync((char*)d_ws + WS_CTL, 0, CTL_ZERO_BYTES, stream) != hipSuccess) { fprintf(stderr, "kernel_launch: memset failed\n"); return; }
    Args a{};
    for (int i = 0; i < 25; ++i) a.in[i] = (const float*)d_in[i];
    a.out = (float*)d_out; a.ws = (unsigned char*)d_ws;
#if MK_MULTI
    for (int p = 0; p < 23; ++p) { a.ph_lo = p; a.ph_hi = p + 1; hipLaunchKernelGGL(mk_fwd, dim3(grid), dim3(NWAVES * 64), LDS_BYTES, stream, a); }
#else
    a.ph_lo = 0; a.ph_hi = 23;
    hipLaunchKernelGGL(mk_fwd, dim3(grid), dim3(NWAVES * 64), LDS_BYTES, stream, a);
#endif
    const hipError_t le = hipPeekAtLastError();
    if (le != hipSuccess) fprintf(stderr, "kernel_launch: launch failed: %s\n", hipGetErrorName(le));
}
```
